# Optimizing an MI355X kernel written in HIP

```python
import jax, jax.numpy as jnp
from jax import lax
import numpy as np

D_MODEL = 1024
BATCH = 8
SEQ = 2048
DEPTH = 1

GRID_W = 64
NA_HEADS = 8
NA_HEAD_DIM = 64
NA_WIN_ROWS_MAX = 8
NA_WIN_COLS = 16
NA_WIDTH = NA_HEADS * NA_HEAD_DIM
MLA_HEADS = 8
MLA_Q_RANK = 256
MLA_KV_RANK = 128
MLA_NOPE_DIM = 64
MLA_ROPE_DIM = 32
MLA_V_DIM = 64
MLA_QK_DIM = MLA_NOPE_DIM + MLA_ROPE_DIM
MLA_WIDTH = MLA_HEADS * MLA_V_DIM
ROPE_THETA = 10000.0
ATTN_BLOCK = 128
IN_SPLITS = (NA_WIDTH, NA_WIDTH, NA_WIDTH, MLA_Q_RANK, MLA_KV_RANK, MLA_ROPE_DIM, D_MODEL, D_MODEL)
IN_COLS = 3 * NA_WIDTH + MLA_Q_RANK + MLA_KV_RANK + MLA_ROPE_DIM + 2 * D_MODEL
N_EXPERTS = 64
TOP_K = 8
N_GROUPS = 8
TOPK_GROUPS = 4
EXPERT_FF = 256
SHARED_FF = 256
ROUTED_SCALE = 2.5
MOE_CHUNK = 128
EPS = 1e-6
NEG_BIG = -1e30

kernel_name = "hybrid_na_mla_moe_encoder_block"


def rms_norm(x, g):
    xf = x.astype(jnp.float32)
    y = xf * lax.rsqrt(jnp.mean(xf * xf, axis=-1, keepdims=True) + EPS)
    return (y * g.astype(jnp.float32)).astype(x.dtype)


def apply_rope(x, positions):
    half = x.shape[-1] // 2
    inv_freq = ROPE_THETA ** (-jnp.arange(half, dtype=jnp.float32) / half)
    ang = positions.astype(jnp.float32)[:, :, None, None] * inv_freq
    cos, sin = jnp.cos(ang), jnp.sin(ang)
    xf = x.astype(jnp.float32)
    x1, x2 = xf[..., :half], xf[..., half:]
    return jnp.concatenate([x1 * cos - x2 * sin, x2 * cos + x1 * sin], axis=-1).astype(x.dtype)


def neighbourhood_attention(q, k, v, rpb):
    B, S, H, Dh = q.shape
    R = S // GRID_W
    kh = min(NA_WIN_ROWS_MAX, R)
    to_grid = lambda t: t.reshape(B, R, GRID_W, H, Dh).transpose(0, 3, 1, 2, 4)
    qg, kg, vg = to_grid(q), to_grid(k), to_grid(v)
    rows = jnp.arange(R)
    row_start = jnp.clip(rows - kh // 2, 0, R - kh)
    key_rows = row_start[:, None] + jnp.arange(kh)[None, :]
    kb = kg[:, :, key_rows]
    vb = vg[:, :, key_rows]
    s = jnp.einsum('bhrqd,bhrjkd->bhrqjk', qg, kb).astype(jnp.float32) * (Dh ** -0.5)
    cols = jnp.arange(GRID_W)
    col_start = jnp.clip(cols - NA_WIN_COLS // 2, 0, GRID_W - NA_WIN_COLS)
    in_win = (cols[None, :] >= col_start[:, None]) & (cols[None, :] < col_start[:, None] + NA_WIN_COLS)
    dr = key_rows - rows[:, None]
    dc = jnp.clip(cols[None, :] - cols[:, None], -(NA_WIN_COLS - 1), NA_WIN_COLS - 1)
    bias = rpb[:, dr[:, None, :, None] + (NA_WIN_ROWS_MAX - 1),
               dc[None, :, None, :] + (NA_WIN_COLS - 1)]
    s = s + bias.astype(jnp.float32)[None]
    s = jnp.where(in_win[:, None, :], s, NEG_BIG)
    p = jax.nn.softmax(s.reshape(B, H, R, GRID_W, kh * GRID_W), axis=-1)
    p = p.reshape(B, H, R, GRID_W, kh, GRID_W).astype(v.dtype)
    o = jnp.einsum('bhrqjk,bhrjkd->bhrqd', p, vb)
    return o.transpose(0, 2, 3, 1, 4).reshape(B, S, H * Dh)


def blocked_full_attention(q, k, v):
    B, S, H, Dqk = q.shape
    Dv = v.shape[-1]
    nb = S // ATTN_BLOCK
    qb = q.reshape(B, nb, ATTN_BLOCK, H, Dqk).transpose(1, 0, 2, 3, 4)
    scale = Dqk ** -0.5

    def one_block(q_blk):
        s = jnp.einsum('bqhd,bkhd->bhqk', q_blk, k).astype(jnp.float32) * scale
        p = jax.nn.softmax(s, axis=-1).astype(v.dtype)
        return jnp.einsum('bhqk,bkhd->bqhd', p, v)

    o = lax.map(one_block, qb)
    return o.transpose(1, 0, 2, 3, 4).reshape(B, S, H * Dv)


def moe_ffn(h, w_router, e_bias, w_eg, w_eu, w_ed, w_sg, w_su, w_sd):
    B, S, D = h.shape
    t = h.reshape(-1, D)
    T = t.shape[0]
    scores = jax.nn.sigmoid((t @ w_router).astype(jnp.float32))
    sel = scores + e_bias.astype(jnp.float32)
    grp = sel.reshape(T, N_GROUPS, N_EXPERTS // N_GROUPS)
    grp_score = jnp.sum(lax.top_k(grp, 2)[0], axis=-1)
    _, gidx = lax.top_k(grp_score, TOPK_GROUPS)
    gmask = jnp.sum(jax.nn.one_hot(gidx, N_GROUPS, dtype=jnp.float32), axis=-2)
    emask = jnp.repeat(gmask, N_EXPERTS // N_GROUPS, axis=-1)
    sel = jnp.where(emask > 0, sel, -jnp.inf)
    _, eidx = lax.top_k(sel, TOP_K)
    w = jnp.take_along_axis(scores, eidx, axis=-1)
    w = w / jnp.sum(w, axis=-1, keepdims=True) * ROUTED_SCALE
    gates = jnp.sum(jax.nn.one_hot(eidx, N_EXPERTS, dtype=jnp.float32) * w[..., None], axis=-2)
    tc = t.reshape(-1, MOE_CHUNK, D)
    gc = gates.reshape(-1, MOE_CHUNK, N_EXPERTS).astype(t.dtype)

    def expert_chunk(args):
        xc, gch = args
        hg = jnp.einsum('cd,edf->cef', xc, w_eg)
        hu = jnp.einsum('cd,edf->cef', xc, w_eu)
        a = jax.nn.silu(hg) * hu * gch[..., None]
        return jnp.einsum('cef,efd->cd', a, w_ed)

    routed = lax.map(expert_chunk, (tc, gc)).reshape(T, D)
    shared = (jax.nn.silu(t @ w_sg) * (t @ w_su)) @ w_sd
    return (routed + shared).reshape(B, S, D)


def setup_inputs(seed: int = 0) -> dict:
    key = jax.random.key(seed)
    ks = iter(jax.random.split(key, 32))
    f32 = jnp.float32
    nrm = lambda shape, s: jax.random.normal(next(ks), shape, f32) * s
    gain = lambda shape: 1.0 + 0.05 * jax.random.normal(next(ks), shape, f32)
    L, D, E, F = DEPTH, D_MODEL, N_EXPERTS, EXPERT_FF
    x = jax.random.normal(next(ks), (BATCH, SEQ, D), f32)
    c = jax.random.normal(next(ks), (BATCH, D), f32)
    positions = jnp.broadcast_to(jnp.arange(SEQ, dtype=jnp.int32)[None, :], (BATCH, SEQ))
    return {
        "x": x,
        "c": c,
        "positions": positions,
        "w_ada": nrm((L, D, 6 * D), 0.3 * D ** -0.5),
        "b_ada": nrm((L, 6 * D), 0.02),
        "g_norm1": gain((L, D)),
        "w_in": nrm((L, D, IN_COLS), D ** -0.5),
        "g_na_q": gain((L, NA_HEAD_DIM)),
        "g_na_k": gain((L, NA_HEAD_DIM)),
        "na_rpb": nrm((L, NA_HEADS, 2 * NA_WIN_ROWS_MAX - 1, 2 * NA_WIN_COLS - 1), 0.1),
        "g_q_lat": gain((L, MLA_Q_RANK)),
        "w_uq": nrm((L, MLA_Q_RANK, MLA_HEADS * MLA_QK_DIM), MLA_Q_RANK ** -0.5),
        "g_kv_lat": gain((L, MLA_KV_RANK)),
        "w_ukv": nrm((L, MLA_KV_RANK, MLA_HEADS * (MLA_NOPE_DIM + MLA_V_DIM)), MLA_KV_RANK ** -0.5),
        "g_mla_q": gain((L, MLA_QK_DIM)),
        "g_mla_k": gain((L, MLA_QK_DIM)),
        "w_proj_na": nrm((L, NA_WIDTH, D), NA_WIDTH ** -0.5),
        "w_proj_mla": nrm((L, MLA_WIDTH, D), MLA_WIDTH ** -0.5),
        "w_out": nrm((L, D, D), D ** -0.5),
        "g_norm2": gain((L, D)),
        "w_router": nrm((L, D, E), D ** -0.5),
        "e_bias": nrm((L, E), 0.01),
        "w_exp_gate": nrm((L, E, D, F), D ** -0.5),
        "w_exp_up": nrm((L, E, D, F), D ** -0.5),
        "w_exp_down": nrm((L, E, F, D), F ** -0.5),
        "w_sh_gate": nrm((L, D, SHARED_FF), D ** -0.5),
        "w_sh_up": nrm((L, D, SHARED_FF), D ** -0.5),
        "w_sh_down": nrm((L, SHARED_FF, D), SHARED_FF ** -0.5),
    }


def reference(x, c, positions, w_ada, b_ada, g_norm1, w_in, g_na_q, g_na_k, na_rpb,
              g_q_lat, w_uq, g_kv_lat, w_ukv, g_mla_q, g_mla_k, w_proj_na, w_proj_mla,
              w_out, g_norm2, w_router, e_bias, w_exp_gate, w_exp_up, w_exp_down,
              w_sh_gate, w_sh_up, w_sh_down):
    B, S, D = x.shape
    split_at = list(np.cumsum(IN_SPLITS)[:-1])
    for l in range(DEPTH):
        mod = jax.nn.silu(c) @ w_ada[l] + b_ada[l]
        shift1, scale1, gate1, shift2, scale2, gate2 = jnp.split(mod[:, None, :], 6, axis=-1)

        h = rms_norm(x, g_norm1[l]) * (1.0 + scale1) + shift1
        proj = h @ w_in[l]
        na_q, na_k, na_v, q_lat, kv_lat, k_rot, gate_na, gate_mla = jnp.split(proj, split_at, axis=-1)

        qa = rms_norm(na_q.reshape(B, S, NA_HEADS, NA_HEAD_DIM), g_na_q[l])
        ka = rms_norm(na_k.reshape(B, S, NA_HEADS, NA_HEAD_DIM), g_na_k[l])
        va = na_v.reshape(B, S, NA_HEADS, NA_HEAD_DIM)
        y_na = neighbourhood_attention(qa, ka, va, na_rpb[l])

        qm = (rms_norm(q_lat, g_q_lat[l]) @ w_uq[l]).reshape(B, S, MLA_HEADS, MLA_QK_DIM)
        q_nope, q_rope = qm[..., :MLA_NOPE_DIM], apply_rope(qm[..., MLA_NOPE_DIM:], positions)
        kvm = (rms_norm(kv_lat, g_kv_lat[l]) @ w_ukv[l]).reshape(B, S, MLA_HEADS, MLA_NOPE_DIM + MLA_V_DIM)
        k_nope, vm = kvm[..., :MLA_NOPE_DIM], kvm[..., MLA_NOPE_DIM:]
        k_rope = jnp.broadcast_to(apply_rope(k_rot[:, :, None, :], positions), (B, S, MLA_HEADS, MLA_ROPE_DIM))
        qm = rms_norm(jnp.concatenate([q_nope, q_rope], axis=-1), g_mla_q[l])
        km = rms_norm(jnp.concatenate([k_nope, k_rope], axis=-1), g_mla_k[l])
        y_mla = blocked_full_attention(qm, km, vm)

        merged = (jax.nn.sigmoid(gate_na) * (y_na @ w_proj_na[l])
                  + jax.nn.sigmoid(gate_mla) * (y_mla @ w_proj_mla[l]))
        x = x + gate1 * (merged @ w_out[l])

        h2 = rms_norm(x, g_norm2[l]) * (1.0 + scale2) + shift2
        y_ffn = moe_ffn(h2, w_router[l], e_bias[l], w_exp_gate[l], w_exp_up[l], w_exp_down[l],
                        w_sh_gate[l], w_sh_up[l], w_sh_down[l])
        x = x + gate2 * y_ffn
    return x
```

```cpp
#include <hip/hip_runtime.h>
#include <cstdio>
#include <cstdint>
#include <cmath>

#define GAS __attribute__((address_space(1)))
#define LAS __attribute__((address_space(3)))
typedef unsigned short bf16_t;
typedef short bf16x8 __attribute__((ext_vector_type(8)));
typedef short s16x4 __attribute__((ext_vector_type(4)));
typedef float f32x4 __attribute__((ext_vector_type(4)));
typedef float f32x2 __attribute__((ext_vector_type(2)));
typedef float f32x16 __attribute__((ext_vector_type(16)));
typedef unsigned u32x4 __attribute__((ext_vector_type(4)));
typedef unsigned u32x2 __attribute__((ext_vector_type(2)));
typedef GAS unsigned gu32;

constexpr int DM = 1024, NB = 8, SEQ = 2048, NT = NB * SEQ;
constexpr int NAH = 8, NAD = 64, GRIDW = 64, GRIDR = SEQ / GRIDW;
constexpr int MH = 8, QRANK = 256, KVRANK = 128, NOPE = 64, ROPE = 32, VD = 64, QKD = 96;
constexpr int NEXP = 64, TOPK = 8, NGRP = 8, TOPKG = 4, EFF = 256;
constexpr float EPS = 1e-6f;
constexpr int INCOLS = 4000, INPAD = 4096;
constexpr int NCHUNK = 2, CHTOK = NT / NCHUNK;
constexpr int NWAVES = 8, NTHR = 512;

constexpr size_t MiB = 1u << 20;
constexpr size_t WS_CTL = 0, CTL_ZERO_BYTES = 1 * MiB;
constexpr size_t WS_MOD   = 1 * MiB;
constexpr size_t WS_RCOS  = WS_MOD + 256 * 1024;
constexpr size_t WS_RSIN  = WS_RCOS + 1 * MiB;
constexpr size_t WS_RFRAG = WS_RSIN + 1 * MiB;
constexpr size_t WS_QSQ   = WS_RFRAG + 256 * 1024;
constexpr size_t WS_KVSQ  = WS_QSQ + 256 * 1024;
constexpr size_t WS_QSS   = WS_KVSQ + 256 * 1024;
constexpr size_t WS_TOKSLOT = WS_QSS + 1 * MiB;
constexpr size_t WS_LIST  = 6 * MiB;
constexpr size_t WS_WLIST = 10 * MiB;
constexpr size_t WS_WIN   = 14 * MiB;
constexpr size_t WS_WUQ   = 22 * MiB;
constexpr size_t WS_WUKV  = WS_WUQ + 512 * 1024;
constexpr size_t WS_WPNA  = 23 * MiB;
constexpr size_t WS_WPMLA = 24 * MiB;
constexpr size_t WS_WOUT  = 25 * MiB;
constexpr size_t WS_KROT  = 27 * MiB;
constexpr size_t WS_B     = 30 * MiB;
constexpr size_t WS_H     = WS_B + 0 * MiB;
constexpr size_t WS_QM    = WS_B + 0 * MiB;
constexpr size_t WS_NAQ   = WS_B + 32 * MiB;
constexpr size_t WS_NAK   = WS_B + 48 * MiB;
constexpr size_t WS_NAV   = WS_B + 64 * MiB;
constexpr size_t WS_QLAT  = WS_B + 80 * MiB;
constexpr size_t WS_KVLAT = WS_B + 88 * MiB;
constexpr size_t WS_SGNA  = WS_B + 96 * MiB;
constexpr size_t WS_SGMLA = WS_B + 128 * MiB;
constexpr size_t WS_KM    = WS_B + 160 * MiB;
constexpr size_t WS_VM    = WS_B + 185 * MiB;
constexpr size_t WS_YNA   = WS_B + 201 * MiB;
constexpr size_t WS_YMLA  = WS_B + 217 * MiB;
constexpr size_t WS_TMP   = WS_B + 32 * MiB;
constexpr size_t WS_MERGED= WS_B + 64 * MiB;
constexpr size_t WS_WD    = WS_B + 0 * MiB;
constexpr size_t WS_ACT   = WS_B + 33 * MiB;
constexpr size_t WS_WGU   = WS_B + 109 * MiB;
constexpr size_t WS_H2    = WS_B + 174 * MiB;
constexpr size_t WS_YS    = WS_B + 109 * MiB;
constexpr size_t WS_END   = WS_B + 262 * MiB;
constexpr int ACT_SHARED_ROW0 = NT * TOPK;
constexpr int YS_SHARED_ROW0 = CHTOK * TOPK;
constexpr int CW_BAR = 4096;
constexpr int CW_CNT = 16384;

constexpr int RING_BYTES = 131072;
constexpr int LDSCTL_OFF = RING_BYTES, MISC_OFF = LDSCTL_OFF + 320;
constexpr int TAB_OFF = RING_BYTES + 1024;
constexpr int LDS_BYTES = 147456;

#define LDS_WAIT() asm volatile("s_waitcnt lgkmcnt(0)" ::: "memory")
#define VM_WAIT() asm volatile("s_waitcnt vmcnt(0)" ::: "memory")
#define SBAR() __builtin_amdgcn_sched_barrier(0)
#define RLX_AGENT __ATOMIC_RELAXED, __HIP_MEMORY_SCOPE_AGENT

__device__ __forceinline__ unsigned f2bf(float f) { unsigned u = __builtin_bit_cast(unsigned, f); return (u + 0x7fffu + ((u >> 16) & 1u)) >> 16; }
__device__ __forceinline__ unsigned pk2(float lo, float hi) { return f2bf(lo) | (f2bf(hi) << 16); }
__device__ __forceinline__ unsigned cvt_pk_bf16(float lo, float hi) { unsigned r; asm volatile("v_cvt_pk_bf16_f32 %0, %1, %2" : "=v"(r) : "v"(lo), "v"(hi)); return r; }
__device__ __forceinline__ float bf2f(unsigned short b) { return __builtin_bit_cast(float, (unsigned)b << 16); }
__device__ __forceinline__ float bflo(unsigned w) { return __builtin_bit_cast(float, w << 16); }
__device__ __forceinline__ float bfhi(unsigned w) { return __builtin_bit_cast(float, w & 0xffff0000u); }
__device__ __forceinline__ float wave_sum(float v) {
#pragma unroll
    for (int o = 1; o < 64; o <<= 1) v += __shfl_xor(v, o);
    return v;
}
__device__ __forceinline__ float sigmoidf_fast(float v) { return __builtin_amdgcn_rcpf(1.0f + __expf(-v)); }
__device__ __forceinline__ float siluf_fast(float v) { return v * sigmoidf_fast(v); }
__device__ __forceinline__ float sq4(f32x4 a) { return (a[0] * a[0] + a[1] * a[1]) + (a[2] * a[2] + a[3] * a[3]); }

struct Args { const void* in[28]; float* out; unsigned char* ws; };
enum { I_x = 0, I_c = 1, I_positions = 2, I_w_ada = 3, I_b_ada = 4, I_g_norm1 = 5, I_w_in = 6, I_g_na_q = 7, I_g_na_k = 8, I_na_rpb = 9, I_g_q_lat = 10, I_w_uq = 11, I_g_kv_lat = 12, I_w_ukv = 13, I_g_mla_q = 14, I_g_mla_k = 15, I_w_proj_na = 16, I_w_proj_mla = 17, I_w_out = 18, I_g_norm2 = 19, I_w_router = 20, I_e_bias = 21, I_w_eg = 22, I_w_eu = 23, I_w_ed = 24, I_w_sg = 25, I_w_su = 26, I_w_sd = 27 };
#define INF(k) ((const float*)A.in[k])
namespace pg8 {
constexpr int BM = 256, BK = 64, HALF = 128, HTB = HALF * BK * 2, STAGE_BYTES = 8 * HTB, NXCD = 8, WGM = 8;
__host__ __device__ __forceinline__ int lds_byte(int r, int c) { const int st = (r >> 4) * 2 + (c >> 5), rr = r & 15, cc = c & 31, ob = rr * 64 + cc * 2; return st * 1024 + (ob ^ (((ob >> 9) & 1) << 5)); }
__host__ __device__ __forceinline__ void stage_rc(int b, int& R, int& C) { const int st = b / 1024, sb = b % 1024, swz = sb ^ (((sb >> 9) & 1) << 5); R = (st >> 1) * 16 + swz / 64; C = (st & 1) * 32 + (swz % 64) / 2; }
__host__ __device__ __forceinline__ int perm32(int rho) { const int n = rho >> 4, i = rho & 15; return 8 * (i >> 2) + 4 * n + (i & 3); }

struct Unit {
    const char* B;
    int m0;
    int pn;
    int e;
    int nrows;
    int orow0;
    const int* l0; const int* l1; int n0, ntot;
};
struct Gemm { const bf16_t* A; int lda; int K; };

template <class Epi, class Sched, bool GATHER>
__device__ __forceinline__ void gemm_phase(LAS unsigned char* lds, const Gemm g, Sched& S, const Epi& E) {
    int tid_ = threadIdx.x; asm volatile("" : "+v"(tid_));
    const int tid = tid_, wid = __builtin_amdgcn_readfirstlane(tid >> 6), lane = tid & 63, wr = wid >> 2, wc = wid & 3, fr = lane & 15, fq = lane >> 4;
    const int K = g.K, nt = K / BK;
    unsigned voffB[2], voffA[2];
#pragma unroll
    for (int i = 0; i < 2; ++i) { int R, C; stage_rc(tid * 16 + i * 8192, R, C); const int Rb = Epi::PERM ? ((R & ~31) + perm32(R & 31)) : R;
        voffA[i] = (unsigned)(R * g.lda + C) * 2u; voffB[i] = (unsigned)(Rb * K + C) * 2u; }
    const size_t hstepA = (size_t)HALF * g.lda * 2;
    const size_t kstep = (size_t)(BK * 2);
    const size_t hstepB = (size_t)HALF * K * 2;
    const unsigned ldsw = (unsigned)wid * 1024u;
    const int aoff = lds_byte(wr * 64 + fr, fq * 8), boff = lds_byte(wc * 32 + fr, fq * 8);
    const char* Abase = (const char*)g.A;
#define PG8_SA(b, h) (((b) * 2 + (h)) * HTB)
#define PG8_SB(b, h) ((4 + (b) * 2 + (h)) * HTB)
#define PG8_STAGE(bufoff, gbase, voff) do { _Pragma("unroll") for (int _i = 0; _i < 2; ++_i) \
        __builtin_amdgcn_global_load_lds((const unsigned*)((const char*)(gbase) + (voff)[_i]), (LAS unsigned*)(lds + (bufoff) + ldsw + _i * 8192), 16, 0, 0); } while (0)
#define PG8_LDA(dst, b, h) do { _Pragma("unroll") for (int m = 0; m < 4; ++m) _Pragma("unroll") for (int k = 0; k < 2; ++k) dst[m][k] = *(const LAS bf16x8*)(lds + PG8_SA(b, h) + aoff + m * 2048 + k * 1024); } while (0)
#define PG8_LDB(dst, b, h) do { _Pragma("unroll") for (int n = 0; n < 2; ++n) _Pragma("unroll") for (int k = 0; k < 2; ++k) dst[n][k] = *(const LAS bf16x8*)(lds + PG8_SB(b, h) + boff + n * 2048 + k * 1024); } while (0)
#define PG8_MMA(ai, bj, At, Bt) do { __builtin_amdgcn_s_setprio(1); _Pragma("unroll") for (int m = 0; m < 4; ++m) _Pragma("unroll") for (int n = 0; n < 2; ++n) _Pragma("unroll") for (int k = 0; k < 2; ++k) \
        acc[ai][bj][m][n] = __builtin_amdgcn_mfma_f32_16x16x32_bf16(Bt[n][k], At[m][k], acc[ai][bj][m][n], 0, 0, 0); __builtin_amdgcn_s_setprio(0); } while (0)
#define PG8_WAIT_V(n) asm volatile("s_waitcnt vmcnt(" #n ")" ::: "memory")
#define PG8_WAIT_L(n) asm volatile("s_waitcnt lgkmcnt(" #n ")" ::: "memory")
#define PG8_BAR __builtin_amdgcn_s_barrier()
#define PG8_SCHED __builtin_amdgcn_sched_barrier(0)
#define PG8_VOFF(dst, u) do { _Pragma("unroll") for (int _h = 0; _h < 2; ++_h) _Pragma("unroll") for (int _i = 0; _i < 2; ++_i) { \
        int _R, _C; stage_rc(tid * 16 + _i * 8192, _R, _C); int _r = (u).m0 + _h * HALF + _R; \
        if ((u).l0) { _r = _r < (u).ntot ? _r : (u).ntot - 1; _r = _r < (u).n0 ? (u).l0[_r] : (u).l1[_r - (u).n0]; } \
        dst[_h][_i] = (unsigned)(_r * g.lda + _C) * 2u; } } while (0)
#define PG8_STA(bufoff, sel_next, h, kt) do { if constexpr (GATHER) { PG8_STAGE(bufoff, Abase + (size_t)(kt) * kstep, ((sel_next) ? nvo[h] : cvo[h])); } \
        else { PG8_STAGE(bufoff, ((sel_next) ? nA : cA) + (h) * hstepA + (size_t)(kt) * kstep, voffA); } } while (0)
    Unit cur, nxt; int ui = 0;
    if (!S.next(0, cur)) return;
    f32x4 acc[2][2][4][2];
#pragma unroll
    for (int a = 0; a < 2; ++a)
#pragma unroll
        for (int b = 0; b < 2; ++b)
#pragma unroll
            for (int m = 0; m < 4; ++m)
#pragma unroll
                for (int n = 0; n < 2; ++n) acc[a][b][m][n] = (f32x4){0.f, 0.f, 0.f, 0.f};
    bf16x8 At[4][2], B0[2][2], B1[2][2];
    unsigned cvo[2][2], nvo[2][2];
    const char* cA = Abase; const char* nA = Abase;
    if constexpr (GATHER) { PG8_VOFF(cvo, cur); } else { cA = Abase + (size_t)cur.m0 * g.lda * 2; }
    const char* cB = cur.B;
    PG8_STAGE(PG8_SB(0, 0), cB, voffB); PG8_STAGE(PG8_SB(0, 1), cB + hstepB, voffB); PG8_STA(PG8_SA(0, 0), false, 0, 0); PG8_STA(PG8_SA(0, 1), false, 1, 0);
    if (wr == 1) PG8_BAR;
    PG8_WAIT_V(2); PG8_BAR;
    PG8_STAGE(PG8_SB(1, 0), cB + kstep, voffB); PG8_STA(PG8_SA(1, 0), false, 0, 1); PG8_STAGE(PG8_SB(1, 1), cB + hstepB + kstep, voffB);
    PG8_WAIT_V(6); PG8_BAR;
    for (;;) {
        const bool has_next = S.next(ui + 1, nxt);
        if constexpr (GATHER) {
            if (has_next) { PG8_VOFF(nvo, nxt); }
            else {
#pragma unroll
                for (int h = 0; h < 2; ++h)
#pragma unroll
                    for (int i = 0; i < 2; ++i) nvo[h][i] = cvo[h][i];
            }
        } else { nA = has_next ? Abase + (size_t)nxt.m0 * g.lda * 2 : cA; }
        const char* nB = has_next ? nxt.B : cB;
        for (int t = 0; t < nt; t += 2) {
            const bool last = (t == nt - 2);
            const int kt2 = last ? 0 : t + 2;
            const char* b2 = last ? nB : cB + (size_t)(t + 2) * kstep; const char* b3 = b2 + kstep;
            PG8_LDB(B0, 0, 0); PG8_LDB(B1, 0, 1); PG8_SCHED; PG8_LDA(At, 0, 0); PG8_STA(PG8_SA(1, 1), false, 1, t + 1);
            PG8_WAIT_V(8); PG8_WAIT_L(0); PG8_BAR; PG8_MMA(0, 0, At, B0); PG8_MMA(0, 1, At, B1); PG8_BAR; PG8_SCHED;
            PG8_LDA(At, 0, 1); PG8_STAGE(PG8_SB(0, 0), b2, voffB); PG8_STAGE(PG8_SB(0, 1), b2 + hstepB, voffB); PG8_STA(PG8_SA(0, 0), last, 0, kt2);
            PG8_WAIT_V(8); PG8_WAIT_L(0); PG8_BAR; PG8_MMA(1, 0, At, B0); PG8_MMA(1, 1, At, B1); PG8_BAR; PG8_SCHED;
            PG8_LDB(B0, 1, 0); PG8_LDB(B1, 1, 1); PG8_SCHED; PG8_LDA(At, 1, 0); PG8_STA(PG8_SA(0, 1), last, 1, kt2);
            PG8_WAIT_V(8); PG8_WAIT_L(0); PG8_BAR; PG8_MMA(0, 0, At, B0); PG8_MMA(0, 1, At, B1); PG8_BAR; PG8_SCHED;
            PG8_LDA(At, 1, 1); PG8_STAGE(PG8_SB(1, 0), b3, voffB); PG8_STAGE(PG8_SB(1, 1), b3 + hstepB, voffB); PG8_STA(PG8_SA(1, 0), last, 0, kt2 + 1);
            PG8_WAIT_V(8); PG8_WAIT_L(0); PG8_BAR; PG8_MMA(1, 0, At, B0); PG8_MMA(1, 1, At, B1); PG8_BAR; PG8_SCHED;
        }
        if (wr == 0) PG8_BAR;
        { int t2 = threadIdx.x; asm volatile("" : "+v"(t2)); const int l2 = t2 & 63; E(acc, cur, wr, wc, l2 & 15, l2 >> 4); }
        if (!has_next) break;
#pragma unroll
        for (int a = 0; a < 2; ++a)
#pragma unroll
            for (int b = 0; b < 2; ++b)
#pragma unroll
                for (int m = 0; m < 4; ++m)
#pragma unroll
                    for (int n = 0; n < 2; ++n) acc[a][b][m][n] = (f32x4){0.f, 0.f, 0.f, 0.f};
        cur = nxt; cB = nB; cA = nA; ++ui;
        if constexpr (GATHER) {
#pragma unroll
            for (int h = 0; h < 2; ++h)
#pragma unroll
                for (int i = 0; i < 2; ++i) cvo[h][i] = nvo[h][i];
        }
        if (wr == 1) PG8_BAR;
    }
    PG8_WAIT_V(0);
    PG8_BAR;
#undef PG8_SA
#undef PG8_SB
#undef PG8_STAGE
#undef PG8_LDA
#undef PG8_LDB
#undef PG8_MMA
#undef PG8_WAIT_V
#undef PG8_WAIT_L
#undef PG8_BAR
#undef PG8_SCHED
#undef PG8_VOFF
#undef PG8_STA
}

struct DenseSched {
    int nM, nN, nwg, G, c; const bf16_t* Bt; int K;
    __device__ void init(int M, int N, int K_, const bf16_t* Bt_, int G_, int c_) { nM = M / BM; nN = N / BM; nwg = nM * nN; G = G_; c = c_; Bt = Bt_; K = K_; }
    __device__ bool next(int i, Unit& u) const {
        const long L = (long)i * G + c; if (L >= nwg) return false;
        int wgid = (int)L; { const int q = nwg / NXCD, r = nwg % NXCD, xcd = wgid % NXCD, off = wgid / NXCD; wgid = (xcd < r ? xcd * (q + 1) : r * (q + 1) + (xcd - r) * q) + off; }
        const int nig = WGM * nN, gid = wgid / nig, fm = gid * WGM, gsz = (nM - fm) < WGM ? (nM - fm) : WGM;
        const int pm = fm + ((wgid % nig) % gsz), pn = (wgid % nig) / gsz;
        u.B = (const char*)Bt + (size_t)pn * BM * K * 2; u.m0 = pm * BM; u.pn = pn; u.e = pm; u.nrows = BM; u.orow0 = pm * BM; u.l0 = nullptr; u.l1 = nullptr; u.n0 = 0; u.ntot = 0;
        return true;
    }
};
}
#define XB_TMO      128
#define XB_XCNT(j)  (256  + 64 * (j))
#define XB_XSUB(j)  (1280 + 64 * (j))
#define XB_XGEN(j)  (2304 + 64 * (j))
#define XB_TOP      3328
#define XB_TOPGEN   3392
#define XCD_BAR_WORDS 3456
#define XB_SPIN_CAP (1u << 18)

__device__ __forceinline__ unsigned xb_ld(unsigned* p)              { return __hip_atomic_load(p, __ATOMIC_RELAXED, __HIP_MEMORY_SCOPE_AGENT); }
__device__ __forceinline__ unsigned xb_add(unsigned* p, unsigned v) { return __hip_atomic_fetch_add(p, v, __ATOMIC_RELAXED, __HIP_MEMORY_SCOPE_AGENT); }
__device__ __forceinline__ unsigned xb_xcc_id() { return (unsigned)__builtin_amdgcn_s_getreg((3 << 11) | 20) & 0xFu; }
#define XB_SPIN(cond, bar) do { unsigned _sp = 0; while (cond) { __builtin_amdgcn_s_sleep(1); \
    if ((++_sp & 255u) == 0u) { if (xb_ld(&(bar)[XB_TMO])) break; if (_sp > XB_SPIN_CAP) { atomicAdd(&(bar)[XB_TMO], 1u); break; } } } } while (0)

struct XcdBarrier { unsigned* bar; unsigned x; volatile LAS unsigned* st; };

__device__ __forceinline__ XcdBarrier xcd_barrier_post(unsigned* bar, volatile LAS unsigned* st) {
    XcdBarrier b; b.bar = bar; b.x = xb_xcc_id(); b.st = st;
    if (threadIdx.x == 0) (void)xb_add(&bar[XB_XCNT(b.x)], 1u);
    return b;
}
__device__ __forceinline__ void xcd_barrier_complete(unsigned* bar, unsigned x, unsigned& nloc, unsigned& nx) {
    const unsigned G = gridDim.x * gridDim.y * gridDim.z;
    unsigned sum, cnt, mine, sp = 0u;
    for (;;) {
        sum = 0u; cnt = 0u; mine = 0u;
#pragma unroll
        for (unsigned j = 0; j < 16; ++j) { const unsigned c = xb_ld(&bar[XB_XCNT(j)]); sum += c; cnt += (c > 0u) ? 1u : 0u; mine = (j == x) ? c : mine; }
        if (sum == G) break;
        __builtin_amdgcn_s_sleep(1);
        if ((++sp & 255u) == 0u) { if (xb_ld(&bar[XB_TMO])) break; if (sp > XB_SPIN_CAP) { atomicAdd(&bar[XB_TMO], 1u); break; } }
    }
    nloc = mine > 0u ? mine : 1u; nx = cnt > 0u ? cnt : 1u;
}
__device__ __forceinline__ void xcd_barrier(const XcdBarrier& b) {
    asm volatile("s_waitcnt vmcnt(0)" ::: "memory");
    __syncthreads();
    int tid_ = threadIdx.x; asm volatile("" : "+v"(tid_));
    if (tid_ == 0) {
        unsigned* bar = b.bar; asm volatile("" : "+s"(bar)); unsigned bx_ = b.x; asm volatile("" : "+s"(bx_));
        __builtin_amdgcn_s_waitcnt(0);
        unsigned nloc = b.st[0], nx = b.st[1];
        if (nloc == 0u) { xcd_barrier_complete(bar, bx_, nloc, nx); b.st[0] = nloc; b.st[1] = nx; }
        const unsigned old = xb_add(&bar[XB_XSUB(bx_)], 1u);
        const unsigned gen = old / nloc;
        if (old + 1u == (gen + 1u) * nloc) {
            __builtin_amdgcn_fence(__ATOMIC_RELEASE, "agent");
            asm volatile("s_waitcnt vmcnt(0)" ::: "memory");
            const unsigned og = xb_add(&bar[XB_TOP], 1u);
            const unsigned tg = og / nx;
            if (og + 1u == (tg + 1u) * nx) xb_add(&bar[XB_TOPGEN], 1u);
            else XB_SPIN(xb_ld(&bar[XB_TOPGEN]) == tg, bar);
            __builtin_amdgcn_fence(__ATOMIC_ACQUIRE, "agent");
            xb_add(&bar[XB_XGEN(bx_)], 1u);
            asm volatile("s_waitcnt vmcnt(0)" ::: "memory");
        } else {
            XB_SPIN(xb_ld(&bar[XB_XGEN(bx_)]) == gen, bar);
            __builtin_amdgcn_fence(__ATOMIC_ACQUIRE, "agent");
            asm volatile("s_waitcnt vmcnt(0)" ::: "memory");
        }
    }
    __syncthreads();
}
namespace epi {
using pg8::Unit;
__device__ __forceinline__ u32x4 pack8(f32x4 a, f32x4 b) { u32x4 w; w.x = cvt_pk_bf16(a[0], a[1]); w.y = cvt_pk_bf16(a[2], a[3]); w.z = cvt_pk_bf16(b[0], b[1]); w.w = cvt_pk_bf16(b[2], b[3]); return w; }

__device__ __forceinline__ float red_fq(float s) { s += __shfl_xor(s, 16); s += __shfl_xor(s, 32); return s; }
__device__ __forceinline__ void unpack8(u32x4 w, f32x4& a, f32x4& b) { a = (f32x4){bflo(w.x), bfhi(w.x), bflo(w.y), bfhi(w.y)}; b = (f32x4){bflo(w.z), bfhi(w.z), bflo(w.w), bfhi(w.w)}; }
__device__ __forceinline__ void rope32(f32x4 (&v)[2], const float* cs, const float* sn, int fq) {
#pragma unroll
    for (int n = 0; n < 2; ++n) {
        const f32x4 c4 = *(const f32x4*)(cs + 8 * (fq & 1) + 4 * n), s4 = *(const f32x4*)(sn + 8 * (fq & 1) + 4 * n);
        f32x4 p; p[0] = __shfl_xor(v[n][0], 32); p[1] = __shfl_xor(v[n][1], 32); p[2] = __shfl_xor(v[n][2], 32); p[3] = __shfl_xor(v[n][3], 32);
        v[n] = (fq < 2) ? (v[n] * c4 - p * s4) : (v[n] * c4 + p * s4);
    }
}

struct EpiInProj {
    static constexpr bool PERM = true;
    bf16_t *naq, *nak, *nav, *qlat, *kvlat, *sgna, *sgmla; float *krot, *qsq, *kvsq; const float *gq, *gk, *rcos, *rsin;
    __device__ __forceinline__ void operator()(const f32x4 (&acc)[2][2][4][2], const Unit& u, int wr, int wc, int fr, int fq) const {
        const int pn = u.pn, row0 = u.orow0 + wr * 64 + fr;
        if (pn < 4) {
            bf16_t* dst = pn < 2 ? naq : nak; const float* g = pn < 2 ? gq : gk; const int head = (pn & 1) * 4 + wc;
            f32x4 gv[2][2];
#pragma unroll
            for (int bj = 0; bj < 2; ++bj)
#pragma unroll
                for (int n = 0; n < 2; ++n) gv[bj][n] = *(const f32x4*)(g + 32 * bj + 8 * fq + 4 * n);
#pragma unroll
            for (int ai = 0; ai < 2; ++ai)
#pragma unroll
                for (int m = 0; m < 4; ++m) {
                    float ss = (sq4(acc[ai][0][m][0]) + sq4(acc[ai][0][m][1])) + (sq4(acc[ai][1][m][0]) + sq4(acc[ai][1][m][1]));
                    ss = red_fq(ss); const float rstd = rsqrtf(ss * (1.0f / 64.0f) + EPS);
                    bf16_t* rp = dst + (size_t)(row0 + ai * 128 + m * 16) * 512 + head * 64 + 8 * fq;
#pragma unroll
                    for (int bj = 0; bj < 2; ++bj) *(u32x4*)(rp + 32 * bj) = pack8(acc[ai][bj][m][0] * rstd * gv[bj][0], acc[ai][bj][m][1] * rstd * gv[bj][1]);
                }
        } else if (pn < 6) {
#pragma unroll
            for (int ai = 0; ai < 2; ++ai)
#pragma unroll
                for (int m = 0; m < 4; ++m) { bf16_t* rp = nav + (size_t)(row0 + ai * 128 + m * 16) * 512 + (pn - 4) * 256 + wc * 32 + 8 * fq;
#pragma unroll
                    for (int bj = 0; bj < 2; ++bj) *(u32x4*)(rp + 128 * bj) = pack8(acc[ai][bj][m][0], acc[ai][bj][m][1]); }
        } else if (pn == 6) {
#pragma unroll
            for (int ai = 0; ai < 2; ++ai)
#pragma unroll
                for (int m = 0; m < 4; ++m) { const int row = row0 + ai * 128 + m * 16; bf16_t* rp = qlat + (size_t)row * 256 + wc * 32 + 8 * fq;
                    float ss = (sq4(acc[ai][0][m][0]) + sq4(acc[ai][0][m][1])) + (sq4(acc[ai][1][m][0]) + sq4(acc[ai][1][m][1]));
                    ss = red_fq(ss); if (fq == 0) qsq[(size_t)row * 4 + wc] = ss;
#pragma unroll
                    for (int bj = 0; bj < 2; ++bj) *(u32x4*)(rp + 128 * bj) = pack8(acc[ai][bj][m][0], acc[ai][bj][m][1]); }
        } else if (pn == 7) {
#pragma unroll
            for (int ai = 0; ai < 2; ++ai)
#pragma unroll
                for (int m = 0; m < 4; ++m) { const int row = row0 + ai * 128 + m * 16;
                    float ss = sq4(acc[ai][0][m][0]) + sq4(acc[ai][0][m][1]);
                    ss = red_fq(ss); if (fq == 0) kvsq[(size_t)row * 4 + wc] = ss;
                    *(u32x4*)(kvlat + (size_t)row * 128 + wc * 32 + 8 * fq) = pack8(acc[ai][0][m][0], acc[ai][0][m][1]);
                    if (wc == 0) { f32x4 v[2] = {acc[ai][1][m][0], acc[ai][1][m][1]};
                        rope32(v, rcos + (size_t)row * 16, rsin + (size_t)row * 16, fq);
                        *(f32x4*)(krot + (size_t)row * 32 + 8 * fq) = v[0]; *(f32x4*)(krot + (size_t)row * 32 + 8 * fq + 4) = v[1]; } }
        } else {
            bf16_t* dst = pn < 12 ? sgna : sgmla; const int cb = ((pn - 8) & 3) * 256 + wc * 32 + 8 * fq;
#pragma unroll
            for (int ai = 0; ai < 2; ++ai)
#pragma unroll
                for (int m = 0; m < 4; ++m) { bf16_t* rp = dst + (size_t)(row0 + ai * 128 + m * 16) * 1024 + cb;
#pragma unroll
                    for (int bj = 0; bj < 2; ++bj) { f32x4 a = acc[ai][bj][m][0], b = acc[ai][bj][m][1];
#pragma unroll
                        for (int e = 0; e < 4; ++e) { a[e] = sigmoidf_fast(a[e]); b[e] = sigmoidf_fast(b[e]); }
                        *(u32x4*)(rp + 128 * bj) = pack8(a, b); } }
        }
    }
};

struct EpiUpQ {
    static constexpr bool PERM = true;
    bf16_t* qm; float* qss; const float* qsq; const float* g; const float *rcos, *rsin;
    __device__ __forceinline__ void operator()(const f32x4 (&acc)[2][2][4][2], const Unit& u, int wr, int wc, int fr, int fq) const {
        const int pn = u.pn, row0 = u.orow0 + wr * 64 + fr;
#pragma unroll
        for (int ai = 0; ai < 2; ++ai)
#pragma unroll
            for (int m = 0; m < 4; ++m) {
                const int row = row0 + ai * 128 + m * 16, b = row >> 11, s = row & 2047;
                const f32x4 sq = *(const f32x4*)(qsq + (size_t)row * 4);
                const float rstd = rsqrtf(((sq[0] + sq[1]) + (sq[2] + sq[3])) * (1.0f / 256.0f) + EPS);
                if (pn < 2) {
                    const int head = pn * 4 + wc;
                    f32x4 v[2][2]; float ss = 0.f;
#pragma unroll
                    for (int bj = 0; bj < 2; ++bj)
#pragma unroll
                        for (int n = 0; n < 2; ++n) { v[bj][n] = acc[ai][bj][m][n] * rstd; ss += sq4(v[bj][n]); }
                    ss = red_fq(ss); if (fq == 0) qss[((size_t)row * 8 + head) * 2 + 0] = ss;
                    bf16_t* rp = qm + ((size_t)(b * 8 + head) * 2048 + s) * 96 + 8 * fq;
#pragma unroll
                    for (int bj = 0; bj < 2; ++bj) *(u32x4*)(rp + 32 * bj) = pack8(v[bj][0] * *(const f32x4*)(g + 32 * bj + 8 * fq), v[bj][1] * *(const f32x4*)(g + 32 * bj + 8 * fq + 4));
                } else {
#pragma unroll
                    for (int bj = 0; bj < 2; ++bj) { const int head = 2 * wc + bj;
                        f32x4 v[2] = {acc[ai][bj][m][0] * rstd, acc[ai][bj][m][1] * rstd};
                        float ss = sq4(v[0]) + sq4(v[1]); ss = red_fq(ss); if (fq == 0) qss[((size_t)row * 8 + head) * 2 + 1] = ss;
                        rope32(v, rcos + (size_t)row * 16, rsin + (size_t)row * 16, fq);
                        *(u32x4*)(qm + ((size_t)(b * 8 + head) * 2048 + s) * 96 + 64 + 8 * fq) = pack8(v[0] * *(const f32x4*)(g + 64 + 8 * fq), v[1] * *(const f32x4*)(g + 64 + 8 * fq + 4)); }
                }
            }
    }
};

struct EpiUpKV {
    static constexpr bool PERM = true;
    bf16_t *km, *vm; const float* kvsq; const float* krot; const float* g;
    __device__ __forceinline__ void operator()(const f32x4 (&acc)[2][2][4][2], const Unit& u, int wr, int wc, int fr, int fq) const {
        const int pn = u.pn, row0 = u.orow0 + wr * 64 + fr, head = 2 * pn + (wc >> 1);
#pragma unroll
        for (int ai = 0; ai < 2; ++ai)
#pragma unroll
            for (int m = 0; m < 4; ++m) {
                const int row = row0 + ai * 128 + m * 16, b = row >> 11, s = row & 2047;
                const f32x4 sq = *(const f32x4*)(kvsq + (size_t)row * 4);
                const float rstd = rsqrtf(((sq[0] + sq[1]) + (sq[2] + sq[3])) * (1.0f / 128.0f) + EPS);
                if ((wc & 1) == 0) {
                    f32x4 v[2][2]; float ss = 0.f;
#pragma unroll
                    for (int bj = 0; bj < 2; ++bj)
#pragma unroll
                        for (int n = 0; n < 2; ++n) { v[bj][n] = acc[ai][bj][m][n] * rstd; ss += sq4(v[bj][n]); }
                    const f32x4 k0 = *(const f32x4*)(krot + (size_t)row * 32 + 8 * fq), k1 = *(const f32x4*)(krot + (size_t)row * 32 + 8 * fq + 4);
                    ss += sq4(k0) + sq4(k1); ss = red_fq(ss);
                    const float r96 = rsqrtf(ss * (1.0f / 96.0f) + EPS);
                    bf16_t* rp = km + ((size_t)(b * 8 + head) * 2048 + s) * 96 + 8 * fq;
#pragma unroll
                    for (int bj = 0; bj < 2; ++bj) *(u32x4*)(rp + 32 * bj) = pack8(v[bj][0] * r96 * *(const f32x4*)(g + 32 * bj + 8 * fq), v[bj][1] * r96 * *(const f32x4*)(g + 32 * bj + 8 * fq + 4));
                    *(u32x4*)(rp + 64) = pack8(k0 * r96 * *(const f32x4*)(g + 64 + 8 * fq), k1 * r96 * *(const f32x4*)(g + 64 + 8 * fq + 4));
                } else {
                    bf16_t* rp = vm + ((size_t)(b * 8 + head) * 2048 + s) * 64 + 8 * fq;
#pragma unroll
                    for (int bj = 0; bj < 2; ++bj) *(u32x4*)(rp + 32 * bj) = pack8(acc[ai][bj][m][0] * rstd, acc[ai][bj][m][1] * rstd);
                }
            }
    }
};

template <int PASS> struct EpiMerge {
    static constexpr bool PERM = true;
    const bf16_t* sg; bf16_t* tmp; bf16_t* out;
    __device__ __forceinline__ void operator()(const f32x4 (&acc)[2][2][4][2], const Unit& u, int wr, int wc, int fr, int fq) const {
        const int row0 = u.orow0 + wr * 64 + fr, cb = u.pn * 256 + wc * 32 + 8 * fq;
#pragma unroll
        for (int ai = 0; ai < 2; ++ai)
#pragma unroll
            for (int m = 0; m < 4; ++m) { const size_t off = (size_t)(row0 + ai * 128 + m * 16) * 1024 + cb;
#pragma unroll
                for (int bj = 0; bj < 2; ++bj) { f32x4 ga, gb; unpack8(*(const u32x4*)(sg + off + 128 * bj), ga, gb);
                    f32x4 a = acc[ai][bj][m][0] * ga, b = acc[ai][bj][m][1] * gb;
                    if (PASS == 1) *(u32x4*)(tmp + off + 128 * bj) = pack8(a, b);
                    else { f32x4 ta, tb; unpack8(*(const u32x4*)(tmp + off + 128 * bj), ta, tb); *(u32x4*)(out + off + 128 * bj) = pack8(a + ta, b + tb); } } }
    }
};

struct EpiOut {
    static constexpr bool PERM = false;
    const float* x; float* x1; const float* mod;
    __device__ __forceinline__ void operator()(const f32x4 (&acc)[2][2][4][2], const Unit& u, int wr, int wc, int fr, int fq) const {
        const int row0 = u.orow0 + wr * 64 + fr, cb = u.pn * 256 + wc * 32 + 4 * fq, b = u.orow0 >> 11;
        f32x4 gt[2][2];
#pragma unroll
        for (int bj = 0; bj < 2; ++bj)
#pragma unroll
            for (int n = 0; n < 2; ++n) gt[bj][n] = *(const f32x4*)(mod + (size_t)b * 6144 + 2048 + cb + 128 * bj + 16 * n);
#pragma unroll
        for (int ai = 0; ai < 2; ++ai)
#pragma unroll
            for (int m = 0; m < 4; ++m) { const size_t off = (size_t)(row0 + ai * 128 + m * 16) * 1024 + cb;
#pragma unroll
                for (int bj = 0; bj < 2; ++bj)
#pragma unroll
                    for (int n = 0; n < 2; ++n) { const f32x4 xv = *(const f32x4*)(x + off + 128 * bj + 16 * n); *(f32x4*)(x1 + off + 128 * bj + 16 * n) = xv + gt[bj][n] * acc[ai][bj][m][n]; } }
    }
};

struct EpiGateUp {
    static constexpr bool PERM = true;
    bf16_t* act;
    __device__ __forceinline__ void operator()(const f32x4 (&acc)[2][2][4][2], const Unit& u, int wr, int wc, int fr, int fq) const {
        const int lr0 = wr * 64 + fr, cb = u.pn * 128 + wc * 32 + 8 * fq;
        const float* wl0 = u.l0 ? (const float*)((const char*)u.l0 + (WS_WLIST - WS_LIST)) : nullptr;
        const float* wl1 = u.l0 ? (const float*)((const char*)u.l1 + (WS_WLIST - WS_LIST)) : nullptr;
#pragma unroll
        for (int ai = 0; ai < 2; ++ai)
#pragma unroll
            for (int m = 0; m < 4; ++m) { const int lr = lr0 + ai * 128 + m * 16;
                if (lr < u.nrows) {
                    float w = 1.0f; if (wl0) { const int i = u.m0 + lr; w = i < u.n0 ? wl0[i] : wl1[i - u.n0]; }
                    f32x4 a = acc[ai][0][m][0], b = acc[ai][0][m][1];
#pragma unroll
                    for (int e = 0; e < 4; ++e) { a[e] = siluf_fast(a[e]) * acc[ai][1][m][0][e] * w; b[e] = siluf_fast(b[e]) * acc[ai][1][m][1][e] * w; }
                    *(u32x4*)(act + (size_t)(u.orow0 + lr) * 256 + cb) = pack8(a, b); } }
    }
};
struct EpiDown {
    static constexpr bool PERM = true;
    bf16_t* ys;
    __device__ __forceinline__ void operator()(const f32x4 (&acc)[2][2][4][2], const Unit& u, int wr, int wc, int fr, int fq) const {
        const int lr0 = wr * 64 + fr, cb = u.pn * 256 + wc * 32 + 8 * fq;
#pragma unroll
        for (int ai = 0; ai < 2; ++ai)
#pragma unroll
            for (int m = 0; m < 4; ++m) { const int lr = lr0 + ai * 128 + m * 16;
                if (lr < u.nrows) { bf16_t* rp = ys + (size_t)(u.orow0 + lr) * 1024 + cb;
#pragma unroll
                    for (int bj = 0; bj < 2; ++bj) *(u32x4*)(rp + 128 * bj) = pack8(acc[ai][bj][m][0], acc[ai][bj][m][1]); } }
    }
};
}
struct Frame {
    LAS unsigned char* lds;
    volatile LAS unsigned* MISC;
    gu32* ctl;
    int tid, lane, wave, vcu, G;
    unsigned char* ws;
    float* out;
    __device__ __forceinline__ void refresh() { int t = threadIdx.x; asm volatile("" : "+v"(t)); tid = t; lane = t & 63; wave = __builtin_amdgcn_readfirstlane(t >> 6);
        asm volatile("" : "+s"(ws)); asm volatile("" : "+s"(out)); ctl = (gu32*)(ws + WS_CTL); }
};
__device__ __forceinline__ int fresh_tid() { int t = threadIdx.x; asm volatile("" : "+v"(t)); return t; }
template <class T> __device__ __forceinline__ T* wsp(const Frame& F, size_t off) { return (T*)(F.ws + off); }

struct MapOff { int off; __device__ int operator()(int n) const { return n + off; } };
struct MapWin { __device__ int operator()(int n) const {
    if (n < 1024) { const int sec = n >> 9, nn = n & 511, hh = nn >> 6, d = nn & 63; return sec * 512 + (hh >> 2) * 256 + 128 * (d >> 5) + 32 * (hh & 3) + (d & 31); }
    return n < 1952 ? n : n + 96; } };
struct MapUq { __device__ int operator()(int n) const { const int hh = n / 96, d = n % 96;
    return d < 64 ? (hh >> 2) * 256 + 128 * (d >> 5) + 32 * (hh & 3) + (d & 31) : 512 + 128 * (hh & 1) + 32 * (hh >> 1) + (d - 64); } };
struct MapUkv { __device__ int operator()(int n) const { const int hh = n >> 7, d = n & 127, dd = d & 63, wcn = 2 * (hh & 1) + (d >> 6);
    return (hh >> 1) * 256 + 128 * (dd >> 5) + 32 * wcn + (dd & 31); } };
struct MapGU { int up; __device__ int operator()(int f) const { return (f >> 7) * 256 + up * 128 + (f & 127); } };

template <class Map> __device__ __forceinline__ void transpose_item(const float* W, int K, int N, bf16_t* WT, Map rm, const float* kscale, LAS float* scr, int item, int lane) {
    const int nblk = N / 32, kb = item / nblk, nb = item % nblk, k0 = 64 * kb, n0 = 32 * nb;
#pragma unroll 8
    for (int i = 0; i < 32; ++i) { const int kk = 2 * i + (lane >> 5); float v = W[(size_t)(k0 + kk) * N + n0 + (lane & 31)]; if (kscale) v *= kscale[k0 + kk]; scr[kk * 33 + (lane & 31)] = v; }
    LDS_WAIT(); asm volatile("" ::: "memory");
    const int c = lane & 7;
#pragma unroll
    for (int j = 0; j < 4; ++j) { const int n = (lane >> 3) + 8 * j; const LAS float* s = scr + (8 * c) * 33 + n;
        u32x4 o; o.x = pk2(s[0 * 33], s[1 * 33]); o.y = pk2(s[2 * 33], s[3 * 33]); o.z = pk2(s[4 * 33], s[5 * 33]); o.w = pk2(s[6 * 33], s[7 * 33]);
        *(u32x4*)(WT + (size_t)rm(n0 + n) * K + k0 + 8 * c) = o; }
    LDS_WAIT(); asm volatile("" ::: "memory");
}

__device__ __forceinline__ void p0_prologue(Frame& F, const Args& A) {
    const int tid = F.tid;
    {
        LAS float* sc = (LAS float*)F.lds;
        LAS float* part = (LAS float*)(F.lds + 32768);
        for (int i = tid; i < NB * DM; i += NTHR) { const float v = INF(I_c)[i]; sc[i] = v / (1.0f + expf(-v)); }
        __syncthreads();
        for (int n0 = 24 * (int)blockIdx.x; n0 < 6 * DM; n0 += 24 * F.G) {
        const int kk = tid >> 5, col = tid & 31;
        float a[8];
#pragma unroll
        for (int b = 0; b < 8; ++b) a[b] = 0.f;
        if (col < 24) {
#pragma unroll 8
            for (int k = kk; k < DM; k += 16) { const float w = INF(I_w_ada)[(size_t)k * 6144 + n0 + col];
#pragma unroll
                for (int b = 0; b < 8; ++b) a[b] = fmaf(sc[b * DM + k], w, a[b]); }
        }
#pragma unroll
        for (int b = 0; b < 8; ++b) part[(kk * 8 + b) * 32 + col] = a[b];
        __syncthreads();
        if (tid < 192) { const int b = tid / 24, cc = tid % 24; float s = 0.f;
#pragma unroll
            for (int q = 0; q < 16; ++q) s += part[(q * 8 + b) * 32 + cc];
            wsp<float>(F, WS_MOD)[(size_t)b * 6144 + n0 + cc] = s + INF(I_b_ada)[n0 + cc]; }
        __syncthreads();
        }
    }
    LAS float* scr = (LAS float*)(F.lds + F.wave * 16384);
    const int gw = F.vcu * NWAVES + F.wave, NGW = F.G * NWAVES;
    constexpr int I_IN = 16 * 125, I_UQ = 4 * 24, I_UKV = 2 * 32, I_PN = 8 * 32, I_OUT = 16 * 32;
    constexpr int NITEMS = I_IN + I_UQ + I_UKV + 2 * I_PN + I_OUT;
    for (int it = gw; it < NITEMS; it += NGW) {
        int r = it;
        if (r < I_IN) { transpose_item(INF(I_w_in), DM, INCOLS, wsp<bf16_t>(F, WS_WIN), MapWin{}, nullptr, scr, r, F.lane); continue; } r -= I_IN;
        if (r < I_UQ) { transpose_item(INF(I_w_uq), QRANK, MH * QKD, wsp<bf16_t>(F, WS_WUQ), MapUq{}, INF(I_g_q_lat), scr, r, F.lane); continue; } r -= I_UQ;
        if (r < I_UKV) { transpose_item(INF(I_w_ukv), KVRANK, MH * 128, wsp<bf16_t>(F, WS_WUKV), MapUkv{}, INF(I_g_kv_lat), scr, r, F.lane); continue; } r -= I_UKV;
        if (r < I_PN) { transpose_item(INF(I_w_proj_na), 512, DM, wsp<bf16_t>(F, WS_WPNA), MapOff{0}, nullptr, scr, r, F.lane); continue; } r -= I_PN;
        if (r < I_PN) { transpose_item(INF(I_w_proj_mla), 512, DM, wsp<bf16_t>(F, WS_WPMLA), MapOff{0}, nullptr, scr, r, F.lane); continue; } r -= I_PN;
        transpose_item(INF(I_w_out), DM, DM, wsp<bf16_t>(F, WS_WOUT), MapOff{0}, nullptr, scr, r, F.lane);
    }
    const int gt = F.vcu * NTHR + tid, NGT = F.G * NTHR;
    for (int i = gt; i < 96 * DM / 8; i += NGT) *(u32x4*)(wsp<bf16_t>(F, WS_WIN) + (size_t)1952 * DM + (size_t)i * 8) = (u32x4){0u, 0u, 0u, 0u};
    for (int i = gt; i < NT * 16; i += NGT) { const int t = i >> 4, q = i & 15;
        const float inv = powf(10000.0f, -(float)q / 16.0f), ang = (float)((const int*)A.in[I_positions])[t] * inv;
        wsp<float>(F, WS_RCOS)[i] = cosf(ang); wsp<float>(F, WS_RSIN)[i] = sinf(ang); }
    for (int i = gt; i < 4 * 64 * 64 * 4; i += NGT) { const int ct = i >> 14, j = (i >> 8) & 63, l = (i >> 2) & 63, q = i & 3;
        wsp<float>(F, WS_RFRAG)[i] = INF(I_w_router)[(size_t)(16 * j + 4 * (l >> 4) + q) * NEXP + 16 * ct + (l & 15)]; }
}

__device__ __forceinline__ void s1_modnorm(Frame& F, const Args& A) {
    const int gw = F.vcu * NWAVES + F.wave, lane = F.lane;
    const float* mod = wsp<float>(F, WS_MOD); bf16_t* H = wsp<bf16_t>(F, WS_H);
    for (int r0 = gw * 8; r0 < NT; r0 += F.G * NWAVES * 8) {
    const int b = r0 >> 11;
    f32x4 ca[4], cs[4];
#pragma unroll
    for (int j = 0; j < 4; ++j) { const int c4 = 4 * lane + 256 * j;
        const f32x4 g = *(const f32x4*)(INF(I_g_norm1) + c4), sc = *(const f32x4*)(mod + (size_t)b * 6144 + 1024 + c4);
        ca[j] = g * (sc + 1.0f); cs[j] = *(const f32x4*)(mod + (size_t)b * 6144 + c4); }
    for (int r = r0; r < r0 + 8; ++r) {
        f32x4 v[4]; float ss = 0.f;
#pragma unroll
        for (int j = 0; j < 4; ++j) { v[j] = *(const f32x4*)(INF(I_x) + (size_t)r * DM + 4 * lane + 256 * j); ss += sq4(v[j]); }
        const float rstd = rsqrtf(wave_sum(ss) * (1.0f / DM) + EPS);
#pragma unroll
        for (int j = 0; j < 4; ++j) { const f32x4 o = v[j] * rstd * ca[j] + cs[j]; u32x2 w; w.x = cvt_pk_bf16(o[0], o[1]); w.y = cvt_pk_bf16(o[2], o[3]);
            *(u32x2*)(H + (size_t)r * DM + 4 * lane + 256 * j) = w; }
    }
    }
}
namespace attn {
__device__ __forceinline__ int crow(int r, int hi) { return (r & 3) + 8 * (r >> 2) + 4 * hi; }
constexpr int KVBLK = 64;
constexpr int L_K = 0, L_V = 26624, L_WS = 43008, L_OST = 45056, L_BIAS = 77824, L_END = 79872;
constexpr int KBUF = 13312, VBUF = 8192;
constexpr float THRN = 8.0f;

template <int DQK> struct Geo { static constexpr int KROWB = DQK * 2 + 16, NCH = DQK / 8, ND0 = DQK / 16; };

__device__ __forceinline__ int v_st(int k, int c) { const int kk = (k & ~0xC) | ((k & 4) << 1) | ((k & 8) >> 1); return ((kk >> 3) * 2 + (c >> 5)) * 512 + ((kk & 7) * 32 + (c & 31)) * 2; }
__device__ __forceinline__ int v_rd_base(int lane) { return ((lane & 3) << 3) | (((lane >> 2) & 3) << 6) | (((lane >> 4) & 1) << 5) | (((lane >> 5) & 1) << 8); }
constexpr int v_rd_off(int d0, int ks, int half) { return d0 * 512 + ks * 2048 + half * 1024; }
template <int OFF> __device__ __forceinline__ s16x4 tr_read(int vb) { s16x4 r; asm volatile("ds_read_b64_tr_b16 %0, %1 offset:%2" : "=&v"(r) : "v"(vb), "i"(OFF) : "memory"); return r; }

template <int D0> __device__ __forceinline__ void pv_one(f32x16& od, int vb, bf16x8 pa0, bf16x8 pa1, bf16x8 pa2, bf16x8 pa3) {
    const s16x4 l0 = tr_read<v_rd_off(D0, 0, 0)>(vb), h0 = tr_read<v_rd_off(D0, 0, 1)>(vb), l1 = tr_read<v_rd_off(D0, 1, 0)>(vb), h1 = tr_read<v_rd_off(D0, 1, 1)>(vb);
    const s16x4 l2 = tr_read<v_rd_off(D0, 2, 0)>(vb), h2 = tr_read<v_rd_off(D0, 2, 1)>(vb), l3 = tr_read<v_rd_off(D0, 3, 0)>(vb), h3 = tr_read<v_rd_off(D0, 3, 1)>(vb);
    asm volatile("s_waitcnt lgkmcnt(0)" ::: "memory"); SBAR();
#define PK(L, H) (bf16x8){L[0], L[1], L[2], L[3], H[0], H[1], H[2], H[3]}
    od = __builtin_amdgcn_mfma_f32_32x32x16_bf16(pa0, PK(l0, h0), od, 0, 0, 0);
    od = __builtin_amdgcn_mfma_f32_32x32x16_bf16(pa1, PK(l1, h1), od, 0, 0, 0);
    od = __builtin_amdgcn_mfma_f32_32x32x16_bf16(pa2, PK(l2, h2), od, 0, 0, 0);
    od = __builtin_amdgcn_mfma_f32_32x32x16_bf16(pa3, PK(l3, h3), od, 0, 0, 0);
#undef PK
}

template <int DQK> __device__ __forceinline__ void qkt(f32x16& p0, f32x16& p1, const LAS unsigned char* Ks, const bf16x8* qr, int r32, int hi) {
    p0 = f32x16{}; p1 = f32x16{};
#pragma unroll
    for (int d0 = 0; d0 < Geo<DQK>::ND0; ++d0) { const int cb = (d0 * 16 + hi * 8) * 2;
        const bf16x8 b0 = *(const LAS bf16x8*)(Ks + r32 * Geo<DQK>::KROWB + cb);
        const bf16x8 b1 = *(const LAS bf16x8*)(Ks + (32 + r32) * Geo<DQK>::KROWB + cb);
        p0 = __builtin_amdgcn_mfma_f32_32x32x16_bf16(b0, qr[d0], p0, 0, 0, 0);
        p1 = __builtin_amdgcn_mfma_f32_32x32x16_bf16(b1, qr[d0], p1, 0, 0, 0); }
}
__device__ __forceinline__ void softmax_tile(f32x16& p0, f32x16& p1, float& m_reg, float& alpha, float& l_reg, float C, float thr_raw,
                                             bf16x8& pa0, bf16x8& pa1, bf16x8& pa2, bf16x8& pa3) {
    float pmax = p0[0];
#pragma unroll
    for (int r = 1; r < 16; ++r) pmax = fmaxf(pmax, p0[r]);
#pragma unroll
    for (int r = 0; r < 16; ++r) pmax = fmaxf(pmax, p1[r]);
    { auto rr = __builtin_amdgcn_permlane32_swap(__float_as_uint(pmax), __float_as_uint(pmax), false, false);
      pmax = fmaxf(__uint_as_float(rr[0]), __uint_as_float(rr[1])); }
    float mn;
    if (__builtin_expect(__all(pmax - m_reg <= thr_raw), 1)) { mn = m_reg; alpha = 1.f; }
    else { mn = fmaxf(m_reg, pmax); alpha = __builtin_amdgcn_exp2f((m_reg - mn) * C); m_reg = mn; }
    const float mnC = -mn * C;
#pragma unroll
    for (int r = 0; r < 16; ++r) { p0[r] = __builtin_amdgcn_exp2f(fmaf(p0[r], C, mnC)); p1[r] = __builtin_amdgcn_exp2f(fmaf(p1[r], C, mnC)); }
    float ps = 0;
#pragma unroll
    for (int r = 0; r < 16; ++r) ps += p0[r];
#pragma unroll
    for (int r = 0; r < 16; ++r) ps += p1[r];
    { auto rr = __builtin_amdgcn_permlane32_swap(__float_as_uint(ps), __float_as_uint(ps), false, false);
      ps = __uint_as_float(rr[0]) + __uint_as_float(rr[1]); }
    l_reg = l_reg * alpha + ps;
#define PK4(P, BASE, OUT) do { unsigned a0 = cvt_pk_bf16(P[BASE + 0], P[BASE + 1]), a1 = cvt_pk_bf16(P[BASE + 2], P[BASE + 3]);   \
    unsigned b0 = cvt_pk_bf16(P[BASE + 4], P[BASE + 5]), b1 = cvt_pk_bf16(P[BASE + 6], P[BASE + 7]);                              \
    auto r0 = __builtin_amdgcn_permlane32_swap(a0, b0, false, false); auto r1 = __builtin_amdgcn_permlane32_swap(a1, b1, false, false); \
    u32x4 w = {r0[0], r1[0], r0[1], r1[1]}; OUT = __builtin_bit_cast(bf16x8, w); } while (0)
    PK4(p0, 0, pa0); PK4(p0, 8, pa1); PK4(p1, 0, pa2); PK4(p1, 8, pa3);
#undef PK4
}

template <int DQK, bool NA>
__device__ __forceinline__ void attn_unit(LAS unsigned char* lds, const bf16_t* Qw, int ldq, float qscale, const bf16_t* Kt, int ldk, const bf16_t* Vt, int ldv, bf16_t* Ow,
                                          int ntiles, float SCALE, int na_first, int na_qc0, int na_dr0) {
    using G = Geo<DQK>;
    int tid_ = threadIdx.x; asm volatile("" : "+v"(tid_));
    const int tid = tid_, lane = tid & 63, r32 = lane & 31, hi = lane >> 5; const int wid = __builtin_amdgcn_readfirstlane(tid >> 6);
    const float C = SCALE * 1.4426950408889634f, thr_raw = THRN / SCALE;
    LAS float* wsf = (LAS float*)(lds + L_WS) + wid * 64;
    bf16x8 qr[G::ND0];
#pragma unroll
    for (int d0 = 0; d0 < G::ND0; ++d0) { u32x4 w = *(const u32x4*)(Qw + (size_t)r32 * ldq + d0 * 16 + hi * 8);
        if (!NA) { f32x4 a, b; a = (f32x4){bflo(w.x), bfhi(w.x), bflo(w.y), bfhi(w.y)} * qscale; b = (f32x4){bflo(w.z), bfhi(w.z), bflo(w.w), bfhi(w.w)} * qscale;
            w.x = cvt_pk_bf16(a[0], a[1]); w.y = cvt_pk_bf16(a[2], a[3]); w.z = cvt_pk_bf16(b[0], b[1]); w.w = cvt_pk_bf16(b[2], b[3]); }
        qr[d0] = __builtin_bit_cast(bf16x8, w); }
    const int vk = tid >> 3, vc = (tid & 7) * 8, vst = v_st(vk, vc);
    const int k0r = tid / G::NCH, k0c = tid % G::NCH; const int k1id = tid + 512, k1r = k1id / G::NCH, k1c = k1id % G::NCH; const bool k1on = (G::NCH == 12) && (tid < 256);
    const int vb0 = (int)(uintptr_t)(lds + L_V) + v_rd_base(lane);
    u32x4 sv, sk0, sk1;
#define SLOAD(j) do { const size_t kb_ = (size_t)(j) * KVBLK; sv = *(const u32x4*)(Vt + (kb_ + vk) * ldv + vc); sk0 = *(const u32x4*)(Kt + (kb_ + k0r) * ldk + k0c * 8); \
        if (k1on) sk1 = *(const u32x4*)(Kt + (kb_ + k1r) * ldk + k1c * 8); } while (0)
#define SWRITE(bf) do { *(LAS u32x4*)(lds + L_V + (bf) * VBUF + vst) = sv; *(LAS u32x4*)(lds + L_K + (bf) * KBUF + k0r * G::KROWB + k0c * 16) = sk0; \
        if (k1on) *(LAS u32x4*)(lds + L_K + (bf) * KBUF + k1r * G::KROWB + k1c * 16) = sk1; } while (0)
    float m_reg = -1e30f, l_reg = 0.f; f32x16 o[2]; o[0] = f32x16{}; o[1] = f32x16{};
    SLOAD(0); VM_WAIT(); SWRITE(0); if (ntiles > 1) SLOAD(1);
    __syncthreads();
    for (int j = 0; j < ntiles; ++j) {
        const int bf = j & 1;
        bool active = true; int dr = 0;
        if (NA) { dr = na_dr0 + j; active = (j >= na_first) && (j < na_first + 8); }
        if (active) {
            f32x16 p0, p1; bf16x8 pa0, pa1, pa2, pa3; float alpha;
            qkt<DQK>(p0, p1, lds + L_K + bf * KBUF, qr, r32, hi);
            if (NA) {
                const LAS float* bt = (const LAS float*)(lds + L_BIAS) + (dr + 7) * 32;
                const int qc = na_qc0 + r32; int cs = qc - 8; cs = cs < 0 ? 0 : (cs > 48 ? 48 : cs);
#pragma unroll
                for (int r = 0; r < 16; ++r) {
                    const int kc0 = crow(r, hi), kc1 = kc0 + 32;
                    int i0 = kc0 - qc + 15; i0 = i0 < 0 ? 0 : (i0 > 30 ? 30 : i0); int i1 = kc1 - qc + 15; i1 = i1 < 0 ? 0 : (i1 > 30 ? 30 : i1);
                    const float b0 = bt[i0], b1 = bt[i1];
                    p0[r] = ((unsigned)(kc0 - cs) < 16u) ? p0[r] + b0 : -1e30f;
                    p1[r] = ((unsigned)(kc1 - cs) < 16u) ? p1[r] + b1 : -1e30f;
                }
            }
            softmax_tile(p0, p1, m_reg, alpha, l_reg, C, thr_raw, pa0, pa1, pa2, pa3);
            if (__any(alpha < 1.f)) { if (hi == 0) wsf[r32] = alpha; LDS_WAIT();
#pragma unroll
                for (int d = 0; d < 2; ++d)
#pragma unroll
                    for (int r = 0; r < 16; ++r) o[d][r] *= wsf[crow(r, hi)]; }
            SBAR();
            pv_one<0>(o[0], vb0 + bf * VBUF, pa0, pa1, pa2, pa3); pv_one<1>(o[1], vb0 + bf * VBUF, pa0, pa1, pa2, pa3);
        }
        if (j + 1 < ntiles) { VM_WAIT(); SWRITE(bf ^ 1); if (j + 2 < ntiles) SLOAD(j + 2); }
        __syncthreads();
    }
#undef SLOAD
#undef SWRITE
    if (hi == 0) wsf[32 + r32] = l_reg; LDS_WAIT();
    float rli[16];
#pragma unroll
    for (int r = 0; r < 16; ++r) rli[r] = __builtin_amdgcn_rcpf(wsf[32 + crow(r, hi)]);
    LAS bf16_t* stg = (LAS bf16_t*)(lds + L_OST) + wid * 2048;
#pragma unroll
    for (int r = 0; r < 16; ++r) { const int orow = crow(r, hi);
#pragma unroll
        for (int d0 = 0; d0 < 2; ++d0) stg[orow * 64 + d0 * 32 + r32] = (bf16_t)f2bf(o[d0][r] * rli[r]); }
    LDS_WAIT();
#pragma unroll
    for (int i = 0; i < 4; ++i) { const int row = i * 8 + (lane >> 3), ch = lane & 7; const u32x4 v = *(const LAS u32x4*)(stg + row * 64 + ch * 8); *(u32x4*)(Ow + (size_t)row * 512 + ch * 8) = v; }
    LDS_WAIT();
    __syncthreads();
}
}

__device__ __forceinline__ void s4_attention(Frame& F, const Args& A) {
    const int wave = F.wave;
    for (int un = F.vcu; un < NB * MH * 8; un += F.G) {
        const int bh = un >> 3, qb = un & 7, b = bh >> 3, h = bh & 7;
        const int s0 = qb * 256 + wave * 32, t0 = b * SEQ + s0, r32 = F.lane & 31;
        const float* qss = wsp<float>(F, WS_QSS) + ((size_t)(t0 + r32) * 8 + h) * 2;
        const float qscale = rsqrtf((qss[0] + qss[1]) * (1.0f / 96.0f) + EPS);
        attn::attn_unit<96, false>(F.lds, wsp<bf16_t>(F, WS_QM) + ((size_t)bh * SEQ + s0) * 96, 96, qscale,
                                   wsp<bf16_t>(F, WS_KM) + (size_t)bh * SEQ * 96, 96, wsp<bf16_t>(F, WS_VM) + (size_t)bh * SEQ * 64, 64,
                                   wsp<bf16_t>(F, WS_YMLA) + (size_t)t0 * 512 + h * 64, SEQ / 64, 0.10206207261596577f, 0, 0, 0);
    }
    for (int un = F.vcu; un < NB * NAH * 8; un += F.G) {
        const int bh = un >> 3, g = un & 7, b = bh >> 3, h = bh & 7;
        LAS float* bt = (LAS float*)(F.lds + attn::L_BIAS);
        for (int i = F.tid; i < 15 * 32; i += NTHR) { const int rr = i >> 5, cc = i & 31; bt[i] = cc < 31 ? INF(I_na_rpb)[(size_t)(h * 15 + rr) * 31 + cc] * 8.0f : 0.f; }
        int lo = 4 * g - 4; lo = lo < 0 ? 0 : (lo > 24 ? 24 : lo); int hi_s = 4 * g + 3 - 4; hi_s = hi_s < 0 ? 0 : (hi_s > 24 ? 24 : hi_s);
        const int ntiles = hi_s + 8 - lo;
        const int qrow = 4 * g + (wave >> 1); int rs = qrow - 4; rs = rs < 0 ? 0 : (rs > 24 ? 24 : rs);
        const int t0 = b * SEQ + qrow * 64 + 32 * (wave & 1);
        __syncthreads();
        attn::attn_unit<64, true>(F.lds, wsp<bf16_t>(F, WS_NAQ) + (size_t)t0 * 512 + h * 64, 512, 1.0f,
                                  wsp<bf16_t>(F, WS_NAK) + (size_t)(b * SEQ + lo * 64) * 512 + h * 64, 512, wsp<bf16_t>(F, WS_NAV) + (size_t)(b * SEQ + lo * 64) * 512 + h * 64, 512,
                                  wsp<bf16_t>(F, WS_YNA) + (size_t)t0 * 512 + h * 64, ntiles, 0.125f, rs - lo, 32 * (wave & 1), lo - qrow);
    }
}
namespace moe {
#define RFL(x) __builtin_amdgcn_readfirstlane(x)
constexpr int ASTR = 1028;
constexpr int L_A = 0, L_LG = 16 * ASTR * 4, L_END = L_LG + 2 * 16 * 64 * 4;
constexpr int T_CNT = 0, T_ABASE = 128, T_YBASE = 200, T_PRE = 336;

__device__ __forceinline__ void s7_router(Frame& F, const Args& A) {
    const int lane = F.lane, wave = F.wave;
    const float* mod = wsp<float>(F, WS_MOD); bf16_t* H2 = wsp<bf16_t>(F, WS_H2);
    LAS float* At = (LAS float*)(F.lds + L_A); LAS float* LG = (LAS float*)(F.lds + L_LG);
    const float* rfrag = wsp<float>(F, WS_RFRAG);
    int* LIST = wsp<int>(F, WS_LIST); float* WLIST = wsp<float>(F, WS_WLIST); unsigned* TOKSLOT = wsp<unsigned>(F, WS_TOKSLOT);
    const float ebias = INF(I_e_bias)[lane];
    for (int un = F.vcu; un < NT / 16; un += F.G) {
        const int row0 = un * 16, b = row0 >> 11;
#pragma unroll
        for (int rr = 0; rr < 2; ++rr) {
            const int lr = 2 * wave + rr, row = row0 + lr;
            f32x4 v[4]; float ss = 0.f;
#pragma unroll
            for (int j = 0; j < 4; ++j) { v[j] = *(const f32x4*)(F.out + (size_t)row * DM + 4 * lane + 256 * j); ss += sq4(v[j]); }
            const float rstd = rsqrtf(wave_sum(ss) * (1.0f / DM) + EPS);
#pragma unroll
            for (int j = 0; j < 4; ++j) { const int c4 = 4 * lane + 256 * j;
                const f32x4 g = *(const f32x4*)(INF(I_g_norm2) + c4), sc = *(const f32x4*)(mod + (size_t)b * 6144 + 4096 + c4), sh = *(const f32x4*)(mod + (size_t)b * 6144 + 3072 + c4);
                const f32x4 o = v[j] * rstd * (g * (sc + 1.0f)) + sh;
                u32x2 w; w.x = cvt_pk_bf16(o[0], o[1]); w.y = cvt_pk_bf16(o[2], o[3]);
                *(u32x2*)(H2 + (size_t)row * DM + c4) = w;
                *(LAS f32x4*)(At + lr * ASTR + c4) = o; }
        }
        __syncthreads();
        {
            const int ct = wave & 3, kh = wave >> 2; f32x4 acc = {0.f, 0.f, 0.f, 0.f};
            const LAS float* ap = At + (lane & 15) * ASTR + 4 * (lane >> 4);
            const float* bp = rfrag + ((size_t)(ct * 64 + 32 * kh) * 64 + lane) * 4;
#pragma unroll 4
            for (int jj = 0; jj < 32; ++jj) { const f32x4 a4 = *(const LAS f32x4*)(ap + 16 * (32 * kh + jj)); const f32x4 b4 = *(const f32x4*)(bp + (size_t)jj * 256);
                acc = __builtin_amdgcn_mfma_f32_16x16x4f32(a4[0], b4[0], acc, 0, 0, 0); acc = __builtin_amdgcn_mfma_f32_16x16x4f32(a4[1], b4[1], acc, 0, 0, 0);
                acc = __builtin_amdgcn_mfma_f32_16x16x4f32(a4[2], b4[2], acc, 0, 0, 0); acc = __builtin_amdgcn_mfma_f32_16x16x4f32(a4[3], b4[3], acc, 0, 0, 0); }
#pragma unroll
            for (int r = 0; r < 4; ++r) LG[(kh * 16 + 4 * (lane >> 4) + r) * 64 + 16 * ct + (lane & 15)] = acc[r];
        }
        __syncthreads();
#pragma unroll 1
        for (int rr = 0; rr < 2; ++rr) {
            const int lr = 2 * wave + rr, tok = row0 + lr;
            const float logit = LG[lr * 64 + lane] + LG[(16 + lr) * 64 + lane];
            const float score = 1.0f / (1.0f + expf(-logit));
            const float sel = score + ebias;
            float m1 = sel; m1 = fmaxf(m1, __shfl_xor(m1, 1)); m1 = fmaxf(m1, __shfl_xor(m1, 2)); m1 = fmaxf(m1, __shfl_xor(m1, 4));
            const unsigned long long bm = __ballot(sel == m1);
            const unsigned gb = (unsigned)(bm >> (lane & ~7)) & 0xffu; const int first = __ffs((int)gb) - 1;
            float m2 = ((lane & 7) == first) ? -INFINITY : sel; m2 = fmaxf(m2, __shfl_xor(m2, 1)); m2 = fmaxf(m2, __shfl_xor(m2, 2)); m2 = fmaxf(m2, __shfl_xor(m2, 4));
            const float gs = m1 + m2; int grank = 0;
#pragma unroll
            for (int q = 0; q < 8; ++q) { const float o = __shfl(gs, 8 * q); grank += (o > gs || (o == gs && q < (lane >> 3))) ? 1 : 0; }
            const bool gsel = grank < TOPKG; const float sm = gsel ? sel : -INFINITY; int rank = 0;
#pragma unroll
            for (int q = 0; q < 64; ++q) { const float o = __shfl(sm, q); rank += (o > sm || (o == sm && q < lane)) ? 1 : 0; }
            const bool chosen = gsel && rank < TOPK;
            const float wsum = wave_sum(chosen ? score : 0.f);
            const float w = score / wsum * 2.5f;
            if (chosen) { const int c = tok >= CHTOK ? 1 : 0, ec = lane * 2 + c;
                const unsigned pos = __hip_atomic_fetch_add((unsigned*)F.ctl + CW_CNT + ec * 16, 1u, RLX_AGENT);
                LIST[(size_t)ec * 8192 + pos] = tok; WLIST[(size_t)ec * 8192 + pos] = w; TOKSLOT[(size_t)tok * 8 + rank] = ((unsigned)lane << 16) | pos; }
        }
        __syncthreads();
    }
    LAS float* scr = (LAS float*)(F.lds + wave * 16384);
    const int gw = F.vcu * NWAVES + wave, NGW = F.G * NWAVES;
    for (int it = gw; it < 65 * 384; it += NGW) {
        const int e = it / 384, r = it % 384;
        const float* wg = e < 64 ? INF(I_w_eg) + (size_t)e * DM * EFF : INF(I_w_sg); const float* wu = e < 64 ? INF(I_w_eu) + (size_t)e * DM * EFF : INF(I_w_su); const float* wd = e < 64 ? INF(I_w_ed) + (size_t)e * EFF * DM : INF(I_w_sd);
        if (r < 128) transpose_item(wg, DM, EFF, wsp<bf16_t>(F, WS_WGU) + (size_t)e * 512 * DM, MapGU{0}, nullptr, scr, r, lane);
        else if (r < 256) transpose_item(wu, DM, EFF, wsp<bf16_t>(F, WS_WGU) + (size_t)e * 512 * DM, MapGU{1}, nullptr, scr, r - 128, lane);
        else transpose_item(wd, EFF, DM, wsp<bf16_t>(F, WS_WD) + (size_t)e * DM * EFF, MapOff{0}, nullptr, scr, r - 256, lane);
    }
}

__device__ __forceinline__ void build_tables(Frame& F) {
    LAS int* tab = (LAS int*)(F.lds + TAB_OFF);
    if (F.tid < 128) tab[T_CNT + F.tid] = (int)__hip_atomic_load((unsigned*)F.ctl + CW_CNT + F.tid * 16, RLX_AGENT);
    __syncthreads();
    if (F.tid == 0) { int a = 0, y0 = 0, y1 = 0;
        for (int e = 0; e < 64; ++e) { tab[T_ABASE + e] = a; tab[T_YBASE + e] = y0; tab[T_YBASE + 64 + e] = y1; a += tab[T_CNT + 2 * e] + tab[T_CNT + 2 * e + 1]; y0 += tab[T_CNT + 2 * e]; y1 += tab[T_CNT + 2 * e + 1]; }
        tab[T_ABASE + 64] = a; }
    __syncthreads();
}

struct GateUpSched {
    const LAS int* tab; const bf16_t* wgu; const int* list; int x, j, per;
    __device__ void init(Frame& F) { tab = (const LAS int*)(F.lds + TAB_OFF); wgu = wsp<bf16_t>(F, WS_WGU); list = wsp<int>(F, WS_LIST); x = (int)blockIdx.x % 8; j = (int)blockIdx.x / 8; per = F.G / 8; }
    __device__ bool next(int i, pg8::Unit& u) const {
        const int L = i * per + j;
        int k = -1, base = 0, a = 0;
#pragma unroll
        for (int q = 0; q < 8; ++q) { const int e = x + 8 * q; const int na = a + ((RFL(tab[T_CNT + 2 * e]) + RFL(tab[T_CNT + 2 * e + 1]) + 255) >> 8) * 2; if (k < 0 && L < na) { k = q; base = a; } a = na; }
        if (k >= 0) {
            const int e = x + 8 * k, r = L - base, mt = r >> 1, pn = r & 1, n0 = RFL(tab[T_CNT + 2 * e]), ntot = n0 + RFL(tab[T_CNT + 2 * e + 1]);
            u.B = (const char*)(wgu + ((size_t)e * 512 + pn * 256) * DM); u.m0 = mt * 256; u.pn = pn; u.e = e; u.nrows = (ntot - mt * 256) < 256 ? (ntot - mt * 256) : 256;
            u.orow0 = RFL(tab[T_ABASE + e]) + mt * 256; u.l0 = list + (size_t)(2 * e) * 8192; u.l1 = list + (size_t)(2 * e + 1) * 8192; u.n0 = n0; u.ntot = ntot; return true; }
        const int r = L - a; if (r >= 16) return false;
        const int mt = x + 8 * (r >> 1), pn = r & 1;
        u.B = (const char*)(wgu + ((size_t)64 * 512 + pn * 256) * DM); u.m0 = mt * 256; u.pn = pn; u.e = 64; u.nrows = 256; u.orow0 = ACT_SHARED_ROW0 + mt * 256; u.l0 = nullptr; u.l1 = nullptr; u.n0 = 0; u.ntot = 0; return true;
    }
};
struct DownSched {
    const LAS int* tab; const bf16_t* wd; int x, j, per, c;
    __device__ void init(Frame& F, int c_) { tab = (const LAS int*)(F.lds + TAB_OFF); wd = wsp<bf16_t>(F, WS_WD); x = (int)blockIdx.x % 8; j = (int)blockIdx.x / 8; per = F.G / 8; c = c_; }
    __device__ bool next(int i, pg8::Unit& u) const {
        const int L = i * per + j;
        u.l0 = nullptr; u.l1 = nullptr; u.n0 = 0; u.ntot = 0;
        int k = -1, base = 0, a = 0;
#pragma unroll
        for (int q = 0; q < 8; ++q) { const int e = x + 8 * q; const int na = a + ((RFL(tab[T_CNT + 2 * e + c]) + 255) >> 8) * 4; if (k < 0 && L < na) { k = q; base = a; } a = na; }
        if (k >= 0) {
            const int e = x + 8 * k, r = L - base, mt = r >> 2, pn = r & 3, n = RFL(tab[T_CNT + 2 * e + c]);
            u.B = (const char*)(wd + ((size_t)e * DM + pn * 256) * EFF); u.m0 = RFL(tab[T_ABASE + e]) + (c ? RFL(tab[T_CNT + 2 * e]) : 0) + mt * 256; u.pn = pn; u.e = e;
            u.nrows = (n - mt * 256) < 256 ? (n - mt * 256) : 256; u.orow0 = RFL(tab[T_YBASE + 64 * c + e]) + mt * 256; return true; }
        const int r = L - a; if (r >= 16) return false;
        const int mt = x + 8 * (r >> 2), pn = r & 3;
        u.B = (const char*)(wd + ((size_t)64 * DM + pn * 256) * EFF); u.m0 = ACT_SHARED_ROW0 + c * CHTOK + mt * 256; u.pn = pn; u.e = 64; u.nrows = 256; u.orow0 = YS_SHARED_ROW0 + mt * 256; return true;
    }
};

__device__ __forceinline__ void combine(Frame& F, int c) {
    const LAS int* tab = (const LAS int*)(F.lds + TAB_OFF);
    const int lane = F.lane, gw = F.vcu * NWAVES + F.wave, NGW = F.G * NWAVES;
    const bf16_t* ys = wsp<bf16_t>(F, WS_YS); const unsigned* TOKSLOT = wsp<unsigned>(F, WS_TOKSLOT); const float* mod = wsp<float>(F, WS_MOD);
    for (int tl = gw; tl < CHTOK; tl += NGW) {
        const int t = c * CHTOK + tl, b = t >> 11;
        int yr[9];
#pragma unroll
        for (int k = 0; k < 8; ++k) { const unsigned s = TOKSLOT[(size_t)t * 8 + k]; yr[k] = tab[T_YBASE + 64 * c + (int)(s >> 16)] + (int)(s & 0xffffu); }
        yr[8] = YS_SHARED_ROW0 + tl;
#pragma unroll
        for (int j = 0; j < 4; ++j) { const int c4 = 4 * lane + 256 * j; f32x4 s = {0.f, 0.f, 0.f, 0.f};
#pragma unroll
            for (int k = 0; k < 9; ++k) { const u32x2 w = *(const u32x2*)(ys + (size_t)yr[k] * DM + c4); s += (f32x4){bflo(w.x), bfhi(w.x), bflo(w.y), bfhi(w.y)}; }
            const f32x4 x1 = *(const f32x4*)(F.out + (size_t)t * DM + c4), g2 = *(const f32x4*)(mod + (size_t)b * 6144 + 5120 + c4);
            *(f32x4*)(F.out + (size_t)t * DM + c4) = x1 + g2 * s; }
    }
}
}
#ifndef PHMASK
#define PHMASK 0xffff
#endif
#define PH(k) ((PHMASK >> (k)) & 1)

__global__ void __launch_bounds__(NTHR, 2) fwd_megakernel(Args args) {
    const Args& A = args;
    extern __shared__ __attribute__((aligned(16))) unsigned char lds_raw[];
    Frame F;
    F.lds = (LAS unsigned char*)lds_raw;
    F.MISC = (volatile LAS unsigned*)(F.lds + MISC_OFF);
    F.tid = threadIdx.x; F.lane = F.tid & 63; F.wave = __builtin_amdgcn_readfirstlane(F.tid >> 6);
    F.G = gridDim.x; { const int bx = blockIdx.x; F.vcu = (F.G % 8 == 0) ? (bx % 8) * (F.G / 8) + bx / 8 : bx; }
    F.ws = args.ws; F.ctl = (gu32*)(args.ws + WS_CTL); F.out = args.out;
    for (int u = F.tid; u < (LDS_BYTES - LDSCTL_OFF) / 4; u += NTHR) ((LAS unsigned*)(F.lds + LDSCTL_OFF))[u] = 0u;
    __syncthreads();
    XcdBarrier bar = xcd_barrier_post((unsigned*)(F.ctl + CW_BAR), F.MISC + 8);
#define GRID_BAR() do { xcd_barrier(bar); F.refresh(); } while (0)
    const int bx = (int)blockIdx.x;

    if (PH(0)) p0_prologue(F, args);
    GRID_BAR();
    if (PH(1)) s1_modnorm(F, args);
    GRID_BAR();
    if (PH(2)) {
        pg8::Gemm g{wsp<bf16_t>(F, WS_H), DM, DM}; pg8::DenseSched S; S.init(NT, INPAD, DM, wsp<bf16_t>(F, WS_WIN), F.G, bx);
        epi::EpiInProj E{wsp<bf16_t>(F, WS_NAQ), wsp<bf16_t>(F, WS_NAK), wsp<bf16_t>(F, WS_NAV), wsp<bf16_t>(F, WS_QLAT), wsp<bf16_t>(F, WS_KVLAT), wsp<bf16_t>(F, WS_SGNA), wsp<bf16_t>(F, WS_SGMLA),
                          wsp<float>(F, WS_KROT), wsp<float>(F, WS_QSQ), wsp<float>(F, WS_KVSQ), INF(I_g_na_q), INF(I_g_na_k), wsp<float>(F, WS_RCOS), wsp<float>(F, WS_RSIN)};
        pg8::gemm_phase<epi::EpiInProj, pg8::DenseSched, false>(F.lds, g, S, E);
    }
    GRID_BAR();
    if (PH(3)) {
        pg8::Gemm g{wsp<bf16_t>(F, WS_QLAT), QRANK, QRANK}; pg8::DenseSched S; S.init(NT, MH * QKD, QRANK, wsp<bf16_t>(F, WS_WUQ), F.G, bx);
        epi::EpiUpQ E{wsp<bf16_t>(F, WS_QM), wsp<float>(F, WS_QSS), wsp<float>(F, WS_QSQ), INF(I_g_mla_q), wsp<float>(F, WS_RCOS), wsp<float>(F, WS_RSIN)};
        pg8::gemm_phase<epi::EpiUpQ, pg8::DenseSched, false>(F.lds, g, S, E);
    }
    if (PH(4)) {
        pg8::Gemm g{wsp<bf16_t>(F, WS_KVLAT), KVRANK, KVRANK}; pg8::DenseSched S; S.init(NT, MH * 128, KVRANK, wsp<bf16_t>(F, WS_WUKV), F.G, bx);
        epi::EpiUpKV E{wsp<bf16_t>(F, WS_KM), wsp<bf16_t>(F, WS_VM), wsp<float>(F, WS_KVSQ), wsp<float>(F, WS_KROT), INF(I_g_mla_k)};
        pg8::gemm_phase<epi::EpiUpKV, pg8::DenseSched, false>(F.lds, g, S, E);
    }
    GRID_BAR();
    if (PH(5)) s4_attention(F, args);
    GRID_BAR();
    if (PH(6)) {
        pg8::Gemm g{wsp<bf16_t>(F, WS_YNA), 512, 512}; pg8::DenseSched S; S.init(NT, DM, 512, wsp<bf16_t>(F, WS_WPNA), F.G, bx);
        epi::EpiMerge<1> E{wsp<bf16_t>(F, WS_SGNA), wsp<bf16_t>(F, WS_TMP), nullptr};
        pg8::gemm_phase<epi::EpiMerge<1>, pg8::DenseSched, false>(F.lds, g, S, E);
    }
    if (PH(7)) {
        pg8::Gemm g{wsp<bf16_t>(F, WS_YMLA), 512, 512}; pg8::DenseSched S; S.init(NT, DM, 512, wsp<bf16_t>(F, WS_WPMLA), F.G, bx);
        epi::EpiMerge<2> E{wsp<bf16_t>(F, WS_SGMLA), wsp<bf16_t>(F, WS_TMP), wsp<bf16_t>(F, WS_MERGED)};
        pg8::gemm_phase<epi::EpiMerge<2>, pg8::DenseSched, false>(F.lds, g, S, E);
    }
    GRID_BAR();
    if (PH(8)) {
        pg8::Gemm g{wsp<bf16_t>(F, WS_MERGED), DM, DM}; pg8::DenseSched S; S.init(NT, DM, DM, wsp<bf16_t>(F, WS_WOUT), F.G, bx);
        epi::EpiOut E{INF(I_x), F.out, wsp<float>(F, WS_MOD)};
        pg8::gemm_phase<epi::EpiOut, pg8::DenseSched, false>(F.lds, g, S, E);
    }
    GRID_BAR();
    if (PH(9)) moe::s7_router(F, args);
    GRID_BAR();
    moe::build_tables(F);
    if (PH(10)) {
        pg8::Gemm g{wsp<bf16_t>(F, WS_H2), DM, DM}; moe::GateUpSched S; S.init(F);
        epi::EpiGateUp E{wsp<bf16_t>(F, WS_ACT)};
        pg8::gemm_phase<epi::EpiGateUp, moe::GateUpSched, true>(F.lds, g, S, E);
    }
    GRID_BAR();
#pragma unroll 1
    for (int c = 0; c < NCHUNK; ++c) {
        if (PH(11)) {
            pg8::Gemm g{wsp<bf16_t>(F, WS_ACT), EFF, EFF}; moe::DownSched S; S.init(F, c);
            epi::EpiDown E{wsp<bf16_t>(F, WS_YS)};
            pg8::gemm_phase<epi::EpiDown, moe::DownSched, false>(F.lds, g, S, E);
        }
        GRID_BAR();
        if (PH(12)) moe::combine(F, c);
        if (c + 1 < NCHUNK) GRID_BAR();
    }
}

extern "C" void kernel_launch(void* const* d_in, const int* in_sizes, int n_in, void* d_out, int out_size, void* d_ws, size_t ws_size, hipStream_t stream) {
    static int grid = 0;
    if (grid == 0) {
        if (n_in != 28 || out_size != NT * DM || ws_size < WS_END) { fprintf(stderr, "kernel_launch: unexpected shapes: n_in %d out %d ws %zu (need %zu)\n", n_in, out_size, ws_size, (size_t)WS_END); grid = -1; return; }
        int dev = 0, cus = 0, per_cu = 0;
        if (hipGetDevice(&dev) != hipSuccess || hipDeviceGetAttribute(&cus, hipDeviceAttributeMultiprocessorCount, dev) != hipSuccess) { grid = -1; return; }
        if (hipFuncSetAttribute((const void*)fwd_megakernel, hipFuncAttributeMaxDynamicSharedMemorySize, LDS_BYTES) != hipSuccess) { fprintf(stderr, "kernel_launch: hipFuncSetAttribute failed\n"); grid = -1; return; }
        if (hipOccupancyMaxActiveBlocksPerMultiprocessor(&per_cu, (const void*)fwd_megakernel, NTHR, LDS_BYTES) != hipSuccess || per_cu < 1) { fprintf(stderr, "kernel_launch: occupancy query says %d blocks/CU\n", per_cu); (void)hipGetLastError(); }
        grid = cus;
        if (grid != 256) fprintf(stderr, "kernel_launch: %d CUs (expected 256)\n", grid);
    }
    if (grid < 0) return;
    if (hipMemsetAsync((char*)d_ws + WS_CTL, 0, CTL_ZERO_BYTES, stream) != hipSuccess) { fprintf(stderr, "kernel_launch: memset failed\n"); return; }
    Args a{};
    for (int i = 0; i < 28; ++i) a.in[i] = d_in[i];
    a.out = (float*)d_out; a.ws = (unsigned char*)d_ws;
    void* kargs[] = {&a};
    const hipError_t le = hipLaunchCooperativeKernel((const void*)fwd_megakernel, dim3(grid), dim3(NTHR), kargs, LDS_BYTES, stream);
    if (le != hipSuccess) fprintf(stderr, "kernel_launch: cooperative launch failed: %s (grid %d)\n", hipGetErrorName(le), grid);
}
```

```cpp
#include <hip/hip_runtime.h>
#include <cstdio>
#include <cstdint>
#include <cmath>

#define GAS __attribute__((address_space(1)))
#define LAS __attribute__((address_space(3)))
typedef unsigned short bf16_t;
typedef short bf16x8 __attribute__((ext_vector_type(8)));
typedef short s16x4 __attribute__((ext_vector_type(4)));
typedef float f32x4 __attribute__((ext_vector_type(4)));
typedef float f32x2 __attribute__((ext_vector_type(2)));
typedef float f32x16 __attribute__((ext_vector_type(16)));
typedef unsigned u32x4 __attribute__((ext_vector_type(4)));
typedef unsigned u32x2 __attribute__((ext_vector_type(2)));
typedef GAS unsigned gu32;

constexpr int DM = 1024, NB = 8, SEQ = 2048, NT = NB * SEQ;
constexpr int NAH = 8, NAD = 64, GRIDW = 64, GRIDR = SEQ / GRIDW;
constexpr int MH = 8, QRANK = 256, KVRANK = 128, NOPE = 64, ROPE = 32, VD = 64, QKD = 96;
constexpr int NEXP = 64, TOPK = 8, NGRP = 8, TOPKG = 4, EFF = 256;
constexpr float EPS = 1e-6f;
constexpr int INCOLS = 4000, INPAD = 4096;
constexpr int NCHUNK = 2, CHTOK = NT / NCHUNK;
constexpr int NWAVES = 8, NTHR = 512;

constexpr size_t MiB = 1u << 20;
constexpr size_t WS_CTL = 0, CTL_ZERO_BYTES = 1 * MiB;
constexpr size_t WS_MOD   = 1 * MiB;
constexpr size_t WS_RCOS  = WS_MOD + 256 * 1024;
constexpr size_t WS_RSIN  = WS_RCOS + 1 * MiB;
constexpr size_t WS_RFRAG = WS_RSIN + 1 * MiB;
constexpr size_t WS_QSQ   = WS_RFRAG + 256 * 1024;
constexpr size_t WS_KVSQ  = WS_QSQ + 256 * 1024;
constexpr size_t WS_QSS   = WS_KVSQ + 256 * 1024;
constexpr size_t WS_TOKSLOT = WS_QSS + 1 * MiB;
constexpr size_t WS_LIST  = 6 * MiB;
constexpr size_t WS_WLIST = 10 * MiB;
constexpr size_t WS_WIN   = 14 * MiB;
constexpr size_t WS_WUQ   = 22 * MiB;
constexpr size_t WS_WUKV  = WS_WUQ + 512 * 1024;
constexpr size_t WS_WPNA  = 23 * MiB;
constexpr size_t WS_WPMLA = 24 * MiB;
constexpr size_t WS_WOUT  = 25 * MiB;
constexpr size_t WS_KROT  = 27 * MiB;
constexpr size_t WS_B     = 30 * MiB;
constexpr size_t WS_H     = WS_B + 0 * MiB;
constexpr size_t WS_QM    = WS_B + 0 * MiB;
constexpr size_t WS_NAQ   = WS_B + 32 * MiB;
constexpr size_t WS_NAK   = WS_B + 48 * MiB;
constexpr size_t WS_NAV   = WS_B + 64 * MiB;
constexpr size_t WS_QLAT  = WS_B + 80 * MiB;
constexpr size_t WS_KVLAT = WS_B + 88 * MiB;
constexpr size_t WS_SGNA  = WS_B + 96 * MiB;
constexpr size_t WS_SGMLA = WS_B + 128 * MiB;
constexpr size_t WS_KM    = WS_B + 160 * MiB;
constexpr size_t WS_VM    = WS_B + 185 * MiB;
constexpr size_t WS_YNA   = WS_B + 201 * MiB;
constexpr size_t WS_YMLA  = WS_B + 217 * MiB;
constexpr size_t WS_TMP   = WS_B + 32 * MiB;
constexpr size_t WS_MERGED= WS_B + 64 * MiB;
constexpr size_t WS_WD    = WS_B + 0 * MiB;
constexpr size_t WS_ACT   = WS_B + 33 * MiB;
constexpr size_t WS_WGU   = WS_B + 109 * MiB;
constexpr size_t WS_H2    = WS_B + 174 * MiB;
constexpr size_t WS_YS    = WS_B + 109 * MiB;
constexpr size_t WS_END   = WS_B + 262 * MiB;
constexpr int ACT_SHARED_ROW0 = NT * TOPK;
constexpr int YS_SHARED_ROW0 = CHTOK * TOPK;
constexpr int CW_BAR = 4096;
constexpr int CW_CNT = 16384;

constexpr int RING_BYTES = 131072;
constexpr int LDSCTL_OFF = RING_BYTES, MISC_OFF = LDSCTL_OFF + 320;
constexpr int TAB_OFF = RING_BYTES + 1024;
constexpr int LDS_BYTES = 147456;

#define LDS_WAIT() asm volatile("s_waitcnt lgkmcnt(0)" ::: "memory")
#define VM_WAIT() asm volatile("s_waitcnt vmcnt(0)" ::: "memory")
#define SBAR() __builtin_amdgcn_sched_barrier(0)
#define RLX_AGENT __ATOMIC_RELAXED, __HIP_MEMORY_SCOPE_AGENT

__device__ __forceinline__ unsigned f2bf(float f) { unsigned u = __builtin_bit_cast(unsigned, f); return (u + 0x7fffu + ((u >> 16) & 1u)) >> 16; }
__device__ __forceinline__ unsigned pk2(float lo, float hi) { return f2bf(lo) | (f2bf(hi) << 16); }
__device__ __forceinline__ unsigned cvt_pk_bf16(float lo, float hi) { unsigned r; asm volatile("v_cvt_pk_bf16_f32 %0, %1, %2" : "=v"(r) : "v"(lo), "v"(hi)); return r; }
__device__ __forceinline__ float bf2f(unsigned short b) { return __builtin_bit_cast(float, (unsigned)b << 16); }
__device__ __forceinline__ float bflo(unsigned w) { return __builtin_bit_cast(float, w << 16); }
__device__ __forceinline__ float bfhi(unsigned w) { return __builtin_bit_cast(float, w & 0xffff0000u); }
__device__ __forceinline__ float wave_sum(float v) {
#pragma unroll
    for (int o = 1; o < 64; o <<= 1) v += __shfl_xor(v, o);
    return v;
}
__device__ __forceinline__ float sigmoidf_fast(float v) { return __builtin_amdgcn_rcpf(1.0f + __expf(-v)); }
__device__ __forceinline__ float siluf_fast(float v) { return v * sigmoidf_fast(v); }
__device__ __forceinline__ float sq4(f32x4 a) { return (a[0] * a[0] + a[1] * a[1]) + (a[2] * a[2] + a[3] * a[3]); }

struct Args { const void* in[28]; float* out; unsigned char* ws; };
enum { I_x = 0, I_c = 1, I_positions = 2, I_w_ada = 3, I_b_ada = 4, I_g_norm1 = 5, I_w_in = 6, I_g_na_q = 7, I_g_na_k = 8, I_na_rpb = 9, I_g_q_lat = 10, I_w_uq = 11, I_g_kv_lat = 12, I_w_ukv = 13, I_g_mla_q = 14, I_g_mla_k = 15, I_w_proj_na = 16, I_w_proj_mla = 17, I_w_out = 18, I_g_norm2 = 19, I_w_router = 20, I_e_bias = 21, I_w_eg = 22, I_w_eu = 23, I_w_ed = 24, I_w_sg = 25, I_w_su = 26, I_w_sd = 27 };
#define INF(k) ((const float*)A.in[k])
namespace pg8 {
constexpr int BM = 256, BK = 64, HALF = 128, HTB = HALF * BK * 2, STAGE_BYTES = 8 * HTB, NXCD = 8, WGM = 8;
__host__ __device__ __forceinline__ int lds_byte(int r, int c) { const int st = (r >> 4) * 2 + (c >> 5), rr = r & 15, cc = c & 31, ob = rr * 64 + cc * 2; return st * 1024 + (ob ^ (((ob >> 9) & 1) << 5)); }
__host__ __device__ __forceinline__ void stage_rc(int b, int& R, int& C) { const int st = b / 1024, sb = b % 1024, swz = sb ^ (((sb >> 9) & 1) << 5); R = (st >> 1) * 16 + swz / 64; C = (st & 1) * 32 + (swz % 64) / 2; }
__host__ __device__ __forceinline__ int perm32(int rho) { const int n = rho >> 4, i = rho & 15; return 8 * (i >> 2) + 4 * n + (i & 3); }

struct Unit {
    const char* B;
    int m0;
    int pn;
    int e;
    int nrows;
    int orow0;
    const int* l0; const int* l1; int n0, ntot;
};
struct Gemm { const bf16_t* A; int lda; int K; };

template <class Epi, class Sched, bool GATHER>
__device__ __forceinline__ void gemm_phase(LAS unsigned char* lds, const Gemm g, Sched& S, const Epi& E) {
    int tid_ = threadIdx.x; asm volatile("" : "+v"(tid_));
    const int tid = tid_, wid = __builtin_amdgcn_readfirstlane(tid >> 6), lane = tid & 63, wr = wid >> 2, wc = wid & 3, fr = lane & 15, fq = lane >> 4;
    const int K = g.K, nt = K / BK;
    unsigned voffB[2], voffA[2];
#pragma unroll
    for (int i = 0; i < 2; ++i) { int R, C; stage_rc(tid * 16 + i * 8192, R, C); const int Rb = Epi::PERM ? ((R & ~31) + perm32(R & 31)) : R;
        voffA[i] = (unsigned)(R * g.lda + C) * 2u; voffB[i] = (unsigned)(Rb * K + C) * 2u; }
    const size_t hstepA = (size_t)HALF * g.lda * 2;
    const size_t kstep = (size_t)(BK * 2);
    const size_t hstepB = (size_t)HALF * K * 2;
    const unsigned ldsw = (unsigned)wid * 1024u;
    const int aoff = lds_byte(wr * 64 + fr, fq * 8), boff = lds_byte(wc * 32 + fr, fq * 8);
    const char* Abase = (const char*)g.A;
#define PG8_SA(b, h) (((b) * 2 + (h)) * HTB)
#define PG8_SB(b, h) ((4 + (b) * 2 + (h)) * HTB)
#define PG8_STAGE(bufoff, gbase, voff) do { _Pragma("unroll") for (int _i = 0; _i < 2; ++_i) \
        __builtin_amdgcn_global_load_lds((const unsigned*)((const char*)(gbase) + (voff)[_i]), (LAS unsigned*)(lds + (bufoff) + ldsw + _i * 8192), 16, 0, 0); } while (0)
#define PG8_LDA(dst, b, h) do { _Pragma("unroll") for (int m = 0; m < 4; ++m) _Pragma("unroll") for (int k = 0; k < 2; ++k) dst[m][k] = *(const LAS bf16x8*)(lds + PG8_SA(b, h) + aoff + m * 2048 + k * 1024); } while (0)
#define PG8_LDB(dst, b, h) do { _Pragma("unroll") for (int n = 0; n < 2; ++n) _Pragma("unroll") for (int k = 0; k < 2; ++k) dst[n][k] = *(const LAS bf16x8*)(lds + PG8_SB(b, h) + boff + n * 2048 + k * 1024); } while (0)
#define PG8_MMA(ai, bj, At, Bt) do { __builtin_amdgcn_s_setprio(1); _Pragma("unroll") for (int m = 0; m < 4; ++m) _Pragma("unroll") for (int n = 0; n < 2; ++n) _Pragma("unroll") for (int k = 0; k < 2; ++k) \
        acc[ai][bj][m][n] = __builtin_amdgcn_mfma_f32_16x16x32_bf16(Bt[n][k], At[m][k], acc[ai][bj][m][n], 0, 0, 0); __builtin_amdgcn_s_setprio(0); } while (0)
#define PG8_WAIT_V(n) asm volatile("s_waitcnt vmcnt(" #n ")" ::: "memory")
#define PG8_WAIT_L(n) asm volatile("s_waitcnt lgkmcnt(" #n ")" ::: "memory")
#define PG8_BAR __builtin_amdgcn_s_barrier()
#define PG8_SCHED __builtin_amdgcn_sched_barrier(0)
#define PG8_VOFF(dst, u) do { _Pragma("unroll") for (int _h = 0; _h < 2; ++_h) _Pragma("unroll") for (int _i = 0; _i < 2; ++_i) { \
        int _R, _C; stage_rc(tid * 16 + _i * 8192, _R, _C); int _r = (u).m0 + _h * HALF + _R; \
        if ((u).l0) { _r = _r < (u).ntot ? _r : (u).ntot - 1; _r = _r < (u).n0 ? (u).l0[_r] : (u).l1[_r - (u).n0]; } \
        dst[_h][_i] = (unsigned)(_r * g.lda + _C) * 2u; } } while (0)
#define PG8_STA(bufoff, sel_next, h, kt) do { if constexpr (GATHER) { PG8_STAGE(bufoff, Abase + (size_t)(kt) * kstep, ((sel_next) ? nvo[h] : cvo[h])); } \
        else { PG8_STAGE(bufoff, ((sel_next) ? nA : cA) + (h) * hstepA + (size_t)(kt) * kstep, voffA); } } while (0)
    Unit cur, nxt; int ui = 0;
    if (!S.next(0, cur)) return;
    f32x4 acc[2][2][4][2];
#pragma unroll
    for (int a = 0; a < 2; ++a)
#pragma unroll
        for (int b = 0; b < 2; ++b)
#pragma unroll
            for (int m = 0; m < 4; ++m)
#pragma unroll
                for (int n = 0; n < 2; ++n) acc[a][b][m][n] = (f32x4){0.f, 0.f, 0.f, 0.f};
    bf16x8 At[4][2], B0[2][2], B1[2][2];
    unsigned cvo[2][2], nvo[2][2];
    const char* cA = Abase; const char* nA = Abase;
    if constexpr (GATHER) { PG8_VOFF(cvo, cur); } else { cA = Abase + (size_t)cur.m0 * g.lda * 2; }
    const char* cB = cur.B;
    PG8_STAGE(PG8_SB(0, 0), cB, voffB); PG8_STAGE(PG8_SB(0, 1), cB + hstepB, voffB); PG8_STA(PG8_SA(0, 0), false, 0, 0); PG8_STA(PG8_SA(0, 1), false, 1, 0);
    if (wr == 1) PG8_BAR;
    PG8_WAIT_V(2); PG8_BAR;
    PG8_STAGE(PG8_SB(1, 0), cB + kstep, voffB); PG8_STA(PG8_SA(1, 0), false, 0, 1); PG8_STAGE(PG8_SB(1, 1), cB + hstepB + kstep, voffB);
    PG8_WAIT_V(6); PG8_BAR;
    for (;;) {
        const bool has_next = S.next(ui + 1, nxt);
        if constexpr (GATHER) {
            if (has_next) { PG8_VOFF(nvo, nxt); }
            else {
#pragma unroll
                for (int h = 0; h < 2; ++h)
#pragma unroll
                    for (int i = 0; i < 2; ++i) nvo[h][i] = cvo[h][i];
            }
        } else { nA = has_next ? Abase + (size_t)nxt.m0 * g.lda * 2 : cA; }
        const char* nB = has_next ? nxt.B : cB;
        for (int t = 0; t < nt; t += 2) {
            const bool last = (t == nt - 2);
            const int kt2 = last ? 0 : t + 2;
            const char* b2 = last ? nB : cB + (size_t)(t + 2) * kstep; const char* b3 = b2 + kstep;
            PG8_LDB(B0, 0, 0); PG8_LDB(B1, 0, 1); PG8_SCHED; PG8_LDA(At, 0, 0); PG8_STA(PG8_SA(1, 1), false, 1, t + 1);
            PG8_WAIT_V(8); PG8_WAIT_L(0); PG8_BAR; PG8_MMA(0, 0, At, B0); PG8_MMA(0, 1, At, B1); PG8_BAR; PG8_SCHED;
            PG8_LDA(At, 0, 1); PG8_STAGE(PG8_SB(0, 0), b2, voffB); PG8_STAGE(PG8_SB(0, 1), b2 + hstepB, voffB); PG8_STA(PG8_SA(0, 0), last, 0, kt2);
            PG8_WAIT_V(8); PG8_WAIT_L(0); PG8_BAR; PG8_MMA(1, 0, At, B0); PG8_MMA(1, 1, At, B1); PG8_BAR; PG8_SCHED;
            PG8_LDB(B0, 1, 0); PG8_LDB(B1, 1, 1); PG8_SCHED; PG8_LDA(At, 1, 0); PG8_STA(PG8_SA(0, 1), last, 1, kt2);
            PG8_WAIT_V(8); PG8_WAIT_L(0); PG8_BAR; PG8_MMA(0, 0, At, B0); PG8_MMA(0, 1, At, B1); PG8_BAR; PG8_SCHED;
            PG8_LDA(At, 1, 1); PG8_STAGE(PG8_SB(1, 0), b3, voffB); PG8_STAGE(PG8_SB(1, 1), b3 + hstepB, voffB); PG8_STA(PG8_SA(1, 0), last, 0, kt2 + 1);
            PG8_WAIT_V(8); PG8_WAIT_L(0); PG8_BAR; PG8_MMA(1, 0, At, B0); PG8_MMA(1, 1, At, B1); PG8_BAR; PG8_SCHED;
        }
        if (wr == 0) PG8_BAR;
        { int t2 = threadIdx.x; asm volatile("" : "+v"(t2)); const int l2 = t2 & 63; E(acc, cur, wr, wc, l2 & 15, l2 >> 4); }
        if (!has_next) break;
#pragma unroll
        for (int a = 0; a < 2; ++a)
#pragma unroll
            for (int b = 0; b < 2; ++b)
#pragma unroll
                for (int m = 0; m < 4; ++m)
#pragma unroll
                    for (int n = 0; n < 2; ++n) acc[a][b][m][n] = (f32x4){0.f, 0.f, 0.f, 0.f};
        cur = nxt; cB = nB; cA = nA; ++ui;
        if constexpr (GATHER) {
#pragma unroll
            for (int h = 0; h < 2; ++h)
#pragma unroll
                for (int i = 0; i < 2; ++i) cvo[h][i] = nvo[h][i];
        }
        if (wr == 1) PG8_BAR;
    }
    PG8_WAIT_V(0);
    PG8_BAR;
#undef PG8_SA
#undef PG8_SB
#undef PG8_STAGE
#undef PG8_LDA
#undef PG8_LDB
#undef PG8_MMA
#undef PG8_WAIT_V
#undef PG8_WAIT_L
#undef PG8_BAR
#undef PG8_SCHED
#undef PG8_VOFF
#undef PG8_STA
}

struct DenseSched {
    int nM, nN, nwg, G, c; const bf16_t* Bt; int K;
    __device__ void init(int M, int N, int K_, const bf16_t* Bt_, int G_, int c_) { nM = M / BM; nN = N / BM; nwg = nM * nN; G = G_; c = c_; Bt = Bt_; K = K_; }
    __device__ bool next(int i, Unit& u) const {
        const long L = (long)i * G + c; if (L >= nwg) return false;
        int wgid = (int)L; { const int q = nwg / NXCD, r = nwg % NXCD, xcd = wgid % NXCD, off = wgid / NXCD; wgid = (xcd < r ? xcd * (q + 1) : r * (q + 1) + (xcd - r) * q) + off; }
        const int nig = WGM * nN, gid = wgid / nig, fm = gid * WGM, gsz = (nM - fm) < WGM ? (nM - fm) : WGM;
        const int pm = fm + ((wgid % nig) % gsz), pn = (wgid % nig) / gsz;
        u.B = (const char*)Bt + (size_t)pn * BM * K * 2; u.m0 = pm * BM; u.pn = pn; u.e = pm; u.nrows = BM; u.orow0 = pm * BM; u.l0 = nullptr; u.l1 = nullptr; u.n0 = 0; u.ntot = 0;
        return true;
    }
};
}
#define XB_TMO      128
#define XB_XCNT(j)  (256  + 64 * (j))
#define XB_XSUB(j)  (1280 + 64 * (j))
#define XB_XGEN(j)  (2304 + 64 * (j))
#define XB_TOP      3328
#define XB_TOPGEN   3392
#define XCD_BAR_WORDS 3456
#define XB_SPIN_CAP (1u << 18)

__device__ __forceinline__ unsigned xb_ld(unsigned* p)              { return __hip_atomic_load(p, __ATOMIC_RELAXED, __HIP_MEMORY_SCOPE_AGENT); }
__device__ __forceinline__ unsigned xb_add(unsigned* p, unsigned v) { return __hip_atomic_fetch_add(p, v, __ATOMIC_RELAXED, __HIP_MEMORY_SCOPE_AGENT); }
__device__ __forceinline__ unsigned xb_xcc_id() { return (unsigned)__builtin_amdgcn_s_getreg((3 << 11) | 20) & 0xFu; }
#define XB_SPIN(cond, bar) do { unsigned _sp = 0; while (cond) { __builtin_amdgcn_s_sleep(1); \
    if ((++_sp & 255u) == 0u) { if (xb_ld(&(bar)[XB_TMO])) break; if (_sp > XB_SPIN_CAP) { atomicAdd(&(bar)[XB_TMO], 1u); break; } } } } while (0)

struct XcdBarrier { unsigned* bar; unsigned x; volatile LAS unsigned* st; };

__device__ __forceinline__ XcdBarrier xcd_barrier_post(unsigned* bar, volatile LAS unsigned* st) {
    XcdBarrier b; b.bar = bar; b.x = xb_xcc_id(); b.st = st;
    if (threadIdx.x == 0) (void)xb_add(&bar[XB_XCNT(b.x)], 1u);
    return b;
}
__device__ __forceinline__ void xcd_barrier_complete(unsigned* bar, unsigned x, unsigned& nloc, unsigned& nx) {
    const unsigned G = gridDim.x * gridDim.y * gridDim.z;
    unsigned sum, cnt, mine, sp = 0u;
    for (;;) {
        sum = 0u; cnt = 0u; mine = 0u;
#pragma unroll
        for (unsigned j = 0; j < 16; ++j) { const unsigned c = xb_ld(&bar[XB_XCNT(j)]); sum += c; cnt += (c > 0u) ? 1u : 0u; mine = (j == x) ? c : mine; }
        if (sum == G) break;
        __builtin_amdgcn_s_sleep(1);
        if ((++sp & 255u) == 0u) { if (xb_ld(&bar[XB_TMO])) break; if (sp > XB_SPIN_CAP) { atomicAdd(&bar[XB_TMO], 1u); break; } }
    }
    nloc = mine > 0u ? mine : 1u; nx = cnt > 0u ? cnt : 1u;
}
__device__ __forceinline__ void xcd_barrier(const XcdBarrier& b) {
    asm volatile("s_waitcnt vmcnt(0)" ::: "memory");
    __syncthreads();
    int tid_ = threadIdx.x; asm volatile("" : "+v"(tid_));
    if (tid_ == 0) {
        unsigned* bar = b.bar; asm volatile("" : "+s"(bar)); unsigned bx_ = b.x; asm volatile("" : "+s"(bx_));
        __builtin_amdgcn_s_waitcnt(0);
        unsigned nloc = b.st[0], nx = b.st[1];
        if (nloc == 0u) { xcd_barrier_complete(bar, bx_, nloc, nx); b.st[0] = nloc; b.st[1] = nx; }
        const unsigned old = xb_add(&bar[XB_XSUB(bx_)], 1u);
        const unsigned gen = old / nloc;
        if (old + 1u == (gen + 1u) * nloc) {
            __builtin_amdgcn_fence(__ATOMIC_RELEASE, "agent");
            asm volatile("s_waitcnt vmcnt(0)" ::: "memory");
            const unsigned og = xb_add(&bar[XB_TOP], 1u);
            const unsigned tg = og / nx;
            if (og + 1u == (tg + 1u) * nx) xb_add(&bar[XB_TOPGEN], 1u);
            else XB_SPIN(xb_ld(&bar[XB_TOPGEN]) == tg, bar);
            __builtin_amdgcn_fence(__ATOMIC_ACQUIRE, "agent");
            xb_add(&bar[XB_XGEN(bx_)], 1u);
            asm volatile("s_waitcnt vmcnt(0)" ::: "memory");
        } else {
            XB_SPIN(xb_ld(&bar[XB_XGEN(bx_)]) == gen, bar);
            __builtin_amdgcn_fence(__ATOMIC_ACQUIRE, "agent");
            asm volatile("s_waitcnt vmcnt(0)" ::: "memory");
        }
    }
    __syncthreads();
}
namespace epi {
using pg8::Unit;
__device__ __forceinline__ u32x4 pack8(f32x4 a, f32x4 b) { u32x4 w; w.x = cvt_pk_bf16(a[0], a[1]); w.y = cvt_pk_bf16(a[2], a[3]); w.z = cvt_pk_bf16(b[0], b[1]); w.w = cvt_pk_bf16(b[2], b[3]); return w; }

__device__ __forceinline__ float red_fq(float s) { s += __shfl_xor(s, 16); s += __shfl_xor(s, 32); return s; }
__device__ __forceinline__ void unpack8(u32x4 w, f32x4& a, f32x4& b) { a = (f32x4){bflo(w.x), bfhi(w.x), bflo(w.y), bfhi(w.y)}; b = (f32x4){bflo(w.z), bfhi(w.z), bflo(w.w), bfhi(w.w)}; }
__device__ __forceinline__ void rope32(f32x4 (&v)[2], const float* cs, const float* sn, int fq) {
#pragma unroll
    for (int n = 0; n < 2; ++n) {
        const f32x4 c4 = *(const f32x4*)(cs + 8 * (fq & 1) + 4 * n), s4 = *(const f32x4*)(sn + 8 * (fq & 1) + 4 * n);
        f32x4 p; p[0] = __shfl_xor(v[n][0], 32); p[1] = __shfl_xor(v[n][1], 32); p[2] = __shfl_xor(v[n][2], 32); p[3] = __shfl_xor(v[n][3], 32);
        v[n] = (fq < 2) ? (v[n] * c4 - p * s4) : (v[n] * c4 + p * s4);
    }
}

struct EpiInProj {
    static constexpr bool PERM = true;
    bf16_t *naq, *nak, *nav, *qlat, *kvlat, *sgna, *sgmla; float *krot, *qsq, *kvsq; const float *gq, *gk, *rcos, *rsin;
    __device__ __forceinline__ void operator()(const f32x4 (&acc)[2][2][4][2], const Unit& u, int wr, int wc, int fr, int fq) const {
        const int pn = u.pn, row0 = u.orow0 + wr * 64 + fr;
        if (pn < 4) {
            bf16_t* dst = pn < 2 ? naq : nak; const float* g = pn < 2 ? gq : gk; const int head = (pn & 1) * 4 + wc;
            f32x4 gv[2][2];
#pragma unroll
            for (int bj = 0; bj < 2; ++bj)
#pragma unroll
                for (int n = 0; n < 2; ++n) gv[bj][n] = *(const f32x4*)(g + 32 * bj + 8 * fq + 4 * n);
#pragma unroll
            for (int ai = 0; ai < 2; ++ai)
#pragma unroll
                for (int m = 0; m < 4; ++m) {
                    float ss = (sq4(acc[ai][0][m][0]) + sq4(acc[ai][0][m][1])) + (sq4(acc[ai][1][m][0]) + sq4(acc[ai][1][m][1]));
                    ss = red_fq(ss); const float rstd = rsqrtf(ss * (1.0f / 64.0f) + EPS);
                    bf16_t* rp = dst + (size_t)(row0 + ai * 128 + m * 16) * 512 + head * 64 + 8 * fq;
#pragma unroll
                    for (int bj = 0; bj < 2; ++bj) *(u32x4*)(rp + 32 * bj) = pack8(acc[ai][bj][m][0] * rstd * gv[bj][0], acc[ai][bj][m][1] * rstd * gv[bj][1]);
                }
        } else if (pn < 6) {
#pragma unroll
            for (int ai = 0; ai < 2; ++ai)
#pragma unroll
                for (int m = 0; m < 4; ++m) { bf16_t* rp = nav + (size_t)(row0 + ai * 128 + m * 16) * 512 + (pn - 4) * 256 + wc * 32 + 8 * fq;
#pragma unroll
                    for (int bj = 0; bj < 2; ++bj) *(u32x4*)(rp + 128 * bj) = pack8(acc[ai][bj][m][0], acc[ai][bj][m][1]); }
        } else if (pn == 6) {
#pragma unroll
            for (int ai = 0; ai < 2; ++ai)
#pragma unroll
                for (int m = 0; m < 4; ++m) { const int row = row0 + ai * 128 + m * 16; bf16_t* rp = qlat + (size_t)row * 256 + wc * 32 + 8 * fq;
                    float ss = (sq4(acc[ai][0][m][0]) + sq4(acc[ai][0][m][1])) + (sq4(acc[ai][1][m][0]) + sq4(acc[ai][1][m][1]));
                    ss = red_fq(ss); if (fq == 0) qsq[(size_t)row * 4 + wc] = ss;
#pragma unroll
                    for (int bj = 0; bj < 2; ++bj) *(u32x4*)(rp + 128 * bj) = pack8(acc[ai][bj][m][0], acc[ai][bj][m][1]); }
        } else if (pn == 7) {
#pragma unroll
            for (int ai = 0; ai < 2; ++ai)
#pragma unroll
                for (int m = 0; m < 4; ++m) { const int row = row0 + ai * 128 + m * 16;
                    float ss = sq4(acc[ai][0][m][0]) + sq4(acc[ai][0][m][1]);
                    ss = red_fq(ss); if (fq == 0) kvsq[(size_t)row * 4 + wc] = ss;
                    *(u32x4*)(kvlat + (size_t)row * 128 + wc * 32 + 8 * fq) = pack8(acc[ai][0][m][0], acc[ai][0][m][1]);
                    if (wc == 0) { f32x4 v[2] = {acc[ai][1][m][0], acc[ai][1][m][1]};
                        rope32(v, rcos + (size_t)row * 16, rsin + (size_t)row * 16, fq);
                        *(f32x4*)(krot + (size_t)row * 32 + 8 * fq) = v[0]; *(f32x4*)(krot + (size_t)row * 32 + 8 * fq + 4) = v[1]; } }
        } else {
            bf16_t* dst = pn < 12 ? sgna : sgmla; const int cb = ((pn - 8) & 3) * 256 + wc * 32 + 8 * fq;
#pragma unroll
            for (int ai = 0; ai < 2; ++ai)
#pragma unroll
                for (int m = 0; m < 4; ++m) { bf16_t* rp = dst + (size_t)(row0 + ai * 128 + m * 16) * 1024 + cb;
#pragma unroll
                    for (int bj = 0; bj < 2; ++bj) { f32x4 a = acc[ai][bj][m][0], b = acc[ai][bj][m][1];
#pragma unroll
                        for (int e = 0; e < 4; ++e) { a[e] = sigmoidf_fast(a[e]); b[e] = sigmoidf_fast(b[e]); }
                        *(u32x4*)(rp + 128 * bj) = pack8(a, b); } }
        }
    }
};

struct EpiUpQ {
    static constexpr bool PERM = true;
    bf16_t* qm; float* qss; const float* qsq; const float* g; const float *rcos, *rsin;
    __device__ __forceinline__ void operator()(const f32x4 (&acc)[2][2][4][2], const Unit& u, int wr, int wc, int fr, int fq) const {
        const int pn = u.pn, row0 = u.orow0 + wr * 64 + fr;
#pragma unroll
        for (int ai = 0; ai < 2; ++ai)
#pragma unroll
            for (int m = 0; m < 4; ++m) {
                const int row = row0 + ai * 128 + m * 16, b = row >> 11, s = row & 2047;
                const f32x4 sq = *(const f32x4*)(qsq + (size_t)row * 4);
                const float rstd = rsqrtf(((sq[0] + sq[1]) + (sq[2] + sq[3])) * (1.0f / 256.0f) + EPS);
                if (pn < 2) {
                    const int head = pn * 4 + wc;
                    f32x4 v[2][2]; float ss = 0.f;
#pragma unroll
                    for (int bj = 0; bj < 2; ++bj)
#pragma unroll
                        for (int n = 0; n < 2; ++n) { v[bj][n] = acc[ai][bj][m][n] * rstd; ss += sq4(v[bj][n]); }
                    ss = red_fq(ss); if (fq == 0) qss[((size_t)row * 8 + head) * 2 + 0] = ss;
                    bf16_t* rp = qm + ((size_t)(b * 8 + head) * 2048 + s) * 96 + 8 * fq;
#pragma unroll
                    for (int bj = 0; bj < 2; ++bj) *(u32x4*)(rp + 32 * bj) = pack8(v[bj][0] * *(const f32x4*)(g + 32 * bj + 8 * fq), v[bj][1] * *(const f32x4*)(g + 32 * bj + 8 * fq + 4));
                } else {
#pragma unroll
                    for (int bj = 0; bj < 2; ++bj) { const int head = 2 * wc + bj;
                        f32x4 v[2] = {acc[ai][bj][m][0] * rstd, acc[ai][bj][m][1] * rstd};
                        float ss = sq4(v[0]) + sq4(v[1]); ss = red_fq(ss); if (fq == 0) qss[((size_t)row * 8 + head) * 2 + 1] = ss;
                        rope32(v, rcos + (size_t)row * 16, rsin + (size_t)row * 16, fq);
                        *(u32x4*)(qm + ((size_t)(b * 8 + head) * 2048 + s) * 96 + 64 + 8 * fq) = pack8(v[0] * *(const f32x4*)(g + 64 + 8 * fq), v[1] * *(const f32x4*)(g + 64 + 8 * fq + 4)); }
                }
            }
    }
};

struct EpiUpKV {
    static constexpr bool PERM = true;
    bf16_t *km, *vm; const float* kvsq; const float* krot; const float* g;
    __device__ __forceinline__ void operator()(const f32x4 (&acc)[2][2][4][2], const Unit& u, int wr, int wc, int fr, int fq) const {
        const int pn = u.pn, row0 = u.orow0 + wr * 64 + fr, head = 2 * pn + (wc >> 1);
#pragma unroll
        for (int ai = 0; ai < 2; ++ai)
#pragma unroll
            for (int m = 0; m < 4; ++m) {
                const int row = row0 + ai * 128 + m * 16, b = row >> 11, s = row & 2047;
                const f32x4 sq = *(const f32x4*)(kvsq + (size_t)row * 4);
                const float rstd = rsqrtf(((sq[0] + sq[1]) + (sq[2] + sq[3])) * (1.0f / 128.0f) + EPS);
                if ((wc & 1) == 0) {
                    f32x4 v[2][2]; float ss = 0.f;
#pragma unroll
                    for (int bj = 0; bj < 2; ++bj)
#pragma unroll
                        for (int n = 0; n < 2; ++n) { v[bj][n] = acc[ai][bj][m][n] * rstd; ss += sq4(v[bj][n]); }
                    const f32x4 k0 = *(const f32x4*)(krot + (size_t)row * 32 + 8 * fq), k1 = *(const f32x4*)(krot + (size_t)row * 32 + 8 * fq + 4);
                    ss += sq4(k0) + sq4(k1); ss = red_fq(ss);
                    const float r96 = rsqrtf(ss * (1.0f / 96.0f) + EPS);
                    bf16_t* rp = km + ((size_t)(b * 8 + head) * 2048 + s) * 96 + 8 * fq;
#pragma unroll
                    for (int bj = 0; bj < 2; ++bj) *(u32x4*)(rp + 32 * bj) = pack8(v[bj][0] * r96 * *(const f32x4*)(g + 32 * bj + 8 * fq), v[bj][1] * r96 * *(const f32x4*)(g + 32 * bj + 8 * fq + 4));
                    *(u32x4*)(rp + 64) = pack8(k0 * r96 * *(const f32x4*)(g + 64 + 8 * fq), k1 * r96 * *(const f32x4*)(g + 64 + 8 * fq + 4));
                } else {
                    bf16_t* rp = vm + ((size_t)(b * 8 + head) * 2048 + s) * 64 + 8 * fq;
#pragma unroll
                    for (int bj = 0; bj < 2; ++bj) *(u32x4*)(rp + 32 * bj) = pack8(acc[ai][bj][m][0] * rstd, acc[ai][bj][m][1] * rstd);
                }
            }
    }
};

template <int PASS> struct EpiMerge {
    static constexpr bool PERM = true;
    const bf16_t* sg; bf16_t* tmp; bf16_t* out;
    __device__ __forceinline__ void operator()(const f32x4 (&acc)[2][2][4][2], const Unit& u, int wr, int wc, int fr, int fq) const {
        const int row0 = u.orow0 + wr * 64 + fr, cb = u.pn * 256 + wc * 32 + 8 * fq;
#pragma unroll
        for (int ai = 0; ai < 2; ++ai)
#pragma unroll
            for (int m = 0; m < 4; ++m) { const size_t off = (size_t)(row0 + ai * 128 + m * 16) * 1024 + cb;
#pragma unroll
                for (int bj = 0; bj < 2; ++bj) { f32x4 ga, gb; unpack8(*(const u32x4*)(sg + off + 128 * bj), ga, gb);
                    f32x4 a = acc[ai][bj][m][0] * ga, b = acc[ai][bj][m][1] * gb;
                    if (PASS == 1) *(u32x4*)(tmp + off + 128 * bj) = pack8(a, b);
                    else { f32x4 ta, tb; unpack8(*(const u32x4*)(tmp + off + 128 * bj), ta, tb); *(u32x4*)(out + off + 128 * bj) = pack8(a + ta, b + tb); } } }
    }
};

struct EpiOut {
    static constexpr bool PERM = false;
    const float* x; float* x1; const float* mod;
    __device__ __forceinline__ void operator()(const f32x4 (&acc)[2][2][4][2], const Unit& u, int wr, int wc, int fr, int fq) const {
        const int row0 = u.orow0 + wr * 64 + fr, cb = u.pn * 256 + wc * 32 + 4 * fq, b = u.orow0 >> 11;
        f32x4 gt[2][2];
#pragma unroll
        for (int bj = 0; bj < 2; ++bj)
#pragma unroll
            for (int n = 0; n < 2; ++n) gt[bj][n] = *(const f32x4*)(mod + (size_t)b * 6144 + 2048 + cb + 128 * bj + 16 * n);
#pragma unroll
        for (int ai = 0; ai < 2; ++ai)
#pragma unroll
            for (int m = 0; m < 4; ++m) { const size_t off = (size_t)(row0 + ai * 128 + m * 16) * 1024 + cb;
#pragma unroll
                for (int bj = 0; bj < 2; ++bj)
#pragma unroll
                    for (int n = 0; n < 2; ++n) { const f32x4 xv = *(const f32x4*)(x + off + 128 * bj + 16 * n); *(f32x4*)(x1 + off + 128 * bj + 16 * n) = xv + gt[bj][n] * acc[ai][bj][m][n]; } }
    }
};

struct EpiGateUp {
    static constexpr bool PERM = true;
    bf16_t* act;
    __device__ __forceinline__ void operator()(const f32x4 (&acc)[2][2][4][2], const Unit& u, int wr, int wc, int fr, int fq) const {
        const int lr0 = wr * 64 + fr, cb = u.pn * 128 + wc * 32 + 8 * fq;
        const float* wl0 = u.l0 ? (const float*)((const char*)u.l0 + (WS_WLIST - WS_LIST)) : nullptr;
        const float* wl1 = u.l0 ? (const float*)((const char*)u.l1 + (WS_WLIST - WS_LIST)) : nullptr;
#pragma unroll
        for (int ai = 0; ai < 2; ++ai)
#pragma unroll
            for (int m = 0; m < 4; ++m) { const int lr = lr0 + ai * 128 + m * 16;
                if (lr < u.nrows) {
                    float w = 1.0f; if (wl0) { const int i = u.m0 + lr; w = i < u.n0 ? wl0[i] : wl1[i - u.n0]; }
                    f32x4 a = acc[ai][0][m][0], b = acc[ai][0][m][1];
#pragma unroll
                    for (int e = 0; e < 4; ++e) { a[e] = siluf_fast(a[e]) * acc[ai][1][m][0][e] * w; b[e] = siluf_fast(b[e]) * acc[ai][1][m][1][e] * w; }
                    *(u32x4*)(act + (size_t)(u.orow0 + lr) * 256 + cb) = pack8(a, b); } }
    }
};
struct EpiDown {
    static constexpr bool PERM = true;
    bf16_t* ys;
    __device__ __forceinline__ void operator()(const f32x4 (&acc)[2][2][4][2], const Unit& u, int wr, int wc, int fr, int fq) const {
        const int lr0 = wr * 64 + fr, cb = u.pn * 256 + wc * 32 + 8 * fq;
#pragma unroll
        for (int ai = 0; ai < 2; ++ai)
#pragma unroll
            for (int m = 0; m < 4; ++m) { const int lr = lr0 + ai * 128 + m * 16;
                if (lr < u.nrows) { bf16_t* rp = ys + (size_t)(u.orow0 + lr) * 1024 + cb;
#pragma unroll
                    for (int bj = 0; bj < 2; ++bj) *(u32x4*)(rp + 128 * bj) = pack8(acc[ai][bj][m][0], acc[ai][bj][m][1]); } }
    }
};
}
struct Frame {
    LAS unsigned char* lds;
    volatile LAS unsigned* MISC;
    gu32* ctl;
    int tid, lane, wave, vcu, G;
    unsigned char* ws;
    float* out;
    __device__ __forceinline__ void refresh() { int t = threadIdx.x; asm volatile("" : "+v"(t)); tid = t; lane = t & 63; wave = __builtin_amdgcn_readfirstlane(t >> 6);
        asm volatile("" : "+s"(ws)); asm volatile("" : "+s"(out)); ctl = (gu32*)(ws + WS_CTL); }
};
__device__ __forceinline__ int fresh_tid() { int t = threadIdx.x; asm volatile("" : "+v"(t)); return t; }
template <class T> __device__ __forceinline__ T* wsp(const Frame& F, size_t off) { return (T*)(F.ws + off); }

struct MapOff { int off; __device__ int operator()(int n) const { return n + off; } };
struct MapWin { __device__ int operator()(int n) const {
    if (n < 1024) { const int sec = n >> 9, nn = n & 511, hh = nn >> 6, d = nn & 63; return sec * 512 + (hh >> 2) * 256 + 128 * (d >> 5) + 32 * (hh & 3) + (d & 31); }
    return n < 1952 ? n : n + 96; } };
struct MapUq { __device__ int operator()(int n) const { const int hh = n / 96, d = n % 96;
    return d < 64 ? (hh >> 2) * 256 + 128 * (d >> 5) + 32 * (hh & 3) + (d & 31) : 512 + 128 * (hh & 1) + 32 * (hh >> 1) + (d - 64); } };
struct MapUkv { __device__ int operator()(int n) const { const int hh = n >> 7, d = n & 127, dd = d & 63, wcn = 2 * (hh & 1) + (d >> 6);
    return (hh >> 1) * 256 + 128 * (dd >> 5) + 32 * wcn + (dd & 31); } };
struct MapGU { int up; __device__ int operator()(int f) const { return (f >> 7) * 256 + up * 128 + (f & 127); } };

template <class Map> __device__ __forceinline__ void transpose_item(const float* W, int K, int N, bf16_t* WT, Map rm, const float* kscale, LAS float* scr, int item, int lane) {
    const int nblk = N / 32, kb = item / nblk, nb = item % nblk, k0 = 64 * kb, n0 = 32 * nb;
    float tv[32];
#pragma unroll
    for (int i = 0; i < 32; ++i) { const int kk = 2 * i + (lane >> 5); tv[i] = W[(size_t)(k0 + kk) * N + n0 + (lane & 31)]; }
#pragma unroll
    for (int i = 0; i < 32; ++i) { const int kk = 2 * i + (lane >> 5); float v = tv[i]; if (kscale) v *= kscale[k0 + kk]; scr[kk * 33 + (lane & 31)] = v; }
    LDS_WAIT(); asm volatile("" ::: "memory");
    const int c = lane & 7;
#pragma unroll
    for (int j = 0; j < 4; ++j) { const int n = (lane >> 3) + 8 * j; const LAS float* s = scr + (8 * c) * 33 + n;
        u32x4 o; o.x = pk2(s[0 * 33], s[1 * 33]); o.y = pk2(s[2 * 33], s[3 * 33]); o.z = pk2(s[4 * 33], s[5 * 33]); o.w = pk2(s[6 * 33], s[7 * 33]);
        *(u32x4*)(WT + (size_t)rm(n0 + n) * K + k0 + 8 * c) = o; }
    LDS_WAIT(); asm volatile("" ::: "memory");
}

__device__ __forceinline__ void p0_prologue(Frame& F, const Args& A) {
    const int tid = F.tid;
    {
        LAS float* sc = (LAS float*)F.lds;
        LAS float* part = (LAS float*)(F.lds + 32768);
        for (int i = tid; i < NB * DM; i += NTHR) { const float v = INF(I_c)[i]; sc[i] = v / (1.0f + expf(-v)); }
        __syncthreads();
        for (int n0 = 24 * (int)blockIdx.x; n0 < 6 * DM; n0 += 24 * F.G) {
        const int kk = tid >> 5, col = tid & 31;
        float a[8];
#pragma unroll
        for (int b = 0; b < 8; ++b) a[b] = 0.f;
        if (col < 24) {
#pragma unroll 1
            for (int k0 = kk; k0 < DM; k0 += 16 * 32) { float wv[32];
#pragma unroll
                for (int q = 0; q < 32; ++q) wv[q] = INF(I_w_ada)[(size_t)(k0 + 16 * q) * 6144 + n0 + col];
#pragma unroll
                for (int q = 0; q < 32; ++q) {
#pragma unroll
                    for (int b = 0; b < 8; ++b) a[b] = fmaf(sc[b * DM + k0 + 16 * q], wv[q], a[b]); } }
        }
#pragma unroll
        for (int b = 0; b < 8; ++b) part[(kk * 8 + b) * 32 + col] = a[b];
        __syncthreads();
        if (tid < 192) { const int b = tid / 24, cc = tid % 24; float s = 0.f;
#pragma unroll
            for (int q = 0; q < 16; ++q) s += part[(q * 8 + b) * 32 + cc];
            wsp<float>(F, WS_MOD)[(size_t)b * 6144 + n0 + cc] = s + INF(I_b_ada)[n0 + cc]; }
        __syncthreads();
        }
    }
    LAS float* scr = (LAS float*)(F.lds + F.wave * 16384);
    const int gw = F.vcu * NWAVES + F.wave, NGW = F.G * NWAVES;
    constexpr int I_IN = 16 * 125, I_UQ = 4 * 24, I_UKV = 2 * 32, I_PN = 8 * 32, I_OUT = 16 * 32;
    constexpr int NITEMS = I_IN + I_UQ + I_UKV + 2 * I_PN + I_OUT;
    for (int it = gw; it < NITEMS; it += NGW) {
        int r = it;
        if (r < I_IN) { transpose_item(INF(I_w_in), DM, INCOLS, wsp<bf16_t>(F, WS_WIN), MapWin{}, nullptr, scr, r, F.lane); continue; } r -= I_IN;
        if (r < I_UQ) { transpose_item(INF(I_w_uq), QRANK, MH * QKD, wsp<bf16_t>(F, WS_WUQ), MapUq{}, INF(I_g_q_lat), scr, r, F.lane); continue; } r -= I_UQ;
        if (r < I_UKV) { transpose_item(INF(I_w_ukv), KVRANK, MH * 128, wsp<bf16_t>(F, WS_WUKV), MapUkv{}, INF(I_g_kv_lat), scr, r, F.lane); continue; } r -= I_UKV;
        if (r < I_PN) { transpose_item(INF(I_w_proj_na), 512, DM, wsp<bf16_t>(F, WS_WPNA), MapOff{0}, nullptr, scr, r, F.lane); continue; } r -= I_PN;
        if (r < I_PN) { transpose_item(INF(I_w_proj_mla), 512, DM, wsp<bf16_t>(F, WS_WPMLA), MapOff{0}, nullptr, scr, r, F.lane); continue; } r -= I_PN;
        transpose_item(INF(I_w_out), DM, DM, wsp<bf16_t>(F, WS_WOUT), MapOff{0}, nullptr, scr, r, F.lane);
    }
    const int gt = F.vcu * NTHR + tid, NGT = F.G * NTHR;
    for (int i = gt; i < 96 * DM / 8; i += NGT) *(u32x4*)(wsp<bf16_t>(F, WS_WIN) + (size_t)1952 * DM + (size_t)i * 8) = (u32x4){0u, 0u, 0u, 0u};
    for (int i = gt; i < NT * 16; i += NGT) { const int t = i >> 4, q = i & 15;
        const float inv = powf(10000.0f, -(float)q / 16.0f), ang = (float)((const int*)A.in[I_positions])[t] * inv;
        wsp<float>(F, WS_RCOS)[i] = cosf(ang); wsp<float>(F, WS_RSIN)[i] = sinf(ang); }
    for (int i = gt; i < 4 * 64 * 64 * 4; i += NGT) { const int ct = i >> 14, j = (i >> 8) & 63, l = (i >> 2) & 63, q = i & 3;
        wsp<float>(F, WS_RFRAG)[i] = INF(I_w_router)[(size_t)(16 * j + 4 * (l >> 4) + q) * NEXP + 16 * ct + (l & 15)]; }
}

__device__ __forceinline__ void s1_modnorm(Frame& F, const Args& A) {
    const int gw = F.vcu * NWAVES + F.wave, lane = F.lane;
    const float* mod = wsp<float>(F, WS_MOD); bf16_t* H = wsp<bf16_t>(F, WS_H);
    for (int r0 = gw * 8; r0 < NT; r0 += F.G * NWAVES * 8) {
    const int b = r0 >> 11;
    f32x4 ca[4], cs[4];
#pragma unroll
    for (int j = 0; j < 4; ++j) { const int c4 = 4 * lane + 256 * j;
        const f32x4 g = *(const f32x4*)(INF(I_g_norm1) + c4), sc = *(const f32x4*)(mod + (size_t)b * 6144 + 1024 + c4);
        ca[j] = g * (sc + 1.0f); cs[j] = *(const f32x4*)(mod + (size_t)b * 6144 + c4); }
    for (int r = r0; r < r0 + 8; ++r) {
        f32x4 v[4]; float ss = 0.f;
#pragma unroll
        for (int j = 0; j < 4; ++j) { v[j] = *(const f32x4*)(INF(I_x) + (size_t)r * DM + 4 * lane + 256 * j); ss += sq4(v[j]); }
        const float rstd = rsqrtf(wave_sum(ss) * (1.0f / DM) + EPS);
#pragma unroll
        for (int j = 0; j < 4; ++j) { const f32x4 o = v[j] * rstd * ca[j] + cs[j]; u32x2 w; w.x = cvt_pk_bf16(o[0], o[1]); w.y = cvt_pk_bf16(o[2], o[3]);
            *(u32x2*)(H + (size_t)r * DM + 4 * lane + 256 * j) = w; }
    }
    }
}
namespace attn {
__device__ __forceinline__ int crow(int r, int hi) { return (r & 3) + 8 * (r >> 2) + 4 * hi; }
constexpr int KVBLK = 64;
constexpr int L_K = 0, L_V = 26624, L_WS = 43008, L_OST = 45056, L_BIAS = 77824, L_END = 79872;
constexpr int KBUF = 13312, VBUF = 8192;
constexpr float THRN = 8.0f;

template <int DQK> struct Geo { static constexpr int KROWB = DQK * 2 + 16, NCH = DQK / 8, ND0 = DQK / 16; };

__device__ __forceinline__ int v_st(int k, int c) { const int kk = (k & ~0xC) | ((k & 4) << 1) | ((k & 8) >> 1); return ((kk >> 3) * 2 + (c >> 5)) * 512 + ((kk & 7) * 32 + (c & 31)) * 2; }
__device__ __forceinline__ int v_rd_base(int lane) { return ((lane & 3) << 3) | (((lane >> 2) & 3) << 6) | (((lane >> 4) & 1) << 5) | (((lane >> 5) & 1) << 8); }
constexpr int v_rd_off(int d0, int ks, int half) { return d0 * 512 + ks * 2048 + half * 1024; }
template <int OFF> __device__ __forceinline__ s16x4 tr_read(int vb) { s16x4 r; asm volatile("ds_read_b64_tr_b16 %0, %1 offset:%2" : "=&v"(r) : "v"(vb), "i"(OFF) : "memory"); return r; }

template <int D0> __device__ __forceinline__ void pv_one(f32x16& od, int vb, bf16x8 pa0, bf16x8 pa1, bf16x8 pa2, bf16x8 pa3) {
    const s16x4 l0 = tr_read<v_rd_off(D0, 0, 0)>(vb), h0 = tr_read<v_rd_off(D0, 0, 1)>(vb), l1 = tr_read<v_rd_off(D0, 1, 0)>(vb), h1 = tr_read<v_rd_off(D0, 1, 1)>(vb);
    const s16x4 l2 = tr_read<v_rd_off(D0, 2, 0)>(vb), h2 = tr_read<v_rd_off(D0, 2, 1)>(vb), l3 = tr_read<v_rd_off(D0, 3, 0)>(vb), h3 = tr_read<v_rd_off(D0, 3, 1)>(vb);
    asm volatile("s_waitcnt lgkmcnt(0)" ::: "memory"); SBAR();
#define PK(L, H) (bf16x8){L[0], L[1], L[2], L[3], H[0], H[1], H[2], H[3]}
    od = __builtin_amdgcn_mfma_f32_32x32x16_bf16(pa0, PK(l0, h0), od, 0, 0, 0);
    od = __builtin_amdgcn_mfma_f32_32x32x16_bf16(pa1, PK(l1, h1), od, 0, 0, 0);
    od = __builtin_amdgcn_mfma_f32_32x32x16_bf16(pa2, PK(l2, h2), od, 0, 0, 0);
    od = __builtin_amdgcn_mfma_f32_32x32x16_bf16(pa3, PK(l3, h3), od, 0, 0, 0);
#undef PK
}

template <int DQK> __device__ __forceinline__ void qkt(f32x16& p0, f32x16& p1, const LAS unsigned char* Ks, const bf16x8* qr, int r32, int hi) {
    p0 = f32x16{}; p1 = f32x16{};
#pragma unroll
    for (int d0 = 0; d0 < Geo<DQK>::ND0; ++d0) { const int cb = (d0 * 16 + hi * 8) * 2;
        const bf16x8 b0 = *(const LAS bf16x8*)(Ks + r32 * Geo<DQK>::KROWB + cb);
        const bf16x8 b1 = *(const LAS bf16x8*)(Ks + (32 + r32) * Geo<DQK>::KROWB + cb);
        p0 = __builtin_amdgcn_mfma_f32_32x32x16_bf16(b0, qr[d0], p0, 0, 0, 0);
        p1 = __builtin_amdgcn_mfma_f32_32x32x16_bf16(b1, qr[d0], p1, 0, 0, 0); }
}
__device__ __forceinline__ void softmax_tile(f32x16& p0, f32x16& p1, float& m_reg, float& alpha, float& l_reg, float C, float thr_raw,
                                             bf16x8& pa0, bf16x8& pa1, bf16x8& pa2, bf16x8& pa3) {
    float pmax = p0[0];
#pragma unroll
    for (int r = 1; r < 16; ++r) pmax = fmaxf(pmax, p0[r]);
#pragma unroll
    for (int r = 0; r < 16; ++r) pmax = fmaxf(pmax, p1[r]);
    { auto rr = __builtin_amdgcn_permlane32_swap(__float_as_uint(pmax), __float_as_uint(pmax), false, false);
      pmax = fmaxf(__uint_as_float(rr[0]), __uint_as_float(rr[1])); }
    float mn;
    if (__builtin_expect(__all(pmax - m_reg <= thr_raw), 1)) { mn = m_reg; alpha = 1.f; }
    else { mn = fmaxf(m_reg, pmax); alpha = __builtin_amdgcn_exp2f((m_reg - mn) * C); m_reg = mn; }
    const float mnC = -mn * C;
#pragma unroll
    for (int r = 0; r < 16; ++r) { p0[r] = __builtin_amdgcn_exp2f(fmaf(p0[r], C, mnC)); p1[r] = __builtin_amdgcn_exp2f(fmaf(p1[r], C, mnC)); }
    float ps = 0;
#pragma unroll
    for (int r = 0; r < 16; ++r) ps += p0[r];
#pragma unroll
    for (int r = 0; r < 16; ++r) ps += p1[r];
    { auto rr = __builtin_amdgcn_permlane32_swap(__float_as_uint(ps), __float_as_uint(ps), false, false);
      ps = __uint_as_float(rr[0]) + __uint_as_float(rr[1]); }
    l_reg = l_reg * alpha + ps;
#define PK4(P, BASE, OUT) do { unsigned a0 = cvt_pk_bf16(P[BASE + 0], P[BASE + 1]), a1 = cvt_pk_bf16(P[BASE + 2], P[BASE + 3]);   \
    unsigned b0 = cvt_pk_bf16(P[BASE + 4], P[BASE + 5]), b1 = cvt_pk_bf16(P[BASE + 6], P[BASE + 7]);                              \
    auto r0 = __builtin_amdgcn_permlane32_swap(a0, b0, false, false); auto r1 = __builtin_amdgcn_permlane32_swap(a1, b1, false, false); \
    u32x4 w = {r0[0], r1[0], r0[1], r1[1]}; OUT = __builtin_bit_cast(bf16x8, w); } while (0)
    PK4(p0, 0, pa0); PK4(p0, 8, pa1); PK4(p1, 0, pa2); PK4(p1, 8, pa3);
#undef PK4
}

template <int DQK, bool NA>
__device__ __forceinline__ void attn_unit(LAS unsigned char* lds, const bf16_t* Qw, int ldq, float qscale, const bf16_t* Kt, int ldk, const bf16_t* Vt, int ldv, bf16_t* Ow,
                                          int ntiles, float SCALE, int na_first, int na_qc0, int na_dr0) {
    using G = Geo<DQK>;
    int tid_ = threadIdx.x; asm volatile("" : "+v"(tid_));
    const int tid = tid_, lane = tid & 63, r32 = lane & 31, hi = lane >> 5; const int wid = __builtin_amdgcn_readfirstlane(tid >> 6);
    const float C = SCALE * 1.4426950408889634f, thr_raw = THRN / SCALE;
    LAS float* wsf = (LAS float*)(lds + L_WS) + wid * 64;
    bf16x8 qr[G::ND0];
#pragma unroll
    for (int d0 = 0; d0 < G::ND0; ++d0) { u32x4 w = *(const u32x4*)(Qw + (size_t)r32 * ldq + d0 * 16 + hi * 8);
        if (!NA) { f32x4 a, b; a = (f32x4){bflo(w.x), bfhi(w.x), bflo(w.y), bfhi(w.y)} * qscale; b = (f32x4){bflo(w.z), bfhi(w.z), bflo(w.w), bfhi(w.w)} * qscale;
            w.x = cvt_pk_bf16(a[0], a[1]); w.y = cvt_pk_bf16(a[2], a[3]); w.z = cvt_pk_bf16(b[0], b[1]); w.w = cvt_pk_bf16(b[2], b[3]); }
        qr[d0] = __builtin_bit_cast(bf16x8, w); }
    const int vk = tid >> 3, vc = (tid & 7) * 8, vst = v_st(vk, vc);
    const int k0r = tid / G::NCH, k0c = tid % G::NCH; const int k1id = tid + 512, k1r = k1id / G::NCH, k1c = k1id % G::NCH; const bool k1on = (G::NCH == 12) && (tid < 256);
    const int vb0 = (int)(uintptr_t)(lds + L_V) + v_rd_base(lane);
    u32x4 sv, sk0, sk1;
#define SLOAD(j) do { const size_t kb_ = (size_t)(j) * KVBLK; sv = *(const u32x4*)(Vt + (kb_ + vk) * ldv + vc); sk0 = *(const u32x4*)(Kt + (kb_ + k0r) * ldk + k0c * 8); \
        if (k1on) sk1 = *(const u32x4*)(Kt + (kb_ + k1r) * ldk + k1c * 8); } while (0)
#define SWRITE(bf) do { *(LAS u32x4*)(lds + L_V + (bf) * VBUF + vst) = sv; *(LAS u32x4*)(lds + L_K + (bf) * KBUF + k0r * G::KROWB + k0c * 16) = sk0; \
        if (k1on) *(LAS u32x4*)(lds + L_K + (bf) * KBUF + k1r * G::KROWB + k1c * 16) = sk1; } while (0)
    float m_reg = -1e30f, l_reg = 0.f; f32x16 o[2]; o[0] = f32x16{}; o[1] = f32x16{};
    SLOAD(0); VM_WAIT(); SWRITE(0); if (ntiles > 1) SLOAD(1);
    __syncthreads();
    for (int j = 0; j < ntiles; ++j) {
        const int bf = j & 1;
        bool active = true; int dr = 0;
        if (NA) { dr = na_dr0 + j; active = (j >= na_first) && (j < na_first + 8); }
        if (active) {
            f32x16 p0, p1; bf16x8 pa0, pa1, pa2, pa3; float alpha;
            qkt<DQK>(p0, p1, lds + L_K + bf * KBUF, qr, r32, hi);
            if (NA) {
                const LAS float* bt = (const LAS float*)(lds + L_BIAS) + (dr + 7) * 32;
                const int qc = na_qc0 + r32; int cs = qc - 8; cs = cs < 0 ? 0 : (cs > 48 ? 48 : cs);
#pragma unroll
                for (int r = 0; r < 16; ++r) {
                    const int kc0 = crow(r, hi), kc1 = kc0 + 32;
                    int i0 = kc0 - qc + 15; i0 = i0 < 0 ? 0 : (i0 > 30 ? 30 : i0); int i1 = kc1 - qc + 15; i1 = i1 < 0 ? 0 : (i1 > 30 ? 30 : i1);
                    const float b0 = bt[i0], b1 = bt[i1];
                    p0[r] = ((unsigned)(kc0 - cs) < 16u) ? p0[r] + b0 : -1e30f;
                    p1[r] = ((unsigned)(kc1 - cs) < 16u) ? p1[r] + b1 : -1e30f;
                }
            }
            softmax_tile(p0, p1, m_reg, alpha, l_reg, C, thr_raw, pa0, pa1, pa2, pa3);
            if (__any(alpha < 1.f)) { if (hi == 0) wsf[r32] = alpha; LDS_WAIT();
#pragma unroll
                for (int d = 0; d < 2; ++d)
#pragma unroll
                    for (int r = 0; r < 16; ++r) o[d][r] *= wsf[crow(r, hi)]; }
            SBAR();
            pv_one<0>(o[0], vb0 + bf * VBUF, pa0, pa1, pa2, pa3); pv_one<1>(o[1], vb0 + bf * VBUF, pa0, pa1, pa2, pa3);
        }
        if (j + 1 < ntiles) { VM_WAIT(); SWRITE(bf ^ 1); if (j + 2 < ntiles) SLOAD(j + 2); }
        __syncthreads();
    }
#undef SLOAD
#undef SWRITE
    if (hi == 0) wsf[32 + r32] = l_reg; LDS_WAIT();
    float rli[16];
#pragma unroll
    for (int r = 0; r < 16; ++r) rli[r] = __builtin_amdgcn_rcpf(wsf[32 + crow(r, hi)]);
    LAS bf16_t* stg = (LAS bf16_t*)(lds + L_OST) + wid * 2048;
#pragma unroll
    for (int r = 0; r < 16; ++r) { const int orow = crow(r, hi);
#pragma unroll
        for (int d0 = 0; d0 < 2; ++d0) stg[orow * 64 + d0 * 32 + r32] = (bf16_t)f2bf(o[d0][r] * rli[r]); }
    LDS_WAIT();
#pragma unroll
    for (int i = 0; i < 4; ++i) { const int row = i * 8 + (lane >> 3), ch = lane & 7; const u32x4 v = *(const LAS u32x4*)(stg + row * 64 + ch * 8); *(u32x4*)(Ow + (size_t)row * 512 + ch * 8) = v; }
    LDS_WAIT();
    __syncthreads();
}
}

__device__ __forceinline__ void s4_attention(Frame& F, const Args& A, int rep_mla, int rep_na) {
    const int wave = F.wave;
    for (int rp = 0; rp < rep_mla; ++rp)
    for (int un = F.vcu; un < NB * MH * 8; un += F.G) {
        const int bh = un >> 3, qb = un & 7, b = bh >> 3, h = bh & 7;
        const int s0 = qb * 256 + wave * 32, t0 = b * SEQ + s0, r32 = F.lane & 31;
        const float* qss = wsp<float>(F, WS_QSS) + ((size_t)(t0 + r32) * 8 + h) * 2;
        const float qscale = rsqrtf((qss[0] + qss[1]) * (1.0f / 96.0f) + EPS);
        attn::attn_unit<96, false>(F.lds, wsp<bf16_t>(F, WS_QM) + ((size_t)bh * SEQ + s0) * 96, 96, qscale,
                                   wsp<bf16_t>(F, WS_KM) + (size_t)bh * SEQ * 96, 96, wsp<bf16_t>(F, WS_VM) + (size_t)bh * SEQ * 64, 64,
                                   wsp<bf16_t>(F, WS_YMLA) + (size_t)t0 * 512 + h * 64, SEQ / 64, 0.10206207261596577f, 0, 0, 0);
    }
    for (int rp = 0; rp < rep_na; ++rp)
    for (int un = F.vcu; un < NB * NAH * 8; un += F.G) {
        const int bh = un >> 3, g = un & 7, b = bh >> 3, h = bh & 7;
        LAS float* bt = (LAS float*)(F.lds + attn::L_BIAS);
        for (int i = F.tid; i < 15 * 32; i += NTHR) { const int rr = i >> 5, cc = i & 31; bt[i] = cc < 31 ? INF(I_na_rpb)[(size_t)(h * 15 + rr) * 31 + cc] * 8.0f : 0.f; }
        int lo = 4 * g - 4; lo = lo < 0 ? 0 : (lo > 24 ? 24 : lo); int hi_s = 4 * g + 3 - 4; hi_s = hi_s < 0 ? 0 : (hi_s > 24 ? 24 : hi_s);
        const int ntiles = hi_s + 8 - lo;
        const int qrow = 4 * g + (wave >> 1); int rs = qrow - 4; rs = rs < 0 ? 0 : (rs > 24 ? 24 : rs);
        const int t0 = b * SEQ + qrow * 64 + 32 * (wave & 1);
        __syncthreads();
        attn::attn_unit<64, true>(F.lds, wsp<bf16_t>(F, WS_NAQ) + (size_t)t0 * 512 + h * 64, 512, 1.0f,
                                  wsp<bf16_t>(F, WS_NAK) + (size_t)(b * SEQ + lo * 64) * 512 + h * 64, 512, wsp<bf16_t>(F, WS_NAV) + (size_t)(b * SEQ + lo * 64) * 512 + h * 64, 512,
                                  wsp<bf16_t>(F, WS_YNA) + (size_t)t0 * 512 + h * 64, ntiles, 0.125f, rs - lo, 32 * (wave & 1), lo - qrow);
    }
}
namespace moe {
#define RFL(x) __builtin_amdgcn_readfirstlane(x)
constexpr int ASTR = 1028;
constexpr int L_A = 0, L_LG = 16 * ASTR * 4, L_END = L_LG + 2 * 16 * 64 * 4;
constexpr int T_CNT = 0, T_ABASE = 128, T_YBASE = 200, T_PRE = 336;

__device__ __forceinline__ void s7_router(Frame& F, const Args& A, int rep_conv, int rep_rt) {
    const int lane = F.lane, wave = F.wave;
    const float* mod = wsp<float>(F, WS_MOD); bf16_t* H2 = wsp<bf16_t>(F, WS_H2);
    LAS float* At = (LAS float*)(F.lds + L_A); LAS float* LG = (LAS float*)(F.lds + L_LG);
    const float* rfrag = wsp<float>(F, WS_RFRAG);
    int* LIST = wsp<int>(F, WS_LIST); float* WLIST = wsp<float>(F, WS_WLIST); unsigned* TOKSLOT = wsp<unsigned>(F, WS_TOKSLOT);
    const float ebias = INF(I_e_bias)[lane];
    for (int rp = 0; rp < rep_rt; ++rp)
    for (int un = F.vcu; un < NT / 16; un += F.G) {
        const bool dry = rp + 1 < rep_rt;
        const int row0 = un * 16, b = row0 >> 11;
        const float* bp = rfrag + ((size_t)((wave & 3) * 64 + 32 * (wave >> 2)) * 64 + lane) * 4;
        f32x4 bA[16], bB[16];
#pragma unroll
        for (int jj = 0; jj < 16; ++jj) bA[jj] = *(const f32x4*)(bp + (size_t)jj * 256);
        SBAR();
#pragma unroll 1
        for (int rr = 0; rr < 2; ++rr) {
            const int lr = 2 * wave + rr, row = row0 + lr;
            f32x4 v[4]; float ss = 0.f;
#pragma unroll
            for (int j = 0; j < 4; ++j) { v[j] = *(const f32x4*)(F.out + (size_t)row * DM + 4 * lane + 256 * j); ss += sq4(v[j]); }
            const float rstd = rsqrtf(wave_sum(ss) * (1.0f / DM) + EPS);
#pragma unroll
            for (int j = 0; j < 4; ++j) { const int c4 = 4 * lane + 256 * j;
                const f32x4 g = *(const f32x4*)(INF(I_g_norm2) + c4), sc = *(const f32x4*)(mod + (size_t)b * 6144 + 4096 + c4), sh = *(const f32x4*)(mod + (size_t)b * 6144 + 3072 + c4);
                const f32x4 o = v[j] * rstd * (g * (sc + 1.0f)) + sh;
                u32x2 w; w.x = cvt_pk_bf16(o[0], o[1]); w.y = cvt_pk_bf16(o[2], o[3]);
                *(u32x2*)(H2 + (size_t)row * DM + c4) = w;
                *(LAS f32x4*)(At + lr * ASTR + c4) = o; }
        }
        __syncthreads();
        {
            const int ct = wave & 3, kh = wave >> 2; f32x4 acc = {0.f, 0.f, 0.f, 0.f};
            const LAS float* ap = At + (lane & 15) * ASTR + 4 * (lane >> 4);
#pragma unroll
            for (int jj = 0; jj < 16; ++jj) bB[jj] = *(const f32x4*)(bp + (size_t)(16 + jj) * 256);
            SBAR();
#pragma unroll
            for (int jj = 0; jj < 16; ++jj) { const f32x4 a4 = *(const LAS f32x4*)(ap + 16 * (32 * kh + jj)); const f32x4 b4 = bA[jj];
                acc = __builtin_amdgcn_mfma_f32_16x16x4f32(a4[0], b4[0], acc, 0, 0, 0); acc = __builtin_amdgcn_mfma_f32_16x16x4f32(a4[1], b4[1], acc, 0, 0, 0);
                acc = __builtin_amdgcn_mfma_f32_16x16x4f32(a4[2], b4[2], acc, 0, 0, 0); acc = __builtin_amdgcn_mfma_f32_16x16x4f32(a4[3], b4[3], acc, 0, 0, 0);
                if ((jj & 3) == 3) SBAR(); }
#pragma unroll
            for (int jj = 0; jj < 16; ++jj) { const f32x4 a4 = *(const LAS f32x4*)(ap + 16 * (32 * kh + 16 + jj)); const f32x4 b4 = bB[jj];
                acc = __builtin_amdgcn_mfma_f32_16x16x4f32(a4[0], b4[0], acc, 0, 0, 0); acc = __builtin_amdgcn_mfma_f32_16x16x4f32(a4[1], b4[1], acc, 0, 0, 0);
                acc = __builtin_amdgcn_mfma_f32_16x16x4f32(a4[2], b4[2], acc, 0, 0, 0); acc = __builtin_amdgcn_mfma_f32_16x16x4f32(a4[3], b4[3], acc, 0, 0, 0);
                if ((jj & 3) == 3) SBAR(); }
#pragma unroll
            for (int r = 0; r < 4; ++r) LG[(kh * 16 + 4 * (lane >> 4) + r) * 64 + 16 * ct + (lane & 15)] = acc[r];
        }
        __syncthreads();
#pragma unroll 1
        for (int rr = 0; rr < 2; ++rr) {
            const int lr = 2 * wave + rr, tok = row0 + lr;
            const float logit = LG[lr * 64 + lane] + LG[(16 + lr) * 64 + lane];
            const float score = 1.0f / (1.0f + expf(-logit));
            const float sel = score + ebias;
            float m1 = sel; m1 = fmaxf(m1, __shfl_xor(m1, 1)); m1 = fmaxf(m1, __shfl_xor(m1, 2)); m1 = fmaxf(m1, __shfl_xor(m1, 4));
            const unsigned long long bm = __ballot(sel == m1);
            const unsigned gb = (unsigned)(bm >> (lane & ~7)) & 0xffu; const int first = __ffs((int)gb) - 1;
            float m2 = ((lane & 7) == first) ? -INFINITY : sel; m2 = fmaxf(m2, __shfl_xor(m2, 1)); m2 = fmaxf(m2, __shfl_xor(m2, 2)); m2 = fmaxf(m2, __shfl_xor(m2, 4));
            const float gs = m1 + m2; int grank = 0;
            { const unsigned ub = __float_as_uint(gs), uo = (ub & 0x80000000u) ? ~ub : (ub | 0x80000000u);
              const unsigned long long key = ((unsigned long long)uo << 8) | (unsigned)(7 - (lane >> 3));
#pragma unroll
              for (int q = 0; q < 8; ++q) { const unsigned long long ok = ((unsigned long long)(unsigned)__builtin_amdgcn_readlane((int)(key >> 32), 8 * q) << 32) | (unsigned)__builtin_amdgcn_readlane((int)(unsigned)key, 8 * q); grank += ok > key ? 1 : 0; } }
            const bool gsel = grank < TOPKG; const float sm = gsel ? sel : -INFINITY; int rank = 0;
            { const unsigned ub = __float_as_uint(sm), uo = (ub & 0x80000000u) ? ~ub : (ub | 0x80000000u);
              const unsigned long long key = ((unsigned long long)uo << 8) | (unsigned)(63 - lane);
              const int khi = (int)(key >> 32), klo = (int)(unsigned)key;
#pragma unroll
              for (int q = 0; q < 64; ++q) { const unsigned long long ok = ((unsigned long long)(unsigned)__builtin_amdgcn_readlane(khi, q) << 32) | (unsigned)__builtin_amdgcn_readlane(klo, q); rank += ok > key ? 1 : 0; } }
            const bool chosen = gsel && rank < TOPK;
            const float wsum = wave_sum(chosen ? score : 0.f);
            const float w = score / wsum * 2.5f;
            if (chosen && !dry) { const int c = tok >= CHTOK ? 1 : 0, ec = lane * 2 + c;
                const unsigned pos = __hip_atomic_fetch_add((unsigned*)F.ctl + CW_CNT + ec * 16, 1u, RLX_AGENT);
                LIST[(size_t)ec * 8192 + pos] = tok; WLIST[(size_t)ec * 8192 + pos] = w; TOKSLOT[(size_t)tok * 8 + rank] = ((unsigned)lane << 16) | pos; }
        }
        __syncthreads();
    }
    LAS float* scr = (LAS float*)(F.lds + wave * 16384);
    const int gw = F.vcu * NWAVES + wave, NGW = F.G * NWAVES;
    for (int rp = 0; rp < rep_conv; ++rp)
    for (int it = gw; it < 65 * 384; it += NGW) {
        const int e = it / 384, r = it % 384;
        const float* wg = e < 64 ? INF(I_w_eg) + (size_t)e * DM * EFF : INF(I_w_sg); const float* wu = e < 64 ? INF(I_w_eu) + (size_t)e * DM * EFF : INF(I_w_su); const float* wd = e < 64 ? INF(I_w_ed) + (size_t)e * EFF * DM : INF(I_w_sd);
        if (r < 128) transpose_item(wg, DM, EFF, wsp<bf16_t>(F, WS_WGU) + (size_t)e * 512 * DM, MapGU{0}, nullptr, scr, r, lane);
        else if (r < 256) transpose_item(wu, DM, EFF, wsp<bf16_t>(F, WS_WGU) + (size_t)e * 512 * DM, MapGU{1}, nullptr, scr, r - 128, lane);
        else transpose_item(wd, EFF, DM, wsp<bf16_t>(F, WS_WD) + (size_t)e * DM * EFF, MapOff{0}, nullptr, scr, r - 256, lane);
    }
}

__device__ __forceinline__ void build_tables(Frame& F) {
    LAS int* tab = (LAS int*)(F.lds + TAB_OFF);
    if (F.tid < 128) tab[T_CNT + F.tid] = (int)__hip_atomic_load((unsigned*)F.ctl + CW_CNT + F.tid * 16, RLX_AGENT);
    __syncthreads();
    if (F.tid == 0) { int a = 0, y0 = 0, y1 = 0;
        for (int e = 0; e < 64; ++e) { tab[T_ABASE + e] = a; tab[T_YBASE + e] = y0; tab[T_YBASE + 64 + e] = y1; a += tab[T_CNT + 2 * e] + tab[T_CNT + 2 * e + 1]; y0 += tab[T_CNT + 2 * e]; y1 += tab[T_CNT + 2 * e + 1]; }
        tab[T_ABASE + 64] = a; }
    __syncthreads();
}

struct GateUpSched {
    const LAS int* tab; const bf16_t* wgu; const int* list; int x, j, per;
    __device__ void init(Frame& F) { tab = (const LAS int*)(F.lds + TAB_OFF); wgu = wsp<bf16_t>(F, WS_WGU); list = wsp<int>(F, WS_LIST); x = (int)blockIdx.x % 8; j = (int)blockIdx.x / 8; per = F.G / 8; }
    __device__ bool next(int i, pg8::Unit& u) const {
        const int L = i * per + j;
        int k = -1, base = 0, a = 0;
#pragma unroll
        for (int q = 0; q < 8; ++q) { const int e = x + 8 * q; const int na = a + ((RFL(tab[T_CNT + 2 * e]) + RFL(tab[T_CNT + 2 * e + 1]) + 255) >> 8) * 2; if (k < 0 && L < na) { k = q; base = a; } a = na; }
        if (k >= 0) {
            const int e = x + 8 * k, r = L - base, mt = r >> 1, pn = r & 1, n0 = RFL(tab[T_CNT + 2 * e]), ntot = n0 + RFL(tab[T_CNT + 2 * e + 1]);
            u.B = (const char*)(wgu + ((size_t)e * 512 + pn * 256) * DM); u.m0 = mt * 256; u.pn = pn; u.e = e; u.nrows = (ntot - mt * 256) < 256 ? (ntot - mt * 256) : 256;
            u.orow0 = RFL(tab[T_ABASE + e]) + mt * 256; u.l0 = list + (size_t)(2 * e) * 8192; u.l1 = list + (size_t)(2 * e + 1) * 8192; u.n0 = n0; u.ntot = ntot; return true; }
        const int r = L - a; if (r >= 16) return false;
        const int mt = x + 8 * (r >> 1), pn = r & 1;
        u.B = (const char*)(wgu + ((size_t)64 * 512 + pn * 256) * DM); u.m0 = mt * 256; u.pn = pn; u.e = 64; u.nrows = 256; u.orow0 = ACT_SHARED_ROW0 + mt * 256; u.l0 = nullptr; u.l1 = nullptr; u.n0 = 0; u.ntot = 0; return true;
    }
};
struct DownSched {
    const LAS int* tab; const bf16_t* wd; int x, j, per, c;
    __device__ void init(Frame& F, int c_) { tab = (const LAS int*)(F.lds + TAB_OFF); wd = wsp<bf16_t>(F, WS_WD); x = (int)blockIdx.x % 8; j = (int)blockIdx.x / 8; per = F.G / 8; c = c_; }
    __device__ bool next(int i, pg8::Unit& u) const {
        const int L = i * per + j;
        u.l0 = nullptr; u.l1 = nullptr; u.n0 = 0; u.ntot = 0;
        int k = -1, base = 0, a = 0;
#pragma unroll
        for (int q = 0; q < 8; ++q) { const int e = x + 8 * q; const int na = a + ((RFL(tab[T_CNT + 2 * e + c]) + 255) >> 8) * 4; if (k < 0 && L < na) { k = q; base = a; } a = na; }
        if (k >= 0) {
            const int e = x + 8 * k, r = L - base, mt = r >> 2, pn = r & 3, n = RFL(tab[T_CNT + 2 * e + c]);
            u.B = (const char*)(wd + ((size_t)e * DM + pn * 256) * EFF); u.m0 = RFL(tab[T_ABASE + e]) + (c ? RFL(tab[T_CNT + 2 * e]) : 0) + mt * 256; u.pn = pn; u.e = e;
            u.nrows = (n - mt * 256) < 256 ? (n - mt * 256) : 256; u.orow0 = RFL(tab[T_YBASE + 64 * c + e]) + mt * 256; return true; }
        const int r = L - a; if (r >= 16) return false;
        const int mt = x + 8 * (r >> 2), pn = r & 3;
        u.B = (const char*)(wd + ((size_t)64 * DM + pn * 256) * EFF); u.m0 = ACT_SHARED_ROW0 + c * CHTOK + mt * 256; u.pn = pn; u.e = 64; u.nrows = 256; u.orow0 = YS_SHARED_ROW0 + mt * 256; return true;
    }
};

__device__ __forceinline__ void combine(Frame& F, int c, bool dry) {
    const LAS int* tab = (const LAS int*)(F.lds + TAB_OFF);
    const int lane = F.lane, gw = F.vcu * NWAVES + F.wave, NGW = F.G * NWAVES;
    const bf16_t* ys = wsp<bf16_t>(F, WS_YS); const unsigned* TOKSLOT = wsp<unsigned>(F, WS_TOKSLOT); const float* mod = wsp<float>(F, WS_MOD);
    for (int tl = gw; tl < CHTOK; tl += NGW) {
        const int t = c * CHTOK + tl, b = t >> 11;
        int yr[9];
#pragma unroll
        for (int k = 0; k < 8; ++k) { const unsigned s = TOKSLOT[(size_t)t * 8 + k]; yr[k] = tab[T_YBASE + 64 * c + (int)(s >> 16)] + (int)(s & 0xffffu); }
        yr[8] = YS_SHARED_ROW0 + tl;
#pragma unroll
        for (int j = 0; j < 4; ++j) { const int c4 = 4 * lane + 256 * j; f32x4 s = {0.f, 0.f, 0.f, 0.f};
#pragma unroll
            for (int k = 0; k < 9; ++k) { const u32x2 w = *(const u32x2*)(ys + (size_t)yr[k] * DM + c4); s += (f32x4){bflo(w.x), bfhi(w.x), bflo(w.y), bfhi(w.y)}; }
            const f32x4 x1 = *(const f32x4*)(F.out + (size_t)t * DM + c4), g2 = *(const f32x4*)(mod + (size_t)b * 6144 + 5120 + c4);
            float* dst = dry ? (float*)(F.ws + WS_B + 253 * MiB) + (((size_t)t * DM + c4) & ((1u << 21) - 1)) : F.out + (size_t)t * DM + c4;
            *(f32x4*)dst = x1 + g2 * s; }
    }
}
}
#ifndef PHMASK
#define PHMASK 0xffff
#endif
#define PH(k) ((PHMASK >> (k)) & 1)
#ifndef REPMASK
#define REPMASK 0
#endif
#ifndef XBAR
#define XBAR 0
#endif
#define REP(k) for (int rep_ = 0; rep_ < 1 + ((REPMASK >> (k)) & 1); ++rep_)

__global__ void __launch_bounds__(NTHR, 2) fwd_megakernel(Args args) {
    const Args& A = args;
    extern __shared__ __attribute__((aligned(16))) unsigned char lds_raw[];
    Frame F;
    F.lds = (LAS unsigned char*)lds_raw;
    F.MISC = (volatile LAS unsigned*)(F.lds + MISC_OFF);
    F.tid = threadIdx.x; F.lane = F.tid & 63; F.wave = __builtin_amdgcn_readfirstlane(F.tid >> 6);
    F.G = gridDim.x; { const int bx = blockIdx.x; F.vcu = (F.G % 8 == 0) ? (bx % 8) * (F.G / 8) + bx / 8 : bx; }
    F.ws = args.ws; F.ctl = (gu32*)(args.ws + WS_CTL); F.out = args.out;
    for (int u = F.tid; u < (LDS_BYTES - LDSCTL_OFF) / 4; u += NTHR) ((LAS unsigned*)(F.lds + LDSCTL_OFF))[u] = 0u;
    __syncthreads();
    XcdBarrier bar = xcd_barrier_post((unsigned*)(F.ctl + CW_BAR), F.MISC + 8);
#define GRID_BAR() do { xcd_barrier(bar); F.refresh(); } while (0)
    const int bx = (int)blockIdx.x;

    REP(0) if (PH(0)) p0_prologue(F, args);
    for (int xb = 0; xb < XBAR; ++xb) GRID_BAR();
    GRID_BAR();
    REP(1) if (PH(1)) s1_modnorm(F, args);
    GRID_BAR();
    REP(2) if (PH(2)) {
        pg8::Gemm g{wsp<bf16_t>(F, WS_H), DM, DM}; pg8::DenseSched S; S.init(NT, INPAD, DM, wsp<bf16_t>(F, WS_WIN), F.G, bx);
        epi::EpiInProj E{wsp<bf16_t>(F, WS_NAQ), wsp<bf16_t>(F, WS_NAK), wsp<bf16_t>(F, WS_NAV), wsp<bf16_t>(F, WS_QLAT), wsp<bf16_t>(F, WS_KVLAT), wsp<bf16_t>(F, WS_SGNA), wsp<bf16_t>(F, WS_SGMLA),
                          wsp<float>(F, WS_KROT), wsp<float>(F, WS_QSQ), wsp<float>(F, WS_KVSQ), INF(I_g_na_q), INF(I_g_na_k), wsp<float>(F, WS_RCOS), wsp<float>(F, WS_RSIN)};
        pg8::gemm_phase<epi::EpiInProj, pg8::DenseSched, false>(F.lds, g, S, E);
    }
    GRID_BAR();
    REP(3) if (PH(3)) {
        pg8::Gemm g{wsp<bf16_t>(F, WS_QLAT), QRANK, QRANK}; pg8::DenseSched S; S.init(NT, MH * QKD, QRANK, wsp<bf16_t>(F, WS_WUQ), F.G, bx);
        epi::EpiUpQ E{wsp<bf16_t>(F, WS_QM), wsp<float>(F, WS_QSS), wsp<float>(F, WS_QSQ), INF(I_g_mla_q), wsp<float>(F, WS_RCOS), wsp<float>(F, WS_RSIN)};
        pg8::gemm_phase<epi::EpiUpQ, pg8::DenseSched, false>(F.lds, g, S, E);
    }
    REP(3) if (PH(4)) {
        pg8::Gemm g{wsp<bf16_t>(F, WS_KVLAT), KVRANK, KVRANK}; pg8::DenseSched S; S.init(NT, MH * 128, KVRANK, wsp<bf16_t>(F, WS_WUKV), F.G, bx);
        epi::EpiUpKV E{wsp<bf16_t>(F, WS_KM), wsp<bf16_t>(F, WS_VM), wsp<float>(F, WS_KVSQ), wsp<float>(F, WS_KROT), INF(I_g_mla_k)};
        pg8::gemm_phase<epi::EpiUpKV, pg8::DenseSched, false>(F.lds, g, S, E);
    }
    GRID_BAR();
    if (PH(5)) s4_attention(F, args, 1 + ((REPMASK >> 4) & 1), 1 + ((REPMASK >> 5) & 1));
    GRID_BAR();
    REP(6) if (PH(6)) {
        pg8::Gemm g{wsp<bf16_t>(F, WS_YNA), 512, 512}; pg8::DenseSched S; S.init(NT, DM, 512, wsp<bf16_t>(F, WS_WPNA), F.G, bx);
        epi::EpiMerge<1> E{wsp<bf16_t>(F, WS_SGNA), wsp<bf16_t>(F, WS_TMP), nullptr};
        pg8::gemm_phase<epi::EpiMerge<1>, pg8::DenseSched, false>(F.lds, g, S, E);
    }
    REP(6) if (PH(7)) {
        pg8::Gemm g{wsp<bf16_t>(F, WS_YMLA), 512, 512}; pg8::DenseSched S; S.init(NT, DM, 512, wsp<bf16_t>(F, WS_WPMLA), F.G, bx);
        epi::EpiMerge<2> E{wsp<bf16_t>(F, WS_SGMLA), wsp<bf16_t>(F, WS_TMP), wsp<bf16_t>(F, WS_MERGED)};
        pg8::gemm_phase<epi::EpiMerge<2>, pg8::DenseSched, false>(F.lds, g, S, E);
    }
    GRID_BAR();
    REP(8) if (PH(8)) {
        pg8::Gemm g{wsp<bf16_t>(F, WS_MERGED), DM, DM}; pg8::DenseSched S; S.init(NT, DM, DM, wsp<bf16_t>(F, WS_WOUT), F.G, bx);
        epi::EpiOut E{INF(I_x), F.out, wsp<float>(F, WS_MOD)};
        pg8::gemm_phase<epi::EpiOut, pg8::DenseSched, false>(F.lds, g, S, E);
    }
    GRID_BAR();
    if (PH(9)) moe::s7_router(F, args, 1 + ((REPMASK >> 9) & 1), 1 + ((REPMASK >> 13) & 1));
    GRID_BAR();
    moe::build_tables(F);
    REP(10) if (PH(10)) {
        pg8::Gemm g{wsp<bf16_t>(F, WS_H2), DM, DM}; moe::GateUpSched S; S.init(F);
        epi::EpiGateUp E{wsp<bf16_t>(F, WS_ACT)};
        pg8::gemm_phase<epi::EpiGateUp, moe::GateUpSched, true>(F.lds, g, S, E);
    }
    GRID_BAR();
#pragma unroll 1
    for (int c = 0; c < NCHUNK; ++c) {
        REP(11) if (PH(11)) {
            pg8::Gemm g{wsp<bf16_t>(F, WS_ACT), EFF, EFF}; moe::DownSched S; S.init(F, c);
            epi::EpiDown E{wsp<bf16_t>(F, WS_YS)};
            pg8::gemm_phase<epi::EpiDown, moe::DownSched, false>(F.lds, g, S, E);
        }
        GRID_BAR();
        if ((REPMASK >> 12) & 1) moe::combine(F, c, true);
        if (PH(12)) moe::combine(F, c, false);
        if (c + 1 < NCHUNK) GRID_BAR();
    }
}

extern "C" void kernel_launch(void* const* d_in, const int* in_sizes, int n_in, void* d_out, int out_size, void* d_ws, size_t ws_size, hipStream_t stream) {
    static int grid = 0;
    if (grid == 0) {
        if (n_in != 28 || out_size != NT * DM || ws_size < WS_END) { fprintf(stderr, "kernel_launch: unexpected shapes: n_in %d out %d ws %zu (need %zu)\n", n_in, out_size, ws_size, (size_t)WS_END); grid = -1; return; }
        int dev = 0, cus = 0, per_cu = 0;
        if (hipGetDevice(&dev) != hipSuccess || hipDeviceGetAttribute(&cus, hipDeviceAttributeMultiprocessorCount, dev) != hipSuccess) { grid = -1; return; }
        if (hipFuncSetAttribute((const void*)fwd_megakernel, hipFuncAttributeMaxDynamicSharedMemorySize, LDS_BYTES) != hipSuccess) { fprintf(stderr, "kernel_launch: hipFuncSetAttribute failed\n"); grid = -1; return; }
        if (hipOccupancyMaxActiveBlocksPerMultiprocessor(&per_cu, (const void*)fwd_megakernel, NTHR, LDS_BYTES) != hipSuccess || per_cu < 1) { fprintf(stderr, "kernel_launch: occupancy query says %d blocks/CU\n", per_cu); (void)hipGetLastError(); }
        grid = cus;
        if (grid != 256) fprintf(stderr, "kernel_launch: %d CUs (expected 256)\n", grid);
    }
    if (grid < 0) return;
    if (hipMemsetAsync((char*)d_ws + WS_CTL, 0, CTL_ZERO_BYTES, stream) != hipSuccess) { fprintf(stderr, "kernel_launch: memset failed\n"); return; }
    Args a{};
    for (int i = 0; i < 28; ++i) a.in[i] = d_in[i];
    a.out = (float*)d_out; a.ws = (unsigned char*)d_ws;
    void* kargs[] = {&a};
    const hipError_t le = hipLaunchCooperativeKernel((const void*)fwd_megakernel, dim3(grid), dim3(NTHR), kargs, LDS_BYTES, stream);
    if (le != hipSuccess) fprintf(stderr, "kernel_launch: cooperative launch failed: %s (grid %d)\n", hipGetErrorName(le), grid);
}
```

```cpp
#include <hip/hip_runtime.h>
#include <cstdio>
#include <cstdint>
#include <cmath>

#define GAS __attribute__((address_space(1)))
#define LAS __attribute__((address_space(3)))
typedef unsigned short bf16_t;
typedef short bf16x8 __attribute__((ext_vector_type(8)));
typedef short s16x4 __attribute__((ext_vector_type(4)));
typedef float f32x4 __attribute__((ext_vector_type(4)));
typedef float f32x2 __attribute__((ext_vector_type(2)));
typedef float f32x16 __attribute__((ext_vector_type(16)));
typedef unsigned u32x4 __attribute__((ext_vector_type(4)));
typedef unsigned u32x2 __attribute__((ext_vector_type(2)));
typedef GAS unsigned gu32;

constexpr int DM = 1024, NB = 8, SEQ = 2048, NT = NB * SEQ;
constexpr int NAH = 8, NAD = 64, GRIDW = 64, GRIDR = SEQ / GRIDW;
constexpr int MH = 8, QRANK = 256, KVRANK = 128, NOPE = 64, ROPE = 32, VD = 64, QKD = 96;
constexpr int NEXP = 64, TOPK = 8, NGRP = 8, TOPKG = 4, EFF = 256;
constexpr float EPS = 1e-6f;
constexpr int INCOLS = 4000, INPAD = 4096;
constexpr int NCHUNK = 1, CHTOK = NT / NCHUNK;
constexpr float YS_SCALE = 16.0f;
constexpr int NWAVES = 8, NTHR = 512;

constexpr size_t MiB = 1u << 20;
constexpr size_t WS_CTL = 0, CTL_ZERO_BYTES = 1 * MiB;
constexpr size_t WS_MOD   = 1 * MiB;
constexpr size_t WS_RCOS  = WS_MOD + 256 * 1024;
constexpr size_t WS_RSIN  = WS_RCOS + 1 * MiB;
constexpr size_t WS_RFRAG = WS_RSIN + 1 * MiB;
constexpr size_t WS_QSQ   = WS_RFRAG + 256 * 1024;
constexpr size_t WS_KVSQ  = WS_QSQ + 256 * 1024;
constexpr size_t WS_QSS   = WS_KVSQ + 256 * 1024;
constexpr size_t WS_TOKSLOT = WS_QSS + 1 * MiB;
constexpr size_t WS_LIST  = 6 * MiB;
constexpr size_t WS_WLIST = 10 * MiB;
constexpr size_t WS_WIN   = 14 * MiB;
constexpr size_t WS_WUQ   = 22 * MiB;
constexpr size_t WS_WUKV  = WS_WUQ + 512 * 1024;
constexpr size_t WS_WPNA  = 23 * MiB;
constexpr size_t WS_WPMLA = 24 * MiB;
constexpr size_t WS_WOUT  = 25 * MiB;
constexpr size_t WS_KROT  = 27 * MiB;
constexpr size_t WS_B     = 30 * MiB;
constexpr size_t WS_H     = WS_B + 0 * MiB;
constexpr size_t WS_QM    = WS_B + 0 * MiB;
constexpr size_t WS_NAQ   = WS_B + 32 * MiB;
constexpr size_t WS_NAK   = WS_B + 48 * MiB;
constexpr size_t WS_NAV   = WS_B + 64 * MiB;
constexpr size_t WS_QLAT  = WS_B + 80 * MiB;
constexpr size_t WS_KVLAT = WS_B + 88 * MiB;
constexpr size_t WS_SGNA  = WS_B + 96 * MiB;
constexpr size_t WS_SGMLA = WS_B + 128 * MiB;
constexpr size_t WS_KM    = WS_B + 160 * MiB;
constexpr size_t WS_VM    = WS_B + 185 * MiB;
constexpr size_t WS_YNA   = WS_B + 201 * MiB;
constexpr size_t WS_YMLA  = WS_B + 217 * MiB;
constexpr size_t WS_TMP   = WS_B + 32 * MiB;
constexpr size_t WS_MERGED= WS_B + 64 * MiB;
constexpr size_t WS_WD    = WS_B + 0 * MiB;
constexpr size_t WS_ACT   = WS_B + 33 * MiB;
constexpr size_t WS_WGU   = WS_B + 109 * MiB;
constexpr size_t WS_H2    = WS_B + 174 * MiB;
constexpr size_t WS_YS    = WS_B + 109 * MiB;
constexpr size_t WS_END   = WS_B + 262 * MiB;
constexpr int ACT_SHARED_ROW0 = NT * TOPK;
constexpr int YS_SHARED_ROW0 = CHTOK * TOPK;
constexpr int CW_BAR = 4096;
constexpr int CW_CNT = 16384;

constexpr int RING_BYTES = 131072;
constexpr int LDSCTL_OFF = RING_BYTES, MISC_OFF = LDSCTL_OFF + 320;
constexpr int TAB_OFF = RING_BYTES + 1024;
constexpr int LDS_BYTES = 147456;

#define LDS_WAIT() asm volatile("s_waitcnt lgkmcnt(0)" ::: "memory")
#define VM_WAIT() asm volatile("s_waitcnt vmcnt(0)" ::: "memory")
#define SBAR() __builtin_amdgcn_sched_barrier(0)
#define RLX_AGENT __ATOMIC_RELAXED, __HIP_MEMORY_SCOPE_AGENT

__device__ __forceinline__ unsigned f2bf(float f) { unsigned u = __builtin_bit_cast(unsigned, f); return (u + 0x7fffu + ((u >> 16) & 1u)) >> 16; }
__device__ __forceinline__ unsigned pk2(float lo, float hi) { return f2bf(lo) | (f2bf(hi) << 16); }
__device__ __forceinline__ unsigned cvt_pk_bf16(float lo, float hi) { unsigned r; asm volatile("v_cvt_pk_bf16_f32 %0, %1, %2" : "=v"(r) : "v"(lo), "v"(hi)); return r; }
__device__ __forceinline__ float bf2f(unsigned short b) { return __builtin_bit_cast(float, (unsigned)b << 16); }
__device__ __forceinline__ float bflo(unsigned w) { return __builtin_bit_cast(float, w << 16); }
__device__ __forceinline__ float bfhi(unsigned w) { return __builtin_bit_cast(float, w & 0xffff0000u); }
__device__ __forceinline__ float wave_sum(float v) {
#pragma unroll
    for (int o = 1; o < 64; o <<= 1) v += __shfl_xor(v, o);
    return v;
}
__device__ __forceinline__ float sigmoidf_fast(float v) { return __builtin_amdgcn_rcpf(1.0f + __expf(-v)); }
__device__ __forceinline__ float siluf_fast(float v) { return v * sigmoidf_fast(v); }
__device__ __forceinline__ float sq4(f32x4 a) { return (a[0] * a[0] + a[1] * a[1]) + (a[2] * a[2] + a[3] * a[3]); }

#ifdef WSPROBE
struct Args { const void* in[28]; float* out; unsigned char* ws; int nrep, pad; };
#else
struct Args { const void* in[28]; float* out; unsigned char* ws; };
#endif
enum { I_x = 0, I_c = 1, I_positions = 2, I_w_ada = 3, I_b_ada = 4, I_g_norm1 = 5, I_w_in = 6, I_g_na_q = 7, I_g_na_k = 8, I_na_rpb = 9, I_g_q_lat = 10, I_w_uq = 11, I_g_kv_lat = 12, I_w_ukv = 13, I_g_mla_q = 14, I_g_mla_k = 15, I_w_proj_na = 16, I_w_proj_mla = 17, I_w_out = 18, I_g_norm2 = 19, I_w_router = 20, I_e_bias = 21, I_w_eg = 22, I_w_eu = 23, I_w_ed = 24, I_w_sg = 25, I_w_su = 26, I_w_sd = 27 };
#define INF(k) ((const float*)A.in[k])
namespace pg8 {
constexpr int BM = 256, BK = 64, HALF = 128, HTB = HALF * BK * 2, STAGE_BYTES = 8 * HTB, NXCD = 8, WGM = 8;
__host__ __device__ __forceinline__ int lds_byte(int r, int c) { const int st = (r >> 4) * 2 + (c >> 5), rr = r & 15, cc = c & 31, ob = rr * 64 + cc * 2; return st * 1024 + (ob ^ (((ob >> 9) & 1) << 5)); }
__host__ __device__ __forceinline__ void stage_rc(int b, int& R, int& C) { const int st = b / 1024, sb = b % 1024, swz = sb ^ (((sb >> 9) & 1) << 5); R = (st >> 1) * 16 + swz / 64; C = (st & 1) * 32 + (swz % 64) / 2; }
__host__ __device__ __forceinline__ int perm32(int rho) { const int n = rho >> 4, i = rho & 15; return 8 * (i >> 2) + 4 * n + (i & 3); }

struct Unit {
    const char* B;
    int m0;
    int pn;
    int e;
    int nrows;
    int orow0;
    const int* l0; const int* l1; int n0, ntot;
};
struct Gemm { const bf16_t* A; int lda; int K; };

template <class Epi, class Sched, bool GATHER>
__device__ __forceinline__ void gemm_phase(LAS unsigned char* lds, const Gemm g, Sched& S, const Epi& E) {
    int tid_ = threadIdx.x; asm volatile("" : "+v"(tid_));
    const int tid = tid_, wid = __builtin_amdgcn_readfirstlane(tid >> 6), lane = tid & 63, wr = wid >> 2, wc = wid & 3, fr = lane & 15, fq = lane >> 4;
    const int K = g.K, nt = K / BK;
    unsigned voffB[2], voffA[2];
#pragma unroll
    for (int i = 0; i < 2; ++i) { int R, C; stage_rc(tid * 16 + i * 8192, R, C); const int Rb = Epi::PERM ? ((R & ~31) + perm32(R & 31)) : R;
        voffA[i] = (unsigned)(R * g.lda + C) * 2u; voffB[i] = (unsigned)(Rb * K + C) * 2u; }
    const size_t hstepA = (size_t)HALF * g.lda * 2;
    const size_t kstep = (size_t)(BK * 2);
    const size_t hstepB = (size_t)HALF * K * 2;
    const unsigned ldsw = (unsigned)wid * 1024u;
    const int aoff = lds_byte(wr * 64 + fr, fq * 8), boff = lds_byte(wc * 32 + fr, fq * 8);
    const char* Abase = (const char*)g.A;
#define PG8_SA(b, h) (((b) * 2 + (h)) * HTB)
#define PG8_SB(b, h) ((4 + (b) * 2 + (h)) * HTB)
#define PG8_STAGE(bufoff, gbase, voff) do { _Pragma("unroll") for (int _i = 0; _i < 2; ++_i) \
        __builtin_amdgcn_global_load_lds((const unsigned*)((const char*)(gbase) + (voff)[_i]), (LAS unsigned*)(lds + (bufoff) + ldsw + _i * 8192), 16, 0, 0); } while (0)
#define PG8_LDA(dst, b, h) do { _Pragma("unroll") for (int m = 0; m < 4; ++m) _Pragma("unroll") for (int k = 0; k < 2; ++k) dst[m][k] = *(const LAS bf16x8*)(lds + PG8_SA(b, h) + aoff + m * 2048 + k * 1024); } while (0)
#define PG8_LDB(dst, b, h) do { _Pragma("unroll") for (int n = 0; n < 2; ++n) _Pragma("unroll") for (int k = 0; k < 2; ++k) dst[n][k] = *(const LAS bf16x8*)(lds + PG8_SB(b, h) + boff + n * 2048 + k * 1024); } while (0)
#define PG8_MMA(ai, bj, At, Bt) do { __builtin_amdgcn_s_setprio(1); _Pragma("unroll") for (int m = 0; m < 4; ++m) _Pragma("unroll") for (int n = 0; n < 2; ++n) _Pragma("unroll") for (int k = 0; k < 2; ++k) \
        acc[ai][bj][m][n] = __builtin_amdgcn_mfma_f32_16x16x32_bf16(Bt[n][k], At[m][k], acc[ai][bj][m][n], 0, 0, 0); __builtin_amdgcn_s_setprio(0); } while (0)
#define PG8_WAIT_V(n) asm volatile("s_waitcnt vmcnt(" #n ")" ::: "memory")
#define PG8_WAIT_L(n) asm volatile("s_waitcnt lgkmcnt(" #n ")" ::: "memory")
#define PG8_BAR __builtin_amdgcn_s_barrier()
#define PG8_SCHED __builtin_amdgcn_sched_barrier(0)
#define PG8_VOFF(dst, u) do { _Pragma("unroll") for (int _h = 0; _h < 2; ++_h) _Pragma("unroll") for (int _i = 0; _i < 2; ++_i) { \
        int _R, _C; stage_rc(tid * 16 + _i * 8192, _R, _C); int _r = (u).m0 + _h * HALF + _R; \
        if ((u).l0) { _r = _r < (u).ntot ? _r : (u).ntot - 1; _r = _r < (u).n0 ? (u).l0[_r] : (u).l1[_r - (u).n0]; } \
        dst[_h][_i] = (unsigned)(_r * g.lda + _C) * 2u; } } while (0)
#define PG8_STA(bufoff, sel_next, h, kt) do { if constexpr (GATHER) { PG8_STAGE(bufoff, Abase + (size_t)(kt) * kstep, ((sel_next) ? nvo[h] : cvo[h])); } \
        else { PG8_STAGE(bufoff, ((sel_next) ? nA : cA) + (h) * hstepA + (size_t)(kt) * kstep, voffA); } } while (0)
    Unit cur, nxt; int ui = 0;
    if (!S.next(0, cur)) return;
    f32x4 acc[2][2][4][2];
#pragma unroll
    for (int a = 0; a < 2; ++a)
#pragma unroll
        for (int b = 0; b < 2; ++b)
#pragma unroll
            for (int m = 0; m < 4; ++m)
#pragma unroll
                for (int n = 0; n < 2; ++n) acc[a][b][m][n] = (f32x4){0.f, 0.f, 0.f, 0.f};
    bf16x8 At[4][2], B0[2][2], B1[2][2];
    unsigned cvo[2][2], nvo[2][2];
    const char* cA = Abase; const char* nA = Abase;
    if constexpr (GATHER) { PG8_VOFF(cvo, cur); } else { cA = Abase + (size_t)cur.m0 * g.lda * 2; }
    const char* cB = cur.B;
    PG8_STAGE(PG8_SB(0, 0), cB, voffB); PG8_STAGE(PG8_SB(0, 1), cB + hstepB, voffB); PG8_STA(PG8_SA(0, 0), false, 0, 0); PG8_STA(PG8_SA(0, 1), false, 1, 0);
    if (wr == 1) PG8_BAR;
    PG8_WAIT_V(2); PG8_BAR;
    PG8_STAGE(PG8_SB(1, 0), cB + kstep, voffB); PG8_STA(PG8_SA(1, 0), false, 0, 1); PG8_STAGE(PG8_SB(1, 1), cB + hstepB + kstep, voffB);
    PG8_WAIT_V(6); PG8_BAR;
    for (;;) {
        const bool has_next = S.next(ui + 1, nxt);
        if constexpr (GATHER) {
            if (has_next) { PG8_VOFF(nvo, nxt); }
            else {
#pragma unroll
                for (int h = 0; h < 2; ++h)
#pragma unroll
                    for (int i = 0; i < 2; ++i) nvo[h][i] = cvo[h][i];
            }
        } else { nA = has_next ? Abase + (size_t)nxt.m0 * g.lda * 2 : cA; }
        const char* nB = has_next ? nxt.B : cB;
        for (int t = 0; t < nt; t += 2) {
            const bool last = (t == nt - 2);
            const int kt2 = last ? 0 : t + 2;
            const char* b2 = last ? nB : cB + (size_t)(t + 2) * kstep; const char* b3 = b2 + kstep;
            PG8_LDB(B0, 0, 0); PG8_LDB(B1, 0, 1); PG8_SCHED; PG8_LDA(At, 0, 0); PG8_STA(PG8_SA(1, 1), false, 1, t + 1);
            PG8_WAIT_V(8); PG8_WAIT_L(0); PG8_BAR; PG8_MMA(0, 0, At, B0); PG8_MMA(0, 1, At, B1); PG8_BAR; PG8_SCHED;
            PG8_LDA(At, 0, 1); PG8_STAGE(PG8_SB(0, 0), b2, voffB); PG8_STAGE(PG8_SB(0, 1), b2 + hstepB, voffB); PG8_STA(PG8_SA(0, 0), last, 0, kt2);
            PG8_WAIT_V(8); PG8_WAIT_L(0); PG8_BAR; PG8_MMA(1, 0, At, B0); PG8_MMA(1, 1, At, B1); PG8_BAR; PG8_SCHED;
            PG8_LDB(B0, 1, 0); PG8_LDB(B1, 1, 1); PG8_SCHED; PG8_LDA(At, 1, 0); PG8_STA(PG8_SA(0, 1), last, 1, kt2);
            PG8_WAIT_V(8); PG8_WAIT_L(0); PG8_BAR; PG8_MMA(0, 0, At, B0); PG8_MMA(0, 1, At, B1); PG8_BAR; PG8_SCHED;
            PG8_LDA(At, 1, 1); PG8_STAGE(PG8_SB(1, 0), b3, voffB); PG8_STAGE(PG8_SB(1, 1), b3 + hstepB, voffB); PG8_STA(PG8_SA(1, 0), last, 0, kt2 + 1);
            PG8_WAIT_V(8); PG8_WAIT_L(0); PG8_BAR; PG8_MMA(1, 0, At, B0); PG8_MMA(1, 1, At, B1); PG8_BAR; PG8_SCHED;
        }
        if (wr == 0) PG8_BAR;
        { int t2 = threadIdx.x; asm volatile("" : "+v"(t2)); const int l2 = t2 & 63; E(acc, cur, wr, wc, l2 & 15, l2 >> 4); }
        if (!has_next) break;
#pragma unroll
        for (int a = 0; a < 2; ++a)
#pragma unroll
            for (int b = 0; b < 2; ++b)
#pragma unroll
                for (int m = 0; m < 4; ++m)
#pragma unroll
                    for (int n = 0; n < 2; ++n) acc[a][b][m][n] = (f32x4){0.f, 0.f, 0.f, 0.f};
        cur = nxt; cB = nB; cA = nA; ++ui;
        if constexpr (GATHER) {
#pragma unroll
            for (int h = 0; h < 2; ++h)
#pragma unroll
                for (int i = 0; i < 2; ++i) cvo[h][i] = nvo[h][i];
        }
        if (wr == 1) PG8_BAR;
    }
    PG8_WAIT_V(0);
    PG8_BAR;
#undef PG8_SA
#undef PG8_SB
#undef PG8_STAGE
#undef PG8_LDA
#undef PG8_LDB
#undef PG8_MMA
#undef PG8_WAIT_V
#undef PG8_WAIT_L
#undef PG8_BAR
#undef PG8_SCHED
#undef PG8_VOFF
#undef PG8_STA
}

struct DenseSched {
    int nM, nN, nwg, G, c; const bf16_t* Bt; int K;
    __device__ void init(int M, int N, int K_, const bf16_t* Bt_, int G_, int c_) { nM = M / BM; nN = N / BM; nwg = nM * nN; G = G_; c = c_; Bt = Bt_; K = K_; }
    __device__ bool next(int i, Unit& u) const {
        const long L = (long)i * G + c; if (L >= nwg) return false;
        int wgid = (int)L; { const int q = nwg / NXCD, r = nwg % NXCD, xcd = wgid % NXCD, off = wgid / NXCD; wgid = (xcd < r ? xcd * (q + 1) : r * (q + 1) + (xcd - r) * q) + off; }
        const int nig = WGM * nN, gid = wgid / nig, fm = gid * WGM, gsz = (nM - fm) < WGM ? (nM - fm) : WGM;
        const int pm = fm + ((wgid % nig) % gsz), pn = (wgid % nig) / gsz;
        u.B = (const char*)Bt + (size_t)pn * BM * K * 2; u.m0 = pm * BM; u.pn = pn; u.e = pm; u.nrows = BM; u.orow0 = pm * BM; u.l0 = nullptr; u.l1 = nullptr; u.n0 = 0; u.ntot = 0;
        return true;
    }
};
}
#define XB_TMO      128
#define XB_XCNT(j)  (256  + 64 * (j))
#define XB_XSUB(j)  (1280 + 64 * (j))
#define XB_XGEN(j)  (2304 + 64 * (j))
#define XB_TOP      3328
#define XB_TOPGEN   3392
#define XCD_BAR_WORDS 3456
#define XB_SPIN_CAP (1u << 18)

__device__ __forceinline__ unsigned xb_ld(unsigned* p)              { return __hip_atomic_load(p, __ATOMIC_RELAXED, __HIP_MEMORY_SCOPE_AGENT); }
__device__ __forceinline__ unsigned xb_add(unsigned* p, unsigned v) { return __hip_atomic_fetch_add(p, v, __ATOMIC_RELAXED, __HIP_MEMORY_SCOPE_AGENT); }
__device__ __forceinline__ unsigned xb_xcc_id() { return (unsigned)__builtin_amdgcn_s_getreg((3 << 11) | 20) & 0xFu; }
#define XB_SPIN(cond, bar) do { unsigned _sp = 0; while (cond) { __builtin_amdgcn_s_sleep(1); \
    if ((++_sp & 255u) == 0u) { if (xb_ld(&(bar)[XB_TMO])) break; if (_sp > XB_SPIN_CAP) { atomicAdd(&(bar)[XB_TMO], 1u); break; } } } } while (0)

struct XcdBarrier { unsigned* bar; unsigned x; volatile LAS unsigned* st; };

__device__ __forceinline__ XcdBarrier xcd_barrier_post(unsigned* bar, volatile LAS unsigned* st) {
    XcdBarrier b; b.bar = bar; b.x = xb_xcc_id(); b.st = st;
    if (threadIdx.x == 0) (void)xb_add(&bar[XB_XCNT(b.x)], 1u);
    return b;
}
__device__ __forceinline__ void xcd_barrier_complete(unsigned* bar, unsigned x, unsigned& nloc, unsigned& nx) {
    const unsigned G = gridDim.x * gridDim.y * gridDim.z;
    unsigned sum, cnt, mine, sp = 0u;
    for (;;) {
        sum = 0u; cnt = 0u; mine = 0u;
#pragma unroll
        for (unsigned j = 0; j < 16; ++j) { const unsigned c = xb_ld(&bar[XB_XCNT(j)]); sum += c; cnt += (c > 0u) ? 1u : 0u; mine = (j == x) ? c : mine; }
        if (sum == G) break;
        __builtin_amdgcn_s_sleep(1);
        if ((++sp & 255u) == 0u) { if (xb_ld(&bar[XB_TMO])) break; if (sp > XB_SPIN_CAP) { atomicAdd(&bar[XB_TMO], 1u); break; } }
    }
    nloc = mine > 0u ? mine : 1u; nx = cnt > 0u ? cnt : 1u;
}
__device__ __forceinline__ void xcd_barrier(const XcdBarrier& b) {
    asm volatile("s_waitcnt vmcnt(0)" ::: "memory");
    __syncthreads();
    int tid_ = threadIdx.x; asm volatile("" : "+v"(tid_));
    if (tid_ == 0) {
        unsigned* bar = b.bar; asm volatile("" : "+s"(bar)); unsigned bx_ = b.x; asm volatile("" : "+s"(bx_));
        __builtin_amdgcn_s_waitcnt(0);
        unsigned nloc = b.st[0], nx = b.st[1];
        if (nloc == 0u) { xcd_barrier_complete(bar, bx_, nloc, nx); b.st[0] = nloc; b.st[1] = nx; }
        const unsigned old = xb_add(&bar[XB_XSUB(bx_)], 1u);
        const unsigned gen = old / nloc;
        if (old + 1u == (gen + 1u) * nloc) {
            __builtin_amdgcn_fence(__ATOMIC_RELEASE, "agent");
            asm volatile("s_waitcnt vmcnt(0)" ::: "memory");
            const unsigned og = xb_add(&bar[XB_TOP], 1u);
            const unsigned tg = og / nx;
            if (og + 1u == (tg + 1u) * nx) xb_add(&bar[XB_TOPGEN], 1u);
            else XB_SPIN(xb_ld(&bar[XB_TOPGEN]) == tg, bar);
            __builtin_amdgcn_fence(__ATOMIC_ACQUIRE, "agent");
            xb_add(&bar[XB_XGEN(bx_)], 1u);
            asm volatile("s_waitcnt vmcnt(0)" ::: "memory");
        } else {
            XB_SPIN(xb_ld(&bar[XB_XGEN(bx_)]) == gen, bar);
            __builtin_amdgcn_fence(__ATOMIC_ACQUIRE, "agent");
            asm volatile("s_waitcnt vmcnt(0)" ::: "memory");
        }
    }
    __syncthreads();
}
namespace epi {
using pg8::Unit;
__device__ __forceinline__ u32x4 pack8(f32x4 a, f32x4 b) { u32x4 w; w.x = cvt_pk_bf16(a[0], a[1]); w.y = cvt_pk_bf16(a[2], a[3]); w.z = cvt_pk_bf16(b[0], b[1]); w.w = cvt_pk_bf16(b[2], b[3]); return w; }

__device__ __forceinline__ float red_fq(float s) { s += __shfl_xor(s, 16); s += __shfl_xor(s, 32); return s; }
__device__ __forceinline__ void unpack8(u32x4 w, f32x4& a, f32x4& b) { a = (f32x4){bflo(w.x), bfhi(w.x), bflo(w.y), bfhi(w.y)}; b = (f32x4){bflo(w.z), bfhi(w.z), bflo(w.w), bfhi(w.w)}; }
__device__ __forceinline__ void rope32(f32x4 (&v)[2], const float* cs, const float* sn, int fq) {
#pragma unroll
    for (int n = 0; n < 2; ++n) {
        const f32x4 c4 = *(const f32x4*)(cs + 8 * (fq & 1) + 4 * n), s4 = *(const f32x4*)(sn + 8 * (fq & 1) + 4 * n);
        f32x4 p; p[0] = __shfl_xor(v[n][0], 32); p[1] = __shfl_xor(v[n][1], 32); p[2] = __shfl_xor(v[n][2], 32); p[3] = __shfl_xor(v[n][3], 32);
        v[n] = (fq < 2) ? (v[n] * c4 - p * s4) : (v[n] * c4 + p * s4);
    }
}

struct EpiInProj {
    static constexpr bool PERM = true;
    bf16_t *naq, *nak, *nav, *qlat, *kvlat, *sgna, *sgmla; float *krot, *qsq, *kvsq; const float *gq, *gk, *rcos, *rsin;
    __device__ __forceinline__ void operator()(const f32x4 (&acc)[2][2][4][2], const Unit& u, int wr, int wc, int fr, int fq) const {
        const int pn = u.pn, row0 = u.orow0 + wr * 64 + fr;
        if (pn < 4) {
            bf16_t* dst = pn < 2 ? naq : nak; const float* g = pn < 2 ? gq : gk; const int head = (pn & 1) * 4 + wc;
            f32x4 gv[2][2];
#pragma unroll
            for (int bj = 0; bj < 2; ++bj)
#pragma unroll
                for (int n = 0; n < 2; ++n) gv[bj][n] = *(const f32x4*)(g + 32 * bj + 8 * fq + 4 * n);
#pragma unroll
            for (int ai = 0; ai < 2; ++ai)
#pragma unroll
                for (int m = 0; m < 4; ++m) {
                    float ss = (sq4(acc[ai][0][m][0]) + sq4(acc[ai][0][m][1])) + (sq4(acc[ai][1][m][0]) + sq4(acc[ai][1][m][1]));
                    ss = red_fq(ss); const float rstd = rsqrtf(ss * (1.0f / 64.0f) + EPS);
                    bf16_t* rp = dst + (size_t)(row0 + ai * 128 + m * 16) * 512 + head * 64 + 8 * fq;
#pragma unroll
                    for (int bj = 0; bj < 2; ++bj) *(u32x4*)(rp + 32 * bj) = pack8(acc[ai][bj][m][0] * rstd * gv[bj][0], acc[ai][bj][m][1] * rstd * gv[bj][1]);
                }
        } else if (pn < 6) {
#pragma unroll
            for (int ai = 0; ai < 2; ++ai)
#pragma unroll
                for (int m = 0; m < 4; ++m) { bf16_t* rp = nav + (size_t)(row0 + ai * 128 + m * 16) * 512 + (pn - 4) * 256 + wc * 32 + 8 * fq;
#pragma unroll
                    for (int bj = 0; bj < 2; ++bj) *(u32x4*)(rp + 128 * bj) = pack8(acc[ai][bj][m][0], acc[ai][bj][m][1]); }
        } else if (pn == 6) {
#pragma unroll
            for (int ai = 0; ai < 2; ++ai)
#pragma unroll
                for (int m = 0; m < 4; ++m) { const int row = row0 + ai * 128 + m * 16; bf16_t* rp = qlat + (size_t)row * 256 + wc * 32 + 8 * fq;
                    float ss = (sq4(acc[ai][0][m][0]) + sq4(acc[ai][0][m][1])) + (sq4(acc[ai][1][m][0]) + sq4(acc[ai][1][m][1]));
                    ss = red_fq(ss); if (fq == 0) qsq[(size_t)row * 4 + wc] = ss;
#pragma unroll
                    for (int bj = 0; bj < 2; ++bj) *(u32x4*)(rp + 128 * bj) = pack8(acc[ai][bj][m][0], acc[ai][bj][m][1]); }
        } else if (pn == 7) {
#pragma unroll
            for (int ai = 0; ai < 2; ++ai)
#pragma unroll
                for (int m = 0; m < 4; ++m) { const int row = row0 + ai * 128 + m * 16;
                    float ss = sq4(acc[ai][0][m][0]) + sq4(acc[ai][0][m][1]);
                    ss = red_fq(ss); if (fq == 0) kvsq[(size_t)row * 4 + wc] = ss;
                    *(u32x4*)(kvlat + (size_t)row * 128 + wc * 32 + 8 * fq) = pack8(acc[ai][0][m][0], acc[ai][0][m][1]);
                    if (wc == 0) { f32x4 v[2] = {acc[ai][1][m][0], acc[ai][1][m][1]};
                        rope32(v, rcos + (size_t)row * 16, rsin + (size_t)row * 16, fq);
                        *(f32x4*)(krot + (size_t)row * 32 + 8 * fq) = v[0]; *(f32x4*)(krot + (size_t)row * 32 + 8 * fq + 4) = v[1]; } }
        } else {
            bf16_t* dst = pn < 12 ? sgna : sgmla; const int cb = ((pn - 8) & 3) * 256 + wc * 32 + 8 * fq;
#pragma unroll
            for (int ai = 0; ai < 2; ++ai)
#pragma unroll
                for (int m = 0; m < 4; ++m) { bf16_t* rp = dst + (size_t)(row0 + ai * 128 + m * 16) * 1024 + cb;
#pragma unroll
                    for (int bj = 0; bj < 2; ++bj) { f32x4 a = acc[ai][bj][m][0], b = acc[ai][bj][m][1];
#pragma unroll
                        for (int e = 0; e < 4; ++e) { a[e] = sigmoidf_fast(a[e]); b[e] = sigmoidf_fast(b[e]); }
                        *(u32x4*)(rp + 128 * bj) = pack8(a, b); } }
        }
    }
};

struct EpiUpQ {
    static constexpr bool PERM = true;
    bf16_t* qm; float* qss; const float* qsq; const float* g; const float *rcos, *rsin;
    __device__ __forceinline__ void operator()(const f32x4 (&acc)[2][2][4][2], const Unit& u, int wr, int wc, int fr, int fq) const {
        const int pn = u.pn, row0 = u.orow0 + wr * 64 + fr;
#pragma unroll
        for (int ai = 0; ai < 2; ++ai)
#pragma unroll
            for (int m = 0; m < 4; ++m) {
                const int row = row0 + ai * 128 + m * 16, b = row >> 11, s = row & 2047;
                const f32x4 sq = *(const f32x4*)(qsq + (size_t)row * 4);
                const float rstd = rsqrtf(((sq[0] + sq[1]) + (sq[2] + sq[3])) * (1.0f / 256.0f) + EPS);
                if (pn < 2) {
                    const int head = pn * 4 + wc;
                    f32x4 v[2][2]; float ss = 0.f;
#pragma unroll
                    for (int bj = 0; bj < 2; ++bj)
#pragma unroll
                        for (int n = 0; n < 2; ++n) { v[bj][n] = acc[ai][bj][m][n] * rstd; ss += sq4(v[bj][n]); }
                    ss = red_fq(ss); if (fq == 0) qss[((size_t)row * 8 + head) * 2 + 0] = ss;
                    bf16_t* rp = qm + ((size_t)(b * 8 + head) * 2048 + s) * 96 + 8 * fq;
#pragma unroll
                    for (int bj = 0; bj < 2; ++bj) *(u32x4*)(rp + 32 * bj) = pack8(v[bj][0] * *(const f32x4*)(g + 32 * bj + 8 * fq), v[bj][1] * *(const f32x4*)(g + 32 * bj + 8 * fq + 4));
                } else {
#pragma unroll
                    for (int bj = 0; bj < 2; ++bj) { const int head = 2 * wc + bj;
                        f32x4 v[2] = {acc[ai][bj][m][0] * rstd, acc[ai][bj][m][1] * rstd};
                        float ss = sq4(v[0]) + sq4(v[1]); ss = red_fq(ss); if (fq == 0) qss[((size_t)row * 8 + head) * 2 + 1] = ss;
                        rope32(v, rcos + (size_t)row * 16, rsin + (size_t)row * 16, fq);
                        *(u32x4*)(qm + ((size_t)(b * 8 + head) * 2048 + s) * 96 + 64 + 8 * fq) = pack8(v[0] * *(const f32x4*)(g + 64 + 8 * fq), v[1] * *(const f32x4*)(g + 64 + 8 * fq + 4)); }
                }
            }
    }
};

struct EpiUpKV {
    static constexpr bool PERM = true;
    bf16_t *km, *vm; const float* kvsq; const float* krot; const float* g;
    __device__ __forceinline__ void operator()(const f32x4 (&acc)[2][2][4][2], const Unit& u, int wr, int wc, int fr, int fq) const {
        const int pn = u.pn, row0 = u.orow0 + wr * 64 + fr, head = 2 * pn + (wc >> 1);
#pragma unroll
        for (int ai = 0; ai < 2; ++ai)
#pragma unroll
            for (int m = 0; m < 4; ++m) {
                const int row = row0 + ai * 128 + m * 16, b = row >> 11, s = row & 2047;
                const f32x4 sq = *(const f32x4*)(kvsq + (size_t)row * 4);
                const float rstd = rsqrtf(((sq[0] + sq[1]) + (sq[2] + sq[3])) * (1.0f / 128.0f) + EPS);
                if ((wc & 1) == 0) {
                    f32x4 v[2][2]; float ss = 0.f;
#pragma unroll
                    for (int bj = 0; bj < 2; ++bj)
#pragma unroll
                        for (int n = 0; n < 2; ++n) { v[bj][n] = acc[ai][bj][m][n] * rstd; ss += sq4(v[bj][n]); }
                    const f32x4 k0 = *(const f32x4*)(krot + (size_t)row * 32 + 8 * fq), k1 = *(const f32x4*)(krot + (size_t)row * 32 + 8 * fq + 4);
                    ss += sq4(k0) + sq4(k1); ss = red_fq(ss);
                    const float r96 = rsqrtf(ss * (1.0f / 96.0f) + EPS);
                    bf16_t* rp = km + ((size_t)(b * 8 + head) * 2048 + s) * 96 + 8 * fq;
#pragma unroll
                    for (int bj = 0; bj < 2; ++bj) *(u32x4*)(rp + 32 * bj) = pack8(v[bj][0] * r96 * *(const f32x4*)(g + 32 * bj + 8 * fq), v[bj][1] * r96 * *(const f32x4*)(g + 32 * bj + 8 * fq + 4));
                    *(u32x4*)(rp + 64) = pack8(k0 * r96 * *(const f32x4*)(g + 64 + 8 * fq), k1 * r96 * *(const f32x4*)(g + 64 + 8 * fq + 4));
                } else {
                    bf16_t* rp = vm + ((size_t)(b * 8 + head) * 2048 + s) * 64 + 8 * fq;
#pragma unroll
                    for (int bj = 0; bj < 2; ++bj) *(u32x4*)(rp + 32 * bj) = pack8(acc[ai][bj][m][0] * rstd, acc[ai][bj][m][1] * rstd);
                }
            }
    }
};

template <int PASS> struct EpiMerge {
    static constexpr bool PERM = true;
    const bf16_t* sg; bf16_t* tmp; bf16_t* out;
    __device__ __forceinline__ void operator()(const f32x4 (&acc)[2][2][4][2], const Unit& u, int wr, int wc, int fr, int fq) const {
        const int row0 = u.orow0 + wr * 64 + fr, cb = u.pn * 256 + wc * 32 + 8 * fq;
#pragma unroll
        for (int ai = 0; ai < 2; ++ai)
#pragma unroll
            for (int m = 0; m < 4; ++m) { const size_t off = (size_t)(row0 + ai * 128 + m * 16) * 1024 + cb;
#pragma unroll
                for (int bj = 0; bj < 2; ++bj) { f32x4 ga, gb; unpack8(*(const u32x4*)(sg + off + 128 * bj), ga, gb);
                    f32x4 a = acc[ai][bj][m][0] * ga, b = acc[ai][bj][m][1] * gb;
                    if (PASS == 1) *(u32x4*)(tmp + off + 128 * bj) = pack8(a, b);
                    else { f32x4 ta, tb; unpack8(*(const u32x4*)(tmp + off + 128 * bj), ta, tb); *(u32x4*)(out + off + 128 * bj) = pack8(a + ta, b + tb); } } }
    }
};

struct EpiOut {
    static constexpr bool PERM = false;
    const float* x; float* x1; const float* mod;
    __device__ __forceinline__ void operator()(const f32x4 (&acc)[2][2][4][2], const Unit& u, int wr, int wc, int fr, int fq) const {
        const int row0 = u.orow0 + wr * 64 + fr, cb = u.pn * 256 + wc * 32 + 4 * fq, b = u.orow0 >> 11;
        f32x4 gt[2][2];
#pragma unroll
        for (int bj = 0; bj < 2; ++bj)
#pragma unroll
            for (int n = 0; n < 2; ++n) gt[bj][n] = *(const f32x4*)(mod + (size_t)b * 6144 + 2048 + cb + 128 * bj + 16 * n);
#pragma unroll
        for (int ai = 0; ai < 2; ++ai)
#pragma unroll
            for (int m = 0; m < 4; ++m) { const size_t off = (size_t)(row0 + ai * 128 + m * 16) * 1024 + cb;
#pragma unroll
                for (int bj = 0; bj < 2; ++bj)
#pragma unroll
                    for (int n = 0; n < 2; ++n) { const f32x4 xv = *(const f32x4*)(x + off + 128 * bj + 16 * n); *(f32x4*)(x1 + off + 128 * bj + 16 * n) = xv + gt[bj][n] * acc[ai][bj][m][n]; } }
    }
};

struct EpiGateUp {
    static constexpr bool PERM = true;
    bf16_t* act;
    __device__ __forceinline__ void operator()(const f32x4 (&acc)[2][2][4][2], const Unit& u, int wr, int wc, int fr, int fq) const {
        const int lr0 = wr * 64 + fr, cb = u.pn * 128 + wc * 32 + 8 * fq;
        const float* wl0 = u.l0 ? (const float*)((const char*)u.l0 + (WS_WLIST - WS_LIST)) : nullptr;
        const float* wl1 = u.l0 ? (const float*)((const char*)u.l1 + (WS_WLIST - WS_LIST)) : nullptr;
#pragma unroll
        for (int ai = 0; ai < 2; ++ai)
#pragma unroll
            for (int m = 0; m < 4; ++m) { const int lr = lr0 + ai * 128 + m * 16;
                if (lr < u.nrows) {
                    float w = 1.0f; if (wl0) { const int i = u.m0 + lr; w = i < u.n0 ? wl0[i] : wl1[i - u.n0]; }
                    f32x4 a = acc[ai][0][m][0], b = acc[ai][0][m][1];
#pragma unroll
                    for (int e = 0; e < 4; ++e) { a[e] = siluf_fast(a[e]) * acc[ai][1][m][0][e] * w; b[e] = siluf_fast(b[e]) * acc[ai][1][m][1][e] * w; }
                    *(u32x4*)(act + (size_t)(u.orow0 + lr) * 256 + cb) = pack8(a, b); } }
    }
};
__device__ __forceinline__ unsigned pk4_fp8(f32x4 a) {
    int w = 0;
    w = __builtin_amdgcn_cvt_pk_fp8_f32(__builtin_amdgcn_fmed3f(a[0] * YS_SCALE, -448.f, 448.f), __builtin_amdgcn_fmed3f(a[1] * YS_SCALE, -448.f, 448.f), w, false);
    w = __builtin_amdgcn_cvt_pk_fp8_f32(__builtin_amdgcn_fmed3f(a[2] * YS_SCALE, -448.f, 448.f), __builtin_amdgcn_fmed3f(a[3] * YS_SCALE, -448.f, 448.f), w, true);
    return (unsigned)w;
}
struct EpiDown {
    static constexpr bool PERM = true;
    unsigned char* ys;
    __device__ __forceinline__ void operator()(const f32x4 (&acc)[2][2][4][2], const Unit& u, int wr, int wc, int fr, int fq) const {
        const int lr0 = wr * 64 + fr, cb = u.pn * 256 + wc * 32 + 8 * fq;
#pragma unroll
        for (int ai = 0; ai < 2; ++ai)
#pragma unroll
            for (int m = 0; m < 4; ++m) { const int lr = lr0 + ai * 128 + m * 16;
                if (lr < u.nrows) { unsigned char* rp = ys + (size_t)(u.orow0 + lr) * 1024 + cb;
#pragma unroll
                    for (int bj = 0; bj < 2; ++bj) { u32x2 w; w.x = pk4_fp8(acc[ai][bj][m][0]); w.y = pk4_fp8(acc[ai][bj][m][1]); *(u32x2*)(rp + 128 * bj) = w; } } }
    }
};
}
struct Frame {
    LAS unsigned char* lds;
    volatile LAS unsigned* MISC;
    gu32* ctl;
    int tid, lane, wave, vcu, G;
    unsigned char* ws;
    float* out;
    __device__ __forceinline__ void refresh() { int t = threadIdx.x; asm volatile("" : "+v"(t)); tid = t; lane = t & 63; wave = __builtin_amdgcn_readfirstlane(t >> 6);
        asm volatile("" : "+s"(ws)); asm volatile("" : "+s"(out)); ctl = (gu32*)(ws + WS_CTL); }
};
__device__ __forceinline__ int fresh_tid() { int t = threadIdx.x; asm volatile("" : "+v"(t)); return t; }
template <class T> __device__ __forceinline__ T* wsp(const Frame& F, size_t off) { return (T*)(F.ws + off); }

struct MapOff { int off; __device__ int operator()(int n) const { return n + off; } };
struct MapWin { __device__ int operator()(int n) const {
    if (n < 1024) { const int sec = n >> 9, nn = n & 511, hh = nn >> 6, d = nn & 63; return sec * 512 + (hh >> 2) * 256 + 128 * (d >> 5) + 32 * (hh & 3) + (d & 31); }
    return n < 1952 ? n : n + 96; } };
struct MapUq { __device__ int operator()(int n) const { const int hh = n / 96, d = n % 96;
    return d < 64 ? (hh >> 2) * 256 + 128 * (d >> 5) + 32 * (hh & 3) + (d & 31) : 512 + 128 * (hh & 1) + 32 * (hh >> 1) + (d - 64); } };
struct MapUkv { __device__ int operator()(int n) const { const int hh = n >> 7, d = n & 127, dd = d & 63, wcn = 2 * (hh & 1) + (d >> 6);
    return (hh >> 1) * 256 + 128 * (dd >> 5) + 32 * wcn + (dd & 31); } };
struct MapGU { int up; __device__ int operator()(int f) const { return (f >> 7) * 256 + up * 128 + (f & 127); } };

template <class Map> __device__ __forceinline__ void transpose_item(const float* W, int K, int N, bf16_t* WT, Map rm, const float* kscale, LAS float* scr, int item, int lane) {
    const int nblk = N / 32, kb = item / nblk, nb = item % nblk, k0 = 64 * kb, n0 = 32 * nb;
    float tv[32];
#pragma unroll
    for (int i = 0; i < 32; ++i) { const int kk = 2 * i + (lane >> 5); tv[i] = W[(size_t)(k0 + kk) * N + n0 + (lane & 31)]; }
#pragma unroll
    for (int i = 0; i < 32; ++i) { const int kk = 2 * i + (lane >> 5); float v = tv[i]; if (kscale) v *= kscale[k0 + kk]; scr[kk * 33 + (lane & 31)] = v; }
    LDS_WAIT(); asm volatile("" ::: "memory");
    const int c = lane & 7;
#pragma unroll
    for (int j = 0; j < 4; ++j) { const int n = (lane >> 3) + 8 * j; const LAS float* s = scr + (8 * c) * 33 + n;
        u32x4 o; o.x = pk2(s[0 * 33], s[1 * 33]); o.y = pk2(s[2 * 33], s[3 * 33]); o.z = pk2(s[4 * 33], s[5 * 33]); o.w = pk2(s[6 * 33], s[7 * 33]);
        *(u32x4*)(WT + (size_t)rm(n0 + n) * K + k0 + 8 * c) = o; }
    LDS_WAIT(); asm volatile("" ::: "memory");
}

__device__ __forceinline__ void p0_prologue(Frame& F, const Args& A) {
    const int tid = F.tid;
    {
        LAS float* sc = (LAS float*)F.lds;
        LAS float* part = (LAS float*)(F.lds + 32768);
        for (int i = tid; i < NB * DM; i += NTHR) { const float v = INF(I_c)[i]; sc[i] = v / (1.0f + expf(-v)); }
        __syncthreads();
        for (int n0 = 24 * (int)blockIdx.x; n0 < 6 * DM; n0 += 24 * F.G) {
        const int kk = tid >> 5, col = tid & 31;
        float a[8];
#pragma unroll
        for (int b = 0; b < 8; ++b) a[b] = 0.f;
        if (col < 24) {
#pragma unroll 1
            for (int k0 = kk; k0 < DM; k0 += 16 * 32) { float wv[32];
#pragma unroll
                for (int q = 0; q < 32; ++q) wv[q] = INF(I_w_ada)[(size_t)(k0 + 16 * q) * 6144 + n0 + col];
#pragma unroll
                for (int q = 0; q < 32; ++q) {
#pragma unroll
                    for (int b = 0; b < 8; ++b) a[b] = fmaf(sc[b * DM + k0 + 16 * q], wv[q], a[b]); } }
        }
#pragma unroll
        for (int b = 0; b < 8; ++b) part[(kk * 8 + b) * 32 + col] = a[b];
        __syncthreads();
        if (tid < 192) { const int b = tid / 24, cc = tid % 24; float s = 0.f;
#pragma unroll
            for (int q = 0; q < 16; ++q) s += part[(q * 8 + b) * 32 + cc];
            wsp<float>(F, WS_MOD)[(size_t)b * 6144 + n0 + cc] = s + INF(I_b_ada)[n0 + cc]; }
        __syncthreads();
        }
    }
}
__device__ __forceinline__ void p0_copies(Frame& F, const Args& A) {
    const int tid = F.tid;
    LAS float* scr = (LAS float*)(F.lds + F.wave * 16384);
    const int gw = F.vcu * NWAVES + F.wave, NGW = F.G * NWAVES;
    constexpr int I_IN = 16 * 125, I_UQ = 4 * 24, I_UKV = 2 * 32, I_PN = 8 * 32, I_OUT = 16 * 32;
    constexpr int NITEMS = I_IN + I_UQ + I_UKV + 2 * I_PN + I_OUT;
    for (int it = gw; it < NITEMS; it += NGW) {
        int r = it;
        if (r < I_IN) { transpose_item(INF(I_w_in), DM, INCOLS, wsp<bf16_t>(F, WS_WIN), MapWin{}, nullptr, scr, r, F.lane); continue; } r -= I_IN;
        if (r < I_UQ) { transpose_item(INF(I_w_uq), QRANK, MH * QKD, wsp<bf16_t>(F, WS_WUQ), MapUq{}, INF(I_g_q_lat), scr, r, F.lane); continue; } r -= I_UQ;
        if (r < I_UKV) { transpose_item(INF(I_w_ukv), KVRANK, MH * 128, wsp<bf16_t>(F, WS_WUKV), MapUkv{}, INF(I_g_kv_lat), scr, r, F.lane); continue; } r -= I_UKV;
        if (r < I_PN) { transpose_item(INF(I_w_proj_na), 512, DM, wsp<bf16_t>(F, WS_WPNA), MapOff{0}, nullptr, scr, r, F.lane); continue; } r -= I_PN;
        if (r < I_PN) { transpose_item(INF(I_w_proj_mla), 512, DM, wsp<bf16_t>(F, WS_WPMLA), MapOff{0}, nullptr, scr, r, F.lane); continue; } r -= I_PN;
        transpose_item(INF(I_w_out), DM, DM, wsp<bf16_t>(F, WS_WOUT), MapOff{0}, nullptr, scr, r, F.lane);
    }
    const int gt = F.vcu * NTHR + tid, NGT = F.G * NTHR;
    for (int i = gt; i < 96 * DM / 8; i += NGT) *(u32x4*)(wsp<bf16_t>(F, WS_WIN) + (size_t)1952 * DM + (size_t)i * 8) = (u32x4){0u, 0u, 0u, 0u};
    for (int i = gt; i < NT * 16; i += NGT) { const int t = i >> 4, q = i & 15;
        const float inv = powf(10000.0f, -(float)q / 16.0f), ang = (float)((const int*)A.in[I_positions])[t] * inv;
        wsp<float>(F, WS_RCOS)[i] = cosf(ang); wsp<float>(F, WS_RSIN)[i] = sinf(ang); }
    for (int i = gt; i < 4 * 64 * 64 * 4; i += NGT) { const int ct = i >> 14, j = (i >> 8) & 63, l = (i >> 2) & 63, q = i & 3;
        wsp<float>(F, WS_RFRAG)[i] = INF(I_w_router)[(size_t)(16 * j + 4 * (l >> 4) + q) * NEXP + 16 * ct + (l & 15)]; }
}

__device__ __forceinline__ void s1_modnorm(Frame& F, const Args& A) {
    const int gw = F.vcu * NWAVES + F.wave, lane = F.lane;
    const float* mod = wsp<float>(F, WS_MOD); bf16_t* H = wsp<bf16_t>(F, WS_H);
    for (int r0 = gw * 8; r0 < NT; r0 += F.G * NWAVES * 8) {
    const int b = r0 >> 11;
    f32x4 ca[4], cs[4];
#pragma unroll
    for (int j = 0; j < 4; ++j) { const int c4 = 4 * lane + 256 * j;
        const f32x4 g = *(const f32x4*)(INF(I_g_norm1) + c4), sc = *(const f32x4*)(mod + (size_t)b * 6144 + 1024 + c4);
        ca[j] = g * (sc + 1.0f); cs[j] = *(const f32x4*)(mod + (size_t)b * 6144 + c4); }
    for (int r = r0; r < r0 + 8; ++r) {
        f32x4 v[4]; float ss = 0.f;
#pragma unroll
        for (int j = 0; j < 4; ++j) { v[j] = *(const f32x4*)(INF(I_x) + (size_t)r * DM + 4 * lane + 256 * j); ss += sq4(v[j]); }
        const float rstd = rsqrtf(wave_sum(ss) * (1.0f / DM) + EPS);
#pragma unroll
        for (int j = 0; j < 4; ++j) { const f32x4 o = v[j] * rstd * ca[j] + cs[j]; u32x2 w; w.x = cvt_pk_bf16(o[0], o[1]); w.y = cvt_pk_bf16(o[2], o[3]);
            *(u32x2*)(H + (size_t)r * DM + 4 * lane + 256 * j) = w; }
    }
    }
}
namespace attn {
__device__ __forceinline__ int crow(int r, int hi) { return (r & 3) + 8 * (r >> 2) + 4 * hi; }
constexpr int KVBLK = 64;
constexpr int L_K = 0, L_V = 26624, L_WS = 43008, L_OST = 45056, L_BIAS = 77824, L_END = 79872;
constexpr int KBUF = 13312, VBUF = 8192;
constexpr float THRN = 8.0f;

template <int DQK> struct Geo { static constexpr int KROWB = DQK * 2 + 16, NCH = DQK / 8, ND0 = DQK / 16; };

__device__ __forceinline__ int v_st(int k, int c) { const int kk = (k & ~0xC) | ((k & 4) << 1) | ((k & 8) >> 1); return ((kk >> 3) * 2 + (c >> 5)) * 512 + ((kk & 7) * 32 + (c & 31)) * 2; }
__device__ __forceinline__ int v_rd_base(int lane) { return ((lane & 3) << 3) | (((lane >> 2) & 3) << 6) | (((lane >> 4) & 1) << 5) | (((lane >> 5) & 1) << 8); }
constexpr int v_rd_off(int d0, int ks, int half) { return d0 * 512 + ks * 2048 + half * 1024; }
template <int OFF> __device__ __forceinline__ s16x4 tr_read(int vb) { s16x4 r; asm volatile("ds_read_b64_tr_b16 %0, %1 offset:%2" : "=&v"(r) : "v"(vb), "i"(OFF) : "memory"); return r; }

template <int D0> __device__ __forceinline__ void pv_one(f32x16& od, int vb, bf16x8 pa0, bf16x8 pa1, bf16x8 pa2, bf16x8 pa3) {
    const s16x4 l0 = tr_read<v_rd_off(D0, 0, 0)>(vb), h0 = tr_read<v_rd_off(D0, 0, 1)>(vb), l1 = tr_read<v_rd_off(D0, 1, 0)>(vb), h1 = tr_read<v_rd_off(D0, 1, 1)>(vb);
    const s16x4 l2 = tr_read<v_rd_off(D0, 2, 0)>(vb), h2 = tr_read<v_rd_off(D0, 2, 1)>(vb), l3 = tr_read<v_rd_off(D0, 3, 0)>(vb), h3 = tr_read<v_rd_off(D0, 3, 1)>(vb);
    asm volatile("s_waitcnt lgkmcnt(0)" ::: "memory"); SBAR();
#define PK(L, H) (bf16x8){L[0], L[1], L[2], L[3], H[0], H[1], H[2], H[3]}
    od = __builtin_amdgcn_mfma_f32_32x32x16_bf16(pa0, PK(l0, h0), od, 0, 0, 0);
    od = __builtin_amdgcn_mfma_f32_32x32x16_bf16(pa1, PK(l1, h1), od, 0, 0, 0);
    od = __builtin_amdgcn_mfma_f32_32x32x16_bf16(pa2, PK(l2, h2), od, 0, 0, 0);
    od = __builtin_amdgcn_mfma_f32_32x32x16_bf16(pa3, PK(l3, h3), od, 0, 0, 0);
#undef PK
}

template <int DQK> __device__ __forceinline__ void qkt(f32x16& p0, f32x16& p1, const LAS unsigned char* Ks, const bf16x8* qr, int r32, int hi) {
    p0 = f32x16{}; p1 = f32x16{};
#pragma unroll
    for (int d0 = 0; d0 < Geo<DQK>::ND0; ++d0) { const int cb = (d0 * 16 + hi * 8) * 2;
        const bf16x8 b0 = *(const LAS bf16x8*)(Ks + r32 * Geo<DQK>::KROWB + cb);
        const bf16x8 b1 = *(const LAS bf16x8*)(Ks + (32 + r32) * Geo<DQK>::KROWB + cb);
        p0 = __builtin_amdgcn_mfma_f32_32x32x16_bf16(b0, qr[d0], p0, 0, 0, 0);
        p1 = __builtin_amdgcn_mfma_f32_32x32x16_bf16(b1, qr[d0], p1, 0, 0, 0); }
}
__device__ __forceinline__ void softmax_tile(f32x16& p0, f32x16& p1, float& m_reg, float& alpha, float& l_reg, float C, float thr_raw,
                                             bf16x8& pa0, bf16x8& pa1, bf16x8& pa2, bf16x8& pa3) {
    float pmax = p0[0];
#pragma unroll
    for (int r = 1; r < 16; ++r) pmax = fmaxf(pmax, p0[r]);
#pragma unroll
    for (int r = 0; r < 16; ++r) pmax = fmaxf(pmax, p1[r]);
    { auto rr = __builtin_amdgcn_permlane32_swap(__float_as_uint(pmax), __float_as_uint(pmax), false, false);
      pmax = fmaxf(__uint_as_float(rr[0]), __uint_as_float(rr[1])); }
    float mn;
    if (__builtin_expect(__all(pmax - m_reg <= thr_raw), 1)) { mn = m_reg; alpha = 1.f; }
    else { mn = fmaxf(m_reg, pmax); alpha = __builtin_amdgcn_exp2f((m_reg - mn) * C); m_reg = mn; }
    const float mnC = -mn * C;
#pragma unroll
    for (int r = 0; r < 16; ++r) { p0[r] = __builtin_amdgcn_exp2f(fmaf(p0[r], C, mnC)); p1[r] = __builtin_amdgcn_exp2f(fmaf(p1[r], C, mnC)); }
    float ps = 0;
#pragma unroll
    for (int r = 0; r < 16; ++r) ps += p0[r];
#pragma unroll
    for (int r = 0; r < 16; ++r) ps += p1[r];
    { auto rr = __builtin_amdgcn_permlane32_swap(__float_as_uint(ps), __float_as_uint(ps), false, false);
      ps = __uint_as_float(rr[0]) + __uint_as_float(rr[1]); }
    l_reg = l_reg * alpha + ps;
#define PK4(P, BASE, OUT) do { unsigned a0 = cvt_pk_bf16(P[BASE + 0], P[BASE + 1]), a1 = cvt_pk_bf16(P[BASE + 2], P[BASE + 3]);   \
    unsigned b0 = cvt_pk_bf16(P[BASE + 4], P[BASE + 5]), b1 = cvt_pk_bf16(P[BASE + 6], P[BASE + 7]);                              \
    auto r0 = __builtin_amdgcn_permlane32_swap(a0, b0, false, false); auto r1 = __builtin_amdgcn_permlane32_swap(a1, b1, false, false); \
    u32x4 w = {r0[0], r1[0], r0[1], r1[1]}; OUT = __builtin_bit_cast(bf16x8, w); } while (0)
    PK4(p0, 0, pa0); PK4(p0, 8, pa1); PK4(p1, 0, pa2); PK4(p1, 8, pa3);
#undef PK4
}

template <int DQK, bool NA>
__device__ __forceinline__ void attn_unit(LAS unsigned char* lds, const bf16_t* Qw, int ldq, float qscale, const bf16_t* Kt, int ldk, const bf16_t* Vt, int ldv, bf16_t* Ow,
                                          int ntiles, float SCALE, int na_first, int na_qc0, int na_dr0) {
    using G = Geo<DQK>;
    int tid_ = threadIdx.x; asm volatile("" : "+v"(tid_));
    const int tid = tid_, lane = tid & 63, r32 = lane & 31, hi = lane >> 5; const int wid = __builtin_amdgcn_readfirstlane(tid >> 6);
    const float C = SCALE * 1.4426950408889634f, thr_raw = THRN / SCALE;
    LAS float* wsf = (LAS float*)(lds + L_WS) + wid * 64;
    bf16x8 qr[G::ND0];
#pragma unroll
    for (int d0 = 0; d0 < G::ND0; ++d0) { u32x4 w = *(const u32x4*)(Qw + (size_t)r32 * ldq + d0 * 16 + hi * 8);
        if (!NA) { f32x4 a, b; a = (f32x4){bflo(w.x), bfhi(w.x), bflo(w.y), bfhi(w.y)} * qscale; b = (f32x4){bflo(w.z), bfhi(w.z), bflo(w.w), bfhi(w.w)} * qscale;
            w.x = cvt_pk_bf16(a[0], a[1]); w.y = cvt_pk_bf16(a[2], a[3]); w.z = cvt_pk_bf16(b[0], b[1]); w.w = cvt_pk_bf16(b[2], b[3]); }
        qr[d0] = __builtin_bit_cast(bf16x8, w); }
    const int vk = tid >> 3, vc = (tid & 7) * 8, vst = v_st(vk, vc);
    const int k0r = tid / G::NCH, k0c = tid % G::NCH; const int k1id = tid + 512, k1r = k1id / G::NCH, k1c = k1id % G::NCH; const bool k1on = (G::NCH == 12) && (tid < 256);
    const int vb0 = (int)(uintptr_t)(lds + L_V) + v_rd_base(lane);
    u32x4 sv, sk0, sk1;
#define SLOAD(j) do { const size_t kb_ = (size_t)(j) * KVBLK; sv = *(const u32x4*)(Vt + (kb_ + vk) * ldv + vc); sk0 = *(const u32x4*)(Kt + (kb_ + k0r) * ldk + k0c * 8); \
        if (k1on) sk1 = *(const u32x4*)(Kt + (kb_ + k1r) * ldk + k1c * 8); } while (0)
#define SWRITE(bf) do { *(LAS u32x4*)(lds + L_V + (bf) * VBUF + vst) = sv; *(LAS u32x4*)(lds + L_K + (bf) * KBUF + k0r * G::KROWB + k0c * 16) = sk0; \
        if (k1on) *(LAS u32x4*)(lds + L_K + (bf) * KBUF + k1r * G::KROWB + k1c * 16) = sk1; } while (0)
    float m_reg = -1e30f, l_reg = 0.f; f32x16 o[2]; o[0] = f32x16{}; o[1] = f32x16{};
    SLOAD(0); VM_WAIT(); SWRITE(0); if (ntiles > 1) SLOAD(1);
    __syncthreads();
    for (int j = 0; j < ntiles; ++j) {
        const int bf = j & 1;
        bool active = true; int dr = 0;
        if (NA) { dr = na_dr0 + j; active = (j >= na_first) && (j < na_first + 8); }
        if (active) {
            f32x16 p0, p1; bf16x8 pa0, pa1, pa2, pa3; float alpha;
            qkt<DQK>(p0, p1, lds + L_K + bf * KBUF, qr, r32, hi);
            if (NA) {
                const LAS float* bt = (const LAS float*)(lds + L_BIAS) + (dr + 7) * 32;
                const int qc = na_qc0 + r32; int cs = qc - 8; cs = cs < 0 ? 0 : (cs > 48 ? 48 : cs);
#pragma unroll
                for (int r = 0; r < 16; ++r) {
                    const int kc0 = crow(r, hi), kc1 = kc0 + 32;
                    int i0 = kc0 - qc + 15; i0 = i0 < 0 ? 0 : (i0 > 30 ? 30 : i0); int i1 = kc1 - qc + 15; i1 = i1 < 0 ? 0 : (i1 > 30 ? 30 : i1);
                    const float b0 = bt[i0], b1 = bt[i1];
                    p0[r] = ((unsigned)(kc0 - cs) < 16u) ? p0[r] + b0 : -1e30f;
                    p1[r] = ((unsigned)(kc1 - cs) < 16u) ? p1[r] + b1 : -1e30f;
                }
            }
            softmax_tile(p0, p1, m_reg, alpha, l_reg, C, thr_raw, pa0, pa1, pa2, pa3);
            if (__any(alpha < 1.f)) { if (hi == 0) wsf[r32] = alpha; LDS_WAIT();
#pragma unroll
                for (int d = 0; d < 2; ++d)
#pragma unroll
                    for (int r = 0; r < 16; ++r) o[d][r] *= wsf[crow(r, hi)]; }
            SBAR();
            pv_one<0>(o[0], vb0 + bf * VBUF, pa0, pa1, pa2, pa3); pv_one<1>(o[1], vb0 + bf * VBUF, pa0, pa1, pa2, pa3);
        }
        if (j + 1 < ntiles) { VM_WAIT(); SWRITE(bf ^ 1); if (j + 2 < ntiles) SLOAD(j + 2); }
        __syncthreads();
    }
#undef SLOAD
#undef SWRITE
    if (hi == 0) wsf[32 + r32] = l_reg; LDS_WAIT();
    float rli[16];
#pragma unroll
    for (int r = 0; r < 16; ++r) rli[r] = __builtin_amdgcn_rcpf(wsf[32 + crow(r, hi)]);
    LAS bf16_t* stg = (LAS bf16_t*)(lds + L_OST) + wid * 2048;
#pragma unroll
    for (int r = 0; r < 16; ++r) { const int orow = crow(r, hi);
#pragma unroll
        for (int d0 = 0; d0 < 2; ++d0) stg[orow * 64 + d0 * 32 + r32] = (bf16_t)f2bf(o[d0][r] * rli[r]); }
    LDS_WAIT();
#pragma unroll
    for (int i = 0; i < 4; ++i) { const int row = i * 8 + (lane >> 3), ch = lane & 7; const u32x4 v = *(const LAS u32x4*)(stg + row * 64 + ch * 8); *(u32x4*)(Ow + (size_t)row * 512 + ch * 8) = v; }
    LDS_WAIT();
    __syncthreads();
}

__device__ __forceinline__ void partialSM(f32x16& p0, f32x16& p1, float& m_reg, float& alpha, float C, float thr_raw) {
    float pmax = p0[0];
#pragma unroll
    for (int r = 1; r < 16; ++r) pmax = fmaxf(pmax, p0[r]);
#pragma unroll
    for (int r = 0; r < 16; ++r) pmax = fmaxf(pmax, p1[r]);
    { auto rr = __builtin_amdgcn_permlane32_swap(__float_as_uint(pmax), __float_as_uint(pmax), false, false);
      pmax = fmaxf(__uint_as_float(rr[0]), __uint_as_float(rr[1])); }
    float mn;
    if (__builtin_expect(__all(pmax - m_reg <= thr_raw), 1)) { mn = m_reg; alpha = 1.f; }
    else { mn = fmaxf(m_reg, pmax); alpha = __builtin_amdgcn_exp2f((m_reg - mn) * C); m_reg = mn; }
    const float mnC = -mn * C;
#pragma unroll
    for (int r = 0; r < 16; ++r) { p0[r] = fmaf(p0[r], C, mnC); p1[r] = fmaf(p1[r], C, mnC); }
#pragma unroll
    for (int r = 0; r < 16; ++r) p0[r] = __builtin_amdgcn_exp2f(p0[r]);
}
__device__ __forceinline__ void finishSM(f32x16& p0, f32x16& p1, float alpha, float& l_reg, bf16x8& pa0, bf16x8& pa1, bf16x8& pa2, bf16x8& pa3) {
#pragma unroll
    for (int r = 0; r < 16; ++r) p1[r] = __builtin_amdgcn_exp2f(p1[r]);
    float ps = 0;
#pragma unroll
    for (int r = 0; r < 16; ++r) ps += p0[r];
#pragma unroll
    for (int r = 0; r < 16; ++r) ps += p1[r];
    { auto rr = __builtin_amdgcn_permlane32_swap(__float_as_uint(ps), __float_as_uint(ps), false, false);
      ps = __uint_as_float(rr[0]) + __uint_as_float(rr[1]); }
    l_reg = l_reg * alpha + ps;
#define PK4(P, BASE, OUT) do { unsigned a0 = cvt_pk_bf16(P[BASE + 0], P[BASE + 1]), a1 = cvt_pk_bf16(P[BASE + 2], P[BASE + 3]);   \
    unsigned b0 = cvt_pk_bf16(P[BASE + 4], P[BASE + 5]), b1 = cvt_pk_bf16(P[BASE + 6], P[BASE + 7]);                              \
    auto r0 = __builtin_amdgcn_permlane32_swap(a0, b0, false, false); auto r1 = __builtin_amdgcn_permlane32_swap(a1, b1, false, false); \
    u32x4 w = {r0[0], r1[0], r0[1], r1[1]}; OUT = __builtin_bit_cast(bf16x8, w); } while (0)
    PK4(p0, 0, pa0); PK4(p0, 8, pa1); PK4(p1, 0, pa2); PK4(p1, 8, pa3);
#undef PK4
}
template <int DQK>
__device__ __forceinline__ void attn_unit_pipe(LAS unsigned char* lds, const bf16_t* Qw, int ldq, float qscale, const bf16_t* Kt, int ldk, const bf16_t* Vt, int ldv, bf16_t* Ow, int ntiles, float SCALE) {
    using G = Geo<DQK>;
    int tid_ = threadIdx.x; asm volatile("" : "+v"(tid_));
    const int tid = tid_, lane = tid & 63, r32 = lane & 31, hi = lane >> 5; const int wid = __builtin_amdgcn_readfirstlane(tid >> 6);
    const float C = SCALE * 1.4426950408889634f, thr_raw = THRN / SCALE;
    LAS float* wsf = (LAS float*)(lds + L_WS) + wid * 64;
    bf16x8 qr[G::ND0];
#pragma unroll
    for (int d0 = 0; d0 < G::ND0; ++d0) { u32x4 w = *(const u32x4*)(Qw + (size_t)r32 * ldq + d0 * 16 + hi * 8);
        f32x4 a, b; a = (f32x4){bflo(w.x), bfhi(w.x), bflo(w.y), bfhi(w.y)} * qscale; b = (f32x4){bflo(w.z), bfhi(w.z), bflo(w.w), bfhi(w.w)} * qscale;
        w.x = cvt_pk_bf16(a[0], a[1]); w.y = cvt_pk_bf16(a[2], a[3]); w.z = cvt_pk_bf16(b[0], b[1]); w.w = cvt_pk_bf16(b[2], b[3]);
        qr[d0] = __builtin_bit_cast(bf16x8, w); }
    const int vk = tid >> 3, vc = (tid & 7) * 8, vst = v_st(vk, vc);
    const int k0r = tid / G::NCH, k0c = tid % G::NCH; const int k1id = tid + 512, k1r = k1id / G::NCH, k1c = k1id % G::NCH; const bool k1on = (G::NCH == 12) && (wid < 4);
    const int vb0 = (int)(uintptr_t)(lds + L_V) + v_rd_base(lane);
    u32x4 evv, ek0, ek1, ovv, ok0, ok1;
#define SLOAD(V_, K0_, K1_, j) do { const size_t kb_ = (size_t)(j) * KVBLK; V_ = *(const u32x4*)(Vt + (kb_ + vk) * ldv + vc); K0_ = *(const u32x4*)(Kt + (kb_ + k0r) * ldk + k0c * 8); \
        if (k1on) K1_ = *(const u32x4*)(Kt + (kb_ + k1r) * ldk + k1c * 8); } while (0)
#define SWRITE(bf, V_, K0_, K1_) do { *(LAS u32x4*)(lds + L_V + (bf) * VBUF + vst) = V_; *(LAS u32x4*)(lds + L_K + (bf) * KBUF + k0r * G::KROWB + k0c * 16) = K0_; \
        if (k1on) *(LAS u32x4*)(lds + L_K + (bf) * KBUF + k1r * G::KROWB + k1c * 16) = K1_; } while (0)
#define RESC(a) do { if (__any((a) < 1.f)) { if (hi == 0) wsf[r32] = (a); LDS_WAIT(); \
        _Pragma("unroll") for (int d = 0; d < 2; ++d) _Pragma("unroll") for (int r = 0; r < 16; ++r) o[d][r] *= wsf[crow(r, hi)]; } } while (0)
    float m_reg = -1e30f, l_reg = 0.f; f32x16 o[2]; o[0] = f32x16{}; o[1] = f32x16{};
    f32x16 pA0, pA1, pB0, pB1; float alA, alB; bf16x8 pa0, pa1, pa2, pa3;
    const LAS unsigned char* K0p = lds + L_K; const LAS unsigned char* K1p = lds + L_K + KBUF;
    SLOAD(evv, ek0, ek1, 0); SWRITE(0, evv, ek0, ek1); __syncthreads();
    qkt<DQK>(pA0, pA1, K0p, qr, r32, hi); partialSM(pA0, pA1, m_reg, alA, C, thr_raw);
    SLOAD(ovv, ok0, ok1, 1); SLOAD(evv, ek0, ek1, 2);
    SWRITE(1, ovv, ok0, ok1); __syncthreads();
    for (int j = 1; j + 1 < ntiles; j += 2) {
        SBAR(); qkt<DQK>(pB0, pB1, K1p, qr, r32, hi);
        finishSM(pA0, pA1, alA, l_reg, pa0, pa1, pa2, pa3); SBAR();
        SLOAD(ovv, ok0, ok1, j + 2); SBAR();
        pv_one<0>(o[0], vb0, pa0, pa1, pa2, pa3); pv_one<1>(o[1], vb0, pa0, pa1, pa2, pa3); partialSM(pB0, pB1, m_reg, alB, C, thr_raw);
        __syncthreads(); SWRITE(0, evv, ek0, ek1);
        RESC(alB); __syncthreads();
        SBAR(); qkt<DQK>(pA0, pA1, K0p, qr, r32, hi);
        finishSM(pB0, pB1, alB, l_reg, pa0, pa1, pa2, pa3); SBAR();
        if (j + 3 < ntiles) SLOAD(evv, ek0, ek1, j + 3); SBAR();
        pv_one<0>(o[0], vb0 + VBUF, pa0, pa1, pa2, pa3); pv_one<1>(o[1], vb0 + VBUF, pa0, pa1, pa2, pa3); partialSM(pA0, pA1, m_reg, alA, C, thr_raw);
        __syncthreads(); SWRITE(1, ovv, ok0, ok1);
        RESC(alA); __syncthreads();
    }
    SBAR(); qkt<DQK>(pB0, pB1, K1p, qr, r32, hi);
    finishSM(pA0, pA1, alA, l_reg, pa0, pa1, pa2, pa3); SBAR();
    pv_one<0>(o[0], vb0, pa0, pa1, pa2, pa3); pv_one<1>(o[1], vb0, pa0, pa1, pa2, pa3); partialSM(pB0, pB1, m_reg, alB, C, thr_raw);
    __syncthreads(); RESC(alB);
    finishSM(pB0, pB1, alB, l_reg, pa0, pa1, pa2, pa3); SBAR();
    pv_one<0>(o[0], vb0 + VBUF, pa0, pa1, pa2, pa3); pv_one<1>(o[1], vb0 + VBUF, pa0, pa1, pa2, pa3);
#undef SLOAD
#undef SWRITE
#undef RESC
    if (hi == 0) wsf[32 + r32] = l_reg; LDS_WAIT();
    float rli[16];
#pragma unroll
    for (int r = 0; r < 16; ++r) rli[r] = __builtin_amdgcn_rcpf(wsf[32 + crow(r, hi)]);
    LAS bf16_t* stg = (LAS bf16_t*)(lds + L_OST) + wid * 2048;
#pragma unroll
    for (int r = 0; r < 16; ++r) { const int orow = crow(r, hi);
#pragma unroll
        for (int d0 = 0; d0 < 2; ++d0) stg[orow * 64 + d0 * 32 + r32] = (bf16_t)f2bf(o[d0][r] * rli[r]); }
    LDS_WAIT();
#pragma unroll
    for (int i = 0; i < 4; ++i) { const int row = i * 8 + (lane >> 3), ch = lane & 7; const u32x4 v = *(const LAS u32x4*)(stg + row * 64 + ch * 8); *(u32x4*)(Ow + (size_t)row * 512 + ch * 8) = v; }
    LDS_WAIT();
    __syncthreads();
}
}

__device__ __forceinline__ void s4_attention(Frame& F, const Args& A, int rep_mla, int rep_na) {
    const int wave = F.wave;
    for (int rp = 0; rp < rep_mla; ++rp)
    for (int un = F.vcu; un < NB * MH * 8; un += F.G) {
        const int bh = un >> 3, qb = un & 7, b = bh >> 3, h = bh & 7;
        const int s0 = qb * 256 + wave * 32, t0 = b * SEQ + s0, r32 = F.lane & 31;
        const float* qss = wsp<float>(F, WS_QSS) + ((size_t)(t0 + r32) * 8 + h) * 2;
        const float qscale = rsqrtf((qss[0] + qss[1]) * (1.0f / 96.0f) + EPS);
        attn::attn_unit_pipe<96>(F.lds, wsp<bf16_t>(F, WS_QM) + ((size_t)bh * SEQ + s0) * 96, 96, qscale,
                                 wsp<bf16_t>(F, WS_KM) + (size_t)bh * SEQ * 96, 96, wsp<bf16_t>(F, WS_VM) + (size_t)bh * SEQ * 64, 64,
                                 wsp<bf16_t>(F, WS_YMLA) + (size_t)t0 * 512 + h * 64, SEQ / 64, 0.10206207261596577f);
    }
    for (int rp = 0; rp < rep_na; ++rp)
    for (int un = F.vcu; un < NB * NAH * 8; un += F.G) {
        const int bh = un >> 3, g = un & 7, b = bh >> 3, h = bh & 7;
        LAS float* bt = (LAS float*)(F.lds + attn::L_BIAS);
        for (int i = F.tid; i < 15 * 32; i += NTHR) { const int rr = i >> 5, cc = i & 31; bt[i] = cc < 31 ? INF(I_na_rpb)[(size_t)(h * 15 + rr) * 31 + cc] * 8.0f : 0.f; }
        int lo = 4 * g - 4; lo = lo < 0 ? 0 : (lo > 24 ? 24 : lo); int hi_s = 4 * g + 3 - 4; hi_s = hi_s < 0 ? 0 : (hi_s > 24 ? 24 : hi_s);
        const int ntiles = hi_s + 8 - lo;
        const int qrow = 4 * g + (wave >> 1); int rs = qrow - 4; rs = rs < 0 ? 0 : (rs > 24 ? 24 : rs);
        const int t0 = b * SEQ + qrow * 64 + 32 * (wave & 1);
        __syncthreads();
        attn::attn_unit<64, true>(F.lds, wsp<bf16_t>(F, WS_NAQ) + (size_t)t0 * 512 + h * 64, 512, 1.0f,
                                  wsp<bf16_t>(F, WS_NAK) + (size_t)(b * SEQ + lo * 64) * 512 + h * 64, 512, wsp<bf16_t>(F, WS_NAV) + (size_t)(b * SEQ + lo * 64) * 512 + h * 64, 512,
                                  wsp<bf16_t>(F, WS_YNA) + (size_t)t0 * 512 + h * 64, ntiles, 0.125f, rs - lo, 32 * (wave & 1), lo - qrow);
    }
}
namespace moe {
#define RFL(x) __builtin_amdgcn_readfirstlane(x)
constexpr int ASTR = 1028;
constexpr int L_A = 0, L_LG = 16 * ASTR * 4, L_END = L_LG + 2 * 16 * 64 * 4;
constexpr int T_CNT = 0, T_ABASE = 128, T_YBASE = 200, T_PRE = 336;

__device__ __forceinline__ void s7_router(Frame& F, const Args& A, int rep_conv, int rep_rt) {
    const int lane = F.lane, wave = F.wave;
    const float* mod = wsp<float>(F, WS_MOD); bf16_t* H2 = wsp<bf16_t>(F, WS_H2);
    LAS float* At = (LAS float*)(F.lds + L_A); LAS float* LG = (LAS float*)(F.lds + L_LG);
    const float* rfrag = wsp<float>(F, WS_RFRAG);
    int* LIST = wsp<int>(F, WS_LIST); float* WLIST = wsp<float>(F, WS_WLIST); unsigned* TOKSLOT = wsp<unsigned>(F, WS_TOKSLOT);
    const float ebias = INF(I_e_bias)[lane];
    for (int rp = 0; rp < rep_rt; ++rp)
    for (int un = F.vcu; un < NT / 16; un += F.G) {
        const bool dry = rp + 1 < rep_rt;
        const int row0 = un * 16, b = row0 >> 11;
        const float* bp = rfrag + ((size_t)((wave & 3) * 64 + 32 * (wave >> 2)) * 64 + lane) * 4;
        f32x4 bA[16], bB[16];
#pragma unroll
        for (int jj = 0; jj < 16; ++jj) bA[jj] = *(const f32x4*)(bp + (size_t)jj * 256);
        SBAR();
#pragma unroll 1
        for (int rr = 0; rr < 2; ++rr) {
            const int lr = 2 * wave + rr, row = row0 + lr;
            f32x4 v[4]; float ss = 0.f;
#pragma unroll
            for (int j = 0; j < 4; ++j) { v[j] = *(const f32x4*)(F.out + (size_t)row * DM + 4 * lane + 256 * j); ss += sq4(v[j]); }
            const float rstd = rsqrtf(wave_sum(ss) * (1.0f / DM) + EPS);
#pragma unroll
            for (int j = 0; j < 4; ++j) { const int c4 = 4 * lane + 256 * j;
                const f32x4 g = *(const f32x4*)(INF(I_g_norm2) + c4), sc = *(const f32x4*)(mod + (size_t)b * 6144 + 4096 + c4), sh = *(const f32x4*)(mod + (size_t)b * 6144 + 3072 + c4);
                const f32x4 o = v[j] * rstd * (g * (sc + 1.0f)) + sh;
                u32x2 w; w.x = cvt_pk_bf16(o[0], o[1]); w.y = cvt_pk_bf16(o[2], o[3]);
                *(u32x2*)(H2 + (size_t)row * DM + c4) = w;
                *(LAS f32x4*)(At + lr * ASTR + c4) = o; }
        }
        __syncthreads();
        {
            const int ct = wave & 3, kh = wave >> 2; f32x4 acc = {0.f, 0.f, 0.f, 0.f};
            const LAS float* ap = At + (lane & 15) * ASTR + 4 * (lane >> 4);
#pragma unroll
            for (int jj = 0; jj < 16; ++jj) bB[jj] = *(const f32x4*)(bp + (size_t)(16 + jj) * 256);
            SBAR();
#pragma unroll
            for (int jj = 0; jj < 16; ++jj) { const f32x4 a4 = *(const LAS f32x4*)(ap + 16 * (32 * kh + jj)); const f32x4 b4 = bA[jj];
                acc = __builtin_amdgcn_mfma_f32_16x16x4f32(a4[0], b4[0], acc, 0, 0, 0); acc = __builtin_amdgcn_mfma_f32_16x16x4f32(a4[1], b4[1], acc, 0, 0, 0);
                acc = __builtin_amdgcn_mfma_f32_16x16x4f32(a4[2], b4[2], acc, 0, 0, 0); acc = __builtin_amdgcn_mfma_f32_16x16x4f32(a4[3], b4[3], acc, 0, 0, 0);
                if ((jj & 3) == 3) SBAR(); }
#pragma unroll
            for (int jj = 0; jj < 16; ++jj) { const f32x4 a4 = *(const LAS f32x4*)(ap + 16 * (32 * kh + 16 + jj)); const f32x4 b4 = bB[jj];
                acc = __builtin_amdgcn_mfma_f32_16x16x4f32(a4[0], b4[0], acc, 0, 0, 0); acc = __builtin_amdgcn_mfma_f32_16x16x4f32(a4[1], b4[1], acc, 0, 0, 0);
                acc = __builtin_amdgcn_mfma_f32_16x16x4f32(a4[2], b4[2], acc, 0, 0, 0); acc = __builtin_amdgcn_mfma_f32_16x16x4f32(a4[3], b4[3], acc, 0, 0, 0);
                if ((jj & 3) == 3) SBAR(); }
#pragma unroll
            for (int r = 0; r < 4; ++r) LG[(kh * 16 + 4 * (lane >> 4) + r) * 64 + 16 * ct + (lane & 15)] = acc[r];
        }
        __syncthreads();
#pragma unroll 1
        for (int rr = 0; rr < 2; ++rr) {
            const int lr = 2 * wave + rr, tok = row0 + lr;
            const float logit = LG[lr * 64 + lane] + LG[(16 + lr) * 64 + lane];
            const float score = 1.0f / (1.0f + expf(-logit));
            const float sel = score + ebias;
            float m1 = sel; m1 = fmaxf(m1, __shfl_xor(m1, 1)); m1 = fmaxf(m1, __shfl_xor(m1, 2)); m1 = fmaxf(m1, __shfl_xor(m1, 4));
            const unsigned long long bm = __ballot(sel == m1);
            const unsigned gb = (unsigned)(bm >> (lane & ~7)) & 0xffu; const int first = __ffs((int)gb) - 1;
            float m2 = ((lane & 7) == first) ? -INFINITY : sel; m2 = fmaxf(m2, __shfl_xor(m2, 1)); m2 = fmaxf(m2, __shfl_xor(m2, 2)); m2 = fmaxf(m2, __shfl_xor(m2, 4));
            const float gs = m1 + m2; int grank = 0;
            { const unsigned ub = __float_as_uint(gs), uo = (ub & 0x80000000u) ? ~ub : (ub | 0x80000000u);
              const unsigned long long key = ((unsigned long long)uo << 8) | (unsigned)(7 - (lane >> 3));
#pragma unroll
              for (int q = 0; q < 8; ++q) { const unsigned long long ok = ((unsigned long long)(unsigned)__builtin_amdgcn_readlane((int)(key >> 32), 8 * q) << 32) | (unsigned)__builtin_amdgcn_readlane((int)(unsigned)key, 8 * q); grank += ok > key ? 1 : 0; } }
            const bool gsel = grank < TOPKG; const float sm = gsel ? sel : -INFINITY; int rank = 0;
            { const unsigned ub = __float_as_uint(sm), uo = (ub & 0x80000000u) ? ~ub : (ub | 0x80000000u);
              const unsigned long long key = ((unsigned long long)uo << 8) | (unsigned)(63 - lane);
              const int khi = (int)(key >> 32), klo = (int)(unsigned)key;
#pragma unroll
              for (int q = 0; q < 64; ++q) { const unsigned long long ok = ((unsigned long long)(unsigned)__builtin_amdgcn_readlane(khi, q) << 32) | (unsigned)__builtin_amdgcn_readlane(klo, q); rank += ok > key ? 1 : 0; } }
            const bool chosen = gsel && rank < TOPK;
            const float wsum = wave_sum(chosen ? score : 0.f);
            const float w = score / wsum * 2.5f;
            if (chosen && !dry) { const int c = tok >= CHTOK ? 1 : 0, ec = lane * 2 + c;
                const unsigned pos = __hip_atomic_fetch_add((unsigned*)F.ctl + CW_CNT + ec * 16, 1u, RLX_AGENT);
                LIST[(size_t)ec * 8192 + pos] = tok; WLIST[(size_t)ec * 8192 + pos] = w; TOKSLOT[(size_t)tok * 8 + rank] = ((unsigned)lane << 16) | pos; }
        }
        __syncthreads();
    }
    LAS float* scr = (LAS float*)(F.lds + wave * 16384);
    const int gw = F.vcu * NWAVES + wave, NGW = F.G * NWAVES;
    for (int rp = 0; rp < rep_conv; ++rp)
    for (int it = gw; it < 65 * 384; it += NGW) {
        const int e = it / 384, r = it % 384;
        const float* wg = e < 64 ? INF(I_w_eg) + (size_t)e * DM * EFF : INF(I_w_sg); const float* wu = e < 64 ? INF(I_w_eu) + (size_t)e * DM * EFF : INF(I_w_su); const float* wd = e < 64 ? INF(I_w_ed) + (size_t)e * EFF * DM : INF(I_w_sd);
        if (r < 128) transpose_item(wg, DM, EFF, wsp<bf16_t>(F, WS_WGU) + (size_t)e * 512 * DM, MapGU{0}, nullptr, scr, r, lane);
        else if (r < 256) transpose_item(wu, DM, EFF, wsp<bf16_t>(F, WS_WGU) + (size_t)e * 512 * DM, MapGU{1}, nullptr, scr, r - 128, lane);
        else transpose_item(wd, EFF, DM, wsp<bf16_t>(F, WS_WD) + (size_t)e * DM * EFF, MapOff{0}, nullptr, scr, r - 256, lane);
    }
}

__device__ __forceinline__ void build_tables(Frame& F) {
    LAS int* tab = (LAS int*)(F.lds + TAB_OFF);
    if (F.tid < 128) tab[T_CNT + F.tid] = (int)__hip_atomic_load((unsigned*)F.ctl + CW_CNT + F.tid * 16, RLX_AGENT);
    __syncthreads();
    if (F.tid == 0) { int a = 0, y0 = 0, y1 = 0;
        for (int e = 0; e < 64; ++e) { tab[T_ABASE + e] = a; tab[T_YBASE + e] = y0; tab[T_YBASE + 64 + e] = y1; a += tab[T_CNT + 2 * e] + tab[T_CNT + 2 * e + 1]; y0 += tab[T_CNT + 2 * e]; y1 += tab[T_CNT + 2 * e + 1]; }
        tab[T_ABASE + 64] = a; }
    __syncthreads();
}

struct GateUpSched {
    const LAS int* tab; const bf16_t* wgu; const int* list; int x, j, per;
    __device__ void init(Frame& F) { tab = (const LAS int*)(F.lds + TAB_OFF); wgu = wsp<bf16_t>(F, WS_WGU); list = wsp<int>(F, WS_LIST); x = (int)blockIdx.x % 8; j = (int)blockIdx.x / 8; per = F.G / 8; }
    __device__ bool next(int i, pg8::Unit& u) const {
        const int L = i * per + j;
        int k = -1, base = 0, a = 0;
#pragma unroll
        for (int q = 0; q < 8; ++q) { const int e = x + 8 * q; const int na = a + ((RFL(tab[T_CNT + 2 * e]) + RFL(tab[T_CNT + 2 * e + 1]) + 255) >> 8) * 2; if (k < 0 && L < na) { k = q; base = a; } a = na; }
        if (k >= 0) {
            const int e = x + 8 * k, r = L - base, mt = r >> 1, pn = r & 1, n0 = RFL(tab[T_CNT + 2 * e]), ntot = n0 + RFL(tab[T_CNT + 2 * e + 1]);
            u.B = (const char*)(wgu + ((size_t)e * 512 + pn * 256) * DM); u.m0 = mt * 256; u.pn = pn; u.e = e; u.nrows = (ntot - mt * 256) < 256 ? (ntot - mt * 256) : 256;
            u.orow0 = RFL(tab[T_ABASE + e]) + mt * 256; u.l0 = list + (size_t)(2 * e) * 8192; u.l1 = list + (size_t)(2 * e + 1) * 8192; u.n0 = n0; u.ntot = ntot; return true; }
        const int r = L - a; if (r >= 16) return false;
        const int mt = x + 8 * (r >> 1), pn = r & 1;
        u.B = (const char*)(wgu + ((size_t)64 * 512 + pn * 256) * DM); u.m0 = mt * 256; u.pn = pn; u.e = 64; u.nrows = 256; u.orow0 = ACT_SHARED_ROW0 + mt * 256; u.l0 = nullptr; u.l1 = nullptr; u.n0 = 0; u.ntot = 0; return true;
    }
};
struct DownSched {
    const LAS int* tab; const bf16_t* wd; int x, j, per, c;
    __device__ void init(Frame& F, int c_) { tab = (const LAS int*)(F.lds + TAB_OFF); wd = wsp<bf16_t>(F, WS_WD); x = (int)blockIdx.x % 8; j = (int)blockIdx.x / 8; per = F.G / 8; c = c_; }
    __device__ bool next(int i, pg8::Unit& u) const {
        const int L = i * per + j;
        u.l0 = nullptr; u.l1 = nullptr; u.n0 = 0; u.ntot = 0;
        int k = -1, base = 0, a = 0;
#pragma unroll
        for (int q = 0; q < 8; ++q) { const int e = x + 8 * q; const int na = a + ((RFL(tab[T_CNT + 2 * e + c]) + 255) >> 8) * 4; if (k < 0 && L < na) { k = q; base = a; } a = na; }
        if (k >= 0) {
            const int e = x + 8 * k, r = L - base, mt = r >> 2, pn = r & 3, n = RFL(tab[T_CNT + 2 * e + c]);
            u.B = (const char*)(wd + ((size_t)e * DM + pn * 256) * EFF); u.m0 = RFL(tab[T_ABASE + e]) + (c ? RFL(tab[T_CNT + 2 * e]) : 0) + mt * 256; u.pn = pn; u.e = e;
            u.nrows = (n - mt * 256) < 256 ? (n - mt * 256) : 256; u.orow0 = RFL(tab[T_YBASE + 64 * c + e]) + mt * 256; return true; }
        const int r = L - a; if (r >= (CHTOK / 256 / 8) * 4) return false;
        const int mt = x + 8 * (r >> 2), pn = r & 3;
        u.B = (const char*)(wd + ((size_t)64 * DM + pn * 256) * EFF); u.m0 = ACT_SHARED_ROW0 + c * CHTOK + mt * 256; u.pn = pn; u.e = 64; u.nrows = 256; u.orow0 = YS_SHARED_ROW0 + mt * 256; return true;
    }
};

__device__ __forceinline__ void combine(Frame& F, int c, bool dry) {
    const LAS int* tab = (const LAS int*)(F.lds + TAB_OFF);
    const int lane = F.lane, gw = F.vcu * NWAVES + F.wave, NGW = F.G * NWAVES;
    const unsigned char* ys = wsp<unsigned char>(F, WS_YS); const unsigned* TOKSLOT = wsp<unsigned>(F, WS_TOKSLOT); const float* mod = wsp<float>(F, WS_MOD);
    for (int tl = gw; tl < CHTOK; tl += NGW) {
        const int t = c * CHTOK + tl, b = t >> 11;
        int yr[9];
#pragma unroll
        for (int k = 0; k < 8; ++k) { const unsigned s = TOKSLOT[(size_t)t * 8 + k]; yr[k] = tab[T_YBASE + 64 * c + (int)(s >> 16)] + (int)(s & 0xffffu); }
        yr[8] = YS_SHARED_ROW0 + tl;
        u32x4 w[9];
#pragma unroll
        for (int k = 0; k < 9; ++k) w[k] = *(const u32x4*)(ys + (size_t)yr[k] * 1024 + 16 * lane);
        f32x4 s[4];
#pragma unroll
        for (int q = 0; q < 4; ++q) s[q] = (f32x4){0.f, 0.f, 0.f, 0.f};
#pragma unroll
        for (int k = 0; k < 9; ++k) {
#pragma unroll
            for (int q = 0; q < 4; ++q) { const auto lo = __builtin_amdgcn_cvt_pk_f32_fp8((int)w[k][q], false), hi = __builtin_amdgcn_cvt_pk_f32_fp8((int)w[k][q], true);
                s[q] += (f32x4){lo[0], lo[1], hi[0], hi[1]}; } }
#pragma unroll
        for (int q = 0; q < 4; ++q) { const int c4 = 16 * lane + 4 * q;
            const f32x4 x1 = *(const f32x4*)(F.out + (size_t)t * DM + c4), g2 = *(const f32x4*)(mod + (size_t)b * 6144 + 5120 + c4);
            float* dst = dry ? (float*)(F.ws + WS_B + 253 * MiB) + (((size_t)t * DM + c4) & ((1u << 21) - 1)) : F.out + (size_t)t * DM + c4;
            *(f32x4*)dst = x1 + g2 * (s[q] * (1.0f / YS_SCALE)); }
    }
}
}
#ifndef PHMASK
#define PHMASK 0xffff
#endif
#define PH(k) ((PHMASK >> (k)) & 1)
#ifndef REPMASK
#define REPMASK 0
#endif
#ifndef XBAR
#define XBAR 0
#endif
#define REP(k) for (int rep_ = 0; rep_ < 1 + ((REPMASK >> (k)) & 1); ++rep_)

__global__ void __launch_bounds__(NTHR, 2) fwd_megakernel(Args args) {
    const Args& A = args;
    extern __shared__ __attribute__((aligned(16))) unsigned char lds_raw[];
    Frame F;
    F.lds = (LAS unsigned char*)lds_raw;
    F.MISC = (volatile LAS unsigned*)(F.lds + MISC_OFF);
    F.tid = threadIdx.x; F.lane = F.tid & 63; F.wave = __builtin_amdgcn_readfirstlane(F.tid >> 6);
    F.G = gridDim.x; { const int bx = blockIdx.x; F.vcu = (F.G % 8 == 0) ? (bx % 8) * (F.G / 8) + bx / 8 : bx; }
    F.ws = args.ws; F.ctl = (gu32*)(args.ws + WS_CTL); F.out = args.out;
    for (int u = F.tid; u < (LDS_BYTES - LDSCTL_OFF) / 4; u += NTHR) ((LAS unsigned*)(F.lds + LDSCTL_OFF))[u] = 0u;
    __syncthreads();
    XcdBarrier bar = xcd_barrier_post((unsigned*)(F.ctl + CW_BAR), F.MISC + 8);
#define GRID_BAR() do { xcd_barrier(bar); F.refresh(); } while (0)
    const int bx = (int)blockIdx.x;

    REP(0) if (PH(0)) p0_prologue(F, args);
    for (int xb = 0; xb < XBAR; ++xb) GRID_BAR();
    GRID_BAR();
    REP(1) if (PH(1)) { p0_copies(F, args); s1_modnorm(F, args); }
#ifdef WSPROBE
    for (int q = 0; q < args.nrep; ++q) s1_modnorm(F, args);
#endif
    GRID_BAR();
    REP(2) if (PH(2)) {
        pg8::Gemm g{wsp<bf16_t>(F, WS_H), DM, DM}; pg8::DenseSched S; S.init(NT, INPAD, DM, wsp<bf16_t>(F, WS_WIN), F.G, bx);
        epi::EpiInProj E{wsp<bf16_t>(F, WS_NAQ), wsp<bf16_t>(F, WS_NAK), wsp<bf16_t>(F, WS_NAV), wsp<bf16_t>(F, WS_QLAT), wsp<bf16_t>(F, WS_KVLAT), wsp<bf16_t>(F, WS_SGNA), wsp<bf16_t>(F, WS_SGMLA),
                          wsp<float>(F, WS_KROT), wsp<float>(F, WS_QSQ), wsp<float>(F, WS_KVSQ), INF(I_g_na_q), INF(I_g_na_k), wsp<float>(F, WS_RCOS), wsp<float>(F, WS_RSIN)};
        pg8::gemm_phase<epi::EpiInProj, pg8::DenseSched, false>(F.lds, g, S, E);
    }
    GRID_BAR();
    REP(3) if (PH(3)) {
        pg8::Gemm g{wsp<bf16_t>(F, WS_QLAT), QRANK, QRANK}; pg8::DenseSched S; S.init(NT, MH * QKD, QRANK, wsp<bf16_t>(F, WS_WUQ), F.G, bx);
        epi::EpiUpQ E{wsp<bf16_t>(F, WS_QM), wsp<float>(F, WS_QSS), wsp<float>(F, WS_QSQ), INF(I_g_mla_q), wsp<float>(F, WS_RCOS), wsp<float>(F, WS_RSIN)};
        pg8::gemm_phase<epi::EpiUpQ, pg8::DenseSched, false>(F.lds, g, S, E);
    }
    REP(3) if (PH(4)) {
        pg8::Gemm g{wsp<bf16_t>(F, WS_KVLAT), KVRANK, KVRANK}; pg8::DenseSched S; S.init(NT, MH * 128, KVRANK, wsp<bf16_t>(F, WS_WUKV), F.G, bx);
        epi::EpiUpKV E{wsp<bf16_t>(F, WS_KM), wsp<bf16_t>(F, WS_VM), wsp<float>(F, WS_KVSQ), wsp<float>(F, WS_KROT), INF(I_g_mla_k)};
        pg8::gemm_phase<epi::EpiUpKV, pg8::DenseSched, false>(F.lds, g, S, E);
    }
    GRID_BAR();
    if (PH(5)) s4_attention(F, args, 1 + ((REPMASK >> 4) & 1), 1 + ((REPMASK >> 5) & 1));
    GRID_BAR();
    REP(6) if (PH(6)) {
        pg8::Gemm g{wsp<bf16_t>(F, WS_YNA), 512, 512}; pg8::DenseSched S; S.init(NT, DM, 512, wsp<bf16_t>(F, WS_WPNA), F.G, bx);
        epi::EpiMerge<1> E{wsp<bf16_t>(F, WS_SGNA), wsp<bf16_t>(F, WS_TMP), nullptr};
        pg8::gemm_phase<epi::EpiMerge<1>, pg8::DenseSched, false>(F.lds, g, S, E);
    }
    REP(6) if (PH(7)) {
        pg8::Gemm g{wsp<bf16_t>(F, WS_YMLA), 512, 512}; pg8::DenseSched S; S.init(NT, DM, 512, wsp<bf16_t>(F, WS_WPMLA), F.G, bx);
        epi::EpiMerge<2> E{wsp<bf16_t>(F, WS_SGMLA), wsp<bf16_t>(F, WS_TMP), wsp<bf16_t>(F, WS_MERGED)};
        pg8::gemm_phase<epi::EpiMerge<2>, pg8::DenseSched, false>(F.lds, g, S, E);
    }
    GRID_BAR();
    REP(8) if (PH(8)) {
        pg8::Gemm g{wsp<bf16_t>(F, WS_MERGED), DM, DM}; pg8::DenseSched S; S.init(NT, DM, DM, wsp<bf16_t>(F, WS_WOUT), F.G, bx);
        epi::EpiOut E{INF(I_x), F.out, wsp<float>(F, WS_MOD)};
        pg8::gemm_phase<epi::EpiOut, pg8::DenseSched, false>(F.lds, g, S, E);
    }
    GRID_BAR();
    if (PH(9)) moe::s7_router(F, args, 1 + ((REPMASK >> 9) & 1), 1 + ((REPMASK >> 13) & 1));
    GRID_BAR();
    moe::build_tables(F);
    REP(10) if (PH(10)) {
        pg8::Gemm g{wsp<bf16_t>(F, WS_H2), DM, DM}; moe::GateUpSched S; S.init(F);
        epi::EpiGateUp E{wsp<bf16_t>(F, WS_ACT)};
        pg8::gemm_phase<epi::EpiGateUp, moe::GateUpSched, true>(F.lds, g, S, E);
    }
    GRID_BAR();
#pragma unroll 1
    for (int c = 0; c < NCHUNK; ++c) {
        REP(11) if (PH(11)) {
            pg8::Gemm g{wsp<bf16_t>(F, WS_ACT), EFF, EFF}; moe::DownSched S; S.init(F, c);
            epi::EpiDown E{wsp<unsigned char>(F, WS_YS)};
            pg8::gemm_phase<epi::EpiDown, moe::DownSched, false>(F.lds, g, S, E);
        }
        GRID_BAR();
        if ((REPMASK >> 12) & 1) moe::combine(F, c, true);
        if (PH(12)) moe::combine(F, c, false);
        if (c + 1 < NCHUNK) GRID_BAR();
    }
}

extern "C" void kernel_launch(void* const* d_in, const int* in_sizes, int n_in, void* d_out, int out_size, void* d_ws, size_t ws_size, hipStream_t stream) {
    static int grid = 0;
    if (grid == 0) {
        if (n_in != 28 || out_size != NT * DM || ws_size < WS_END) { fprintf(stderr, "kernel_launch: unexpected shapes: n_in %d out %d ws %zu (need %zu)\n", n_in, out_size, ws_size, (size_t)WS_END); grid = -1; return; }
        int dev = 0, cus = 0, per_cu = 0;
        if (hipGetDevice(&dev) != hipSuccess || hipDeviceGetAttribute(&cus, hipDeviceAttributeMultiprocessorCount, dev) != hipSuccess) { grid = -1; return; }
        if (hipFuncSetAttribute((const void*)fwd_megakernel, hipFuncAttributeMaxDynamicSharedMemorySize, LDS_BYTES) != hipSuccess) { fprintf(stderr, "kernel_launch: hipFuncSetAttribute failed\n"); grid = -1; return; }
        if (hipOccupancyMaxActiveBlocksPerMultiprocessor(&per_cu, (const void*)fwd_megakernel, NTHR, LDS_BYTES) != hipSuccess || per_cu < 1) { fprintf(stderr, "kernel_launch: occupancy query says %d blocks/CU\n", per_cu); (void)hipGetLastError(); }
        grid = cus;
        if (grid != 256) fprintf(stderr, "kernel_launch: %d CUs (expected 256)\n", grid);
    }
    if (grid < 0) return;
    if (hipMemsetAsync((char*)d_ws + WS_CTL, 0, CTL_ZERO_BYTES, stream) != hipSuccess) { fprintf(stderr, "kernel_launch: memset failed\n"); return; }
    Args a{};
    for (int i = 0; i < 28; ++i) a.in[i] = d_in[i];
    a.out = (float*)d_out; a.ws = (unsigned char*)d_ws;
#ifdef WSPROBE
    a.nrep = (int)(ws_size >> 26); a.pad = 0;
#endif
    void* kargs[] = {&a};
    const hipError_t le = hipLaunchCooperativeKernel((const void*)fwd_megakernel, dim3(grid), dim3(NTHR), kargs, LDS_BYTES, stream);
    if (le != hipSuccess) fprintf(stderr, "kernel_launch: cooperative launch failed: %s (grid %d)\n", hipGetErrorName(le), grid);
}
```

```cpp
#include <hip/hip_runtime.h>
#include <cstdio>
#include <cstdint>
#include <cmath>

#define GAS __attribute__((address_space(1)))
#define LAS __attribute__((address_space(3)))
typedef unsigned short bf16_t;
typedef short bf16x8 __attribute__((ext_vector_type(8)));
typedef short s16x4 __attribute__((ext_vector_type(4)));
typedef float f32x4 __attribute__((ext_vector_type(4)));
typedef float f32x2 __attribute__((ext_vector_type(2)));
typedef float f32x16 __attribute__((ext_vector_type(16)));
typedef unsigned u32x4 __attribute__((ext_vector_type(4)));
typedef int i32x4 __attribute__((ext_vector_type(4)));
typedef unsigned u32x2 __attribute__((ext_vector_type(2)));
typedef GAS unsigned gu32;

constexpr int DM = 1024, NB = 8, SEQ = 2048, NT = NB * SEQ;
constexpr int NAH = 8, NAD = 64, GRIDW = 64, GRIDR = SEQ / GRIDW;
constexpr int MH = 8, QRANK = 256, KVRANK = 128, NOPE = 64, ROPE = 32, VD = 64, QKD = 96;
constexpr int NEXP = 64, TOPK = 8, NGRP = 8, TOPKG = 4, EFF = 256;
constexpr float EPS = 1e-6f;
constexpr int INCOLS = 4000, INPAD = 4096;
constexpr int NCHUNK = 1, CHTOK = NT / NCHUNK;
constexpr float YS_SCALE = 16.0f;
constexpr float WGU_SCALE = 64.0f, ACT_SCALE = 16.0f, WD_SCALE = 32.0f;
constexpr int NWAVES = 8, NTHR = 512;

constexpr size_t MiB = 1u << 20;
constexpr size_t WS_CTL = 0, CTL_ZERO_BYTES = 1 * MiB;
constexpr size_t WS_MOD   = 1 * MiB;
constexpr size_t WS_RCOS  = WS_MOD + 256 * 1024;
constexpr size_t WS_RSIN  = WS_RCOS + 1 * MiB;
constexpr size_t WS_RFRAG = WS_RSIN + 1 * MiB;
constexpr size_t WS_QSQ   = WS_RFRAG + 256 * 1024;
constexpr size_t WS_KVSQ  = WS_QSQ + 256 * 1024;
constexpr size_t WS_QSS   = WS_KVSQ + 256 * 1024;
constexpr size_t WS_TOKSLOT = WS_QSS + 1 * MiB;
constexpr size_t WS_LIST  = 6 * MiB;
constexpr size_t WS_WLIST = 10 * MiB;
constexpr size_t WS_WIN   = 14 * MiB;
constexpr size_t WS_WUQ   = 22 * MiB;
constexpr size_t WS_WUKV  = WS_WUQ + 512 * 1024;
constexpr size_t WS_WPNA  = 23 * MiB;
constexpr size_t WS_WPMLA = 24 * MiB;
constexpr size_t WS_WOUT  = 25 * MiB;
constexpr size_t WS_KROT  = 27 * MiB;
constexpr size_t WS_B     = 30 * MiB;
constexpr size_t WS_H     = WS_B + 0 * MiB;
constexpr size_t WS_QM    = WS_B + 0 * MiB;
constexpr size_t WS_NAQ   = WS_B + 32 * MiB;
constexpr size_t WS_NAK   = WS_B + 48 * MiB;
constexpr size_t WS_NAV   = WS_B + 64 * MiB;
constexpr size_t WS_QLAT  = WS_B + 80 * MiB;
constexpr size_t WS_KVLAT = WS_B + 88 * MiB;
constexpr size_t WS_SGNA  = WS_B + 96 * MiB;
constexpr size_t WS_SGMLA = WS_B + 128 * MiB;
constexpr size_t WS_KM    = WS_B + 160 * MiB;
constexpr size_t WS_VM    = WS_B + 185 * MiB;
constexpr size_t WS_YNA   = WS_B + 201 * MiB;
constexpr size_t WS_WPCAT = WS_B + 234 * MiB;
constexpr size_t WS_TMP   = WS_B + 32 * MiB;
constexpr size_t WS_MERGED= WS_B + 64 * MiB;
constexpr size_t WS_WD    = WS_B + 0 * MiB;
constexpr size_t WS_ACT   = WS_B + 33 * MiB;
constexpr size_t WS_WGU   = WS_B + 109 * MiB;
constexpr size_t WS_H2    = WS_B + 174 * MiB;
constexpr size_t WS_YS    = WS_B + 109 * MiB;
constexpr size_t WS_END   = WS_B + 262 * MiB;
constexpr int ACT_SHARED_ROW0 = NT * TOPK;
constexpr int YS_SHARED_ROW0 = CHTOK * TOPK;
constexpr int CW_BAR = 4096;
constexpr int CW_CNT = 16384;

constexpr int RING_BYTES = 131072;
constexpr int LDSCTL_OFF = RING_BYTES, MISC_OFF = LDSCTL_OFF + 320;
constexpr int TAB_OFF = RING_BYTES + 1024;
constexpr int LDS_BYTES = 147456;

#define LDS_WAIT() asm volatile("s_waitcnt lgkmcnt(0)" ::: "memory")
#define VM_WAIT() asm volatile("s_waitcnt vmcnt(0)" ::: "memory")
#define SBAR() __builtin_amdgcn_sched_barrier(0)
#define RLX_AGENT __ATOMIC_RELAXED, __HIP_MEMORY_SCOPE_AGENT

__device__ __forceinline__ unsigned f2bf(float f) { unsigned u = __builtin_bit_cast(unsigned, f); return (u + 0x7fffu + ((u >> 16) & 1u)) >> 16; }
__device__ __forceinline__ unsigned pk2(float lo, float hi) { return f2bf(lo) | (f2bf(hi) << 16); }
__device__ __forceinline__ unsigned cvt_pk_bf16(float lo, float hi) { unsigned r; asm volatile("v_cvt_pk_bf16_f32 %0, %1, %2" : "=v"(r) : "v"(lo), "v"(hi)); return r; }
__device__ __forceinline__ float bf2f(unsigned short b) { return __builtin_bit_cast(float, (unsigned)b << 16); }
__device__ __forceinline__ float bflo(unsigned w) { return __builtin_bit_cast(float, w << 16); }
__device__ __forceinline__ float bfhi(unsigned w) { return __builtin_bit_cast(float, w & 0xffff0000u); }
__device__ __forceinline__ int lane_fresh() { int t = threadIdx.x; asm volatile("" : "+v"(t)); return t & 63; }
__device__ __forceinline__ float shx(float v, int m, int lane) { return __builtin_bit_cast(float, __builtin_amdgcn_ds_bpermute((lane ^ m) << 2, __builtin_bit_cast(int, v))); }
__device__ __forceinline__ int shup_i(int v, int d, int lane) { return __builtin_amdgcn_ds_bpermute(((lane - d) & 63) << 2, v); }
__device__ __forceinline__ float wave_sum(float v) {
    const int l = lane_fresh();
#pragma unroll
    for (int o = 1; o < 64; o <<= 1) v += shx(v, o, l);
    return v;
}
__device__ __forceinline__ float sigmoidf_fast(float v) { return __builtin_amdgcn_rcpf(1.0f + __expf(-v)); }
__device__ __forceinline__ float siluf_fast(float v) { return v * sigmoidf_fast(v); }
__device__ __forceinline__ float sq4(f32x4 a) { return (a[0] * a[0] + a[1] * a[1]) + (a[2] * a[2] + a[3] * a[3]); }

#ifdef WSPROBE
struct Args { const void* in[28]; float* out; unsigned char* ws; int nrep, pad; };
#else
struct Args { const void* in[28]; float* out; unsigned char* ws; };
#endif
enum { I_x = 0, I_c = 1, I_positions = 2, I_w_ada = 3, I_b_ada = 4, I_g_norm1 = 5, I_w_in = 6, I_g_na_q = 7, I_g_na_k = 8, I_na_rpb = 9, I_g_q_lat = 10, I_w_uq = 11, I_g_kv_lat = 12, I_w_ukv = 13, I_g_mla_q = 14, I_g_mla_k = 15, I_w_proj_na = 16, I_w_proj_mla = 17, I_w_out = 18, I_g_norm2 = 19, I_w_router = 20, I_e_bias = 21, I_w_eg = 22, I_w_eu = 23, I_w_ed = 24, I_w_sg = 25, I_w_su = 26, I_w_sd = 27 };
#define INF(k) ((const float*)A.in[k])

#ifndef TSWG
#define TSWG 0
#endif

__device__ __forceinline__ unsigned cvt4_fp8(f32x4 a, float sc) {
    int w = 0;
    w = __builtin_amdgcn_cvt_pk_fp8_f32(__builtin_amdgcn_fmed3f(a[0] * sc, -448.f, 448.f), __builtin_amdgcn_fmed3f(a[1] * sc, -448.f, 448.f), w, false);
    w = __builtin_amdgcn_cvt_pk_fp8_f32(__builtin_amdgcn_fmed3f(a[2] * sc, -448.f, 448.f), __builtin_amdgcn_fmed3f(a[3] * sc, -448.f, 448.f), w, true);
    return (unsigned)w;
}
namespace pg8 {
constexpr int BM = 256, BK = 64, HALF = 128, HTB = HALF * BK * 2, STAGE_BYTES = 8 * HTB, NXCD = 8, WGM = 8;
__host__ __device__ __forceinline__ int lds_byte(int r, int c) { const int st = (r >> 4) * 2 + (c >> 5), rr = r & 15, cc = c & 31, ob = rr * 64 + cc * 2; return st * 1024 + (ob ^ (((ob >> 9) & 1) << 5)); }
__host__ __device__ __forceinline__ void stage_rc(int b, int& R, int& C) { const int st = b / 1024, sb = b % 1024, swz = sb ^ (((sb >> 9) & 1) << 5); R = (st >> 1) * 16 + swz / 64; C = (st & 1) * 32 + (swz % 64) / 2; }
__host__ __device__ __forceinline__ int perm32(int rho) { const int n = rho >> 4, i = rho & 15; return 8 * (i >> 2) + 4 * n + (i & 3); }

struct Unit {
    const char* B;
    int m0;
    int pn;
    int e;
    int nrows;
    int orow0;
    const int* l0; const int* l1; int n0, ntot;
};
struct Gemm { const bf16_t* A; int lda; int K; };

template <class Epi, class Sched, bool GATHER, bool FP8 = false, bool HALFK = false>
__device__ __forceinline__ void gemm_phase(LAS unsigned char* lds, const Gemm g, Sched& S, const Epi& E) {
    int tid_ = threadIdx.x; asm volatile("" : "+v"(tid_));
    const int tid = tid_, wid = __builtin_amdgcn_readfirstlane(tid >> 6), lane = tid & 63, wr = wid >> 2, wc = wid & 3, fr = lane & 15, fq = lane >> 4;
    const int K = g.K; int nt_ = K / BK; asm volatile("" : "+s"(nt_)); const int nt = nt_;
    unsigned voffB[2], voffA[2];
#pragma unroll
    for (int i = 0; i < 2; ++i) { int R, C; stage_rc(tid * 16 + i * 8192, R, C); const int Rb = Epi::PERM ? ((R & ~31) + perm32(R & 31)) : R;
        voffA[i] = (unsigned)(R * g.lda + C) * 2u; voffB[i] = (unsigned)(Rb * K + C) * 2u; }
    const size_t hstepA = (size_t)HALF * g.lda * 2;
    const size_t kstep = (size_t)(BK * 2);
    const size_t hstepB = (size_t)HALF * K * 2;
    const unsigned ldsw = (unsigned)wid * 1024u;
    const int aoff = lds_byte(wr * 64 + fr, fq * 8), boff = lds_byte(wc * 32 + fr, fq * 8);
    const char* Abase = (const char*)g.A;
#define PG8_SA(b, h) (((b) * 2 + (h)) * HTB)
#define PG8_SB(b, h) ((4 + (b) * 2 + (h)) * HTB)
#define PG8_STAGE(bufoff, gbase, voff) do { _Pragma("unroll") for (int _i = 0; _i < 2; ++_i) \
        __builtin_amdgcn_global_load_lds((const unsigned*)((const char*)(gbase) + (voff)[_i]), (LAS unsigned*)(lds + (bufoff) + ldsw + _i * 8192), 16, 0, 0); } while (0)
#define PG8_LDA(dst, b, h) do { _Pragma("unroll") for (int m = 0; m < 4; ++m) _Pragma("unroll") for (int k = 0; k < 2; ++k) dst[m][k] = *(const LAS bf16x8*)(lds + PG8_SA(b, h) + aoff + m * 2048 + k * 1024); } while (0)
#define PG8_LDB(dst, b, h) do { _Pragma("unroll") for (int n = 0; n < 2; ++n) _Pragma("unroll") for (int k = 0; k < 2; ++k) dst[n][k] = *(const LAS bf16x8*)(lds + PG8_SB(b, h) + boff + n * 2048 + k * 1024); } while (0)
#define PG8_CAT(x0, x1) __builtin_shufflevector(__builtin_bit_cast(i32x4, x0), __builtin_bit_cast(i32x4, x1), 0, 1, 2, 3, 4, 5, 6, 7)
#define PG8_MMA(ai, bj, At, Bt) do { __builtin_amdgcn_s_setprio(1); if constexpr (FP8) { _Pragma("unroll") for (int m = 0; m < 4; ++m) _Pragma("unroll") for (int n = 0; n < 2; ++n) \
        acc[ai][bj][m][n] = __builtin_amdgcn_mfma_scale_f32_16x16x128_f8f6f4(PG8_CAT(Bt[n][0], Bt[n][1]), PG8_CAT(At[m][0], At[m][1]), acc[ai][bj][m][n], 0, 0, 0, 0x7f7f7f7f, 0, 0x7f7f7f7f); } \
        else { _Pragma("unroll") for (int m = 0; m < 4; ++m) _Pragma("unroll") for (int n = 0; n < 2; ++n) _Pragma("unroll") for (int k = 0; k < 2; ++k) \
        acc[ai][bj][m][n] = __builtin_amdgcn_mfma_f32_16x16x32_bf16(Bt[n][k], At[m][k], acc[ai][bj][m][n], 0, 0, 0); } __builtin_amdgcn_s_setprio(0); } while (0)
#define PG8_MM2(ai) do { if constexpr (HALFK) { if (t < (nt >> 1)) { PG8_MMA(ai, 0, At, B0); } else { PG8_MMA(ai, 1, At, B1); } } else { PG8_MMA(ai, 0, At, B0); PG8_MMA(ai, 1, At, B1); } } while (0)
#define PG8_WAIT_V(n) asm volatile("s_waitcnt vmcnt(" #n ")" ::: "memory")
#define PG8_WAIT_L(n) asm volatile("s_waitcnt lgkmcnt(" #n ")" ::: "memory")
#define PG8_BAR __builtin_amdgcn_s_barrier()
#define PG8_SCHED __builtin_amdgcn_sched_barrier(0)
#define PG8_VOFF(dst, u) do { int _t = threadIdx.x; asm volatile("" : "+v"(_t)); _Pragma("unroll") for (int _h = 0; _h < 2; ++_h) _Pragma("unroll") for (int _i = 0; _i < 2; ++_i) { \
        int _R, _C; stage_rc(_t * 16 + _i * 8192, _R, _C); int _r = (u).m0 + _h * HALF + _R; \
        if ((u).l0) { _r = _r < (u).ntot ? _r : (u).ntot - 1; _r = _r < (u).n0 ? (u).l0[_r] : (u).l1[_r - (u).n0]; } \
        dst[_h][_i] = (unsigned)(_r * g.lda + _C) * 2u; } } while (0)
#define PG8_VROW(dst, u) do { int _t = threadIdx.x; asm volatile("" : "+v"(_t)); _Pragma("unroll") for (int _h = 0; _h < 2; ++_h) _Pragma("unroll") for (int _i = 0; _i < 2; ++_i) { \
        int _R, _C; stage_rc(_t * 16 + _i * 8192, _R, _C); int _r = (u).m0 + _h * HALF + _R; \
        if ((u).l0) { _r = _r < (u).ntot ? _r : (u).ntot - 1; _r = _r < (u).n0 ? (u).l0[_r] : (u).l1[_r - (u).n0]; } \
        dst[_h][_i] = _r; } } while (0)
#define PG8_STA(bufoff, sel_next, h, kt) do { if constexpr (GATHER) { PG8_STAGE(bufoff, Abase + (size_t)(kt) * kstep, cvo[h]); } \
        else { PG8_STAGE(bufoff, ((sel_next) ? nA : cA) + (h) * hstepA + (size_t)(kt) * kstep, voffA); } } while (0)
    Unit cur, nxt; int ui = 0;
    if (!S.next(0, cur)) return;
    E.prefetch(cur, 0, tid, lds);
    f32x4 acc[2][2][4][2];
#pragma unroll
    for (int a = 0; a < 2; ++a)
#pragma unroll
        for (int b = 0; b < 2; ++b)
#pragma unroll
            for (int m = 0; m < 4; ++m)
#pragma unroll
                for (int n = 0; n < 2; ++n) acc[a][b][m][n] = (f32x4){0.f, 0.f, 0.f, 0.f};
    bf16x8 At[4][2], B0[2][2], B1[2][2];
    unsigned cvo[2][2]; int nvr[2][2];
    const char* cA = Abase; const char* nA = Abase;
    if constexpr (GATHER) { PG8_VOFF(cvo, cur); } else { cA = Abase + (size_t)cur.m0 * g.lda * 2; }
    const char* cB = cur.B;
    PG8_STAGE(PG8_SB(0, 0), cB, voffB); PG8_STAGE(PG8_SB(0, 1), cB + hstepB, voffB); PG8_STA(PG8_SA(0, 0), false, 0, 0); PG8_STA(PG8_SA(0, 1), false, 1, 0);
    if (wr == 1) PG8_BAR;
    PG8_WAIT_V(2); PG8_BAR;
    PG8_STAGE(PG8_SB(1, 0), cB + kstep, voffB); PG8_STA(PG8_SA(1, 0), false, 0, 1); PG8_STAGE(PG8_SB(1, 1), cB + hstepB + kstep, voffB);
    PG8_WAIT_V(6); PG8_BAR;
    for (;;) {
        const bool has_next = S.next(ui + 1, nxt);
        if constexpr (GATHER) {
            if (has_next) { PG8_VROW(nvr, nxt); }
        } else { nA = has_next ? Abase + (size_t)nxt.m0 * g.lda * 2 : cA; }
        const char* nB = has_next ? nxt.B : cB;
#pragma unroll 1
        for (int t = 0; t < nt; t += 2) {
            const bool last = (t == nt - 2);
            const int kt2 = last ? 0 : t + 2;
            const char* b2 = last ? nB : cB + (size_t)(t + 2) * kstep; const char* b3 = b2 + kstep;
            PG8_LDB(B0, 0, 0); PG8_LDB(B1, 0, 1); PG8_SCHED; PG8_LDA(At, 0, 0); PG8_STA(PG8_SA(1, 1), false, 1, t + 1);
            if constexpr (GATHER) { if (last && has_next) { int _t = threadIdx.x; asm volatile("" : "+v"(_t));
#pragma unroll
                for (int h = 0; h < 2; ++h)
#pragma unroll
                    for (int i = 0; i < 2; ++i) { int _R, _C; stage_rc(_t * 16 + i * 8192, _R, _C); cvo[h][i] = (unsigned)(nvr[h][i] * g.lda + _C) * 2u; } } }
            PG8_WAIT_V(8); PG8_WAIT_L(0); PG8_BAR; PG8_MM2(0); PG8_BAR; PG8_SCHED;
            PG8_LDA(At, 0, 1); PG8_STAGE(PG8_SB(0, 0), b2, voffB); PG8_STAGE(PG8_SB(0, 1), b2 + hstepB, voffB); PG8_STA(PG8_SA(0, 0), last, 0, kt2);
            PG8_WAIT_V(8); PG8_WAIT_L(0); PG8_BAR; PG8_MM2(1); PG8_BAR; PG8_SCHED;
            PG8_LDB(B0, 1, 0); PG8_LDB(B1, 1, 1); PG8_SCHED; PG8_LDA(At, 1, 0); PG8_STA(PG8_SA(0, 1), last, 1, kt2);
            PG8_WAIT_V(8); PG8_WAIT_L(0); PG8_BAR; PG8_MM2(0); PG8_BAR; PG8_SCHED;
            PG8_LDA(At, 1, 1); PG8_STAGE(PG8_SB(1, 0), b3, voffB); PG8_STAGE(PG8_SB(1, 1), b3 + hstepB, voffB); PG8_STA(PG8_SA(1, 0), last, 0, kt2 + 1);
            PG8_WAIT_V(8); PG8_WAIT_L(0); PG8_BAR; PG8_MM2(1); PG8_BAR; PG8_SCHED;
        }
        S.publish(wid);
        if (wr == 0) PG8_BAR;
        { int t2 = threadIdx.x; asm volatile("" : "+v"(t2)); const int l2 = t2 & 63; E(acc, cur, wr, wc, l2 & 15, l2 >> 4, ui, lds); }
        if (!has_next) break;
#pragma unroll
        for (int a = 0; a < 2; ++a)
#pragma unroll
            for (int b = 0; b < 2; ++b)
#pragma unroll
                for (int m = 0; m < 4; ++m)
#pragma unroll
                    for (int n = 0; n < 2; ++n) acc[a][b][m][n] = (f32x4){0.f, 0.f, 0.f, 0.f};
        cur = nxt; cB = nB; cA = nA; ++ui;
        E.prefetch(cur, ui, tid, lds);

        if (wr == 1) PG8_BAR;
    }
    PG8_WAIT_V(0);
    PG8_BAR;
#undef PG8_SA
#undef PG8_SB
#undef PG8_STAGE
#undef PG8_LDA
#undef PG8_LDB
#undef PG8_MMA
#undef PG8_MM2
#undef PG8_CAT
#undef PG8_WAIT_V
#undef PG8_WAIT_L
#undef PG8_BAR
#undef PG8_SCHED
#undef PG8_VOFF
#undef PG8_VROW
#undef PG8_STA
}

struct DenseSched {
    int nM, nN, nwg, G, c; const bf16_t* Bt; int K;
    __device__ void init(int M, int N, int K_, const bf16_t* Bt_, int G_, int c_) { nM = M / BM; nN = N / BM; nwg = nM * nN; G = G_; c = c_; Bt = Bt_; K = K_; }
    __device__ __forceinline__ void publish(int) {}
    __device__ bool next(int i, Unit& u) const {
        const long L = (long)i * G + c; if (L >= nwg) return false;
        int wgid = (int)L; { const int q = nwg / NXCD, r = nwg % NXCD, xcd = wgid % NXCD, off = wgid / NXCD; wgid = (xcd < r ? xcd * (q + 1) : r * (q + 1) + (xcd - r) * q) + off; }
        const int nig = WGM * nN, gid = wgid / nig, fm = gid * WGM, gsz = (nM - fm) < WGM ? (nM - fm) : WGM;
        const int pm = fm + ((wgid % nig) % gsz), pn = (wgid % nig) / gsz;
        u.B = (const char*)Bt + (size_t)pn * BM * K * 2; u.m0 = pm * BM; u.pn = pn; u.e = pm; u.nrows = BM; u.orow0 = pm * BM; u.l0 = nullptr; u.l1 = nullptr; u.n0 = 0; u.ntot = 0;
        return true;
    }
};
}
#define XB_TMO      128
#define XB_XCNT(j)  (256  + 64 * (j))
#define XB_XSUB(j)  (1280 + 64 * (j))
#define XB_XGEN(j)  (2304 + 64 * (j))
#define XB_TOP      3328
#define XB_TOPGEN   3392
#define XCD_BAR_WORDS 3456
#define XB_SPIN_CAP (1u << 18)

__device__ __forceinline__ unsigned xb_ld(unsigned* p)              { return __hip_atomic_load(p, __ATOMIC_RELAXED, __HIP_MEMORY_SCOPE_AGENT); }
__device__ __forceinline__ unsigned xb_add(unsigned* p, unsigned v) { return __hip_atomic_fetch_add(p, v, __ATOMIC_RELAXED, __HIP_MEMORY_SCOPE_AGENT); }
__device__ __forceinline__ unsigned xb_xcc_id() { return (unsigned)__builtin_amdgcn_s_getreg((3 << 11) | 20) & 0xFu; }
#define XB_SPIN(cond, bar) do { unsigned _sp = 0; while (cond) { __builtin_amdgcn_s_sleep(1); \
    if ((++_sp & 255u) == 0u) { if (xb_ld(&(bar)[XB_TMO])) break; if (_sp > XB_SPIN_CAP) { atomicAdd(&(bar)[XB_TMO], 1u); break; } } } } while (0)

struct XcdBarrier { unsigned* bar; unsigned x; volatile LAS unsigned* st; };

__device__ __forceinline__ XcdBarrier xcd_barrier_post(unsigned* bar, volatile LAS unsigned* st) {
    XcdBarrier b; b.bar = bar; b.x = xb_xcc_id(); b.st = st;
    if (threadIdx.x == 0) (void)xb_add(&bar[XB_XCNT(b.x)], 1u);
    return b;
}
__device__ __forceinline__ void xcd_barrier_complete(unsigned* bar, unsigned x, unsigned& nloc, unsigned& nx) {
    const unsigned G = gridDim.x * gridDim.y * gridDim.z;
    unsigned sum, cnt, mine, sp = 0u;
    for (;;) {
        sum = 0u; cnt = 0u; mine = 0u;
#pragma unroll
        for (unsigned j = 0; j < 16; ++j) { const unsigned c = xb_ld(&bar[XB_XCNT(j)]); sum += c; cnt += (c > 0u) ? 1u : 0u; mine = (j == x) ? c : mine; }
        if (sum == G) break;
        __builtin_amdgcn_s_sleep(1);
        if ((++sp & 255u) == 0u) { if (xb_ld(&bar[XB_TMO])) break; if (sp > XB_SPIN_CAP) { atomicAdd(&bar[XB_TMO], 1u); break; } }
    }
    nloc = mine > 0u ? mine : 1u; nx = cnt > 0u ? cnt : 1u;
}
__device__ __forceinline__ void xcd_barrier(const XcdBarrier& b) {
    asm volatile("s_waitcnt vmcnt(0)" ::: "memory");
    __syncthreads();
    int tid_ = threadIdx.x; asm volatile("" : "+v"(tid_));
    if (tid_ == 0) {
        unsigned* bar = b.bar; asm volatile("" : "+s"(bar)); unsigned bx_ = b.x; asm volatile("" : "+s"(bx_));
        __builtin_amdgcn_s_waitcnt(0);
        unsigned nloc = b.st[0], nx = b.st[1];
        if (nloc == 0u) { xcd_barrier_complete(bar, bx_, nloc, nx); b.st[0] = nloc; b.st[1] = nx; }
        const unsigned old = xb_add(&bar[XB_XSUB(bx_)], 1u);
        const unsigned gen = old / nloc;
        if (old + 1u == (gen + 1u) * nloc) {
            __builtin_amdgcn_fence(__ATOMIC_RELEASE, "agent");
            asm volatile("s_waitcnt vmcnt(0)" ::: "memory");
            const unsigned og = xb_add(&bar[XB_TOP], 1u);
            const unsigned tg = og / nx;
            if (og + 1u == (tg + 1u) * nx) xb_add(&bar[XB_TOPGEN], 1u);
            else XB_SPIN(xb_ld(&bar[XB_TOPGEN]) == tg, bar);
            __builtin_amdgcn_fence(__ATOMIC_ACQUIRE, "agent");
            xb_add(&bar[XB_XGEN(bx_)], 1u);
            asm volatile("s_waitcnt vmcnt(0)" ::: "memory");
        } else {
            XB_SPIN(xb_ld(&bar[XB_XGEN(bx_)]) == gen, bar);
            __builtin_amdgcn_fence(__ATOMIC_ACQUIRE, "agent");
            asm volatile("s_waitcnt vmcnt(0)" ::: "memory");
        }
    }
    __syncthreads();
}
namespace epi {
using pg8::Unit;
__device__ __forceinline__ u32x4 pack8(f32x4 a, f32x4 b) { u32x4 w; w.x = cvt_pk_bf16(a[0], a[1]); w.y = cvt_pk_bf16(a[2], a[3]); w.z = cvt_pk_bf16(b[0], b[1]); w.w = cvt_pk_bf16(b[2], b[3]); return w; }

__device__ __forceinline__ float red_fq(float s) { const int l = lane_fresh(); s += shx(s, 16, l); s += shx(s, 32, l); return s; }
__device__ __forceinline__ void unpack8(u32x4 w, f32x4& a, f32x4& b) { a = (f32x4){bflo(w.x), bfhi(w.x), bflo(w.y), bfhi(w.y)}; b = (f32x4){bflo(w.z), bfhi(w.z), bflo(w.w), bfhi(w.w)}; }
__device__ __forceinline__ void rope32(f32x4 (&v)[2], const float* cs, const float* sn, int fq) {
#pragma unroll
    for (int n = 0; n < 2; ++n) {
        const f32x4 c4 = *(const f32x4*)(cs + 8 * (fq & 1) + 4 * n), s4 = *(const f32x4*)(sn + 8 * (fq & 1) + 4 * n);
        const int l_ = lane_fresh(); f32x4 p; p[0] = shx(v[n][0], 32, l_); p[1] = shx(v[n][1], 32, l_); p[2] = shx(v[n][2], 32, l_); p[3] = shx(v[n][3], 32, l_);
        v[n] = (fq < 2) ? (v[n] * c4 - p * s4) : (v[n] * c4 + p * s4);
    }
}

struct EpiInProj {
    static constexpr bool PERM = true;
    __device__ __forceinline__ void prefetch(const Unit&, int, int, LAS unsigned char*) const {}
    bf16_t *naq, *nak, *nav, *qlat, *kvlat, *sgna, *sgmla; float *krot, *qsq, *kvsq; const float *gq, *gk, *rcos, *rsin;
    __device__ __forceinline__ void operator()(const f32x4 (&acc)[2][2][4][2], const Unit& u, int wr, int wc, int fr, int fq, int ui, LAS unsigned char* lds) const {
        const int pn = u.pn, row0 = u.orow0 + wr * 64 + fr;
        if (pn < 4) {
            bf16_t* dst = pn < 2 ? naq : nak; const float* g = pn < 2 ? gq : gk; const int head = (pn & 1) * 4 + wc;
            f32x4 gv[2][2];
#pragma unroll
            for (int bj = 0; bj < 2; ++bj)
#pragma unroll
                for (int n = 0; n < 2; ++n) gv[bj][n] = *(const f32x4*)(g + 32 * bj + 8 * fq + 4 * n);
#pragma unroll
            for (int ai = 0; ai < 2; ++ai)
#pragma unroll
                for (int m = 0; m < 4; ++m) {
                    float ss = (sq4(acc[ai][0][m][0]) + sq4(acc[ai][0][m][1])) + (sq4(acc[ai][1][m][0]) + sq4(acc[ai][1][m][1]));
                    ss = red_fq(ss); const float rstd = rsqrtf(ss * (1.0f / 64.0f) + EPS);
                    bf16_t* rp = dst + (size_t)(row0 + ai * 128 + m * 16) * 512 + head * 64 + 8 * fq;
#pragma unroll
                    for (int bj = 0; bj < 2; ++bj) *(u32x4*)(rp + 32 * bj) = pack8(acc[ai][bj][m][0] * rstd * gv[bj][0], acc[ai][bj][m][1] * rstd * gv[bj][1]);
                }
        } else if (pn < 6) {
#pragma unroll
            for (int ai = 0; ai < 2; ++ai)
#pragma unroll
                for (int m = 0; m < 4; ++m) { bf16_t* rp = nav + (size_t)(row0 + ai * 128 + m * 16) * 512 + (pn - 4) * 256 + wc * 32 + 8 * fq;
#pragma unroll
                    for (int bj = 0; bj < 2; ++bj) *(u32x4*)(rp + 128 * bj) = pack8(acc[ai][bj][m][0], acc[ai][bj][m][1]); }
        } else if (pn == 6) {
#pragma unroll
            for (int ai = 0; ai < 2; ++ai)
#pragma unroll
                for (int m = 0; m < 4; ++m) { const int row = row0 + ai * 128 + m * 16; bf16_t* rp = qlat + (size_t)row * 256 + wc * 32 + 8 * fq;
                    float ss = (sq4(acc[ai][0][m][0]) + sq4(acc[ai][0][m][1])) + (sq4(acc[ai][1][m][0]) + sq4(acc[ai][1][m][1]));
                    ss = red_fq(ss); if (fq == 0) qsq[(size_t)row * 4 + wc] = ss;
#pragma unroll
                    for (int bj = 0; bj < 2; ++bj) *(u32x4*)(rp + 128 * bj) = pack8(acc[ai][bj][m][0], acc[ai][bj][m][1]); }
        } else if (pn == 7) {
#pragma unroll
            for (int ai = 0; ai < 2; ++ai)
#pragma unroll
                for (int m = 0; m < 4; ++m) { const int row = row0 + ai * 128 + m * 16;
                    float ss = sq4(acc[ai][0][m][0]) + sq4(acc[ai][0][m][1]);
                    ss = red_fq(ss); if (fq == 0) kvsq[(size_t)row * 4 + wc] = ss;
                    *(u32x4*)(kvlat + (size_t)row * 128 + wc * 32 + 8 * fq) = pack8(acc[ai][0][m][0], acc[ai][0][m][1]);
                    if (wc == 0) { f32x4 v[2] = {acc[ai][1][m][0], acc[ai][1][m][1]};
                        rope32(v, rcos + (size_t)row * 16, rsin + (size_t)row * 16, fq);
                        *(f32x4*)(krot + (size_t)row * 32 + 8 * fq) = v[0]; *(f32x4*)(krot + (size_t)row * 32 + 8 * fq + 4) = v[1]; } }
        } else {
            bf16_t* dst = pn < 12 ? sgna : sgmla; const int cb = ((pn - 8) & 3) * 256 + wc * 32 + 8 * fq;
#pragma unroll
            for (int ai = 0; ai < 2; ++ai)
#pragma unroll
                for (int m = 0; m < 4; ++m) { bf16_t* rp = dst + (size_t)(row0 + ai * 128 + m * 16) * 1024 + cb;
#pragma unroll
                    for (int bj = 0; bj < 2; ++bj) { f32x4 a = acc[ai][bj][m][0], b = acc[ai][bj][m][1];
#pragma unroll
                        for (int e = 0; e < 4; ++e) { a[e] = sigmoidf_fast(a[e]); b[e] = sigmoidf_fast(b[e]); }
                        *(u32x4*)(rp + 128 * bj) = pack8(a, b); } }
        }
    }
};

struct EpiUpQ {
    static constexpr bool PERM = true;
    __device__ __forceinline__ void prefetch(const Unit&, int, int, LAS unsigned char*) const {}
    bf16_t* qm; float* qss; const float* qsq; const float* g; const float *rcos, *rsin;
    __device__ __forceinline__ void operator()(const f32x4 (&acc)[2][2][4][2], const Unit& u, int wr, int wc, int fr, int fq, int ui, LAS unsigned char* lds) const {
        const int pn = u.pn, row0 = u.orow0 + wr * 64 + fr;
#pragma unroll
        for (int ai = 0; ai < 2; ++ai)
#pragma unroll
            for (int m = 0; m < 4; ++m) {
                const int row = row0 + ai * 128 + m * 16, b = row >> 11, s = row & 2047;
                const f32x4 sq = *(const f32x4*)(qsq + (size_t)row * 4);
                const float rstd = rsqrtf(((sq[0] + sq[1]) + (sq[2] + sq[3])) * (1.0f / 256.0f) + EPS);
                if (pn < 2) {
                    const int head = pn * 4 + wc;
                    f32x4 v[2][2]; float ss = 0.f;
#pragma unroll
                    for (int bj = 0; bj < 2; ++bj)
#pragma unroll
                        for (int n = 0; n < 2; ++n) { v[bj][n] = acc[ai][bj][m][n] * rstd; ss += sq4(v[bj][n]); }
                    ss = red_fq(ss); if (fq == 0) qss[((size_t)row * 8 + head) * 2 + 0] = ss;
                    bf16_t* rp = qm + ((size_t)(b * 8 + head) * 2048 + s) * 96 + 8 * fq;
#pragma unroll
                    for (int bj = 0; bj < 2; ++bj) *(u32x4*)(rp + 32 * bj) = pack8(v[bj][0] * *(const f32x4*)(g + 32 * bj + 8 * fq), v[bj][1] * *(const f32x4*)(g + 32 * bj + 8 * fq + 4));
                } else {
#pragma unroll
                    for (int bj = 0; bj < 2; ++bj) { const int head = 2 * wc + bj;
                        f32x4 v[2] = {acc[ai][bj][m][0] * rstd, acc[ai][bj][m][1] * rstd};
                        float ss = sq4(v[0]) + sq4(v[1]); ss = red_fq(ss); if (fq == 0) qss[((size_t)row * 8 + head) * 2 + 1] = ss;
                        rope32(v, rcos + (size_t)row * 16, rsin + (size_t)row * 16, fq);
                        *(u32x4*)(qm + ((size_t)(b * 8 + head) * 2048 + s) * 96 + 64 + 8 * fq) = pack8(v[0] * *(const f32x4*)(g + 64 + 8 * fq), v[1] * *(const f32x4*)(g + 64 + 8 * fq + 4)); }
                }
            }
    }
};

struct EpiUpKV {
    static constexpr bool PERM = true;
    __device__ __forceinline__ void prefetch(const Unit&, int, int, LAS unsigned char*) const {}
    bf16_t *km, *vm; const float* kvsq; const float* krot; const float* g;
    __device__ __forceinline__ void operator()(const f32x4 (&acc)[2][2][4][2], const Unit& u, int wr, int wc, int fr, int fq, int ui, LAS unsigned char* lds) const {
        const int pn = u.pn, row0 = u.orow0 + wr * 64 + fr, head = 2 * pn + (wc >> 1);
#pragma unroll
        for (int ai = 0; ai < 2; ++ai)
#pragma unroll
            for (int m = 0; m < 4; ++m) {
                const int row = row0 + ai * 128 + m * 16, b = row >> 11, s = row & 2047;
                const f32x4 sq = *(const f32x4*)(kvsq + (size_t)row * 4);
                const float rstd = rsqrtf(((sq[0] + sq[1]) + (sq[2] + sq[3])) * (1.0f / 128.0f) + EPS);
                if ((wc & 1) == 0) {
                    f32x4 v[2][2]; float ss = 0.f;
#pragma unroll
                    for (int bj = 0; bj < 2; ++bj)
#pragma unroll
                        for (int n = 0; n < 2; ++n) { v[bj][n] = acc[ai][bj][m][n] * rstd; ss += sq4(v[bj][n]); }
                    const f32x4 k0 = *(const f32x4*)(krot + (size_t)row * 32 + 8 * fq), k1 = *(const f32x4*)(krot + (size_t)row * 32 + 8 * fq + 4);
                    ss += sq4(k0) + sq4(k1); ss = red_fq(ss);
                    const float r96 = rsqrtf(ss * (1.0f / 96.0f) + EPS);
                    bf16_t* rp = km + ((size_t)(b * 8 + head) * 2048 + s) * 96 + 8 * fq;
#pragma unroll
                    for (int bj = 0; bj < 2; ++bj) *(u32x4*)(rp + 32 * bj) = pack8(v[bj][0] * r96 * *(const f32x4*)(g + 32 * bj + 8 * fq), v[bj][1] * r96 * *(const f32x4*)(g + 32 * bj + 8 * fq + 4));
                    *(u32x4*)(rp + 64) = pack8(k0 * r96 * *(const f32x4*)(g + 64 + 8 * fq), k1 * r96 * *(const f32x4*)(g + 64 + 8 * fq + 4));
                } else {
                    bf16_t* rp = vm + ((size_t)(b * 8 + head) * 2048 + s) * 64 + 8 * fq;
#pragma unroll
                    for (int bj = 0; bj < 2; ++bj) *(u32x4*)(rp + 32 * bj) = pack8(acc[ai][bj][m][0] * rstd, acc[ai][bj][m][1] * rstd);
                }
            }
    }
};

struct EpiMergeCat {
    static constexpr bool PERM = true;
    __device__ __forceinline__ void prefetch(const Unit&, int, int, LAS unsigned char*) const {}
    const bf16_t *sgna, *sgmla; bf16_t* out;
    __device__ __forceinline__ void operator()(const f32x4 (&acc)[2][2][4][2], const Unit& u, int wr, int wc, int fr, int fq, int ui, LAS unsigned char* lds) const {
        const int row0 = u.orow0 + wr * 64 + fr, cb = u.pn * 128 + wc * 32 + 8 * fq;
#pragma unroll
        for (int ai = 0; ai < 2; ++ai)
#pragma unroll
            for (int m = 0; m < 4; ++m) { const size_t off = (size_t)(row0 + ai * 128 + m * 16) * 1024 + cb;
                f32x4 ga, gb, ha, hb; unpack8(__builtin_nontemporal_load((const u32x4*)(sgna + off)), ga, gb); unpack8(__builtin_nontemporal_load((const u32x4*)(sgmla + off)), ha, hb);
                *(u32x4*)(out + off) = pack8(acc[ai][0][m][0] * ga + acc[ai][1][m][0] * ha, acc[ai][0][m][1] * gb + acc[ai][1][m][1] * hb); }
    }
};

struct EpiOut {
    static constexpr bool PERM = false;
    __device__ __forceinline__ void prefetch(const Unit&, int, int, LAS unsigned char*) const {}
    const float* x; float* x1; const float* mod;
    __device__ __forceinline__ void operator()(const f32x4 (&acc)[2][2][4][2], const Unit& u, int wr, int wc, int fr, int fq, int ui, LAS unsigned char* lds) const {
        const int row0 = u.orow0 + wr * 64 + fr, cb = u.pn * 256 + wc * 32 + 4 * fq, b = u.orow0 >> 11;
        f32x4 gt[2][2];
#pragma unroll
        for (int bj = 0; bj < 2; ++bj)
#pragma unroll
            for (int n = 0; n < 2; ++n) gt[bj][n] = *(const f32x4*)(mod + (size_t)b * 6144 + 2048 + cb + 128 * bj + 16 * n);
#pragma unroll
        for (int ai = 0; ai < 2; ++ai)
#pragma unroll
            for (int m = 0; m < 4; ++m) { const size_t off = (size_t)(row0 + ai * 128 + m * 16) * 1024 + cb;
#pragma unroll
                for (int bj = 0; bj < 2; ++bj)
#pragma unroll
                    for (int n = 0; n < 2; ++n) { const f32x4 xv = __builtin_nontemporal_load((const f32x4*)(x + off + 128 * bj + 16 * n)); *(f32x4*)(x1 + off + 128 * bj + 16 * n) = xv + gt[bj][n] * acc[ai][bj][m][n]; } }
    }
};

struct EpiGateUp {
    static constexpr bool PERM = true;
    __device__ __forceinline__ void prefetch(const Unit&, int, int, LAS unsigned char*) const {}
    unsigned char* act;
    __device__ __forceinline__ void operator()(const f32x4 (&acc)[2][2][4][2], const Unit& u, int wr, int wc, int fr, int fq, int ui, LAS unsigned char* lds) const {
        const int lr0 = wr * 64 + fr, cb = u.pn * 128 + wc * 32 + 8 * fq;
#pragma unroll
        for (int ai = 0; ai < 2; ++ai)
#pragma unroll
            for (int m = 0; m < 4; ++m) { const int lr = lr0 + ai * 128 + m * 16;
                if (lr < u.nrows) {
                    f32x4 a = acc[ai][0][m][0], b = acc[ai][0][m][1];
#pragma unroll
                    for (int e = 0; e < 4; ++e) { a[e] = siluf_fast(a[e] * (1.0f / WGU_SCALE)) * (acc[ai][1][m][0][e] * (1.0f / WGU_SCALE)); b[e] = siluf_fast(b[e] * (1.0f / WGU_SCALE)) * (acc[ai][1][m][1][e] * (1.0f / WGU_SCALE)); }
                    u32x2 w; w.x = cvt4_fp8(a, ACT_SCALE); w.y = cvt4_fp8(b, ACT_SCALE); *(u32x2*)(act + (size_t)(u.orow0 + lr) * 256 + cb) = w; } }
    }
};
__device__ __forceinline__ unsigned pk4_fp8_unused(f32x4 a) {
    int w = 0;
    w = __builtin_amdgcn_cvt_pk_fp8_f32(__builtin_amdgcn_fmed3f(a[0] * YS_SCALE, -448.f, 448.f), __builtin_amdgcn_fmed3f(a[1] * YS_SCALE, -448.f, 448.f), w, false);
    w = __builtin_amdgcn_cvt_pk_fp8_f32(__builtin_amdgcn_fmed3f(a[2] * YS_SCALE, -448.f, 448.f), __builtin_amdgcn_fmed3f(a[3] * YS_SCALE, -448.f, 448.f), w, true);
    return (unsigned)w;
}
struct EpiDown {
    static constexpr bool PERM = true;
    __device__ __forceinline__ void prefetch(const Unit& u, int ui, int tid, LAS unsigned char* lds) const {
        if (tid < 256) { LAS float* wl = (LAS float*)(lds + RING_BYTES + 1024 + 12288) + (ui & 1) * 256; wl[tid] = u.l1 ? ((const float*)u.l1)[tid] : 1.0f; } }
    unsigned char* ys; int dry;
    __device__ __forceinline__ void operator()(const f32x4 (&acc)[2][2][4][2], const Unit& u, int wr, int wc, int fr, int fq, int ui, LAS unsigned char* lds) const {
        if (dry) { float t = 0.f; _Pragma("unroll") for (int ai = 0; ai < 2; ++ai) _Pragma("unroll") for (int bj = 0; bj < 2; ++bj) _Pragma("unroll") for (int m = 0; m < 4; ++m) t += acc[ai][bj][m][0][0] + acc[ai][bj][m][1][3]; asm volatile("" :: "v"(t)); return; }
        const int lr0 = wr * 64 + fr, cb = u.pn * 256 + wc * 32 + 8 * fq;
#pragma unroll
        for (int ai = 0; ai < 2; ++ai)
#pragma unroll
            for (int m = 0; m < 4; ++m) { const int lr = lr0 + ai * 128 + m * 16;
                if (lr < u.nrows) { unsigned char* rp = ys + (size_t)(u.orow0 + lr) * 1024 + cb;
                    const float sc = (YS_SCALE / (ACT_SCALE * WD_SCALE)) * ((const LAS float*)(lds + RING_BYTES + 1024 + 12288))[(ui & 1) * 256 + lr];
#pragma unroll
                    for (int bj = 0; bj < 2; ++bj) { u32x2 w; w.x = cvt4_fp8(acc[ai][bj][m][0], sc); w.y = cvt4_fp8(acc[ai][bj][m][1], sc); *(u32x2*)(rp + 128 * bj) = w; } } }
    }
};
}
struct Frame {
    LAS unsigned char* lds;
    volatile LAS unsigned* MISC;
    gu32* ctl;
    int tid, lane, wave, vcu, G;
    unsigned char* ws;
    float* out;
    __device__ __forceinline__ void refresh() { int t = threadIdx.x; asm volatile("" : "+v"(t)); tid = t; lane = t & 63; wave = __builtin_amdgcn_readfirstlane(t >> 6);
        asm volatile("" : "+s"(ws)); asm volatile("" : "+s"(out)); ctl = (gu32*)(ws + WS_CTL); }
};
__device__ __forceinline__ int fresh_tid() { int t = threadIdx.x; asm volatile("" : "+v"(t)); return t; }
template <class T> __device__ __forceinline__ T* wsp(const Frame& F, size_t off) { return (T*)(F.ws + off); }

struct MapOff { int off; __device__ int operator()(int n) const { return n + off; } };
struct MapWin { __device__ int operator()(int n) const {
    if (n < 1024) { const int sec = n >> 9, nn = n & 511, hh = nn >> 6, d = nn & 63; return sec * 512 + (hh >> 2) * 256 + 128 * (d >> 5) + 32 * (hh & 3) + (d & 31); }
    return n < 1952 ? n : n + 96; } };
struct MapUq { __device__ int operator()(int n) const { const int hh = n / 96, d = n % 96;
    return d < 64 ? (hh >> 2) * 256 + 128 * (d >> 5) + 32 * (hh & 3) + (d & 31) : 512 + 128 * (hh & 1) + 32 * (hh >> 1) + (d - 64); } };
struct MapUkv { __device__ int operator()(int n) const { const int hh = n >> 7, d = n & 127, dd = d & 63, wcn = 2 * (hh & 1) + (d >> 6);
    return (hh >> 1) * 256 + 128 * (dd >> 5) + 32 * wcn + (dd & 31); } };
struct MapCat { int up; __device__ int operator()(int n) const { return (n >> 7) * 256 + up * 128 + (n & 127); } };
struct MapGU { int up; __device__ int operator()(int f) const { return (f >> 7) * 256 + up * 128 + (f & 127); } };

template <class Map> __device__ __forceinline__ void transpose_item(const float* W, int K, int N, bf16_t* WT, Map rm, const float* kscale, LAS float* scr, int item, int lane, int ldt = 0, int koff = 0) {
    if (ldt == 0) ldt = K;
    const int nblk = N / 32, kb = item / nblk, nb = item % nblk, k0 = 64 * kb, n0 = 32 * nb;
    float tv[32];
#pragma unroll
    for (int i = 0; i < 32; ++i) { const int kk = 2 * i + (lane >> 5); tv[i] = __builtin_nontemporal_load(W + (size_t)(k0 + kk) * N + n0 + (lane & 31)); }
#pragma unroll
    for (int i = 0; i < 32; ++i) { const int kk = 2 * i + (lane >> 5); float v = tv[i]; if (kscale) v *= kscale[k0 + kk]; scr[kk * 33 + (lane & 31)] = v; }
    LDS_WAIT(); asm volatile("" ::: "memory");
    const int c = lane & 7;
#pragma unroll
    for (int j = 0; j < 4; ++j) { const int n = (lane >> 3) + 8 * j; const LAS float* s = scr + (8 * c) * 33 + n;
        u32x4 o; o.x = pk2(s[0 * 33], s[1 * 33]); o.y = pk2(s[2 * 33], s[3 * 33]); o.z = pk2(s[4 * 33], s[5 * 33]); o.w = pk2(s[6 * 33], s[7 * 33]);
        *(u32x4*)(WT + (size_t)rm(n0 + n) * ldt + koff + k0 + 8 * c) = o; }
    LDS_WAIT(); asm volatile("" ::: "memory");
}


template <class Map> __device__ __forceinline__ void transpose_item_fp8(const float* W, int K, int N, unsigned char* WT, Map rm, float sc, LAS float* scr, int item, int lane) {
    const int nblk = N / 32, kb = item / nblk, nb = item % nblk, k0 = 64 * kb, n0 = 32 * nb;
    float tv[32];
#pragma unroll
    for (int i = 0; i < 32; ++i) { const int kk = 2 * i + (lane >> 5); tv[i] = __builtin_nontemporal_load(W + (size_t)(k0 + kk) * N + n0 + (lane & 31)); }
#pragma unroll
    for (int i = 0; i < 32; ++i) { const int kk = 2 * i + (lane >> 5); scr[kk * 33 + (lane & 31)] = tv[i]; }
    LDS_WAIT(); asm volatile("" ::: "memory");
    const int c = lane & 3;
#pragma unroll
    for (int j = 0; j < 2; ++j) { const int n = (lane >> 2) + 16 * j; const LAS float* s = scr + (16 * c) * 33 + n;
        u32x4 o;
#pragma unroll
        for (int q = 0; q < 4; ++q) o[q] = cvt4_fp8((f32x4){s[(4 * q + 0) * 33], s[(4 * q + 1) * 33], s[(4 * q + 2) * 33], s[(4 * q + 3) * 33]}, sc);
        *(u32x4*)(WT + (size_t)rm(n0 + n) * K + k0 + 16 * c) = o; }
    LDS_WAIT(); asm volatile("" ::: "memory");
}

__device__ __forceinline__ void p0_prologue(Frame& F, const Args& A) {
    const int tid = F.tid;
    {
        LAS float* sc = (LAS float*)F.lds;
        LAS float* part = (LAS float*)(F.lds + 32768);
        for (int i = tid; i < NB * DM; i += NTHR) { const float v = INF(I_c)[i]; sc[i] = v / (1.0f + expf(-v)); }
        __syncthreads();
        for (int n0 = 24 * (int)blockIdx.x; n0 < 6 * DM; n0 += 24 * F.G) {
        const int kk = tid >> 5, col = tid & 31;
        float a[8];
#pragma unroll
        for (int b = 0; b < 8; ++b) a[b] = 0.f;
        if (col < 24) {
#pragma unroll 1
            for (int k0 = kk; k0 < DM; k0 += 16 * 32) { float wv[32];
#pragma unroll
                for (int q = 0; q < 32; ++q) wv[q] = __builtin_nontemporal_load(INF(I_w_ada) + (size_t)(k0 + 16 * q) * 6144 + n0 + col);
#pragma unroll
                for (int q = 0; q < 32; ++q) {
#pragma unroll
                    for (int b = 0; b < 8; ++b) a[b] = fmaf(sc[b * DM + k0 + 16 * q], wv[q], a[b]); } }
        }
#pragma unroll
        for (int b = 0; b < 8; ++b) part[(kk * 8 + b) * 32 + col] = a[b];
        __syncthreads();
        if (tid < 192) { const int b = tid / 24, cc = tid % 24; float s = 0.f;
#pragma unroll
            for (int q = 0; q < 16; ++q) s += part[(q * 8 + b) * 32 + cc];
            wsp<float>(F, WS_MOD)[(size_t)b * 6144 + n0 + cc] = s + INF(I_b_ada)[n0 + cc]; }
        __syncthreads();
        }
    }
}
__device__ __forceinline__ void p0_copies(Frame& F, const Args& A) {
    const int tid = F.tid;
    LAS float* scr = (LAS float*)(F.lds + F.wave * 16384);
    const int gw = F.vcu * NWAVES + F.wave, NGW = F.G * NWAVES;
    constexpr int I_IN = 16 * 125, I_UQ = 4 * 24, I_UKV = 2 * 32, I_PN = 8 * 32, I_OUT = 16 * 32;
    constexpr int NITEMS = I_IN + I_UQ + I_UKV + 2 * I_PN + I_OUT;
    for (int it = gw; it < NITEMS; it += NGW) {
        int r = it;
        if (r < I_IN) { transpose_item(INF(I_w_in), DM, INCOLS, wsp<bf16_t>(F, WS_WIN), MapWin{}, nullptr, scr, r, F.lane); continue; } r -= I_IN;
        if (r < I_UQ) { transpose_item(INF(I_w_uq), QRANK, MH * QKD, wsp<bf16_t>(F, WS_WUQ), MapUq{}, INF(I_g_q_lat), scr, r, F.lane); continue; } r -= I_UQ;
        if (r < I_UKV) { transpose_item(INF(I_w_ukv), KVRANK, MH * 128, wsp<bf16_t>(F, WS_WUKV), MapUkv{}, INF(I_g_kv_lat), scr, r, F.lane); continue; } r -= I_UKV;
        if (r < I_PN) { transpose_item(INF(I_w_proj_na), 512, DM, wsp<bf16_t>(F, WS_WPCAT), MapCat{0}, nullptr, scr, r, F.lane, 1024, 0); continue; } r -= I_PN;
        if (r < I_PN) { transpose_item(INF(I_w_proj_mla), 512, DM, wsp<bf16_t>(F, WS_WPCAT), MapCat{1}, nullptr, scr, r, F.lane, 1024, 512); continue; } r -= I_PN;
        transpose_item(INF(I_w_out), DM, DM, wsp<bf16_t>(F, WS_WOUT), MapOff{0}, nullptr, scr, r, F.lane);
    }
#ifdef TSA
    if (blockIdx.x == TSWG && threadIdx.x == 0) { const unsigned long long t_ = __builtin_amdgcn_s_memrealtime(); ((LAS unsigned*)(F.lds + TAB_OFF + 2048))[44] = (unsigned)t_; ((LAS unsigned*)(F.lds + TAB_OFF + 2048))[45] = (unsigned)(t_ >> 32); }
#endif
    const int gt = F.vcu * NTHR + tid, NGT = F.G * NTHR;
    for (int i = gt; i < 96 * DM / 8; i += NGT) *(u32x4*)(wsp<bf16_t>(F, WS_WIN) + (size_t)1952 * DM + (size_t)i * 8) = (u32x4){0u, 0u, 0u, 0u};
    for (int i = gt; i < 2048 * 64; i += NGT) { const int row = i >> 6, q = i & 63; *(u32x4*)(wsp<bf16_t>(F, WS_WPCAT) + (size_t)row * 1024 + ((row & 128) ? 0 : 512) + q * 8) = (u32x4){0u, 0u, 0u, 0u}; }
    for (int i = gt; i < NT * 16; i += NGT) { const int t = i >> 4, q = i & 15;
        const float inv = powf(10000.0f, -(float)q / 16.0f), ang = (float)((const int*)A.in[I_positions])[t] * inv;
        wsp<float>(F, WS_RCOS)[i] = cosf(ang); wsp<float>(F, WS_RSIN)[i] = sinf(ang); }
    for (int i = gt; i < 4 * 64 * 64 * 4; i += NGT) { const int ct = i >> 14, j = (i >> 8) & 63, l = (i >> 2) & 63, q = i & 3;
        wsp<float>(F, WS_RFRAG)[i] = INF(I_w_router)[(size_t)(16 * j + 4 * (l >> 4) + q) * NEXP + 16 * ct + (l & 15)]; }
#ifdef TSA
    if (blockIdx.x == TSWG && threadIdx.x == 0) { const unsigned long long t_ = __builtin_amdgcn_s_memrealtime(); ((LAS unsigned*)(F.lds + TAB_OFF + 2048))[46] = (unsigned)t_; ((LAS unsigned*)(F.lds + TAB_OFF + 2048))[47] = (unsigned)(t_ >> 32); }
#endif
}

__device__ __forceinline__ void s1_modnorm(Frame& F, const Args& A) {
    const int gw = F.vcu * NWAVES + F.wave, lane = F.lane;
    const float* mod = wsp<float>(F, WS_MOD); bf16_t* H = wsp<bf16_t>(F, WS_H);
    for (int r0 = gw * 8; r0 < NT; r0 += F.G * NWAVES * 8) {
    const int b = r0 >> 11;
    f32x4 ca[4], cs[4];
#pragma unroll
    for (int j = 0; j < 4; ++j) { const int c4 = 4 * lane + 256 * j;
        const f32x4 g = *(const f32x4*)(INF(I_g_norm1) + c4), sc = *(const f32x4*)(mod + (size_t)b * 6144 + 1024 + c4);
        ca[j] = g * (sc + 1.0f); cs[j] = *(const f32x4*)(mod + (size_t)b * 6144 + c4); }
#pragma unroll 1
    for (int qb = 0; qb < 8; qb += 4) {
    f32x4 v[4][4];
#pragma unroll
    for (int q = 0; q < 4; ++q)
#pragma unroll
        for (int j = 0; j < 4; ++j) v[q][j] = __builtin_nontemporal_load((const f32x4*)(INF(I_x) + (size_t)(r0 + qb + q) * DM + 4 * lane + 256 * j));
#pragma unroll
    for (int q = 0; q < 4; ++q) { float ss = 0.f;
#pragma unroll
        for (int j = 0; j < 4; ++j) ss += sq4(v[q][j]);
        const float rstd = rsqrtf(wave_sum(ss) * (1.0f / DM) + EPS);
#pragma unroll
        for (int j = 0; j < 4; ++j) { const f32x4 o = v[q][j] * rstd * ca[j] + cs[j]; u32x2 w; w.x = cvt_pk_bf16(o[0], o[1]); w.y = cvt_pk_bf16(o[2], o[3]);
            *(u32x2*)(H + (size_t)(r0 + qb + q) * DM + 4 * lane + 256 * j) = w; }
    }
    }
    }
}
namespace attn {
__device__ __forceinline__ int crow(int r, int hi) { return (r & 3) + 8 * (r >> 2) + 4 * hi; }
constexpr int KVBLK = 64;
constexpr int L_K = 0, L_V = 26624, L_WS = 43008, L_OST = 45056, L_BIAS = 77824, L_MASK = L_BIAS + 4 * 15 * 128 * 4, L_END = L_MASK + 4 * 128 * 4;
constexpr int KBUF = 13312, VBUF = 8192;
constexpr float THRN = 8.0f;

template <int DQK> struct Geo { static constexpr int KROWB = DQK * 2 + 16, NCH = DQK / 8, ND0 = DQK / 16; };

__device__ __forceinline__ int v_st(int k, int c) { const int kk = (k & ~0xC) | ((k & 4) << 1) | ((k & 8) >> 1); return ((kk >> 3) * 2 + (c >> 5)) * 512 + ((kk & 7) * 32 + (c & 31)) * 2; }
__device__ __forceinline__ int v_rd_base(int lane) { return ((lane & 3) << 3) | (((lane >> 2) & 3) << 6) | (((lane >> 4) & 1) << 5) | (((lane >> 5) & 1) << 8); }
constexpr int v_rd_off(int d0, int ks, int half) { return d0 * 512 + ks * 2048 + half * 1024; }
template <int OFF> __device__ __forceinline__ s16x4 tr_read(int vb) { s16x4 r; asm volatile("ds_read_b64_tr_b16 %0, %1 offset:%2" : "=&v"(r) : "v"(vb), "i"(OFF) : "memory"); return r; }

template <int D0> __device__ __forceinline__ void pv_one(f32x16& od, int vb, bf16x8 pa0, bf16x8 pa1, bf16x8 pa2, bf16x8 pa3) {
    const s16x4 l0 = tr_read<v_rd_off(D0, 0, 0)>(vb), h0 = tr_read<v_rd_off(D0, 0, 1)>(vb), l1 = tr_read<v_rd_off(D0, 1, 0)>(vb), h1 = tr_read<v_rd_off(D0, 1, 1)>(vb);
    const s16x4 l2 = tr_read<v_rd_off(D0, 2, 0)>(vb), h2 = tr_read<v_rd_off(D0, 2, 1)>(vb), l3 = tr_read<v_rd_off(D0, 3, 0)>(vb), h3 = tr_read<v_rd_off(D0, 3, 1)>(vb);
    asm volatile("s_waitcnt lgkmcnt(0)" ::: "memory"); SBAR();
#define PK(L, H) (bf16x8){L[0], L[1], L[2], L[3], H[0], H[1], H[2], H[3]}
    od = __builtin_amdgcn_mfma_f32_32x32x16_bf16(pa0, PK(l0, h0), od, 0, 0, 0);
    od = __builtin_amdgcn_mfma_f32_32x32x16_bf16(pa1, PK(l1, h1), od, 0, 0, 0);
    od = __builtin_amdgcn_mfma_f32_32x32x16_bf16(pa2, PK(l2, h2), od, 0, 0, 0);
    od = __builtin_amdgcn_mfma_f32_32x32x16_bf16(pa3, PK(l3, h3), od, 0, 0, 0);
#undef PK
}

template <int DQK> __device__ __forceinline__ void qkt(f32x16& p0, f32x16& p1, const LAS unsigned char* Ks, const bf16x8* qr, int r32, int hi) {
    p0 = f32x16{}; p1 = f32x16{};
#pragma unroll
    for (int d0 = 0; d0 < Geo<DQK>::ND0; ++d0) { const int cb = (d0 * 16 + hi * 8) * 2;
        const bf16x8 b0 = *(const LAS bf16x8*)(Ks + r32 * Geo<DQK>::KROWB + cb);
        const bf16x8 b1 = *(const LAS bf16x8*)(Ks + (32 + r32) * Geo<DQK>::KROWB + cb);
        p0 = __builtin_amdgcn_mfma_f32_32x32x16_bf16(b0, qr[d0], p0, 0, 0, 0);
        p1 = __builtin_amdgcn_mfma_f32_32x32x16_bf16(b1, qr[d0], p1, 0, 0, 0); }
}
__device__ __forceinline__ void softmax_tile(f32x16& p0, f32x16& p1, float& l_reg, float C, float nBC, bf16x8& pa0, bf16x8& pa1, bf16x8& pa2, bf16x8& pa3) {
#pragma unroll
    for (int r = 0; r < 16; ++r) { p0[r] = __builtin_amdgcn_exp2f(fmaf(p0[r], C, nBC)); p1[r] = __builtin_amdgcn_exp2f(fmaf(p1[r], C, nBC)); }
    float ps = 0;
#pragma unroll
    for (int r = 0; r < 16; ++r) ps += p0[r];
#pragma unroll
    for (int r = 0; r < 16; ++r) ps += p1[r];
    l_reg += ps;
#define PK4(P, BASE, OUT) do { unsigned a0 = cvt_pk_bf16(P[BASE + 0], P[BASE + 1]), a1 = cvt_pk_bf16(P[BASE + 2], P[BASE + 3]);   \
    unsigned b0 = cvt_pk_bf16(P[BASE + 4], P[BASE + 5]), b1 = cvt_pk_bf16(P[BASE + 6], P[BASE + 7]);                              \
    auto r0 = __builtin_amdgcn_permlane32_swap(a0, b0, false, false); auto r1 = __builtin_amdgcn_permlane32_swap(a1, b1, false, false); \
    u32x4 w = {r0[0], r1[0], r0[1], r1[1]}; OUT = __builtin_bit_cast(bf16x8, w); } while (0)
    PK4(p0, 0, pa0); PK4(p0, 8, pa1); PK4(p1, 0, pa2); PK4(p1, 8, pa3);
#undef PK4
}

template <int DQK, bool NA>
__device__ __forceinline__ void attn_unit(LAS unsigned char* lds, const bf16_t* Qw, int ldq, float qscale, const bf16_t* Kt, int ldk, const bf16_t* Vt, int ldv, bf16_t* Ow,
                                          int ntiles, float SCALE, float bound_raw, int na_first, int na_qc0, int na_dr0) {
    using G = Geo<DQK>;
    int tid_ = threadIdx.x; asm volatile("" : "+v"(tid_));
    const int tid = tid_, lane = tid & 63, r32 = lane & 31, hi = lane >> 5; const int wid = __builtin_amdgcn_readfirstlane(tid >> 6);
    const float C = SCALE * 1.4426950408889634f, nBC = -bound_raw * C;
    LAS float* wsf = (LAS float*)(lds + L_WS) + wid * 64;
    bf16x8 qr[G::ND0];
#pragma unroll
    for (int d0 = 0; d0 < G::ND0; ++d0) { u32x4 w = *(const u32x4*)(Qw + (size_t)r32 * ldq + d0 * 16 + hi * 8);
        if (!NA) { f32x4 a, b; a = (f32x4){bflo(w.x), bfhi(w.x), bflo(w.y), bfhi(w.y)} * qscale; b = (f32x4){bflo(w.z), bfhi(w.z), bflo(w.w), bfhi(w.w)} * qscale;
            w.x = cvt_pk_bf16(a[0], a[1]); w.y = cvt_pk_bf16(a[2], a[3]); w.z = cvt_pk_bf16(b[0], b[1]); w.w = cvt_pk_bf16(b[2], b[3]); }
        qr[d0] = __builtin_bit_cast(bf16x8, w); }
    const int vk = tid >> 3, vc = (tid & 7) * 8, vst = v_st(vk, vc);
    const int k0r = tid / G::NCH, k0c = tid % G::NCH; const int k1id = tid + 512, k1r = k1id / G::NCH, k1c = k1id % G::NCH; const bool k1on = (G::NCH == 12) && (tid < 256);
    const int vb0 = (int)(uintptr_t)(lds + L_V) + v_rd_base(lane);
    u32x4 sv, sk0, sk1;
#define SLOAD(j) do { const size_t kb_ = (size_t)(j) * KVBLK; sv = *(const u32x4*)(Vt + (kb_ + vk) * ldv + vc); sk0 = *(const u32x4*)(Kt + (kb_ + k0r) * ldk + k0c * 8); \
        if (k1on) sk1 = *(const u32x4*)(Kt + (kb_ + k1r) * ldk + k1c * 8); } while (0)
#define SWRITE(bf) do { *(LAS u32x4*)(lds + L_V + (bf) * VBUF + vst) = sv; *(LAS u32x4*)(lds + L_K + (bf) * KBUF + k0r * G::KROWB + k0c * 16) = sk0; \
        if (k1on) *(LAS u32x4*)(lds + L_K + (bf) * KBUF + k1r * G::KROWB + k1c * 16) = sk1; } while (0)
    float l_reg = 0.f; f32x16 o[2]; o[0] = f32x16{}; o[1] = f32x16{};
    const LAS float* tb_lane = nullptr; f32x4 mk0[4], mk1[4];
    if (NA) { const int qc = na_qc0 + r32, i0 = 4 * hi - qc + 63, sft = i0 & 3;
        tb_lane = (const LAS float*)(lds + L_BIAS) + sft * (15 * 128) + (i0 - sft);
        int qe = qc < 8 ? 8 : (qc > 56 ? 56 : qc); const int j0 = 4 * hi - qe + 56, sf2 = j0 & 3;
        const LAS float* tm = (const LAS float*)(lds + L_MASK) + sf2 * 128 + (j0 - sf2);
#pragma unroll
        for (int g4 = 0; g4 < 4; ++g4) { mk0[g4] = *(const LAS f32x4*)(tm + 8 * g4); mk1[g4] = *(const LAS f32x4*)(tm + 8 * g4 + 32); } }
    SLOAD(0); VM_WAIT(); SWRITE(0); if (ntiles > 1) SLOAD(1);
    __syncthreads();
    for (int j = 0; j < ntiles; ++j) {
        const int bf = j & 1;
        bool active = true; int dr = 0;
        if (NA) { dr = na_dr0 + j; active = (j >= na_first) && (j < na_first + 8); }
        if (active) {
            f32x16 p0, p1; bf16x8 pa0, pa1, pa2, pa3;
            qkt<DQK>(p0, p1, lds + L_K + bf * KBUF, qr, r32, hi);
            if (NA) {
                const LAS float* bt = tb_lane + (dr + 7) * 128;
#pragma unroll
                for (int g4 = 0; g4 < 4; ++g4) {
                    const f32x4 b0 = *(const LAS f32x4*)(bt + 8 * g4), b1 = *(const LAS f32x4*)(bt + 8 * g4 + 32);
#pragma unroll
                    for (int e = 0; e < 4; ++e) { p0[4 * g4 + e] = (p0[4 * g4 + e] + b0[e]) + mk0[g4][e]; p1[4 * g4 + e] = (p1[4 * g4 + e] + b1[e]) + mk1[g4][e]; }
                }
            }
            softmax_tile(p0, p1, l_reg, C, nBC, pa0, pa1, pa2, pa3);
            SBAR();
            pv_one<0>(o[0], vb0 + bf * VBUF, pa0, pa1, pa2, pa3); pv_one<1>(o[1], vb0 + bf * VBUF, pa0, pa1, pa2, pa3);
        }
        if (j + 1 < ntiles) { VM_WAIT(); SWRITE(bf ^ 1); if (j + 2 < ntiles) SLOAD(j + 2); }
        __syncthreads();
    }
#undef SLOAD
#undef SWRITE
    { auto rr = __builtin_amdgcn_permlane32_swap(__float_as_uint(l_reg), __float_as_uint(l_reg), false, false); l_reg = __uint_as_float(rr[0]) + __uint_as_float(rr[1]); }
    if (hi == 0) wsf[32 + r32] = l_reg; LDS_WAIT();
    float rli[16];
#pragma unroll
    for (int r = 0; r < 16; ++r) rli[r] = __builtin_amdgcn_rcpf(wsf[32 + crow(r, hi)]);
    LAS bf16_t* stg = (LAS bf16_t*)(lds + L_OST) + wid * 2048;
#pragma unroll
    for (int r = 0; r < 16; ++r) { const int orow = crow(r, hi);
#pragma unroll
        for (int d0 = 0; d0 < 2; ++d0) stg[orow * 64 + d0 * 32 + r32] = (bf16_t)f2bf(o[d0][r] * rli[r]); }
    LDS_WAIT();
#pragma unroll
    for (int i = 0; i < 4; ++i) { const int row = i * 8 + (lane >> 3), ch = lane & 7; const u32x4 v = *(const LAS u32x4*)(stg + row * 64 + ch * 8); *(u32x4*)(Ow + (size_t)row * 1024 + ch * 8) = v; }
    LDS_WAIT();
    __syncthreads();
}

__device__ __forceinline__ void partialSM(f32x16& p0, f32x16& p1, float C, float nBC) {
#pragma unroll
    for (int r = 0; r < 16; ++r) { p0[r] = fmaf(p0[r], C, nBC); p1[r] = fmaf(p1[r], C, nBC); }
#pragma unroll
    for (int r = 0; r < 16; ++r) p0[r] = __builtin_amdgcn_exp2f(p0[r]);
}
__device__ __forceinline__ void finishSM(f32x16& p0, f32x16& p1, float& l_reg, bf16x8& pa0, bf16x8& pa1, bf16x8& pa2, bf16x8& pa3) {
#pragma unroll
    for (int r = 0; r < 16; ++r) p1[r] = __builtin_amdgcn_exp2f(p1[r]);
    float ps = 0;
#pragma unroll
    for (int r = 0; r < 16; ++r) ps += p0[r];
#pragma unroll
    for (int r = 0; r < 16; ++r) ps += p1[r];
    l_reg += ps;
#define PK4(P, BASE, OUT) do { unsigned a0 = cvt_pk_bf16(P[BASE + 0], P[BASE + 1]), a1 = cvt_pk_bf16(P[BASE + 2], P[BASE + 3]);   \
    unsigned b0 = cvt_pk_bf16(P[BASE + 4], P[BASE + 5]), b1 = cvt_pk_bf16(P[BASE + 6], P[BASE + 7]);                              \
    auto r0 = __builtin_amdgcn_permlane32_swap(a0, b0, false, false); auto r1 = __builtin_amdgcn_permlane32_swap(a1, b1, false, false); \
    u32x4 w = {r0[0], r1[0], r0[1], r1[1]}; OUT = __builtin_bit_cast(bf16x8, w); } while (0)
    PK4(p0, 0, pa0); PK4(p0, 8, pa1); PK4(p1, 0, pa2); PK4(p1, 8, pa3);
#undef PK4
}
template <int DQK>
__device__ __forceinline__ void attn_unit_pipe(LAS unsigned char* lds, const bf16_t* Qw, int ldq, float qscale, const bf16_t* Kt, int ldk, const bf16_t* Vt, int ldv, bf16_t* Ow, int ntiles, float SCALE, float bound_raw) {
    using G = Geo<DQK>;
    int tid_ = threadIdx.x; asm volatile("" : "+v"(tid_));
    const int tid = tid_, lane = tid & 63, r32 = lane & 31, hi = lane >> 5; const int wid = __builtin_amdgcn_readfirstlane(tid >> 6);
    const float C = SCALE * 1.4426950408889634f, nBC = -bound_raw * C;
    constexpr int P_K = 0, P_V = 3 * KBUF, P_WS = P_V + 3 * VBUF, P_OST = P_WS + 2048;
    LAS float* wsf = (LAS float*)(lds + P_WS) + wid * 64;
    bf16x8 qr[G::ND0];
#pragma unroll
    for (int d0 = 0; d0 < G::ND0; ++d0) { u32x4 w = *(const u32x4*)(Qw + (size_t)r32 * ldq + d0 * 16 + hi * 8);
        f32x4 a, b; a = (f32x4){bflo(w.x), bfhi(w.x), bflo(w.y), bfhi(w.y)} * qscale; b = (f32x4){bflo(w.z), bfhi(w.z), bflo(w.w), bfhi(w.w)} * qscale;
        w.x = cvt_pk_bf16(a[0], a[1]); w.y = cvt_pk_bf16(a[2], a[3]); w.z = cvt_pk_bf16(b[0], b[1]); w.w = cvt_pk_bf16(b[2], b[3]);
        qr[d0] = __builtin_bit_cast(bf16x8, w); }
    const int vk = tid >> 3, vc = (tid & 7) * 8, vst = v_st(vk, vc);
    const int k0r = tid / G::NCH, k0c = tid % G::NCH; const int k1id = tid + 512, k1r = k1id / G::NCH, k1c = k1id % G::NCH; const bool k1on = (G::NCH == 12) && (wid < 4);
    const int vb0 = (int)(uintptr_t)(lds + P_V) + v_rd_base(lane);
    u32x4 evv, ek0, ek1, ovv, ok0, ok1;
    const __amdgpu_buffer_rsrc_t krs = __builtin_amdgcn_make_buffer_rsrc((void*)Kt, 0, 0x7fffffff, 0x00020000);
    const __amdgpu_buffer_rsrc_t vrs = __builtin_amdgcn_make_buffer_rsrc((void*)Vt, 0, 0x7fffffff, 0x00020000);
    const int voV = (vk * ldv + vc) * 2, voK0 = (k0r * ldk + k0c * 8) * 2, voK1 = (k1r * ldk + k1c * 8) * 2;
#define SLOAD(V_, K0_, K1_, j) do { V_ = __builtin_bit_cast(u32x4, __builtin_amdgcn_raw_buffer_load_b128(vrs, voV, (j) * (KVBLK * 2) * ldv, 0)); \
        K0_ = __builtin_bit_cast(u32x4, __builtin_amdgcn_raw_buffer_load_b128(krs, voK0, (j) * (KVBLK * 2) * ldk, 0)); \
        if (k1on) K1_ = __builtin_bit_cast(u32x4, __builtin_amdgcn_raw_buffer_load_b128(krs, voK1, (j) * (KVBLK * 2) * ldk, 0)); } while (0)
#define SWRITE(bf, V_, K0_, K1_) do { *(LAS u32x4*)(lds + P_V + (bf) * VBUF + vst) = V_; *(LAS u32x4*)(lds + P_K + (bf) * KBUF + k0r * G::KROWB + k0c * 16) = K0_; \
        if (k1on) *(LAS u32x4*)(lds + P_K + (bf) * KBUF + k1r * G::KROWB + k1c * 16) = K1_; } while (0)
#define RESC(a) do { if (__any((a) < 1.f)) { if (hi == 0) wsf[r32] = (a); LDS_WAIT(); \
        _Pragma("unroll") for (int d = 0; d < 2; ++d) _Pragma("unroll") for (int r = 0; r < 16; ++r) o[d][r] *= wsf[crow(r, hi)]; } } while (0)
    float l_reg = 0.f; f32x16 o[2]; o[0] = f32x16{}; o[1] = f32x16{};
    f32x16 pA0, pA1, pB0, pB1; bf16x8 pa0, pa1, pa2, pa3;
    const LAS unsigned char* Kp = lds + P_K;
    SLOAD(evv, ek0, ek1, 0); SWRITE(0, evv, ek0, ek1); __syncthreads();
    qkt<DQK>(pA0, pA1, Kp, qr, r32, hi); partialSM(pA0, pA1, C, nBC);
    SLOAD(ovv, ok0, ok1, 1); SLOAD(evv, ek0, ek1, 2);
    SWRITE(1, ovv, ok0, ok1); __syncthreads();
    int pb = 0, cb = 1, nb = 2;
    for (int j = 1; j + 1 < ntiles; j += 2) {
        SBAR(); qkt<DQK>(pB0, pB1, Kp + cb * KBUF, qr, r32, hi);
        finishSM(pA0, pA1, l_reg, pa0, pa1, pa2, pa3); SBAR();
        SLOAD(ovv, ok0, ok1, j + 2); SBAR();
        pv_one<0>(o[0], vb0 + pb * VBUF, pa0, pa1, pa2, pa3); pv_one<1>(o[1], vb0 + pb * VBUF, pa0, pa1, pa2, pa3); partialSM(pB0, pB1, C, nBC);
        SWRITE(nb, evv, ek0, ek1);
        __syncthreads();
        SBAR(); qkt<DQK>(pA0, pA1, Kp + nb * KBUF, qr, r32, hi);
        finishSM(pB0, pB1, l_reg, pa0, pa1, pa2, pa3); SBAR();
        if (j + 3 < ntiles) SLOAD(evv, ek0, ek1, j + 3); SBAR();
        pv_one<0>(o[0], vb0 + cb * VBUF, pa0, pa1, pa2, pa3); pv_one<1>(o[1], vb0 + cb * VBUF, pa0, pa1, pa2, pa3); partialSM(pA0, pA1, C, nBC);
        SWRITE(pb, ovv, ok0, ok1);
        __syncthreads();
        { const int t_ = cb; cb = pb; pb = nb; nb = t_; }
    }
    SBAR(); qkt<DQK>(pB0, pB1, Kp + cb * KBUF, qr, r32, hi);
    finishSM(pA0, pA1, l_reg, pa0, pa1, pa2, pa3); SBAR();
    pv_one<0>(o[0], vb0 + pb * VBUF, pa0, pa1, pa2, pa3); pv_one<1>(o[1], vb0 + pb * VBUF, pa0, pa1, pa2, pa3); partialSM(pB0, pB1, C, nBC);
    finishSM(pB0, pB1, l_reg, pa0, pa1, pa2, pa3); SBAR();
    pv_one<0>(o[0], vb0 + cb * VBUF, pa0, pa1, pa2, pa3); pv_one<1>(o[1], vb0 + cb * VBUF, pa0, pa1, pa2, pa3);
#undef SLOAD
#undef SWRITE
#undef RESC
    { auto rr = __builtin_amdgcn_permlane32_swap(__float_as_uint(l_reg), __float_as_uint(l_reg), false, false); l_reg = __uint_as_float(rr[0]) + __uint_as_float(rr[1]); }
    if (hi == 0) wsf[32 + r32] = l_reg; LDS_WAIT();
    float rli[16];
#pragma unroll
    for (int r = 0; r < 16; ++r) rli[r] = __builtin_amdgcn_rcpf(wsf[32 + crow(r, hi)]);
    LAS bf16_t* stg = (LAS bf16_t*)(lds + P_OST) + wid * 2048;
#pragma unroll
    for (int r = 0; r < 16; ++r) { const int orow = crow(r, hi);
#pragma unroll
        for (int d0 = 0; d0 < 2; ++d0) stg[orow * 64 + d0 * 32 + r32] = (bf16_t)f2bf(o[d0][r] * rli[r]); }
    LDS_WAIT();
#pragma unroll
    for (int i = 0; i < 4; ++i) { const int row = i * 8 + (lane >> 3), ch = lane & 7; const u32x4 v = *(const LAS u32x4*)(stg + row * 64 + ch * 8); *(u32x4*)(Ow + (size_t)row * 1024 + ch * 8) = v; }
    LDS_WAIT();
    __syncthreads();
}
}

__device__ __forceinline__ void s4_attention(Frame& F, const Args& A, int rep_mla, int rep_na) {
    const int wave = F.wave;
    float bound_mla;
    { int l = threadIdx.x & 63; asm volatile("" : "+v"(l)); float mq = 0.f, mk = 0.f;
      for (int i = l; i < QKD; i += 64) { mq = fmaxf(mq, fabsf(INF(I_g_mla_q)[i])); mk = fmaxf(mk, fabsf(INF(I_g_mla_k)[i])); }
#pragma unroll
      for (int o = 1; o < 64; o <<= 1) { mq = fmaxf(mq, shx(mq, o, l)); mk = fmaxf(mk, shx(mk, o, l)); }
      bound_mla = (float)QKD * mq * mk * 1.0001f; }
    for (int rp = 0; rp < rep_mla; ++rp)
    for (int un = F.vcu; un < NB * MH * 8; un += F.G) {
        const int bh = un >> 3, qb = un & 7, b = bh >> 3, h = bh & 7;
        const int s0 = qb * 256 + wave * 32, t0 = b * SEQ + s0, r32 = F.lane & 31;
        const float* qss = wsp<float>(F, WS_QSS) + ((size_t)(t0 + r32) * 8 + h) * 2;
        const float qscale = rsqrtf((qss[0] + qss[1]) * (1.0f / 96.0f) + EPS);
        attn::attn_unit_pipe<96>(F.lds, wsp<bf16_t>(F, WS_QM) + ((size_t)bh * SEQ + s0) * 96, 96, qscale,
                                 wsp<bf16_t>(F, WS_KM) + (size_t)bh * SEQ * 96, 96, wsp<bf16_t>(F, WS_VM) + (size_t)bh * SEQ * 64, 64,
                                 wsp<bf16_t>(F, WS_YNA) + (size_t)t0 * 1024 + 512 + h * 64, SEQ / 64, 0.10206207261596577f, bound_mla);
    }
#ifdef TSA
    if (blockIdx.x == TSWG && threadIdx.x == 0) { const unsigned long long t_ = __builtin_amdgcn_s_memrealtime(); ((LAS unsigned*)(F.lds + TAB_OFF + 2048))[40] = (unsigned)t_; ((LAS unsigned*)(F.lds + TAB_OFF + 2048))[41] = (unsigned)(t_ >> 32); }
#endif
    float bound_na;
    { int l = threadIdx.x & 63; asm volatile("" : "+v"(l)); float nq = fabsf(INF(I_g_na_q)[l]), nk = fabsf(INF(I_g_na_k)[l]), bm = 0.f;
      for (int i = l; i < NAH * 15 * 31; i += 64) bm = fmaxf(bm, fabsf(INF(I_na_rpb)[i]));
#pragma unroll
      for (int o = 1; o < 64; o <<= 1) { nq = fmaxf(nq, shx(nq, o, l)); nk = fmaxf(nk, shx(nk, o, l)); bm = fmaxf(bm, shx(bm, o, l)); }
      bound_na = (float)NAD * nq * nk * 1.0001f + 8.0f * bm; }
    for (int rp = 0; rp < rep_na; ++rp)
    for (int un = F.vcu; un < NB * NAH * 8; un += F.G) {
        const int bh = un >> 3, g = un & 7, b = bh >> 3, h = bh & 7;
        LAS float* tb = (LAS float*)(F.lds + attn::L_BIAS); LAS float* tm = (LAS float*)(F.lds + attn::L_MASK);
        for (int i = F.tid; i < 4 * 15 * 128; i += NTHR) { const int sft = i / (15 * 128), rr = (i / 128) % 15, ii = (i & 127) + sft - 48;
            tb[i] = (ii >= 0 && ii <= 30) ? INF(I_na_rpb)[(size_t)(h * 15 + rr) * 31 + ii] * 8.0f : 0.f; }
        for (int i = F.tid; i < 4 * 128; i += NTHR) { const int sft = i >> 7, dd = (i & 127) + sft - 56; tm[i] = (dd >= -8 && dd <= 7) ? 0.f : -1e30f; }
        int lo = 4 * g - 4; lo = lo < 0 ? 0 : (lo > 24 ? 24 : lo); int hi_s = 4 * g + 3 - 4; hi_s = hi_s < 0 ? 0 : (hi_s > 24 ? 24 : hi_s);
        const int ntiles = hi_s + 8 - lo;
        const int qrow = 4 * g + (wave >> 1); int rs = qrow - 4; rs = rs < 0 ? 0 : (rs > 24 ? 24 : rs);
        const int t0 = b * SEQ + qrow * 64 + 32 * (wave & 1);
        __syncthreads();
        attn::attn_unit<64, true>(F.lds, wsp<bf16_t>(F, WS_NAQ) + (size_t)t0 * 512 + h * 64, 512, 1.0f,
                                  wsp<bf16_t>(F, WS_NAK) + (size_t)(b * SEQ + lo * 64) * 512 + h * 64, 512, wsp<bf16_t>(F, WS_NAV) + (size_t)(b * SEQ + lo * 64) * 512 + h * 64, 512,
                                  wsp<bf16_t>(F, WS_YNA) + (size_t)t0 * 1024 + h * 64, ntiles, 0.125f, bound_na, rs - lo, 32 * (wave & 1), lo - qrow);
    }
}
namespace moe {
#define RFL(x) __builtin_amdgcn_readfirstlane(x)
constexpr int ASTR = 1028;
constexpr int L_A = 0, L_LG = 16 * ASTR * 4, L_END = L_LG + 2 * 16 * 64 * 4;
constexpr int T_CNT = 0, T_ABASE = 128, T_YBASE = 200, T_PRE = 336, T_MBOX = 340;
constexpr bool DYNQ = false;
constexpr int CW_Q = 20480;

__device__ __forceinline__ void s7_router(Frame& F, const Args& A, int rep_conv, int rep_rt) {
    const int lane = F.lane, wave = F.wave;
    const float* mod = wsp<float>(F, WS_MOD); unsigned char* H2 = wsp<unsigned char>(F, WS_H2);
    LAS float* At = (LAS float*)(F.lds + L_A); LAS float* LG = (LAS float*)(F.lds + L_LG);
    const float* rfrag = wsp<float>(F, WS_RFRAG);
    int* LIST = wsp<int>(F, WS_LIST); float* WLIST = wsp<float>(F, WS_WLIST); unsigned* TOKSLOT = wsp<unsigned>(F, WS_TOKSLOT);
    const float ebias = INF(I_e_bias)[lane];
    LAS unsigned* pe = (LAS unsigned*)(F.lds + 81920);
    LAS float* pw = (LAS float*)(F.lds + 81920 + 4096);
    LAS unsigned* lcnt = (LAS unsigned*)(F.lds + 81920 + 8192);
    if (F.tid < 128) lcnt[F.tid] = 0u;
    __syncthreads();
    int ulocal = 0;
#ifdef TSA
#define RT_ACC(k) do { if (blockIdx.x == TSWG && threadIdx.x == 0) { const unsigned long long t_ = __builtin_amdgcn_s_memrealtime(); LAS unsigned* q_ = (LAS unsigned*)(F.lds + TAB_OFF + 2048); const unsigned long long d_ = t_ - rt_prev; unsigned long long a_ = ((unsigned long long)q_[2 * (k) + 1] << 32) | q_[2 * (k)]; a_ += d_; q_[2 * (k)] = (unsigned)a_; q_[2 * (k) + 1] = (unsigned)(a_ >> 32); rt_prev = t_; } } while (0)
    unsigned long long rt_prev = __builtin_amdgcn_s_memrealtime();
    if (blockIdx.x == TSWG && threadIdx.x == 0) { LAS unsigned* q_ = (LAS unsigned*)(F.lds + TAB_OFF + 2048); for (int k = 48; k < 64; ++k) q_[k] = 0u; }
#else
#define RT_ACC(k) do {} while (0)
#endif
    for (int rp = 0; rp < rep_rt; ++rp)
    for (int un = F.vcu; un < NT / 16; un += F.G) {
        const bool dry = rp + 1 < rep_rt;
        const int row0 = un * 16, b = row0 >> 11;
        const float* bp = rfrag + ((size_t)((wave & 3) * 64 + 32 * (wave >> 2)) * 64 + lane) * 4;
        f32x4 bA[16], bB[16];
#pragma unroll
        for (int jj = 0; jj < 16; ++jj) bA[jj] = *(const f32x4*)(bp + (size_t)jj * 256);
        SBAR();
        {
            f32x4 v[2][4], cg[4], csc[4], csh[4];
#pragma unroll
            for (int rr = 0; rr < 2; ++rr)
#pragma unroll
                for (int j = 0; j < 4; ++j) v[rr][j] = __builtin_nontemporal_load((const f32x4*)(F.out + (size_t)(row0 + 2 * wave + rr) * DM + 4 * lane + 256 * j));
#pragma unroll
            for (int j = 0; j < 4; ++j) { const int c4 = 4 * lane + 256 * j;
                cg[j] = *(const f32x4*)(INF(I_g_norm2) + c4); csc[j] = *(const f32x4*)(mod + (size_t)b * 6144 + 4096 + c4); csh[j] = *(const f32x4*)(mod + (size_t)b * 6144 + 3072 + c4); }
#pragma unroll
            for (int rr = 0; rr < 2; ++rr) { const int lr = 2 * wave + rr, row = row0 + lr; float ss = 0.f;
#pragma unroll
                for (int j = 0; j < 4; ++j) ss += sq4(v[rr][j]);
                const float rstd = rsqrtf(wave_sum(ss) * (1.0f / DM) + EPS);
#pragma unroll
                for (int j = 0; j < 4; ++j) { const int c4 = 4 * lane + 256 * j;
                    const f32x4 o = v[rr][j] * rstd * (cg[j] * (csc[j] + 1.0f)) + csh[j];
                    *(unsigned*)(H2 + (size_t)row * DM + c4) = cvt4_fp8(o, 1.0f);
                    *(LAS f32x4*)(At + lr * ASTR + c4) = o; } }
        }
        __syncthreads(); RT_ACC(24);
        {
            const int ct = wave & 3, kh = wave >> 2; f32x4 acc = {0.f, 0.f, 0.f, 0.f};
            const LAS float* ap = At + (lane & 15) * ASTR + 4 * (lane >> 4);
#pragma unroll
            for (int jj = 0; jj < 16; ++jj) bB[jj] = *(const f32x4*)(bp + (size_t)(16 + jj) * 256);
            SBAR();
#pragma unroll
            for (int jj = 0; jj < 16; ++jj) { const f32x4 a4 = *(const LAS f32x4*)(ap + 16 * (32 * kh + jj)); const f32x4 b4 = bA[jj];
                acc = __builtin_amdgcn_mfma_f32_16x16x4f32(a4[0], b4[0], acc, 0, 0, 0); acc = __builtin_amdgcn_mfma_f32_16x16x4f32(a4[1], b4[1], acc, 0, 0, 0);
                acc = __builtin_amdgcn_mfma_f32_16x16x4f32(a4[2], b4[2], acc, 0, 0, 0); acc = __builtin_amdgcn_mfma_f32_16x16x4f32(a4[3], b4[3], acc, 0, 0, 0);
                if ((jj & 3) == 3) SBAR(); }
#pragma unroll
            for (int jj = 0; jj < 16; ++jj) { const f32x4 a4 = *(const LAS f32x4*)(ap + 16 * (32 * kh + 16 + jj)); const f32x4 b4 = bB[jj];
                acc = __builtin_amdgcn_mfma_f32_16x16x4f32(a4[0], b4[0], acc, 0, 0, 0); acc = __builtin_amdgcn_mfma_f32_16x16x4f32(a4[1], b4[1], acc, 0, 0, 0);
                acc = __builtin_amdgcn_mfma_f32_16x16x4f32(a4[2], b4[2], acc, 0, 0, 0); acc = __builtin_amdgcn_mfma_f32_16x16x4f32(a4[3], b4[3], acc, 0, 0, 0);
                if ((jj & 3) == 3) SBAR(); }
#pragma unroll
            for (int r = 0; r < 4; ++r) LG[(kh * 16 + 4 * (lane >> 4) + r) * 64 + 16 * ct + (lane & 15)] = acc[r];
        }
        __syncthreads(); RT_ACC(25);
#pragma unroll 1
        for (int rr = 0; rr < 2; ++rr) {
            const int lr = 2 * wave + rr, tok = row0 + lr;
            const float logit = LG[lr * 64 + lane] + LG[(16 + lr) * 64 + lane];
            const float score = 1.0f / (1.0f + expf(-logit));
            const float sel = score + ebias;
            const int l_ = lane_fresh(); float m1 = sel; m1 = fmaxf(m1, shx(m1, 1, l_)); m1 = fmaxf(m1, shx(m1, 2, l_)); m1 = fmaxf(m1, shx(m1, 4, l_));
            const unsigned long long bm = __ballot(sel == m1);
            const unsigned gb = (unsigned)(bm >> (lane & ~7)) & 0xffu; const int first = __ffs((int)gb) - 1;
            float m2 = ((lane & 7) == first) ? -INFINITY : sel; m2 = fmaxf(m2, shx(m2, 1, l_)); m2 = fmaxf(m2, shx(m2, 2, l_)); m2 = fmaxf(m2, shx(m2, 4, l_));
            const float gs = m1 + m2; int grank = 0;
            { const unsigned ub = __float_as_uint(gs), uo = (ub & 0x80000000u) ? ~ub : (ub | 0x80000000u);
              const unsigned long long key = ((unsigned long long)uo << 8) | (unsigned)(7 - (lane >> 3));
#pragma unroll
              for (int q = 0; q < 8; ++q) { const unsigned long long ok = ((unsigned long long)(unsigned)__builtin_amdgcn_readlane((int)(key >> 32), 8 * q) << 32) | (unsigned)__builtin_amdgcn_readlane((int)(unsigned)key, 8 * q); grank += ok > key ? 1 : 0; } }
            const bool gsel = grank < TOPKG; const float sm = gsel ? sel : -INFINITY; int rank = 0;
            { const unsigned ub = __float_as_uint(sm), uo = (ub & 0x80000000u) ? ~ub : (ub | 0x80000000u);
              const unsigned long long key = ((unsigned long long)uo << 8) | (unsigned)(63 - lane);
              const int khi = (int)(key >> 32), klo = (int)(unsigned)key;
#pragma unroll
              for (int q = 0; q < 64; ++q) { const unsigned long long ok = ((unsigned long long)(unsigned)__builtin_amdgcn_readlane(khi, q) << 32) | (unsigned)__builtin_amdgcn_readlane(klo, q); rank += ok > key ? 1 : 0; } }
            const bool chosen = gsel && rank < TOPK;
            const float wsum = wave_sum(chosen ? score : 0.f);
            const float w = score / wsum * 2.5f;
            if (chosen && !dry) { const unsigned lp = __hip_atomic_fetch_add(lcnt + lane, 1u, __ATOMIC_RELAXED, __HIP_MEMORY_SCOPE_WORKGROUP);
                const int pi = ((ulocal * 16 + lr) * 8 + rank) & 1023; pe[pi] = ((unsigned)lane << 16) | lp; pw[pi] = w; }
        }
        if (!dry) ++ulocal;
        __syncthreads(); RT_ACC(26);
    }
    if (F.tid < 64) { const unsigned n = lcnt[F.tid]; lcnt[64 + F.tid] = n ? __hip_atomic_fetch_add((unsigned*)F.ctl + CW_CNT + (F.tid * 2) * 16, n, RLX_AGENT) : 0u; }
    __syncthreads();
    for (int pi = F.tid; pi < ulocal * 128; pi += NTHR) {
        const int ul = pi >> 7, lr = (pi >> 3) & 15, rank = pi & 7, tok = (F.vcu + ul * F.G) * 16 + lr;
        const unsigned v = pe[pi], e = v >> 16, pos = lcnt[64 + e] + (v & 0xffffu);
        LIST[(size_t)(e * 2) * 8192 + pos] = tok; WLIST[(size_t)(e * 2) * 8192 + pos] = pw[pi]; TOKSLOT[(size_t)tok * 8 + rank] = (e << 16) | pos; }
    __syncthreads(); RT_ACC(27);
#ifdef TSA
    if (blockIdx.x == TSWG && threadIdx.x == 0) { const unsigned long long t_ = __builtin_amdgcn_s_memrealtime(); ((LAS unsigned*)(F.lds + TAB_OFF + 2048))[42] = (unsigned)t_; ((LAS unsigned*)(F.lds + TAB_OFF + 2048))[43] = (unsigned)(t_ >> 32); }
#endif
    LAS float* scr = (LAS float*)(F.lds + wave * 16384);
    const int gw = F.vcu * NWAVES + wave, NGW = F.G * NWAVES;
    for (int rp = 0; rp < rep_conv; ++rp)
    for (int it = gw; it < 65 * 384; it += NGW) {
        const int e = it / 384, r = it % 384;
        const float* wg = e < 64 ? INF(I_w_eg) + (size_t)e * DM * EFF : INF(I_w_sg); const float* wu = e < 64 ? INF(I_w_eu) + (size_t)e * DM * EFF : INF(I_w_su); const float* wd = e < 64 ? INF(I_w_ed) + (size_t)e * EFF * DM : INF(I_w_sd);
        if (r < 128) transpose_item_fp8(wg, DM, EFF, wsp<unsigned char>(F, WS_WGU) + (size_t)e * 512 * DM, MapGU{0}, WGU_SCALE, scr, r, lane);
        else if (r < 256) transpose_item_fp8(wu, DM, EFF, wsp<unsigned char>(F, WS_WGU) + (size_t)e * 512 * DM, MapGU{1}, WGU_SCALE, scr, r - 128, lane);
        else transpose_item_fp8(wd, EFF, DM, wsp<unsigned char>(F, WS_WD) + (size_t)e * DM * EFF, MapOff{0}, WD_SCALE, scr, r - 256, lane);
    }
}

__device__ __forceinline__ void build_tables(Frame& F) {
    LAS int* tab = (LAS int*)(F.lds + TAB_OFF);
    if (F.tid < 128) tab[T_CNT + F.tid] = (int)__hip_atomic_load((unsigned*)F.ctl + CW_CNT + F.tid * 16, RLX_AGENT);
    __syncthreads();
    if (F.tid < 64) { const int e = F.tid; const int c0 = tab[T_CNT + 2 * e], c1 = tab[T_CNT + 2 * e + 1];
        int a = c0 + c1, y0 = c0, y1 = c1;
#pragma unroll
        for (int o = 1; o < 64; o <<= 1) { const int ta = shup_i(a, o, e), t0 = shup_i(y0, o, e), t1 = shup_i(y1, o, e); if (e >= o) { a += ta; y0 += t0; y1 += t1; } }
        tab[T_ABASE + e] = a - (c0 + c1); tab[T_YBASE + e] = y0 - c0; tab[T_YBASE + 64 + e] = y1 - c1; if (e == 63) tab[T_ABASE + 64] = a; }
    if (F.tid == 64) { tab[T_MBOX] = 0; tab[T_MBOX + 1] = 0; }
    __syncthreads();
}

struct GateUpSched {
    const LAS int* tab; const unsigned char* wgu; const int* list; int x, j, per;
    unsigned* qc; LAS int* mbox; unsigned pend;
    __device__ __forceinline__ int unit_index(int i) const { return (!DYNQ || i < 2) ? i * per + j : RFL(mbox[i & 1]); }
    __device__ __forceinline__ void grab() { if (DYNQ) if (RFL((int)(threadIdx.x >> 6)) == 0 && (threadIdx.x & 63) == 0) pend = __hip_atomic_fetch_add(qc, 1u, RLX_AGENT); }
    __device__ __forceinline__ void publish(int wid) { if (DYNQ) if (wid == 0) { if ((threadIdx.x & 63) == 0) mbox[nslot] = (int)(2 * per + pend); LDS_WAIT(); } nslot ^= 1; }
    int nslot;
    __device__ void init(Frame& F) { tab = (const LAS int*)(F.lds + TAB_OFF); wgu = wsp<unsigned char>(F, WS_WGU); list = wsp<int>(F, WS_LIST); x = (int)blockIdx.x % 8; j = (int)blockIdx.x / 8; per = F.G / 8;
        qc = (unsigned*)F.ctl + CW_Q + (0 * 8 + x) * 16; mbox = (LAS int*)(F.lds + TAB_OFF) + T_MBOX; pend = 0; nslot = 0; }
    __device__ bool next(int i, pg8::Unit& u) {
        const int L = unit_index(i);
        int k = -1, base = 0, a = 0;
#pragma unroll
        for (int q = 0; q < 8; ++q) { const int e = x + 8 * q; const int na = a + ((RFL(tab[T_CNT + 2 * e]) + RFL(tab[T_CNT + 2 * e + 1]) + 255) >> 8) * 2; if (k < 0 && L < na) { k = q; base = a; } a = na; }
        if (k >= 0) {
            if (i >= 1) grab();
            const int e = x + 8 * k, r = L - base, mt = r >> 1, pn = r & 1, n0 = RFL(tab[T_CNT + 2 * e]), ntot = n0 + RFL(tab[T_CNT + 2 * e + 1]);
            u.B = (const char*)(wgu + ((size_t)e * 512 + pn * 256) * DM); u.m0 = mt * 256; u.pn = pn; u.e = e; u.nrows = (ntot - mt * 256) < 256 ? (ntot - mt * 256) : 256;
            u.orow0 = RFL(tab[T_ABASE + e]) + mt * 256; u.l0 = list + (size_t)(2 * e) * 8192; u.l1 = list + (size_t)(2 * e + 1) * 8192; u.n0 = n0; u.ntot = ntot; return true; }
        const int r = L - a; if (r >= 16) return false;
        if (i >= 1) grab();
        const int mt = x + 8 * (r >> 1), pn = r & 1;
        u.B = (const char*)(wgu + ((size_t)64 * 512 + pn * 256) * DM); u.m0 = mt * 256; u.pn = pn; u.e = 64; u.nrows = 256; u.orow0 = ACT_SHARED_ROW0 + mt * 256; u.l0 = nullptr; u.l1 = nullptr; u.n0 = 0; u.ntot = 0; return true;
    }
};
struct DownSched {
    const LAS int* tab; const unsigned char* wd; const int* tab0; int x, j, per, c;
    unsigned* qc; LAS int* mbox; unsigned pend;
    __device__ __forceinline__ int unit_index(int i) const { return (!DYNQ || i < 2) ? i * per + j : RFL(mbox[i & 1]); }
    __device__ __forceinline__ void grab() { if (DYNQ) if (RFL((int)(threadIdx.x >> 6)) == 0 && (threadIdx.x & 63) == 0) pend = __hip_atomic_fetch_add(qc, 1u, RLX_AGENT); }
    __device__ __forceinline__ void publish(int wid) { if (DYNQ) if (wid == 0) { if ((threadIdx.x & 63) == 0) mbox[nslot] = (int)(2 * per + pend); LDS_WAIT(); } nslot ^= 1; }
    int nslot;
    __device__ void init(Frame& F, int c_) { tab = (const LAS int*)(F.lds + TAB_OFF); wd = wsp<unsigned char>(F, WS_WD); tab0 = wsp<int>(F, WS_LIST); x = (int)blockIdx.x % 8; j = (int)blockIdx.x / 8; per = F.G / 8; c = c_;
        qc = (unsigned*)F.ctl + CW_Q + ((1 + c_) * 8 + x) * 16; mbox = (LAS int*)(F.lds + TAB_OFF) + T_MBOX; pend = 0; nslot = 0; }
    __device__ bool next(int i, pg8::Unit& u) {
        const int L = unit_index(i);
        u.l0 = nullptr; u.l1 = nullptr; u.n0 = 0; u.ntot = 0;
        const float* wlist = (const float*)((const char*)tab0 + (WS_WLIST - WS_LIST));
        int k = -1, base = 0, a = 0;
#pragma unroll
        for (int q = 0; q < 8; ++q) { const int e = x + 8 * q; const int na = a + ((RFL(tab[T_CNT + 2 * e + c]) + 255) >> 8) * 4; if (k < 0 && L < na) { k = q; base = a; } a = na; }
        if (k >= 0) {
            if (i >= 1) grab();
            const int e = x + 8 * k, r = L - base, mt = r >> 2, pn = r & 3, n = RFL(tab[T_CNT + 2 * e + c]);
            u.B = (const char*)(wd + ((size_t)e * DM + pn * 256) * EFF); u.m0 = RFL(tab[T_ABASE + e]) + (c ? RFL(tab[T_CNT + 2 * e]) : 0) + mt * 256; u.pn = pn; u.e = e;
            u.nrows = (n - mt * 256) < 256 ? (n - mt * 256) : 256; u.orow0 = RFL(tab[T_YBASE + 64 * c + e]) + mt * 256; u.l1 = (const int*)(wlist + (size_t)(2 * e + c) * 8192 + mt * 256); return true; }
        const int r = L - a; if (r >= (CHTOK / 256 / 8) * 4) return false;
        if (i >= 1) grab();
        const int mt = x + 8 * (r >> 2), pn = r & 3;
        u.B = (const char*)(wd + ((size_t)64 * DM + pn * 256) * EFF); u.m0 = ACT_SHARED_ROW0 + c * CHTOK + mt * 256; u.pn = pn; u.e = 64; u.nrows = 256; u.orow0 = YS_SHARED_ROW0 + mt * 256; return true;
    }
};

__device__ __forceinline__ void combine(Frame& F, int c, bool dry) {
    const LAS int* tab = (const LAS int*)(F.lds + TAB_OFF);
    const int lane = F.lane, gw = F.vcu * NWAVES + F.wave, NGW = F.G * NWAVES;
    const unsigned char* ys = wsp<unsigned char>(F, WS_YS); const unsigned* TOKSLOT = wsp<unsigned>(F, WS_TOKSLOT); const float* mod = wsp<float>(F, WS_MOD);
    for (int tl = gw; tl < CHTOK; tl += NGW) {
        const int t = c * CHTOK + tl, b = t >> 11;
        int yr[9];
#pragma unroll
        for (int k = 0; k < 8; ++k) { const unsigned s = TOKSLOT[(size_t)t * 8 + k]; yr[k] = tab[T_YBASE + 64 * c + (int)(s >> 16)] + (int)(s & 0xffffu); }
        yr[8] = YS_SHARED_ROW0 + tl;
        u32x4 w[9];
#pragma unroll
        for (int k = 0; k < 9; ++k) w[k] = __builtin_nontemporal_load((const u32x4*)(ys + (size_t)yr[k] * 1024 + 16 * lane));
        f32x4 s[4];
#pragma unroll
        for (int q = 0; q < 4; ++q) s[q] = (f32x4){0.f, 0.f, 0.f, 0.f};
#pragma unroll
        for (int k = 0; k < 9; ++k) {
#pragma unroll
            for (int q = 0; q < 4; ++q) { const auto lo = __builtin_amdgcn_cvt_pk_f32_fp8((int)w[k][q], false), hi = __builtin_amdgcn_cvt_pk_f32_fp8((int)w[k][q], true);
                s[q] += (f32x4){lo[0], lo[1], hi[0], hi[1]}; } }
#pragma unroll
        for (int q = 0; q < 4; ++q) { const int c4 = 16 * lane + 4 * q;
            const f32x4 x1 = __builtin_nontemporal_load((const f32x4*)(F.out + (size_t)t * DM + c4)), g2 = *(const f32x4*)(mod + (size_t)b * 6144 + 5120 + c4);
            float* dst = dry ? (float*)(F.ws + WS_B + 253 * MiB) + (((size_t)t * DM + c4) & ((1u << 21) - 1)) : F.out + (size_t)t * DM + c4;
            *(f32x4*)dst = x1 + g2 * (s[q] * (1.0f / YS_SCALE)); }
    }
}
}
#ifndef PHMASK
#define PHMASK 0xffff
#endif
#define PH(k) ((PHMASK >> (k)) & 1)
#ifndef REPMASK
#define REPMASK 0
#endif
#ifndef XBAR
#define XBAR 0
#endif
#ifndef BARMASK
#define BARMASK 0
#endif
#define REP(k) for (int rep_ = 0; rep_ < 1 + ((REPMASK >> (k)) & 1); ++rep_)
#define MIDBAR(k) do { if (((BARMASK >> (k)) & 1) && rep_ == 0) GRID_BAR(); } while (0)

__global__ void __launch_bounds__(NTHR, 2) fwd_megakernel(Args args) {
    const Args& A = args;
    extern __shared__ __attribute__((aligned(16))) unsigned char lds_raw[];
    Frame F;
    F.lds = (LAS unsigned char*)lds_raw;
    F.MISC = (volatile LAS unsigned*)(F.lds + MISC_OFF);
    F.tid = threadIdx.x; F.lane = F.tid & 63; F.wave = __builtin_amdgcn_readfirstlane(F.tid >> 6);
    F.G = gridDim.x; { const int bx = blockIdx.x; F.vcu = (F.G % 8 == 0) ? (bx % 8) * (F.G / 8) + bx / 8 : bx; }
    F.ws = args.ws; F.ctl = (gu32*)(args.ws + WS_CTL); F.out = args.out;
    for (int u = F.tid; u < (LDS_BYTES - LDSCTL_OFF) / 4; u += NTHR) ((LAS unsigned*)(F.lds + LDSCTL_OFF))[u] = 0u;
    __syncthreads();
    XcdBarrier bar = xcd_barrier_post((unsigned*)(F.ctl + CW_BAR), F.MISC + 8);
#ifdef TSA
#define STAMP(k) do { if (blockIdx.x == TSWG && threadIdx.x == 0) { const unsigned long long t_ = __builtin_amdgcn_s_memrealtime(); ((LAS unsigned*)(F.lds + TAB_OFF + 2048))[2 * (k)] = (unsigned)t_; ((LAS unsigned*)(F.lds + TAB_OFF + 2048))[2 * (k) + 1] = (unsigned)(t_ >> 32); } } while (0)
#else
#define STAMP(k) do {} while (0)
#endif
#ifndef TSWG
#define TSWG 0
#endif
    int nbar_ = 0;
#define GRID_BAR() do { xcd_barrier(bar); F.refresh(); ++nbar_; STAMP(nbar_); } while (0)
    const int bx = (int)blockIdx.x;
    STAMP(0);

    REP(0) if (PH(0)) p0_prologue(F, args);
    for (int xb = 0; xb < XBAR; ++xb) GRID_BAR();
    GRID_BAR();
    REP(1) if (PH(1)) { p0_copies(F, args); s1_modnorm(F, args); }
#ifdef WSPROBE
    for (int q = 0; q < args.nrep; ++q) s1_modnorm(F, args);
#endif
    GRID_BAR();
    REP(2) if (PH(2)) {
        pg8::Gemm g{wsp<bf16_t>(F, WS_H), DM, DM}; pg8::DenseSched S; S.init(NT, INPAD, DM, wsp<bf16_t>(F, WS_WIN), F.G, bx);
        epi::EpiInProj E{wsp<bf16_t>(F, WS_NAQ), wsp<bf16_t>(F, WS_NAK), wsp<bf16_t>(F, WS_NAV), wsp<bf16_t>(F, WS_QLAT), wsp<bf16_t>(F, WS_KVLAT), wsp<bf16_t>(F, WS_SGNA), wsp<bf16_t>(F, WS_SGMLA),
                          wsp<float>(F, WS_KROT), wsp<float>(F, WS_QSQ), wsp<float>(F, WS_KVSQ), INF(I_g_na_q), INF(I_g_na_k), wsp<float>(F, WS_RCOS), wsp<float>(F, WS_RSIN)};
        pg8::gemm_phase<epi::EpiInProj, pg8::DenseSched, false>(F.lds, g, S, E);
        MIDBAR(2);
    }
    GRID_BAR();
    REP(3) if (PH(3)) {
        pg8::Gemm g{wsp<bf16_t>(F, WS_QLAT), QRANK, QRANK}; pg8::DenseSched S; S.init(NT, MH * QKD, QRANK, wsp<bf16_t>(F, WS_WUQ), F.G, bx);
        epi::EpiUpQ E{wsp<bf16_t>(F, WS_QM), wsp<float>(F, WS_QSS), wsp<float>(F, WS_QSQ), INF(I_g_mla_q), wsp<float>(F, WS_RCOS), wsp<float>(F, WS_RSIN)};
        pg8::gemm_phase<epi::EpiUpQ, pg8::DenseSched, false>(F.lds, g, S, E);
    }
    REP(3) if (PH(4)) {
        pg8::Gemm g{wsp<bf16_t>(F, WS_KVLAT), KVRANK, KVRANK}; pg8::DenseSched S; S.init(NT, MH * 128, KVRANK, wsp<bf16_t>(F, WS_WUKV), F.G, bx);
        epi::EpiUpKV E{wsp<bf16_t>(F, WS_KM), wsp<bf16_t>(F, WS_VM), wsp<float>(F, WS_KVSQ), wsp<float>(F, WS_KROT), INF(I_g_mla_k)};
        pg8::gemm_phase<epi::EpiUpKV, pg8::DenseSched, false>(F.lds, g, S, E);
    }
    GRID_BAR();
    if (PH(5)) s4_attention(F, args, 1 + ((REPMASK >> 4) & 1), 1 + ((REPMASK >> 5) & 1));
    GRID_BAR();
    REP(6) if (PH(6)) {
        pg8::Gemm g{wsp<bf16_t>(F, WS_YNA), DM, DM}; pg8::DenseSched S; S.init(NT, 2048, DM, wsp<bf16_t>(F, WS_WPCAT), F.G, bx);
        epi::EpiMergeCat E{wsp<bf16_t>(F, WS_SGNA), wsp<bf16_t>(F, WS_SGMLA), wsp<bf16_t>(F, WS_MERGED)};
        pg8::gemm_phase<epi::EpiMergeCat, pg8::DenseSched, false, false, true>(F.lds, g, S, E);
    }
    GRID_BAR();
    REP(8) if (PH(8)) {
        pg8::Gemm g{wsp<bf16_t>(F, WS_MERGED), DM, DM}; pg8::DenseSched S; S.init(NT, DM, DM, wsp<bf16_t>(F, WS_WOUT), F.G, bx);
        epi::EpiOut E{INF(I_x), F.out, wsp<float>(F, WS_MOD)};
        pg8::gemm_phase<epi::EpiOut, pg8::DenseSched, false>(F.lds, g, S, E);
    }
    GRID_BAR();
    if (PH(9)) moe::s7_router(F, args, 1 + ((REPMASK >> 9) & 1), 1 + ((REPMASK >> 13) & 1));
    GRID_BAR();
    moe::build_tables(F);
    REP(10) if (PH(10)) {
        pg8::Gemm g{wsp<bf16_t>(F, WS_H2), DM / 2, DM / 2}; moe::GateUpSched S; S.init(F);
        epi::EpiGateUp E{wsp<unsigned char>(F, WS_ACT)};
        pg8::gemm_phase<epi::EpiGateUp, moe::GateUpSched, true, true>(F.lds, g, S, E);
        MIDBAR(10);
    }
    GRID_BAR();
#pragma unroll 1
    for (int c = 0; c < NCHUNK; ++c) {
        for (int rep_ = 0; rep_ < 1 + (((REPMASK >> 11) | (REPMASK >> 14)) & 1); ++rep_) if (PH(11)) {
            pg8::Gemm g{wsp<bf16_t>(F, WS_ACT), EFF / 2, EFF / 2}; moe::DownSched S; S.init(F, c);
            epi::EpiDown E{wsp<unsigned char>(F, WS_YS), ((REPMASK >> 14) & 1) && rep_ == 0};
            pg8::gemm_phase<epi::EpiDown, moe::DownSched, true, true>(F.lds, g, S, E);
            MIDBAR(11);
        }
        GRID_BAR();
        if ((REPMASK >> 12) & 1) moe::combine(F, c, true);
        if (PH(12)) moe::combine(F, c, false);
        if (c + 1 < NCHUNK) GRID_BAR();
    }
#ifdef TSA
    __syncthreads(); STAMP(11);
    if (blockIdx.x == TSWG && threadIdx.x == 0) { LAS unsigned* tsb = (LAS unsigned*)(F.lds + TAB_OFF + 2048);
        const unsigned long long ta = ((unsigned long long)tsb[2 * TSA + 1] << 32) | tsb[2 * TSA], tb = ((unsigned long long)tsb[2 * TSB + 1] << 32) | tsb[2 * TSB];
#ifdef TSD
        const unsigned long long dl = (((unsigned long long)tsb[2 * TSD + 1] << 32) | tsb[2 * TSD]) * TSMULT,
#else
        const unsigned long long dl = (tb - ta) * TSMULT,
#endif
        t0 = __builtin_amdgcn_s_memrealtime();
        while (__builtin_amdgcn_s_memrealtime() - t0 < dl) __builtin_amdgcn_s_sleep(8); }
#endif
}

extern "C" void kernel_launch(void* const* d_in, const int* in_sizes, int n_in, void* d_out, int out_size, void* d_ws, size_t ws_size, hipStream_t stream) {
    static int grid = 0;
    if (grid == 0) {
        if (n_in != 28 || out_size != NT * DM || ws_size < WS_END) { fprintf(stderr, "kernel_launch: unexpected shapes: n_in %d out %d ws %zu (need %zu)\n", n_in, out_size, ws_size, (size_t)WS_END); grid = -1; return; }
        int dev = 0, cus = 0, per_cu = 0;
        if (hipGetDevice(&dev) != hipSuccess || hipDeviceGetAttribute(&cus, hipDeviceAttributeMultiprocessorCount, dev) != hipSuccess) { grid = -1; return; }
        if (hipFuncSetAttribute((const void*)fwd_megakernel, hipFuncAttributeMaxDynamicSharedMemorySize, LDS_BYTES) != hipSuccess) { fprintf(stderr, "kernel_launch: hipFuncSetAttribute failed\n"); grid = -1; return; }
        if (hipOccupancyMaxActiveBlocksPerMultiprocessor(&per_cu, (const void*)fwd_megakernel, NTHR, LDS_BYTES) != hipSuccess || per_cu < 1) { fprintf(stderr, "kernel_launch: occupancy query says %d blocks/CU\n", per_cu); (void)hipGetLastError(); }
        grid = cus;
        if (grid != 256) fprintf(stderr, "kernel_launch: %d CUs (expected 256)\n", grid);
    }
    if (grid < 0) return;
    if (hipMemsetAsync((char*)d_ws + WS_CTL, 0, CTL_ZERO_BYTES, stream) != hipSuccess) { fprintf(stderr, "kernel_launch: memset failed\n"); return; }
    Args a{};
    for (int i = 0; i < 28; ++i) a.in[i] = d_in[i];
    a.out = (float*)d_out; a.ws = (unsigned char*)d_ws;
#ifdef WSPROBE
    a.nrep = (int)(ws_size >> 26); a.pad = 0;
#endif
    void* kargs[] = {&a};
    const hipError_t le = hipLaunchCooperativeKernel((const void*)fwd_megakernel, dim3(grid), dim3(NTHR), kargs, LDS_BYTES, stream);
    if (le != hipSuccess) fprintf(stderr, "kernel_launch: cooperative launch failed: %s (grid %d)\n", hipGetErrorName(le), grid);
}
```

```cpp
#include <hip/hip_runtime.h>
#include <cstdio>
#include <cstdint>
#include <cmath>

#define GAS __attribute__((address_space(1)))
#define LAS __attribute__((address_space(3)))
typedef unsigned short bf16_t;
typedef short bf16x8 __attribute__((ext_vector_type(8)));
typedef short s16x4 __attribute__((ext_vector_type(4)));
typedef float f32x4 __attribute__((ext_vector_type(4)));
typedef float f32x2 __attribute__((ext_vector_type(2)));
typedef float f32x16 __attribute__((ext_vector_type(16)));
typedef unsigned u32x4 __attribute__((ext_vector_type(4)));
typedef int i32x4 __attribute__((ext_vector_type(4)));
typedef unsigned u32x2 __attribute__((ext_vector_type(2)));
typedef GAS unsigned gu32;

constexpr int DM = 1024, NB = 8, SEQ = 2048, NT = NB * SEQ;
constexpr int NAH = 8, NAD = 64, GRIDW = 64, GRIDR = SEQ / GRIDW;
constexpr int MH = 8, QRANK = 256, KVRANK = 128, NOPE = 64, ROPE = 32, VD = 64, QKD = 96;
constexpr int NEXP = 64, TOPK = 8, NGRP = 8, TOPKG = 4, EFF = 256;
constexpr float EPS = 1e-6f;
constexpr int INCOLS = 4000, INPAD = 4096;
constexpr int NCHUNK = 1, CHTOK = NT / NCHUNK;
constexpr float YS_SCALE = 16.0f;
constexpr float WGU_SCALE = 64.0f, ACT_SCALE = 16.0f, WD_SCALE = 32.0f;
constexpr int NWAVES = 8, NTHR = 512;

constexpr size_t MiB = 1u << 20;
constexpr size_t WS_CTL = 0, CTL_ZERO_BYTES = 1 * MiB;
constexpr size_t WS_MOD   = 1 * MiB;
constexpr size_t WS_RCOS  = WS_MOD + 256 * 1024;
constexpr size_t WS_RSIN  = WS_RCOS + 1 * MiB;
constexpr size_t WS_RFRAG = WS_RSIN + 1 * MiB;
constexpr size_t WS_QSQ   = WS_RFRAG + 256 * 1024;
constexpr size_t WS_KVSQ  = WS_QSQ + 256 * 1024;
constexpr size_t WS_QSS   = WS_KVSQ + 256 * 1024;
constexpr size_t WS_TOKSLOT = WS_QSS + 1 * MiB;
constexpr size_t WS_LIST  = 6 * MiB;
constexpr size_t WS_WLIST = 10 * MiB;
constexpr size_t WS_WIN   = 14 * MiB;
constexpr size_t WS_WUQ   = 22 * MiB;
constexpr size_t WS_WUKV  = WS_WUQ + 512 * 1024;
constexpr size_t WS_WPNA  = 23 * MiB;
constexpr size_t WS_WPMLA = 24 * MiB;
constexpr size_t WS_WOUT  = 25 * MiB;
constexpr size_t WS_KROT  = 27 * MiB;
constexpr size_t WS_B     = 30 * MiB;
constexpr size_t WS_H     = WS_B + 0 * MiB;
constexpr size_t WS_QM    = WS_B + 0 * MiB;
constexpr size_t WS_NAQ   = WS_B + 32 * MiB;
constexpr size_t WS_NAK   = WS_B + 48 * MiB;
constexpr size_t WS_NAV   = WS_B + 64 * MiB;
constexpr size_t WS_QLAT  = WS_B + 80 * MiB;
constexpr size_t WS_KVLAT = WS_B + 88 * MiB;
constexpr size_t WS_SGNA  = WS_B + 96 * MiB;
constexpr size_t WS_SGMLA = WS_B + 128 * MiB;
constexpr size_t WS_KM    = WS_B + 160 * MiB;
constexpr size_t WS_VM    = WS_B + 185 * MiB;
constexpr size_t WS_YNA   = WS_B + 201 * MiB;
constexpr size_t WS_WPCAT = WS_B + 234 * MiB;
constexpr size_t WS_TMP   = WS_B + 32 * MiB;
constexpr size_t WS_MERGED= WS_B + 64 * MiB;
constexpr size_t WS_WD    = WS_B + 0 * MiB;
constexpr size_t WS_ACT   = WS_B + 33 * MiB;
constexpr size_t WS_WGU   = WS_B + 109 * MiB;
constexpr size_t WS_H2    = WS_B + 174 * MiB;
constexpr size_t WS_YS    = WS_B + 109 * MiB;
constexpr size_t WS_END   = WS_B + 262 * MiB;
constexpr int ACT_SHARED_ROW0 = NT * TOPK;
constexpr int YS_SHARED_ROW0 = CHTOK * TOPK;
constexpr int CW_BAR = 4096;
constexpr int CW_CNT = 16384;

constexpr int RING_BYTES = 131072;
constexpr int LDSCTL_OFF = RING_BYTES, MISC_OFF = LDSCTL_OFF + 320;
constexpr int TAB_OFF = RING_BYTES + 1024;
constexpr int LDS_BYTES = 147456;

#define LDS_WAIT() asm volatile("s_waitcnt lgkmcnt(0)" ::: "memory")
#define VM_WAIT() asm volatile("s_waitcnt vmcnt(0)" ::: "memory")
#define SBAR() __builtin_amdgcn_sched_barrier(0)
#define RLX_AGENT __ATOMIC_RELAXED, __HIP_MEMORY_SCOPE_AGENT

__device__ __forceinline__ unsigned f2bf(float f) { unsigned u = __builtin_bit_cast(unsigned, f); return (u + 0x7fffu + ((u >> 16) & 1u)) >> 16; }
__device__ __forceinline__ unsigned pk2(float lo, float hi) { return f2bf(lo) | (f2bf(hi) << 16); }
__device__ __forceinline__ unsigned cvt_pk_bf16(float lo, float hi) { unsigned r; asm volatile("v_cvt_pk_bf16_f32 %0, %1, %2" : "=v"(r) : "v"(lo), "v"(hi)); return r; }
__device__ __forceinline__ float bf2f(unsigned short b) { return __builtin_bit_cast(float, (unsigned)b << 16); }
__device__ __forceinline__ float bflo(unsigned w) { return __builtin_bit_cast(float, w << 16); }
__device__ __forceinline__ float bfhi(unsigned w) { return __builtin_bit_cast(float, w & 0xffff0000u); }
__device__ __forceinline__ int lane_fresh() { int t = threadIdx.x; asm volatile("" : "+v"(t)); return t & 63; }
__device__ __forceinline__ float shx(float v, int m, int lane) { return __builtin_bit_cast(float, __builtin_amdgcn_ds_bpermute((lane ^ m) << 2, __builtin_bit_cast(int, v))); }
__device__ __forceinline__ int shup_i(int v, int d, int lane) { return __builtin_amdgcn_ds_bpermute(((lane - d) & 63) << 2, v); }
__device__ __forceinline__ float wave_sum(float v) {
    const int l = lane_fresh();
#pragma unroll
    for (int o = 1; o < 64; o <<= 1) v += shx(v, o, l);
    return v;
}
__device__ __forceinline__ float sigmoidf_fast(float v) { return __builtin_amdgcn_rcpf(1.0f + __expf(-v)); }
__device__ __forceinline__ float siluf_fast(float v) { return v * sigmoidf_fast(v); }
__device__ __forceinline__ float sq4(f32x4 a) { return (a[0] * a[0] + a[1] * a[1]) + (a[2] * a[2] + a[3] * a[3]); }

#ifdef WSPROBE
struct Args { const void* in[28]; float* out; unsigned char* ws; int nrep, pad; };
#else
struct Args { const void* in[28]; float* out; unsigned char* ws; };
#endif
enum { I_x = 0, I_c = 1, I_positions = 2, I_w_ada = 3, I_b_ada = 4, I_g_norm1 = 5, I_w_in = 6, I_g_na_q = 7, I_g_na_k = 8, I_na_rpb = 9, I_g_q_lat = 10, I_w_uq = 11, I_g_kv_lat = 12, I_w_ukv = 13, I_g_mla_q = 14, I_g_mla_k = 15, I_w_proj_na = 16, I_w_proj_mla = 17, I_w_out = 18, I_g_norm2 = 19, I_w_router = 20, I_e_bias = 21, I_w_eg = 22, I_w_eu = 23, I_w_ed = 24, I_w_sg = 25, I_w_su = 26, I_w_sd = 27 };
#define INF(k) ((const float*)A.in[k])

#ifndef TSWG
#define TSWG 0
#endif

__device__ __forceinline__ unsigned cvt4_fp8(f32x4 a, float sc) {
    int w = 0;
    w = __builtin_amdgcn_cvt_pk_fp8_f32(__builtin_amdgcn_fmed3f(a[0] * sc, -448.f, 448.f), __builtin_amdgcn_fmed3f(a[1] * sc, -448.f, 448.f), w, false);
    w = __builtin_amdgcn_cvt_pk_fp8_f32(__builtin_amdgcn_fmed3f(a[2] * sc, -448.f, 448.f), __builtin_amdgcn_fmed3f(a[3] * sc, -448.f, 448.f), w, true);
    return (unsigned)w;
}
namespace pg8 {
constexpr int BM = 256, BK = 64, HALF = 128, HTB = HALF * BK * 2, STAGE_BYTES = 8 * HTB, NXCD = 8, WGM = 8;
__host__ __device__ __forceinline__ int lds_byte(int r, int c) { const int st = (r >> 4) * 2 + (c >> 5), rr = r & 15, cc = c & 31, ob = rr * 64 + cc * 2; return st * 1024 + (ob ^ (((ob >> 9) & 1) << 5)); }
__host__ __device__ __forceinline__ void stage_rc(int b, int& R, int& C) { const int st = b / 1024, sb = b % 1024, swz = sb ^ (((sb >> 9) & 1) << 5); R = (st >> 1) * 16 + swz / 64; C = (st & 1) * 32 + (swz % 64) / 2; }
__host__ __device__ __forceinline__ int perm32(int rho) { const int n = rho >> 4, i = rho & 15; return 8 * (i >> 2) + 4 * n + (i & 3); }

struct Unit {
    const char* B;
    int m0;
    int pn;
    int e;
    int nrows;
    int orow0;
    const int* l0; const int* l1; int n0, ntot;
};
struct Gemm { const bf16_t* A; int lda; int K; };

template <class Epi, class Sched, bool GATHER, bool FP8 = false, bool HALFK = false>
__device__ __forceinline__ void gemm_phase(LAS unsigned char* lds, const Gemm g, Sched& S, const Epi& E) {
    int tid_ = threadIdx.x; asm volatile("" : "+v"(tid_));
    const int tid = tid_, wid = __builtin_amdgcn_readfirstlane(tid >> 6), lane = tid & 63, wr = wid >> 2, wc = wid & 3, fr = lane & 15, fq = lane >> 4;
    const int K = g.K; int nt_ = K / BK; asm volatile("" : "+s"(nt_)); const int nt = nt_;
    unsigned voffB[2], voffA[2];
#pragma unroll
    for (int i = 0; i < 2; ++i) { int R, C; stage_rc(tid * 16 + i * 8192, R, C); const int Rb = Epi::PERM ? ((R & ~31) + perm32(R & 31)) : R;
        voffA[i] = (unsigned)(R * g.lda + C) * 2u; voffB[i] = (unsigned)(Rb * K + C) * 2u; }
    const size_t hstepA = (size_t)HALF * g.lda * 2;
    const size_t kstep = (size_t)(BK * 2);
    const size_t hstepB = (size_t)HALF * K * 2;
    const unsigned ldsw = (unsigned)wid * 1024u;
    const int aoff = lds_byte(wr * 64 + fr, fq * 8), boff = lds_byte(wc * 32 + fr, fq * 8);
    const char* Abase = (const char*)g.A;
#define PG8_SA(b, h) (((b) * 2 + (h)) * HTB)
#define PG8_SB(b, h) ((4 + (b) * 2 + (h)) * HTB)
#define PG8_STAGE(bufoff, gbase, voff) do { _Pragma("unroll") for (int _i = 0; _i < 2; ++_i) \
        __builtin_amdgcn_global_load_lds((const unsigned*)((const char*)(gbase) + (voff)[_i]), (LAS unsigned*)(lds + (bufoff) + ldsw + _i * 8192), 16, 0, 0); } while (0)
#define PG8_LDA(dst, b, h) do { _Pragma("unroll") for (int m = 0; m < 4; ++m) _Pragma("unroll") for (int k = 0; k < 2; ++k) dst[m][k] = *(const LAS bf16x8*)(lds + PG8_SA(b, h) + aoff + m * 2048 + k * 1024); } while (0)
#define PG8_LDB(dst, b, h) do { _Pragma("unroll") for (int n = 0; n < 2; ++n) _Pragma("unroll") for (int k = 0; k < 2; ++k) dst[n][k] = *(const LAS bf16x8*)(lds + PG8_SB(b, h) + boff + n * 2048 + k * 1024); } while (0)
#define PG8_CAT(x0, x1) __builtin_shufflevector(__builtin_bit_cast(i32x4, x0), __builtin_bit_cast(i32x4, x1), 0, 1, 2, 3, 4, 5, 6, 7)
#define PG8_MMA(ai, bj, At, Bt) do { __builtin_amdgcn_s_setprio(1); if constexpr (FP8) { _Pragma("unroll") for (int m = 0; m < 4; ++m) _Pragma("unroll") for (int n = 0; n < 2; ++n) \
        acc[ai][bj][m][n] = __builtin_amdgcn_mfma_scale_f32_16x16x128_f8f6f4(PG8_CAT(Bt[n][0], Bt[n][1]), PG8_CAT(At[m][0], At[m][1]), acc[ai][bj][m][n], 0, 0, 0, 0x7f7f7f7f, 0, 0x7f7f7f7f); } \
        else { _Pragma("unroll") for (int m = 0; m < 4; ++m) _Pragma("unroll") for (int n = 0; n < 2; ++n) _Pragma("unroll") for (int k = 0; k < 2; ++k) \
        acc[ai][bj][m][n] = __builtin_amdgcn_mfma_f32_16x16x32_bf16(Bt[n][k], At[m][k], acc[ai][bj][m][n], 0, 0, 0); } __builtin_amdgcn_s_setprio(0); } while (0)
#define PG8_MM2(ai) do { if constexpr (HALFK) { if (t < (nt >> 1)) { PG8_MMA(ai, 0, At, B0); } else { PG8_MMA(ai, 1, At, B1); } } else { PG8_MMA(ai, 0, At, B0); PG8_MMA(ai, 1, At, B1); } } while (0)
#define PG8_WAIT_V(n) asm volatile("s_waitcnt vmcnt(" #n ")" ::: "memory")
#define PG8_WAIT_L(n) asm volatile("s_waitcnt lgkmcnt(" #n ")" ::: "memory")
#define PG8_BAR __builtin_amdgcn_s_barrier()
#define PG8_SCHED __builtin_amdgcn_sched_barrier(0)
#define PG8_VOFF(dst, u) do { int _t = threadIdx.x; asm volatile("" : "+v"(_t)); _Pragma("unroll") for (int _h = 0; _h < 2; ++_h) _Pragma("unroll") for (int _i = 0; _i < 2; ++_i) { \
        int _R, _C; stage_rc(_t * 16 + _i * 8192, _R, _C); int _r = (u).m0 + _h * HALF + _R; \
        if ((u).l0) { _r = _r < (u).ntot ? _r : (u).ntot - 1; _r = _r < (u).n0 ? (u).l0[_r] : (u).l1[_r - (u).n0]; } \
        dst[_h][_i] = (unsigned)(_r * g.lda + _C) * 2u; } } while (0)
#define PG8_VROW(dst, u) do { int _t = threadIdx.x; asm volatile("" : "+v"(_t)); _Pragma("unroll") for (int _h = 0; _h < 2; ++_h) _Pragma("unroll") for (int _i = 0; _i < 2; ++_i) { \
        int _R, _C; stage_rc(_t * 16 + _i * 8192, _R, _C); int _r = (u).m0 + _h * HALF + _R; \
        if ((u).l0) { _r = _r < (u).ntot ? _r : (u).ntot - 1; _r = _r < (u).n0 ? (u).l0[_r] : (u).l1[_r - (u).n0]; } \
        dst[_h][_i] = _r; } } while (0)
#define PG8_STA(bufoff, sel_next, h, kt) do { if constexpr (GATHER) { PG8_STAGE(bufoff, Abase + (size_t)(kt) * kstep, cvo[h]); } \
        else { PG8_STAGE(bufoff, ((sel_next) ? nA : cA) + (h) * hstepA + (size_t)(kt) * kstep, voffA); } } while (0)
    Unit cur, nxt; int ui = 0;
    if (!S.next(0, cur)) return;
    E.prefetch(cur, 0, tid, lds);
    f32x4 acc[2][2][4][2];
#pragma unroll
    for (int a = 0; a < 2; ++a)
#pragma unroll
        for (int b = 0; b < 2; ++b)
#pragma unroll
            for (int m = 0; m < 4; ++m)
#pragma unroll
                for (int n = 0; n < 2; ++n) acc[a][b][m][n] = (f32x4){0.f, 0.f, 0.f, 0.f};
    bf16x8 At[4][2], B0[2][2], B1[2][2];
    unsigned cvo[2][2]; int nvr[2][2];
    const char* cA = Abase; const char* nA = Abase;
    if constexpr (GATHER) { PG8_VOFF(cvo, cur); } else { cA = Abase + (size_t)cur.m0 * g.lda * 2; }
    const char* cB = cur.B;
    PG8_STAGE(PG8_SB(0, 0), cB, voffB); PG8_STAGE(PG8_SB(0, 1), cB + hstepB, voffB); PG8_STA(PG8_SA(0, 0), false, 0, 0); PG8_STA(PG8_SA(0, 1), false, 1, 0);
    if (wr == 1) PG8_BAR;
    PG8_WAIT_V(2); PG8_BAR;
    PG8_STAGE(PG8_SB(1, 0), cB + kstep, voffB); PG8_STA(PG8_SA(1, 0), false, 0, 1); PG8_STAGE(PG8_SB(1, 1), cB + hstepB + kstep, voffB);
    PG8_WAIT_V(6); PG8_BAR;
    for (;;) {
        const bool has_next = S.next(ui + 1, nxt);
        if constexpr (GATHER) {
            if (has_next) { PG8_VROW(nvr, nxt); }
        } else { nA = has_next ? Abase + (size_t)nxt.m0 * g.lda * 2 : cA; }
        const char* nB = has_next ? nxt.B : cB;
#pragma unroll 1
        for (int t = 0; t < nt; t += 2) {
            const bool last = (t == nt - 2);
            const int kt2 = last ? 0 : t + 2;
            const char* b2 = last ? nB : cB + (size_t)(t + 2) * kstep; const char* b3 = b2 + kstep;
            PG8_LDB(B0, 0, 0); PG8_LDB(B1, 0, 1); PG8_SCHED; PG8_LDA(At, 0, 0); PG8_STA(PG8_SA(1, 1), false, 1, t + 1);
            if constexpr (GATHER) { if (last && has_next) { int _t = threadIdx.x; asm volatile("" : "+v"(_t));
#pragma unroll
                for (int h = 0; h < 2; ++h)
#pragma unroll
                    for (int i = 0; i < 2; ++i) { int _R, _C; stage_rc(_t * 16 + i * 8192, _R, _C); cvo[h][i] = (unsigned)(nvr[h][i] * g.lda + _C) * 2u; } } }
            PG8_WAIT_V(8); PG8_WAIT_L(0); PG8_BAR; PG8_MM2(0); PG8_BAR; PG8_SCHED;
            PG8_LDA(At, 0, 1); PG8_STAGE(PG8_SB(0, 0), b2, voffB); PG8_STAGE(PG8_SB(0, 1), b2 + hstepB, voffB); PG8_STA(PG8_SA(0, 0), last, 0, kt2);
            PG8_WAIT_V(8); PG8_WAIT_L(0); PG8_BAR; PG8_MM2(1); PG8_BAR; PG8_SCHED;
            PG8_LDB(B0, 1, 0); PG8_LDB(B1, 1, 1); PG8_SCHED; PG8_LDA(At, 1, 0); PG8_STA(PG8_SA(0, 1), last, 1, kt2);
            PG8_WAIT_V(8); PG8_WAIT_L(0); PG8_BAR; PG8_MM2(0); PG8_BAR; PG8_SCHED;
            PG8_LDA(At, 1, 1); PG8_STAGE(PG8_SB(1, 0), b3, voffB); PG8_STAGE(PG8_SB(1, 1), b3 + hstepB, voffB); PG8_STA(PG8_SA(1, 0), last, 0, kt2 + 1);
            PG8_WAIT_V(8); PG8_WAIT_L(0); PG8_BAR; PG8_MM2(1); PG8_BAR; PG8_SCHED;
        }
        S.publish(wid);
        if (wr == 0) PG8_BAR;
        { int t2 = threadIdx.x; asm volatile("" : "+v"(t2)); const int l2 = t2 & 63; E(acc, cur, wr, wc, l2 & 15, l2 >> 4, ui, lds); }
        if (!has_next) break;
#pragma unroll
        for (int a = 0; a < 2; ++a)
#pragma unroll
            for (int b = 0; b < 2; ++b)
#pragma unroll
                for (int m = 0; m < 4; ++m)
#pragma unroll
                    for (int n = 0; n < 2; ++n) acc[a][b][m][n] = (f32x4){0.f, 0.f, 0.f, 0.f};
        cur = nxt; cB = nB; cA = nA; ++ui;
        E.prefetch(cur, ui, tid, lds);

        if (wr == 1) PG8_BAR;
    }
    PG8_WAIT_V(0);
    PG8_BAR;
#undef PG8_SA
#undef PG8_SB
#undef PG8_STAGE
#undef PG8_LDA
#undef PG8_LDB
#undef PG8_MMA
#undef PG8_MM2
#undef PG8_CAT
#undef PG8_WAIT_V
#undef PG8_WAIT_L
#undef PG8_BAR
#undef PG8_SCHED
#undef PG8_VOFF
#undef PG8_VROW
#undef PG8_STA
}

struct DenseSched {
    int nM, nN, nwg, G, c; const bf16_t* Bt; int K;
    __device__ void init(int M, int N, int K_, const bf16_t* Bt_, int G_, int c_) { nM = M / BM; nN = N / BM; nwg = nM * nN; G = G_; c = c_; Bt = Bt_; K = K_; }
    __device__ __forceinline__ void publish(int) {}
    __device__ bool next(int i, Unit& u) const {
        const long L = (long)i * G + c; if (L >= nwg) return false;
        int wgid = (int)L; { const int q = nwg / NXCD, r = nwg % NXCD, xcd = wgid % NXCD, off = wgid / NXCD; wgid = (xcd < r ? xcd * (q + 1) : r * (q + 1) + (xcd - r) * q) + off; }
        const int nig = WGM * nN, gid = wgid / nig, fm = gid * WGM, gsz = (nM - fm) < WGM ? (nM - fm) : WGM;
        const int pm = fm + ((wgid % nig) % gsz), pn = (wgid % nig) / gsz;
        u.B = (const char*)Bt + (size_t)pn * BM * K * 2; u.m0 = pm * BM; u.pn = pn; u.e = pm; u.nrows = BM; u.orow0 = pm * BM; u.l0 = nullptr; u.l1 = nullptr; u.n0 = 0; u.ntot = 0;
        return true;
    }
};
}
#define XB_TMO      128
#define XB_XCNT(j)  (256  + 64 * (j))
#define XB_XSUB(j)  (1280 + 64 * (j))
#define XB_XGEN(j)  (2304 + 64 * (j))
#define XB_TOP      3328
#define XB_TOPGEN   3392
#define XCD_BAR_WORDS 3456
#define XB_SPIN_CAP (1u << 18)

__device__ __forceinline__ unsigned xb_ld(unsigned* p)              { return __hip_atomic_load(p, __ATOMIC_RELAXED, __HIP_MEMORY_SCOPE_AGENT); }
__device__ __forceinline__ unsigned xb_add(unsigned* p, unsigned v) { return __hip_atomic_fetch_add(p, v, __ATOMIC_RELAXED, __HIP_MEMORY_SCOPE_AGENT); }
__device__ __forceinline__ unsigned xb_xcc_id() { return (unsigned)__builtin_amdgcn_s_getreg((3 << 11) | 20) & 0xFu; }
#define XB_SPIN(cond, bar) do { unsigned _sp = 0; while (cond) { __builtin_amdgcn_s_sleep(1); \
    if ((++_sp & 255u) == 0u) { if (xb_ld(&(bar)[XB_TMO])) break; if (_sp > XB_SPIN_CAP) { atomicAdd(&(bar)[XB_TMO], 1u); break; } } } } while (0)

struct XcdBarrier { unsigned* bar; unsigned x; volatile LAS unsigned* st; };

__device__ __forceinline__ XcdBarrier xcd_barrier_post(unsigned* bar, volatile LAS unsigned* st) {
    XcdBarrier b; b.bar = bar; b.x = xb_xcc_id(); b.st = st;
    if (threadIdx.x == 0) (void)xb_add(&bar[XB_XCNT(b.x)], 1u);
    return b;
}
__device__ __forceinline__ void xcd_barrier_complete(unsigned* bar, unsigned x, unsigned& nloc, unsigned& nx) {
    const unsigned G = gridDim.x * gridDim.y * gridDim.z;
    unsigned sum, cnt, mine, sp = 0u;
    for (;;) {
        sum = 0u; cnt = 0u; mine = 0u;
#pragma unroll
        for (unsigned j = 0; j < 16; ++j) { const unsigned c = xb_ld(&bar[XB_XCNT(j)]); sum += c; cnt += (c > 0u) ? 1u : 0u; mine = (j == x) ? c : mine; }
        if (sum == G) break;
        __builtin_amdgcn_s_sleep(1);
        if ((++sp & 255u) == 0u) { if (xb_ld(&bar[XB_TMO])) break; if (sp > XB_SPIN_CAP) { atomicAdd(&bar[XB_TMO], 1u); break; } }
    }
    nloc = mine > 0u ? mine : 1u; nx = cnt > 0u ? cnt : 1u;
}
__device__ __forceinline__ void xcd_barrier(const XcdBarrier& b) {
    asm volatile("s_waitcnt vmcnt(0)" ::: "memory");
    __syncthreads();
    int tid_ = threadIdx.x; asm volatile("" : "+v"(tid_));
    if (tid_ == 0) {
        unsigned* bar = b.bar; asm volatile("" : "+s"(bar)); unsigned bx_ = b.x; asm volatile("" : "+s"(bx_));
        __builtin_amdgcn_s_waitcnt(0);
        unsigned nloc = b.st[0], nx = b.st[1];
        if (nloc == 0u) { xcd_barrier_complete(bar, bx_, nloc, nx); b.st[0] = nloc; b.st[1] = nx; }
        const unsigned old = xb_add(&bar[XB_XSUB(bx_)], 1u);
        const unsigned gen = old / nloc;
        if (old + 1u == (gen + 1u) * nloc) {
            __builtin_amdgcn_fence(__ATOMIC_RELEASE, "agent");
            asm volatile("s_waitcnt vmcnt(0)" ::: "memory");
            const unsigned og = xb_add(&bar[XB_TOP], 1u);
            const unsigned tg = og / nx;
            if (og + 1u == (tg + 1u) * nx) xb_add(&bar[XB_TOPGEN], 1u);
            else XB_SPIN(xb_ld(&bar[XB_TOPGEN]) == tg, bar);
            __builtin_amdgcn_fence(__ATOMIC_ACQUIRE, "agent");
            xb_add(&bar[XB_XGEN(bx_)], 1u);
            asm volatile("s_waitcnt vmcnt(0)" ::: "memory");
        } else {
            XB_SPIN(xb_ld(&bar[XB_XGEN(bx_)]) == gen, bar);
            __builtin_amdgcn_fence(__ATOMIC_ACQUIRE, "agent");
            asm volatile("s_waitcnt vmcnt(0)" ::: "memory");
        }
    }
    __syncthreads();
}
namespace epi {
using pg8::Unit;
__device__ __forceinline__ u32x4 pack8(f32x4 a, f32x4 b) { u32x4 w; w.x = cvt_pk_bf16(a[0], a[1]); w.y = cvt_pk_bf16(a[2], a[3]); w.z = cvt_pk_bf16(b[0], b[1]); w.w = cvt_pk_bf16(b[2], b[3]); return w; }

__device__ __forceinline__ float red_fq(float s) { const int l = lane_fresh(); s += shx(s, 16, l); s += shx(s, 32, l); return s; }
__device__ __forceinline__ void unpack8(u32x4 w, f32x4& a, f32x4& b) { a = (f32x4){bflo(w.x), bfhi(w.x), bflo(w.y), bfhi(w.y)}; b = (f32x4){bflo(w.z), bfhi(w.z), bflo(w.w), bfhi(w.w)}; }
__device__ __forceinline__ void rope32(f32x4 (&v)[2], const float* cs, const float* sn, int fq) {
#pragma unroll
    for (int n = 0; n < 2; ++n) {
        const f32x4 c4 = *(const f32x4*)(cs + 8 * (fq & 1) + 4 * n), s4 = *(const f32x4*)(sn + 8 * (fq & 1) + 4 * n);
        const int l_ = lane_fresh(); f32x4 p; p[0] = shx(v[n][0], 32, l_); p[1] = shx(v[n][1], 32, l_); p[2] = shx(v[n][2], 32, l_); p[3] = shx(v[n][3], 32, l_);
        v[n] = (fq < 2) ? (v[n] * c4 - p * s4) : (v[n] * c4 + p * s4);
    }
}

struct EpiInProj {
    static constexpr bool PERM = true;
    __device__ __forceinline__ void prefetch(const Unit&, int, int, LAS unsigned char*) const {}
    bf16_t *naq, *nak, *nav, *qlat, *kvlat, *sgna, *sgmla; float *krot, *qsq, *kvsq; const float *gq, *gk, *rcos, *rsin;
    __device__ __forceinline__ void operator()(const f32x4 (&acc)[2][2][4][2], const Unit& u, int wr, int wc, int fr, int fq, int ui, LAS unsigned char* lds) const {
        const int pn = u.pn, row0 = u.orow0 + wr * 64 + fr;
        if (pn < 4) {
            bf16_t* dst = pn < 2 ? naq : nak; const float* g = pn < 2 ? gq : gk; const int head = (pn & 1) * 4 + wc;
            f32x4 gv[2][2];
#pragma unroll
            for (int bj = 0; bj < 2; ++bj)
#pragma unroll
                for (int n = 0; n < 2; ++n) gv[bj][n] = *(const f32x4*)(g + 32 * bj + 8 * fq + 4 * n);
#pragma unroll
            for (int ai = 0; ai < 2; ++ai)
#pragma unroll
                for (int m = 0; m < 4; ++m) {
                    float ss = (sq4(acc[ai][0][m][0]) + sq4(acc[ai][0][m][1])) + (sq4(acc[ai][1][m][0]) + sq4(acc[ai][1][m][1]));
                    ss = red_fq(ss); const float rstd = rsqrtf(ss * (1.0f / 64.0f) + EPS);
                    bf16_t* rp = dst + (size_t)(row0 + ai * 128 + m * 16) * 512 + head * 64 + 8 * fq;
#pragma unroll
                    for (int bj = 0; bj < 2; ++bj) *(u32x4*)(rp + 32 * bj) = pack8(acc[ai][bj][m][0] * rstd * gv[bj][0], acc[ai][bj][m][1] * rstd * gv[bj][1]);
                }
        } else if (pn < 6) {
#pragma unroll
            for (int ai = 0; ai < 2; ++ai)
#pragma unroll
                for (int m = 0; m < 4; ++m) { bf16_t* rp = nav + (size_t)(row0 + ai * 128 + m * 16) * 512 + (pn - 4) * 256 + wc * 32 + 8 * fq;
#pragma unroll
                    for (int bj = 0; bj < 2; ++bj) *(u32x4*)(rp + 128 * bj) = pack8(acc[ai][bj][m][0], acc[ai][bj][m][1]); }
        } else if (pn == 6) {
#pragma unroll
            for (int ai = 0; ai < 2; ++ai)
#pragma unroll
                for (int m = 0; m < 4; ++m) { const int row = row0 + ai * 128 + m * 16; bf16_t* rp = qlat + (size_t)row * 256 + wc * 32 + 8 * fq;
                    float ss = (sq4(acc[ai][0][m][0]) + sq4(acc[ai][0][m][1])) + (sq4(acc[ai][1][m][0]) + sq4(acc[ai][1][m][1]));
                    ss = red_fq(ss); if (fq == 0) qsq[(size_t)row * 4 + wc] = ss;
#pragma unroll
                    for (int bj = 0; bj < 2; ++bj) *(u32x4*)(rp + 128 * bj) = pack8(acc[ai][bj][m][0], acc[ai][bj][m][1]); }
        } else if (pn == 7) {
#pragma unroll
            for (int ai = 0; ai < 2; ++ai)
#pragma unroll
                for (int m = 0; m < 4; ++m) { const int row = row0 + ai * 128 + m * 16;
                    float ss = sq4(acc[ai][0][m][0]) + sq4(acc[ai][0][m][1]);
                    ss = red_fq(ss); if (fq == 0) kvsq[(size_t)row * 4 + wc] = ss;
                    *(u32x4*)(kvlat + (size_t)row * 128 + wc * 32 + 8 * fq) = pack8(acc[ai][0][m][0], acc[ai][0][m][1]);
                    if (wc == 0) { f32x4 v[2] = {acc[ai][1][m][0], acc[ai][1][m][1]};
                        rope32(v, rcos + (size_t)row * 16, rsin + (size_t)row * 16, fq);
                        *(f32x4*)(krot + (size_t)row * 32 + 8 * fq) = v[0]; *(f32x4*)(krot + (size_t)row * 32 + 8 * fq + 4) = v[1]; } }
        } else {
            bf16_t* dst = pn < 12 ? sgna : sgmla; const int cb = ((pn - 8) & 3) * 256 + wc * 32 + 8 * fq;
#pragma unroll
            for (int ai = 0; ai < 2; ++ai)
#pragma unroll
                for (int m = 0; m < 4; ++m) { bf16_t* rp = dst + (size_t)(row0 + ai * 128 + m * 16) * 1024 + cb;
#pragma unroll
                    for (int bj = 0; bj < 2; ++bj) { f32x4 a = acc[ai][bj][m][0], b = acc[ai][bj][m][1];
#pragma unroll
                        for (int e = 0; e < 4; ++e) { a[e] = sigmoidf_fast(a[e]); b[e] = sigmoidf_fast(b[e]); }
                        *(u32x4*)(rp + 128 * bj) = pack8(a, b); } }
        }
    }
};

struct EpiUpQ {
    static constexpr bool PERM = true;
    __device__ __forceinline__ void prefetch(const Unit&, int, int, LAS unsigned char*) const {}
    bf16_t* qm; float* qss; const float* qsq; const float* g; const float *rcos, *rsin;
    __device__ __forceinline__ void operator()(const f32x4 (&acc)[2][2][4][2], const Unit& u, int wr, int wc, int fr, int fq, int ui, LAS unsigned char* lds) const {
        const int pn = u.pn, row0 = u.orow0 + wr * 64 + fr;
#pragma unroll
        for (int ai = 0; ai < 2; ++ai)
#pragma unroll
            for (int m = 0; m < 4; ++m) {
                const int row = row0 + ai * 128 + m * 16, b = row >> 11, s = row & 2047;
                const f32x4 sq = *(const f32x4*)(qsq + (size_t)row * 4);
                const float rstd = rsqrtf(((sq[0] + sq[1]) + (sq[2] + sq[3])) * (1.0f / 256.0f) + EPS);
                if (pn < 2) {
                    const int head = pn * 4 + wc;
                    f32x4 v[2][2]; float ss = 0.f;
#pragma unroll
                    for (int bj = 0; bj < 2; ++bj)
#pragma unroll
                        for (int n = 0; n < 2; ++n) { v[bj][n] = acc[ai][bj][m][n] * rstd; ss += sq4(v[bj][n]); }
                    ss = red_fq(ss); if (fq == 0) qss[((size_t)row * 8 + head) * 2 + 0] = ss;
                    bf16_t* rp = qm + ((size_t)(b * 8 + head) * 2048 + s) * 96 + 8 * fq;
#pragma unroll
                    for (int bj = 0; bj < 2; ++bj) *(u32x4*)(rp + 32 * bj) = pack8(v[bj][0] * *(const f32x4*)(g + 32 * bj + 8 * fq), v[bj][1] * *(const f32x4*)(g + 32 * bj + 8 * fq + 4));
                } else {
#pragma unroll
                    for (int bj = 0; bj < 2; ++bj) { const int head = 2 * wc + bj;
                        f32x4 v[2] = {acc[ai][bj][m][0] * rstd, acc[ai][bj][m][1] * rstd};
                        float ss = sq4(v[0]) + sq4(v[1]); ss = red_fq(ss); if (fq == 0) qss[((size_t)row * 8 + head) * 2 + 1] = ss;
                        rope32(v, rcos + (size_t)row * 16, rsin + (size_t)row * 16, fq);
                        *(u32x4*)(qm + ((size_t)(b * 8 + head) * 2048 + s) * 96 + 64 + 8 * fq) = pack8(v[0] * *(const f32x4*)(g + 64 + 8 * fq), v[1] * *(const f32x4*)(g + 64 + 8 * fq + 4)); }
                }
            }
    }
};

struct EpiUpKV {
    static constexpr bool PERM = true;
    __device__ __forceinline__ void prefetch(const Unit&, int, int, LAS unsigned char*) const {}
    bf16_t *km, *vm; const float* kvsq; const float* krot; const float* g;
    __device__ __forceinline__ void operator()(const f32x4 (&acc)[2][2][4][2], const Unit& u, int wr, int wc, int fr, int fq, int ui, LAS unsigned char* lds) const {
        const int pn = u.pn, row0 = u.orow0 + wr * 64 + fr, head = 2 * pn + (wc >> 1);
#pragma unroll
        for (int ai = 0; ai < 2; ++ai)
#pragma unroll
            for (int m = 0; m < 4; ++m) {
                const int row = row0 + ai * 128 + m * 16, b = row >> 11, s = row & 2047;
                const f32x4 sq = *(const f32x4*)(kvsq + (size_t)row * 4);
                const float rstd = rsqrtf(((sq[0] + sq[1]) + (sq[2] + sq[3])) * (1.0f / 128.0f) + EPS);
                if ((wc & 1) == 0) {
                    f32x4 v[2][2]; float ss = 0.f;
#pragma unroll
                    for (int bj = 0; bj < 2; ++bj)
#pragma unroll
                        for (int n = 0; n < 2; ++n) { v[bj][n] = acc[ai][bj][m][n] * rstd; ss += sq4(v[bj][n]); }
                    const f32x4 k0 = *(const f32x4*)(krot + (size_t)row * 32 + 8 * fq), k1 = *(const f32x4*)(krot + (size_t)row * 32 + 8 * fq + 4);
                    ss += sq4(k0) + sq4(k1); ss = red_fq(ss);
                    const float r96 = rsqrtf(ss * (1.0f / 96.0f) + EPS);
                    bf16_t* rp = km + ((size_t)(b * 8 + head) * 2048 + s) * 96 + 8 * fq;
#pragma unroll
                    for (int bj = 0; bj < 2; ++bj) *(u32x4*)(rp + 32 * bj) = pack8(v[bj][0] * r96 * *(const f32x4*)(g + 32 * bj + 8 * fq), v[bj][1] * r96 * *(const f32x4*)(g + 32 * bj + 8 * fq + 4));
                    *(u32x4*)(rp + 64) = pack8(k0 * r96 * *(const f32x4*)(g + 64 + 8 * fq), k1 * r96 * *(const f32x4*)(g + 64 + 8 * fq + 4));
                } else {
                    bf16_t* rp = vm + ((size_t)(b * 8 + head) * 2048 + s) * 64 + 8 * fq;
#pragma unroll
                    for (int bj = 0; bj < 2; ++bj) *(u32x4*)(rp + 32 * bj) = pack8(acc[ai][bj][m][0] * rstd, acc[ai][bj][m][1] * rstd);
                }
            }
    }
};

struct EpiMergeCat {
    static constexpr bool PERM = true;
    __device__ __forceinline__ void prefetch(const Unit&, int, int, LAS unsigned char*) const {}
    const bf16_t *sgna, *sgmla; bf16_t* out;
    __device__ __forceinline__ void operator()(const f32x4 (&acc)[2][2][4][2], const Unit& u, int wr, int wc, int fr, int fq, int ui, LAS unsigned char* lds) const {
        const int row0 = u.orow0 + wr * 64 + fr, cb = u.pn * 128 + wc * 32 + 8 * fq;
#pragma unroll
        for (int ai = 0; ai < 2; ++ai)
#pragma unroll
            for (int m = 0; m < 4; ++m) { const size_t off = (size_t)(row0 + ai * 128 + m * 16) * 1024 + cb;
                f32x4 ga, gb, ha, hb; unpack8(*(const u32x4*)(sgna + off), ga, gb); unpack8(*(const u32x4*)(sgmla + off), ha, hb);
                *(u32x4*)(out + off) = pack8(acc[ai][0][m][0] * ga + acc[ai][1][m][0] * ha, acc[ai][0][m][1] * gb + acc[ai][1][m][1] * hb); }
    }
};

struct EpiOut {
    static constexpr bool PERM = false;
    __device__ __forceinline__ void prefetch(const Unit&, int, int, LAS unsigned char*) const {}
    const float* x; float* x1; const float* mod;
    __device__ __forceinline__ void operator()(const f32x4 (&acc)[2][2][4][2], const Unit& u, int wr, int wc, int fr, int fq, int ui, LAS unsigned char* lds) const {
        const int row0 = u.orow0 + wr * 64 + fr, cb = u.pn * 256 + wc * 32 + 4 * fq, b = u.orow0 >> 11;
        f32x4 gt[2][2];
#pragma unroll
        for (int bj = 0; bj < 2; ++bj)
#pragma unroll
            for (int n = 0; n < 2; ++n) gt[bj][n] = *(const f32x4*)(mod + (size_t)b * 6144 + 2048 + cb + 128 * bj + 16 * n);
#pragma unroll
        for (int ai = 0; ai < 2; ++ai)
#pragma unroll
            for (int m = 0; m < 4; ++m) { const size_t off = (size_t)(row0 + ai * 128 + m * 16) * 1024 + cb;
#pragma unroll
                for (int bj = 0; bj < 2; ++bj)
#pragma unroll
                    for (int n = 0; n < 2; ++n) { const f32x4 xv = *(const f32x4*)(x + off + 128 * bj + 16 * n); *(f32x4*)(x1 + off + 128 * bj + 16 * n) = xv + gt[bj][n] * acc[ai][bj][m][n]; } }
    }
};

struct EpiGateUp {
    static constexpr bool PERM = true;
    __device__ __forceinline__ void prefetch(const Unit&, int, int, LAS unsigned char*) const {}
    unsigned char* act;
    __device__ __forceinline__ void operator()(const f32x4 (&acc)[2][2][4][2], const Unit& u, int wr, int wc, int fr, int fq, int ui, LAS unsigned char* lds) const {
        const int lr0 = wr * 64 + fr, cb = u.pn * 128 + wc * 32 + 8 * fq;
#pragma unroll
        for (int ai = 0; ai < 2; ++ai)
#pragma unroll
            for (int m = 0; m < 4; ++m) { const int lr = lr0 + ai * 128 + m * 16;
                if (lr < u.nrows) {
                    f32x4 a = acc[ai][0][m][0], b = acc[ai][0][m][1];
#pragma unroll
                    for (int e = 0; e < 4; ++e) { a[e] = siluf_fast(a[e] * (1.0f / WGU_SCALE)) * (acc[ai][1][m][0][e] * (1.0f / WGU_SCALE)); b[e] = siluf_fast(b[e] * (1.0f / WGU_SCALE)) * (acc[ai][1][m][1][e] * (1.0f / WGU_SCALE)); }
                    u32x2 w; w.x = cvt4_fp8(a, ACT_SCALE); w.y = cvt4_fp8(b, ACT_SCALE); *(u32x2*)(act + (size_t)(u.orow0 + lr) * 256 + cb) = w; } }
    }
};
__device__ __forceinline__ unsigned pk4_fp8_unused(f32x4 a) {
    int w = 0;
    w = __builtin_amdgcn_cvt_pk_fp8_f32(__builtin_amdgcn_fmed3f(a[0] * YS_SCALE, -448.f, 448.f), __builtin_amdgcn_fmed3f(a[1] * YS_SCALE, -448.f, 448.f), w, false);
    w = __builtin_amdgcn_cvt_pk_fp8_f32(__builtin_amdgcn_fmed3f(a[2] * YS_SCALE, -448.f, 448.f), __builtin_amdgcn_fmed3f(a[3] * YS_SCALE, -448.f, 448.f), w, true);
    return (unsigned)w;
}
struct EpiDown {
    static constexpr bool PERM = true;
    __device__ __forceinline__ void prefetch(const Unit& u, int ui, int tid, LAS unsigned char* lds) const {
        if (tid < 256) { LAS float* wl = (LAS float*)(lds + RING_BYTES + 1024 + 12288) + (ui & 1) * 256; wl[tid] = u.l1 ? ((const float*)u.l1)[tid] : 1.0f; } }
    unsigned char* ys; int dry;
    __device__ __forceinline__ void operator()(const f32x4 (&acc)[2][2][4][2], const Unit& u, int wr, int wc, int fr, int fq, int ui, LAS unsigned char* lds) const {
        if (dry) { float t = 0.f; _Pragma("unroll") for (int ai = 0; ai < 2; ++ai) _Pragma("unroll") for (int bj = 0; bj < 2; ++bj) _Pragma("unroll") for (int m = 0; m < 4; ++m) t += acc[ai][bj][m][0][0] + acc[ai][bj][m][1][3]; asm volatile("" :: "v"(t)); return; }
        const int lr0 = wr * 64 + fr, cb = u.pn * 256 + wc * 32 + 8 * fq;
#pragma unroll
        for (int ai = 0; ai < 2; ++ai)
#pragma unroll
            for (int m = 0; m < 4; ++m) { const int lr = lr0 + ai * 128 + m * 16;
                if (lr < u.nrows) { unsigned char* rp = ys + (size_t)(u.orow0 + lr) * 1024 + cb;
                    const float sc = (YS_SCALE / (ACT_SCALE * WD_SCALE)) * ((const LAS float*)(lds + RING_BYTES + 1024 + 12288))[(ui & 1) * 256 + lr];
#pragma unroll
                    for (int bj = 0; bj < 2; ++bj) { u32x2 w; w.x = cvt4_fp8(acc[ai][bj][m][0], sc); w.y = cvt4_fp8(acc[ai][bj][m][1], sc); *(u32x2*)(rp + 128 * bj) = w; } } }
    }
};
}
struct Frame {
    LAS unsigned char* lds;
    volatile LAS unsigned* MISC;
    gu32* ctl;
    int tid, lane, wave, vcu, G;
    unsigned char* ws;
    float* out;
    __device__ __forceinline__ void refresh() { int t = threadIdx.x; asm volatile("" : "+v"(t)); tid = t; lane = t & 63; wave = __builtin_amdgcn_readfirstlane(t >> 6);
        asm volatile("" : "+s"(ws)); asm volatile("" : "+s"(out)); ctl = (gu32*)(ws + WS_CTL); }
};
__device__ __forceinline__ int fresh_tid() { int t = threadIdx.x; asm volatile("" : "+v"(t)); return t; }
template <class T> __device__ __forceinline__ T* wsp(const Frame& F, size_t off) { return (T*)(F.ws + off); }

struct MapOff { int off; __device__ int operator()(int n) const { return n + off; } };
struct MapWin { __device__ int operator()(int n) const {
    if (n < 1024) { const int sec = n >> 9, nn = n & 511, hh = nn >> 6, d = nn & 63; return sec * 512 + (hh >> 2) * 256 + 128 * (d >> 5) + 32 * (hh & 3) + (d & 31); }
    return n < 1952 ? n : n + 96; } };
struct MapUq { __device__ int operator()(int n) const { const int hh = n / 96, d = n % 96;
    return d < 64 ? (hh >> 2) * 256 + 128 * (d >> 5) + 32 * (hh & 3) + (d & 31) : 512 + 128 * (hh & 1) + 32 * (hh >> 1) + (d - 64); } };
struct MapUkv { __device__ int operator()(int n) const { const int hh = n >> 7, d = n & 127, dd = d & 63, wcn = 2 * (hh & 1) + (d >> 6);
    return (hh >> 1) * 256 + 128 * (dd >> 5) + 32 * wcn + (dd & 31); } };
struct MapCat { int up; __device__ int operator()(int n) const { return (n >> 7) * 256 + up * 128 + (n & 127); } };
struct MapGU { int up; __device__ int operator()(int f) const { return (f >> 7) * 256 + up * 128 + (f & 127); } };

template <class Map> __device__ __forceinline__ void transpose_item(const float* W, int K, int N, bf16_t* WT, Map rm, const float* kscale, LAS float* scr, int item, int lane, int ldt = 0, int koff = 0) {
    if (ldt == 0) ldt = K;
    const int nblk = N / 32, kb = item / nblk, nb = item % nblk, k0 = 64 * kb, n0 = 32 * nb;
    float tv[32];
#pragma unroll
    for (int i = 0; i < 32; ++i) { const int kk = 2 * i + (lane >> 5); tv[i] = __builtin_nontemporal_load(W + (size_t)(k0 + kk) * N + n0 + (lane & 31)); }
#pragma unroll
    for (int i = 0; i < 32; ++i) { const int kk = 2 * i + (lane >> 5); float v = tv[i]; if (kscale) v *= kscale[k0 + kk]; scr[kk * 33 + (lane & 31)] = v; }
    LDS_WAIT(); asm volatile("" ::: "memory");
    const int c = lane & 7;
#pragma unroll
    for (int j = 0; j < 4; ++j) { const int n = (lane >> 3) + 8 * j; const LAS float* s = scr + (8 * c) * 33 + n;
        u32x4 o; o.x = pk2(s[0 * 33], s[1 * 33]); o.y = pk2(s[2 * 33], s[3 * 33]); o.z = pk2(s[4 * 33], s[5 * 33]); o.w = pk2(s[6 * 33], s[7 * 33]);
        *(u32x4*)(WT + (size_t)rm(n0 + n) * ldt + koff + k0 + 8 * c) = o; }
    LDS_WAIT(); asm volatile("" ::: "memory");
}


template <class Map> __device__ __forceinline__ void transpose_item_fp8(const float* W, int K, int N, unsigned char* WT, Map rm, float sc, LAS float* scr, int item, int lane) {
    const int nblk = N / 32, kb = item / nblk, nb = item % nblk, k0 = 64 * kb, n0 = 32 * nb;
    float tv[32];
#pragma unroll
    for (int i = 0; i < 32; ++i) { const int kk = 2 * i + (lane >> 5); tv[i] = __builtin_nontemporal_load(W + (size_t)(k0 + kk) * N + n0 + (lane & 31)); }
#pragma unroll
    for (int i = 0; i < 32; ++i) { const int kk = 2 * i + (lane >> 5); scr[kk * 33 + (lane & 31)] = tv[i]; }
    LDS_WAIT(); asm volatile("" ::: "memory");
    const int c = lane & 3;
#pragma unroll
    for (int j = 0; j < 2; ++j) { const int n = (lane >> 2) + 16 * j; const LAS float* s = scr + (16 * c) * 33 + n;
        u32x4 o;
#pragma unroll
        for (int q = 0; q < 4; ++q) o[q] = cvt4_fp8((f32x4){s[(4 * q + 0) * 33], s[(4 * q + 1) * 33], s[(4 * q + 2) * 33], s[(4 * q + 3) * 33]}, sc);
        *(u32x4*)(WT + (size_t)rm(n0 + n) * K + k0 + 16 * c) = o; }
    LDS_WAIT(); asm volatile("" ::: "memory");
}

__device__ __forceinline__ void p0_prologue(Frame& F, const Args& A) {
    const int tid = F.tid;
    {
        LAS float* sc = (LAS float*)F.lds;
        LAS float* part = (LAS float*)(F.lds + 32768);
        for (int i = tid; i < NB * DM; i += NTHR) { const float v = INF(I_c)[i]; sc[i] = v / (1.0f + expf(-v)); }
        __syncthreads();
        for (int n0 = 24 * (int)blockIdx.x; n0 < 6 * DM; n0 += 24 * F.G) {
        const int kk = tid >> 5, col = tid & 31;
        float a[8];
#pragma unroll
        for (int b = 0; b < 8; ++b) a[b] = 0.f;
        if (col < 24) {
#pragma unroll 1
            for (int k0 = kk; k0 < DM; k0 += 16 * 32) { float wv[32];
#pragma unroll
                for (int q = 0; q < 32; ++q) wv[q] = INF(I_w_ada)[(size_t)(k0 + 16 * q) * 6144 + n0 + col];
#pragma unroll
                for (int q = 0; q < 32; ++q) {
#pragma unroll
                    for (int b = 0; b < 8; ++b) a[b] = fmaf(sc[b * DM + k0 + 16 * q], wv[q], a[b]); } }
        }
#pragma unroll
        for (int b = 0; b < 8; ++b) part[(kk * 8 + b) * 32 + col] = a[b];
        __syncthreads();
        if (tid < 192) { const int b = tid / 24, cc = tid % 24; float s = 0.f;
#pragma unroll
            for (int q = 0; q < 16; ++q) s += part[(q * 8 + b) * 32 + cc];
            wsp<float>(F, WS_MOD)[(size_t)b * 6144 + n0 + cc] = s + INF(I_b_ada)[n0 + cc]; }
        __syncthreads();
        }
    }
}
__device__ __forceinline__ void p0_copies(Frame& F, const Args& A) {
    const int tid = F.tid;
    LAS float* scr = (LAS float*)(F.lds + F.wave * 16384);
    const int gw = F.vcu * NWAVES + F.wave, NGW = F.G * NWAVES;
    constexpr int I_IN = 16 * 125, I_UQ = 4 * 24, I_UKV = 2 * 32, I_PN = 8 * 32, I_OUT = 16 * 32;
    constexpr int NITEMS = I_IN + I_UQ + I_UKV + 2 * I_PN + I_OUT;
    for (int it = gw; it < NITEMS; it += NGW) {
        int r = it;
        if (r < I_IN) { transpose_item(INF(I_w_in), DM, INCOLS, wsp<bf16_t>(F, WS_WIN), MapWin{}, nullptr, scr, r, F.lane); continue; } r -= I_IN;
        if (r < I_UQ) { transpose_item(INF(I_w_uq), QRANK, MH * QKD, wsp<bf16_t>(F, WS_WUQ), MapUq{}, INF(I_g_q_lat), scr, r, F.lane); continue; } r -= I_UQ;
        if (r < I_UKV) { transpose_item(INF(I_w_ukv), KVRANK, MH * 128, wsp<bf16_t>(F, WS_WUKV), MapUkv{}, INF(I_g_kv_lat), scr, r, F.lane); continue; } r -= I_UKV;
        if (r < I_PN) { transpose_item(INF(I_w_proj_na), 512, DM, wsp<bf16_t>(F, WS_WPCAT), MapCat{0}, nullptr, scr, r, F.lane, 1024, 0); continue; } r -= I_PN;
        if (r < I_PN) { transpose_item(INF(I_w_proj_mla), 512, DM, wsp<bf16_t>(F, WS_WPCAT), MapCat{1}, nullptr, scr, r, F.lane, 1024, 512); continue; } r -= I_PN;
        transpose_item(INF(I_w_out), DM, DM, wsp<bf16_t>(F, WS_WOUT), MapOff{0}, nullptr, scr, r, F.lane);
    }
#ifdef TSA
    if (blockIdx.x == TSWG && threadIdx.x == 0) { const unsigned long long t_ = __builtin_amdgcn_s_memrealtime(); ((LAS unsigned*)(F.lds + TAB_OFF + 2048))[44] = (unsigned)t_; ((LAS unsigned*)(F.lds + TAB_OFF + 2048))[45] = (unsigned)(t_ >> 32); }
#endif
    const int gt = F.vcu * NTHR + tid, NGT = F.G * NTHR;
    for (int i = gt; i < 96 * DM / 8; i += NGT) *(u32x4*)(wsp<bf16_t>(F, WS_WIN) + (size_t)1952 * DM + (size_t)i * 8) = (u32x4){0u, 0u, 0u, 0u};
    for (int i = gt; i < 2048 * 64; i += NGT) { const int row = i >> 6, q = i & 63; *(u32x4*)(wsp<bf16_t>(F, WS_WPCAT) + (size_t)row * 1024 + ((row & 128) ? 0 : 512) + q * 8) = (u32x4){0u, 0u, 0u, 0u}; }
    for (int i = gt; i < NT * 16; i += NGT) { const int t = i >> 4, q = i & 15;
        const float inv = powf(10000.0f, -(float)q / 16.0f), ang = (float)((const int*)A.in[I_positions])[t] * inv;
        wsp<float>(F, WS_RCOS)[i] = cosf(ang); wsp<float>(F, WS_RSIN)[i] = sinf(ang); }
    for (int i = gt; i < 4 * 32 * 64; i += NGT) { const int ct = i >> 11, ks = (i >> 6) & 31, l = i & 63; float w[8];
#pragma unroll
        for (int j = 0; j < 8; ++j) w[j] = INF(I_w_router)[(size_t)(32 * ks + 8 * (l >> 4) + j) * NEXP + 16 * ct + (l & 15)];
        u32x4 hw, lw;
#pragma unroll
        for (int q = 0; q < 4; ++q) { const unsigned h2 = pk2(w[2 * q], w[2 * q + 1]); hw[q] = h2; lw[q] = pk2(w[2 * q] - bflo(h2), w[2 * q + 1] - bfhi(h2)); }
        wsp<u32x4>(F, WS_RFRAG)[(size_t)i * 2] = hw; wsp<u32x4>(F, WS_RFRAG)[(size_t)i * 2 + 1] = lw; }
#ifdef TSA
    if (blockIdx.x == TSWG && threadIdx.x == 0) { const unsigned long long t_ = __builtin_amdgcn_s_memrealtime(); ((LAS unsigned*)(F.lds + TAB_OFF + 2048))[46] = (unsigned)t_; ((LAS unsigned*)(F.lds + TAB_OFF + 2048))[47] = (unsigned)(t_ >> 32); }
#endif
}

__device__ __forceinline__ void s1_modnorm(Frame& F, const Args& A) {
    const int gw = F.vcu * NWAVES + F.wave, lane = F.lane;
    const float* mod = wsp<float>(F, WS_MOD); bf16_t* H = wsp<bf16_t>(F, WS_H);
    for (int r0 = gw * 8; r0 < NT; r0 += F.G * NWAVES * 8) {
    const int b = r0 >> 11;
    f32x4 ca[4], cs[4];
#pragma unroll
    for (int j = 0; j < 4; ++j) { const int c4 = 4 * lane + 256 * j;
        const f32x4 g = *(const f32x4*)(INF(I_g_norm1) + c4), sc = *(const f32x4*)(mod + (size_t)b * 6144 + 1024 + c4);
        ca[j] = g * (sc + 1.0f); cs[j] = *(const f32x4*)(mod + (size_t)b * 6144 + c4); }
#pragma unroll 1
    for (int qb = 0; qb < 8; qb += 4) {
    f32x4 v[4][4];
#pragma unroll
    for (int q = 0; q < 4; ++q)
#pragma unroll
        for (int j = 0; j < 4; ++j) v[q][j] = __builtin_nontemporal_load((const f32x4*)(INF(I_x) + (size_t)(r0 + qb + q) * DM + 4 * lane + 256 * j));
#pragma unroll
    for (int q = 0; q < 4; ++q) { float ss = 0.f;
#pragma unroll
        for (int j = 0; j < 4; ++j) ss += sq4(v[q][j]);
        const float rstd = rsqrtf(wave_sum(ss) * (1.0f / DM) + EPS);
#pragma unroll
        for (int j = 0; j < 4; ++j) { const f32x4 o = v[q][j] * rstd * ca[j] + cs[j]; u32x2 w; w.x = cvt_pk_bf16(o[0], o[1]); w.y = cvt_pk_bf16(o[2], o[3]);
            *(u32x2*)(H + (size_t)(r0 + qb + q) * DM + 4 * lane + 256 * j) = w; }
    }
    }
    }
}
namespace attn {
__device__ __forceinline__ int crow(int r, int hi) { return (r & 3) + 8 * (r >> 2) + 4 * hi; }
constexpr int KVBLK = 64;
constexpr int L_K = 0, L_V = 26624, L_WS = 43008, L_OST = 45056, L_BIAS = 77824, L_MASK = L_BIAS + 4 * 15 * 128 * 4, L_END = L_MASK + 4 * 128 * 4;
constexpr int KBUF = 13312, VBUF = 8192;
constexpr float THRN = 8.0f;

template <int DQK> struct Geo { static constexpr int KROWB = DQK * 2 + 16, NCH = DQK / 8, ND0 = DQK / 16; };

__device__ __forceinline__ int v_st(int k, int c) { const int kk = (k & ~0xC) | ((k & 4) << 1) | ((k & 8) >> 1); return ((kk >> 3) * 2 + (c >> 5)) * 512 + ((kk & 7) * 32 + (c & 31)) * 2; }
__device__ __forceinline__ int v_rd_base(int lane) { return ((lane & 3) << 3) | (((lane >> 2) & 3) << 6) | (((lane >> 4) & 1) << 5) | (((lane >> 5) & 1) << 8); }
constexpr int v_rd_off(int d0, int ks, int half) { return d0 * 512 + ks * 2048 + half * 1024; }
template <int OFF> __device__ __forceinline__ s16x4 tr_read(int vb) { s16x4 r; asm volatile("ds_read_b64_tr_b16 %0, %1 offset:%2" : "=&v"(r) : "v"(vb), "i"(OFF) : "memory"); return r; }

template <int D0> __device__ __forceinline__ void pv_one(f32x16& od, int vb, bf16x8 pa0, bf16x8 pa1, bf16x8 pa2, bf16x8 pa3) {
    const s16x4 l0 = tr_read<v_rd_off(D0, 0, 0)>(vb), h0 = tr_read<v_rd_off(D0, 0, 1)>(vb), l1 = tr_read<v_rd_off(D0, 1, 0)>(vb), h1 = tr_read<v_rd_off(D0, 1, 1)>(vb);
    const s16x4 l2 = tr_read<v_rd_off(D0, 2, 0)>(vb), h2 = tr_read<v_rd_off(D0, 2, 1)>(vb), l3 = tr_read<v_rd_off(D0, 3, 0)>(vb), h3 = tr_read<v_rd_off(D0, 3, 1)>(vb);
    asm volatile("s_waitcnt lgkmcnt(0)" ::: "memory"); SBAR();
#define PK(L, H) (bf16x8){L[0], L[1], L[2], L[3], H[0], H[1], H[2], H[3]}
    od = __builtin_amdgcn_mfma_f32_32x32x16_bf16(pa0, PK(l0, h0), od, 0, 0, 0);
    od = __builtin_amdgcn_mfma_f32_32x32x16_bf16(pa1, PK(l1, h1), od, 0, 0, 0);
    od = __builtin_amdgcn_mfma_f32_32x32x16_bf16(pa2, PK(l2, h2), od, 0, 0, 0);
    od = __builtin_amdgcn_mfma_f32_32x32x16_bf16(pa3, PK(l3, h3), od, 0, 0, 0);
#undef PK
}

template <int DQK> __device__ __forceinline__ void qkt(f32x16& p0, f32x16& p1, const LAS unsigned char* Ks, const bf16x8* qr, int r32, int hi) {
    p0 = f32x16{}; p1 = f32x16{};
#pragma unroll
    for (int d0 = 0; d0 < Geo<DQK>::ND0; ++d0) { const int cb = (d0 * 16 + hi * 8) * 2;
        const bf16x8 b0 = *(const LAS bf16x8*)(Ks + r32 * Geo<DQK>::KROWB + cb);
        const bf16x8 b1 = *(const LAS bf16x8*)(Ks + (32 + r32) * Geo<DQK>::KROWB + cb);
        p0 = __builtin_amdgcn_mfma_f32_32x32x16_bf16(b0, qr[d0], p0, 0, 0, 0);
        p1 = __builtin_amdgcn_mfma_f32_32x32x16_bf16(b1, qr[d0], p1, 0, 0, 0); }
}
__device__ __forceinline__ void softmax_tile(f32x16& p0, f32x16& p1, float& l_reg, float C, float nBC, bf16x8& pa0, bf16x8& pa1, bf16x8& pa2, bf16x8& pa3) {
#pragma unroll
    for (int r = 0; r < 16; ++r) { p0[r] = __builtin_amdgcn_exp2f(fmaf(p0[r], C, nBC)); p1[r] = __builtin_amdgcn_exp2f(fmaf(p1[r], C, nBC)); }
    float ps = 0;
#pragma unroll
    for (int r = 0; r < 16; ++r) ps += p0[r];
#pragma unroll
    for (int r = 0; r < 16; ++r) ps += p1[r];
    l_reg += ps;
#define PK4(P, BASE, OUT) do { unsigned a0 = cvt_pk_bf16(P[BASE + 0], P[BASE + 1]), a1 = cvt_pk_bf16(P[BASE + 2], P[BASE + 3]);   \
    unsigned b0 = cvt_pk_bf16(P[BASE + 4], P[BASE + 5]), b1 = cvt_pk_bf16(P[BASE + 6], P[BASE + 7]);                              \
    auto r0 = __builtin_amdgcn_permlane32_swap(a0, b0, false, false); auto r1 = __builtin_amdgcn_permlane32_swap(a1, b1, false, false); \
    u32x4 w = {r0[0], r1[0], r0[1], r1[1]}; OUT = __builtin_bit_cast(bf16x8, w); } while (0)
    PK4(p0, 0, pa0); PK4(p0, 8, pa1); PK4(p1, 0, pa2); PK4(p1, 8, pa3);
#undef PK4
}

template <int DQK, bool NA>
__device__ __forceinline__ void attn_unit(LAS unsigned char* lds, const bf16_t* Qw, int ldq, float qscale, const bf16_t* Kt, int ldk, const bf16_t* Vt, int ldv, bf16_t* Ow,
                                          int ntiles, float SCALE, float bound_raw, int na_first, int na_qc0, int na_dr0) {
    using G = Geo<DQK>;
    int tid_ = threadIdx.x; asm volatile("" : "+v"(tid_));
    const int tid = tid_, lane = tid & 63, r32 = lane & 31, hi = lane >> 5; const int wid = __builtin_amdgcn_readfirstlane(tid >> 6);
    const float C = SCALE * 1.4426950408889634f, nBC = -bound_raw * C;
    LAS float* wsf = (LAS float*)(lds + L_WS) + wid * 64;
    bf16x8 qr[G::ND0];
#pragma unroll
    for (int d0 = 0; d0 < G::ND0; ++d0) { u32x4 w = *(const u32x4*)(Qw + (size_t)r32 * ldq + d0 * 16 + hi * 8);
        if (!NA) { f32x4 a, b; a = (f32x4){bflo(w.x), bfhi(w.x), bflo(w.y), bfhi(w.y)} * qscale; b = (f32x4){bflo(w.z), bfhi(w.z), bflo(w.w), bfhi(w.w)} * qscale;
            w.x = cvt_pk_bf16(a[0], a[1]); w.y = cvt_pk_bf16(a[2], a[3]); w.z = cvt_pk_bf16(b[0], b[1]); w.w = cvt_pk_bf16(b[2], b[3]); }
        qr[d0] = __builtin_bit_cast(bf16x8, w); }
    const int vk = tid >> 3, vc = (tid & 7) * 8, vst = v_st(vk, vc);
    const int k0r = tid / G::NCH, k0c = tid % G::NCH; const int k1id = tid + 512, k1r = k1id / G::NCH, k1c = k1id % G::NCH; const bool k1on = (G::NCH == 12) && (tid < 256);
    const int vb0 = (int)(uintptr_t)(lds + L_V) + v_rd_base(lane);
    u32x4 sv, sk0, sk1;
#define SLOAD(j) do { const size_t kb_ = (size_t)(j) * KVBLK; sv = *(const u32x4*)(Vt + (kb_ + vk) * ldv + vc); sk0 = *(const u32x4*)(Kt + (kb_ + k0r) * ldk + k0c * 8); \
        if (k1on) sk1 = *(const u32x4*)(Kt + (kb_ + k1r) * ldk + k1c * 8); } while (0)
#define SWRITE(bf) do { *(LAS u32x4*)(lds + L_V + (bf) * VBUF + vst) = sv; *(LAS u32x4*)(lds + L_K + (bf) * KBUF + k0r * G::KROWB + k0c * 16) = sk0; \
        if (k1on) *(LAS u32x4*)(lds + L_K + (bf) * KBUF + k1r * G::KROWB + k1c * 16) = sk1; } while (0)
    float l_reg = 0.f; f32x16 o[2]; o[0] = f32x16{}; o[1] = f32x16{};
    const LAS float* tb_lane = nullptr; f32x4 mk0[4], mk1[4];
    if (NA) { const int qc = na_qc0 + r32, i0 = 4 * hi - qc + 63, sft = i0 & 3;
        tb_lane = (const LAS float*)(lds + L_BIAS) + sft * (15 * 128) + (i0 - sft);
        int qe = qc < 8 ? 8 : (qc > 56 ? 56 : qc); const int j0 = 4 * hi - qe + 56, sf2 = j0 & 3;
        const LAS float* tm = (const LAS float*)(lds + L_MASK) + sf2 * 128 + (j0 - sf2);
#pragma unroll
        for (int g4 = 0; g4 < 4; ++g4) { mk0[g4] = *(const LAS f32x4*)(tm + 8 * g4); mk1[g4] = *(const LAS f32x4*)(tm + 8 * g4 + 32); } }
    SLOAD(0); VM_WAIT(); SWRITE(0); if (ntiles > 1) SLOAD(1);
    __syncthreads();
    for (int j = 0; j < ntiles; ++j) {
        const int bf = j & 1;
        bool active = true; int dr = 0;
        if (NA) { dr = na_dr0 + j; active = (j >= na_first) && (j < na_first + 8); }
        if (active) {
            f32x16 p0, p1; bf16x8 pa0, pa1, pa2, pa3;
            qkt<DQK>(p0, p1, lds + L_K + bf * KBUF, qr, r32, hi);
            if (NA) {
                const LAS float* bt = tb_lane + (dr + 7) * 128;
#pragma unroll
                for (int g4 = 0; g4 < 4; ++g4) {
                    const f32x4 b0 = *(const LAS f32x4*)(bt + 8 * g4), b1 = *(const LAS f32x4*)(bt + 8 * g4 + 32);
#pragma unroll
                    for (int e = 0; e < 4; ++e) { p0[4 * g4 + e] = (p0[4 * g4 + e] + b0[e]) + mk0[g4][e]; p1[4 * g4 + e] = (p1[4 * g4 + e] + b1[e]) + mk1[g4][e]; }
                }
            }
            softmax_tile(p0, p1, l_reg, C, nBC, pa0, pa1, pa2, pa3);
            SBAR();
            pv_one<0>(o[0], vb0 + bf * VBUF, pa0, pa1, pa2, pa3); pv_one<1>(o[1], vb0 + bf * VBUF, pa0, pa1, pa2, pa3);
        }
        if (j + 1 < ntiles) { VM_WAIT(); SWRITE(bf ^ 1); if (j + 2 < ntiles) SLOAD(j + 2); }
        __syncthreads();
    }
#undef SLOAD
#undef SWRITE
    { auto rr = __builtin_amdgcn_permlane32_swap(__float_as_uint(l_reg), __float_as_uint(l_reg), false, false); l_reg = __uint_as_float(rr[0]) + __uint_as_float(rr[1]); }
    if (hi == 0) wsf[32 + r32] = l_reg; LDS_WAIT();
    float rli[16];
#pragma unroll
    for (int r = 0; r < 16; ++r) rli[r] = __builtin_amdgcn_rcpf(wsf[32 + crow(r, hi)]);
    LAS bf16_t* stg = (LAS bf16_t*)(lds + L_OST) + wid * 2048;
#pragma unroll
    for (int r = 0; r < 16; ++r) { const int orow = crow(r, hi);
#pragma unroll
        for (int d0 = 0; d0 < 2; ++d0) stg[orow * 64 + d0 * 32 + r32] = (bf16_t)f2bf(o[d0][r] * rli[r]); }
    LDS_WAIT();
#pragma unroll
    for (int i = 0; i < 4; ++i) { const int row = i * 8 + (lane >> 3), ch = lane & 7; const u32x4 v = *(const LAS u32x4*)(stg + row * 64 + ch * 8); *(u32x4*)(Ow + (size_t)row * 1024 + ch * 8) = v; }
    LDS_WAIT();
    __syncthreads();
}

__device__ __forceinline__ void partialSM(f32x16& p0, f32x16& p1, float C, float nBC) {
#pragma unroll
    for (int r = 0; r < 16; ++r) { p0[r] = fmaf(p0[r], C, nBC); p1[r] = fmaf(p1[r], C, nBC); }
#pragma unroll
    for (int r = 0; r < 16; ++r) p0[r] = __builtin_amdgcn_exp2f(p0[r]);
}
__device__ __forceinline__ void finishSM(f32x16& p0, f32x16& p1, float& l_reg, bf16x8& pa0, bf16x8& pa1, bf16x8& pa2, bf16x8& pa3) {
#pragma unroll
    for (int r = 0; r < 16; ++r) p1[r] = __builtin_amdgcn_exp2f(p1[r]);
    float ps = 0;
#pragma unroll
    for (int r = 0; r < 16; ++r) ps += p0[r];
#pragma unroll
    for (int r = 0; r < 16; ++r) ps += p1[r];
    l_reg += ps;
#define PK4(P, BASE, OUT) do { unsigned a0 = cvt_pk_bf16(P[BASE + 0], P[BASE + 1]), a1 = cvt_pk_bf16(P[BASE + 2], P[BASE + 3]);   \
    unsigned b0 = cvt_pk_bf16(P[BASE + 4], P[BASE + 5]), b1 = cvt_pk_bf16(P[BASE + 6], P[BASE + 7]);                              \
    auto r0 = __builtin_amdgcn_permlane32_swap(a0, b0, false, false); auto r1 = __builtin_amdgcn_permlane32_swap(a1, b1, false, false); \
    u32x4 w = {r0[0], r1[0], r0[1], r1[1]}; OUT = __builtin_bit_cast(bf16x8, w); } while (0)
    PK4(p0, 0, pa0); PK4(p0, 8, pa1); PK4(p1, 0, pa2); PK4(p1, 8, pa3);
#undef PK4
}
template <int DQK>
__device__ __forceinline__ void attn_unit_pipe(LAS unsigned char* lds, const bf16_t* Qw, int ldq, float qscale, const bf16_t* Kt, int ldk, const bf16_t* Vt, int ldv, bf16_t* Ow, int ntiles, float SCALE, float bound_raw) {
    using G = Geo<DQK>;
    int tid_ = threadIdx.x; asm volatile("" : "+v"(tid_));
    const int tid = tid_, lane = tid & 63, r32 = lane & 31, hi = lane >> 5; const int wid = __builtin_amdgcn_readfirstlane(tid >> 6);
    const float C = SCALE * 1.4426950408889634f, nBC = -bound_raw * C;
    constexpr int P_K = 0, P_V = 3 * KBUF, P_WS = P_V + 3 * VBUF, P_OST = P_WS + 2048;
    LAS float* wsf = (LAS float*)(lds + P_WS) + wid * 64;
    bf16x8 qr[G::ND0];
#pragma unroll
    for (int d0 = 0; d0 < G::ND0; ++d0) { u32x4 w = *(const u32x4*)(Qw + (size_t)r32 * ldq + d0 * 16 + hi * 8);
        f32x4 a, b; a = (f32x4){bflo(w.x), bfhi(w.x), bflo(w.y), bfhi(w.y)} * qscale; b = (f32x4){bflo(w.z), bfhi(w.z), bflo(w.w), bfhi(w.w)} * qscale;
        w.x = cvt_pk_bf16(a[0], a[1]); w.y = cvt_pk_bf16(a[2], a[3]); w.z = cvt_pk_bf16(b[0], b[1]); w.w = cvt_pk_bf16(b[2], b[3]);
        qr[d0] = __builtin_bit_cast(bf16x8, w); }
    const int vk = tid >> 3, vc = (tid & 7) * 8, vst = v_st(vk, vc);
    const int k0r = tid / G::NCH, k0c = tid % G::NCH; const int k1id = tid + 512, k1r = k1id / G::NCH, k1c = k1id % G::NCH; const bool k1on = (G::NCH == 12) && (wid < 4);
    const int vb0 = (int)(uintptr_t)(lds + P_V) + v_rd_base(lane);
    u32x4 evv, ek0, ek1, ovv, ok0, ok1;
    const __amdgpu_buffer_rsrc_t krs = __builtin_amdgcn_make_buffer_rsrc((void*)Kt, 0, 0x7fffffff, 0x00020000);
    const __amdgpu_buffer_rsrc_t vrs = __builtin_amdgcn_make_buffer_rsrc((void*)Vt, 0, 0x7fffffff, 0x00020000);
    const int voV = (vk * ldv + vc) * 2, voK0 = (k0r * ldk + k0c * 8) * 2, voK1 = (k1r * ldk + k1c * 8) * 2;
#define SLOAD(V_, K0_, K1_, j) do { V_ = __builtin_bit_cast(u32x4, __builtin_amdgcn_raw_buffer_load_b128(vrs, voV, (j) * (KVBLK * 2) * ldv, 0)); \
        K0_ = __builtin_bit_cast(u32x4, __builtin_amdgcn_raw_buffer_load_b128(krs, voK0, (j) * (KVBLK * 2) * ldk, 0)); \
        if (k1on) K1_ = __builtin_bit_cast(u32x4, __builtin_amdgcn_raw_buffer_load_b128(krs, voK1, (j) * (KVBLK * 2) * ldk, 0)); } while (0)
#define SWRITE(bf, V_, K0_, K1_) do { *(LAS u32x4*)(lds + P_V + (bf) * VBUF + vst) = V_; *(LAS u32x4*)(lds + P_K + (bf) * KBUF + k0r * G::KROWB + k0c * 16) = K0_; \
        if (k1on) *(LAS u32x4*)(lds + P_K + (bf) * KBUF + k1r * G::KROWB + k1c * 16) = K1_; } while (0)
#define RESC(a) do { if (__any((a) < 1.f)) { if (hi == 0) wsf[r32] = (a); LDS_WAIT(); \
        _Pragma("unroll") for (int d = 0; d < 2; ++d) _Pragma("unroll") for (int r = 0; r < 16; ++r) o[d][r] *= wsf[crow(r, hi)]; } } while (0)
    float l_reg = 0.f; f32x16 o[2]; o[0] = f32x16{}; o[1] = f32x16{};
    f32x16 pA0, pA1, pB0, pB1; bf16x8 pa0, pa1, pa2, pa3;
    const LAS unsigned char* Kp = lds + P_K;
    SLOAD(evv, ek0, ek1, 0); SWRITE(0, evv, ek0, ek1); __syncthreads();
    qkt<DQK>(pA0, pA1, Kp, qr, r32, hi); partialSM(pA0, pA1, C, nBC);
    SLOAD(ovv, ok0, ok1, 1); SLOAD(evv, ek0, ek1, 2);
    SWRITE(1, ovv, ok0, ok1); __syncthreads();
    int pb = 0, cb = 1, nb = 2;
    for (int j = 1; j + 1 < ntiles; j += 2) {
        SBAR(); qkt<DQK>(pB0, pB1, Kp + cb * KBUF, qr, r32, hi);
        finishSM(pA0, pA1, l_reg, pa0, pa1, pa2, pa3); SBAR();
        SLOAD(ovv, ok0, ok1, j + 2); SBAR();
        pv_one<0>(o[0], vb0 + pb * VBUF, pa0, pa1, pa2, pa3); pv_one<1>(o[1], vb0 + pb * VBUF, pa0, pa1, pa2, pa3); partialSM(pB0, pB1, C, nBC);
        SWRITE(nb, evv, ek0, ek1);
        __syncthreads();
        SBAR(); qkt<DQK>(pA0, pA1, Kp + nb * KBUF, qr, r32, hi);
        finishSM(pB0, pB1, l_reg, pa0, pa1, pa2, pa3); SBAR();
        if (j + 3 < ntiles) SLOAD(evv, ek0, ek1, j + 3); SBAR();
        pv_one<0>(o[0], vb0 + cb * VBUF, pa0, pa1, pa2, pa3); pv_one<1>(o[1], vb0 + cb * VBUF, pa0, pa1, pa2, pa3); partialSM(pA0, pA1, C, nBC);
        SWRITE(pb, ovv, ok0, ok1);
        __syncthreads();
        { const int t_ = cb; cb = pb; pb = nb; nb = t_; }
    }
    SBAR(); qkt<DQK>(pB0, pB1, Kp + cb * KBUF, qr, r32, hi);
    finishSM(pA0, pA1, l_reg, pa0, pa1, pa2, pa3); SBAR();
    pv_one<0>(o[0], vb0 + pb * VBUF, pa0, pa1, pa2, pa3); pv_one<1>(o[1], vb0 + pb * VBUF, pa0, pa1, pa2, pa3); partialSM(pB0, pB1, C, nBC);
    finishSM(pB0, pB1, l_reg, pa0, pa1, pa2, pa3); SBAR();
    pv_one<0>(o[0], vb0 + cb * VBUF, pa0, pa1, pa2, pa3); pv_one<1>(o[1], vb0 + cb * VBUF, pa0, pa1, pa2, pa3);
#undef SLOAD
#undef SWRITE
#undef RESC
    { auto rr = __builtin_amdgcn_permlane32_swap(__float_as_uint(l_reg), __float_as_uint(l_reg), false, false); l_reg = __uint_as_float(rr[0]) + __uint_as_float(rr[1]); }
    if (hi == 0) wsf[32 + r32] = l_reg; LDS_WAIT();
    float rli[16];
#pragma unroll
    for (int r = 0; r < 16; ++r) rli[r] = __builtin_amdgcn_rcpf(wsf[32 + crow(r, hi)]);
    LAS bf16_t* stg = (LAS bf16_t*)(lds + P_OST) + wid * 2048;
#pragma unroll
    for (int r = 0; r < 16; ++r) { const int orow = crow(r, hi);
#pragma unroll
        for (int d0 = 0; d0 < 2; ++d0) stg[orow * 64 + d0 * 32 + r32] = (bf16_t)f2bf(o[d0][r] * rli[r]); }
    LDS_WAIT();
#pragma unroll
    for (int i = 0; i < 4; ++i) { const int row = i * 8 + (lane >> 3), ch = lane & 7; const u32x4 v = *(const LAS u32x4*)(stg + row * 64 + ch * 8); *(u32x4*)(Ow + (size_t)row * 1024 + ch * 8) = v; }
    LDS_WAIT();
    __syncthreads();
}
}

__device__ __forceinline__ void s4_attention(Frame& F, const Args& A, int rep_mla, int rep_na) {
    const int wave = F.wave;
    float bound_mla;
    { int l = threadIdx.x & 63; asm volatile("" : "+v"(l)); float mq = 0.f, mk = 0.f;
      for (int i = l; i < QKD; i += 64) { mq = fmaxf(mq, fabsf(INF(I_g_mla_q)[i])); mk = fmaxf(mk, fabsf(INF(I_g_mla_k)[i])); }
#pragma unroll
      for (int o = 1; o < 64; o <<= 1) { mq = fmaxf(mq, shx(mq, o, l)); mk = fmaxf(mk, shx(mk, o, l)); }
      bound_mla = (float)QKD * mq * mk * 1.0001f; }
    for (int rp = 0; rp < rep_mla; ++rp)
    for (int un = F.vcu; un < NB * MH * 8; un += F.G) {
        const int bh = un >> 3, qb = un & 7, b = bh >> 3, h = bh & 7;
        const int s0 = qb * 256 + wave * 32, t0 = b * SEQ + s0, r32 = F.lane & 31;
        const float* qss = wsp<float>(F, WS_QSS) + ((size_t)(t0 + r32) * 8 + h) * 2;
        const float qscale = rsqrtf((qss[0] + qss[1]) * (1.0f / 96.0f) + EPS);
        attn::attn_unit_pipe<96>(F.lds, wsp<bf16_t>(F, WS_QM) + ((size_t)bh * SEQ + s0) * 96, 96, qscale,
                                 wsp<bf16_t>(F, WS_KM) + (size_t)bh * SEQ * 96, 96, wsp<bf16_t>(F, WS_VM) + (size_t)bh * SEQ * 64, 64,
                                 wsp<bf16_t>(F, WS_YNA) + (size_t)t0 * 1024 + 512 + h * 64, SEQ / 64, 0.10206207261596577f, bound_mla);
    }
#ifdef TSA
    if (blockIdx.x == TSWG && threadIdx.x == 0) { const unsigned long long t_ = __builtin_amdgcn_s_memrealtime(); ((LAS unsigned*)(F.lds + TAB_OFF + 2048))[40] = (unsigned)t_; ((LAS unsigned*)(F.lds + TAB_OFF + 2048))[41] = (unsigned)(t_ >> 32); }
#endif
    float bound_na;
    { int l = threadIdx.x & 63; asm volatile("" : "+v"(l)); float nq = fabsf(INF(I_g_na_q)[l]), nk = fabsf(INF(I_g_na_k)[l]), bm = 0.f;
      for (int i = l; i < NAH * 15 * 31; i += 64) bm = fmaxf(bm, fabsf(INF(I_na_rpb)[i]));
#pragma unroll
      for (int o = 1; o < 64; o <<= 1) { nq = fmaxf(nq, shx(nq, o, l)); nk = fmaxf(nk, shx(nk, o, l)); bm = fmaxf(bm, shx(bm, o, l)); }
      bound_na = (float)NAD * nq * nk * 1.0001f + 8.0f * bm; }
    for (int rp = 0; rp < rep_na; ++rp)
    for (int un = F.vcu; un < NB * NAH * 8; un += F.G) {
        const int bh = un >> 3, g = un & 7, b = bh >> 3, h = bh & 7;
        LAS float* tb = (LAS float*)(F.lds + attn::L_BIAS); LAS float* tm = (LAS float*)(F.lds + attn::L_MASK);
        for (int i = F.tid; i < 4 * 15 * 128; i += NTHR) { const int sft = i / (15 * 128), rr = (i / 128) % 15, ii = (i & 127) + sft - 48;
            tb[i] = (ii >= 0 && ii <= 30) ? INF(I_na_rpb)[(size_t)(h * 15 + rr) * 31 + ii] * 8.0f : 0.f; }
        for (int i = F.tid; i < 4 * 128; i += NTHR) { const int sft = i >> 7, dd = (i & 127) + sft - 56; tm[i] = (dd >= -8 && dd <= 7) ? 0.f : -1e30f; }
        int lo = 4 * g - 4; lo = lo < 0 ? 0 : (lo > 24 ? 24 : lo); int hi_s = 4 * g + 3 - 4; hi_s = hi_s < 0 ? 0 : (hi_s > 24 ? 24 : hi_s);
        const int ntiles = hi_s + 8 - lo;
        const int qrow = 4 * g + (wave >> 1); int rs = qrow - 4; rs = rs < 0 ? 0 : (rs > 24 ? 24 : rs);
        const int t0 = b * SEQ + qrow * 64 + 32 * (wave & 1);
        __syncthreads();
        attn::attn_unit<64, true>(F.lds, wsp<bf16_t>(F, WS_NAQ) + (size_t)t0 * 512 + h * 64, 512, 1.0f,
                                  wsp<bf16_t>(F, WS_NAK) + (size_t)(b * SEQ + lo * 64) * 512 + h * 64, 512, wsp<bf16_t>(F, WS_NAV) + (size_t)(b * SEQ + lo * 64) * 512 + h * 64, 512,
                                  wsp<bf16_t>(F, WS_YNA) + (size_t)t0 * 1024 + h * 64, ntiles, 0.125f, bound_na, rs - lo, 32 * (wave & 1), lo - qrow);
    }
}
namespace moe {
#define RFL(x) __builtin_amdgcn_readfirstlane(x)
constexpr int ASTRB = 2064;
constexpr int L_AHI = 0, L_ALO = 16 * ASTRB, L_LG = 32 * ASTRB, L_END = L_LG + 2 * 16 * 64 * 4;
constexpr int T_CNT = 0, T_ABASE = 128, T_YBASE = 200, T_PRE = 336, T_MBOX = 340;
constexpr bool DYNQ = false;
constexpr int CW_Q = 20480;

__device__ __forceinline__ void s7_router(Frame& F, const Args& A, int rep_conv, int rep_rt) {
    const int lane = F.lane, wave = F.wave;
    const float* mod = wsp<float>(F, WS_MOD); unsigned char* H2 = wsp<unsigned char>(F, WS_H2);
    LAS unsigned char* Ahi = F.lds + L_AHI; LAS unsigned char* Alo = F.lds + L_ALO; LAS float* LG = (LAS float*)(F.lds + L_LG);
    const u32x4* rfrag = wsp<u32x4>(F, WS_RFRAG);
    int* LIST = wsp<int>(F, WS_LIST); float* WLIST = wsp<float>(F, WS_WLIST); unsigned* TOKSLOT = wsp<unsigned>(F, WS_TOKSLOT);
    LAS unsigned* pe = (LAS unsigned*)(F.lds + 81920);
    LAS float* pw = (LAS float*)(F.lds + 81920 + 4096);
    LAS unsigned* lcnt = (LAS unsigned*)(F.lds + 81920 + 8192);
    if (F.tid < 128) lcnt[F.tid] = 0u;
    __syncthreads();
    int ulocal = 0;
#ifdef TSA
#define RT_ACC(k) do { if (blockIdx.x == TSWG && threadIdx.x == 0) { const unsigned long long t_ = __builtin_amdgcn_s_memrealtime(); LAS unsigned* q_ = (LAS unsigned*)(F.lds + TAB_OFF + 2048); const unsigned long long d_ = t_ - rt_prev; unsigned long long a_ = ((unsigned long long)q_[2 * (k) + 1] << 32) | q_[2 * (k)]; a_ += d_; q_[2 * (k)] = (unsigned)a_; q_[2 * (k) + 1] = (unsigned)(a_ >> 32); rt_prev = t_; } } while (0)
    unsigned long long rt_prev = __builtin_amdgcn_s_memrealtime();
    if (blockIdx.x == TSWG && threadIdx.x == 0) { LAS unsigned* q_ = (LAS unsigned*)(F.lds + TAB_OFF + 2048); for (int k = 48; k < 64; ++k) q_[k] = 0u; }
#else
#define RT_ACC(k) do {} while (0)
#endif
    for (int rp = 0; rp < rep_rt; ++rp)
    for (int un = F.vcu; un < NT / 16; un += F.G) {
        const bool dry = rp + 1 < rep_rt;
        const int row0 = un * 16, b = row0 >> 11;
        const u32x4* bp = rfrag + ((size_t)((wave & 3) * 32 + 16 * (wave >> 2)) * 64 + lane) * 2;
        u32x4 bA[8][2], bB[8][2];
#pragma unroll
        for (int jj = 0; jj < 8; ++jj) { bA[jj][0] = bp[(size_t)jj * 128]; bA[jj][1] = bp[(size_t)jj * 128 + 1]; }
        SBAR();
        {
            f32x4 v[2][4], cg[4], csh[4];
#pragma unroll
            for (int rr = 0; rr < 2; ++rr)
#pragma unroll
                for (int j = 0; j < 4; ++j) v[rr][j] = *(const f32x4*)(F.out + (size_t)(row0 + 2 * wave + rr) * DM + 4 * lane + 256 * j);
#pragma unroll
            for (int j = 0; j < 4; ++j) { const int c4 = 4 * lane + 256 * j;
                cg[j] = *(const f32x4*)(INF(I_g_norm2) + c4) * (*(const f32x4*)(mod + (size_t)b * 6144 + 4096 + c4) + 1.0f); csh[j] = *(const f32x4*)(mod + (size_t)b * 6144 + 3072 + c4); }
#pragma unroll
            for (int rr = 0; rr < 2; ++rr) { const int lr = 2 * wave + rr, row = row0 + lr; float ss = 0.f;
#pragma unroll
                for (int j = 0; j < 4; ++j) ss += sq4(v[rr][j]);
                const float rstd = rsqrtf(wave_sum(ss) * (1.0f / DM) + EPS);
#pragma unroll
                for (int j = 0; j < 4; ++j) { const int c4 = 4 * lane + 256 * j;
                    const f32x4 o = v[rr][j] * rstd * cg[j] + csh[j];
                    *(unsigned*)(H2 + (size_t)row * DM + c4) = cvt4_fp8(o, 1.0f);
                    u32x2 hw; hw.x = cvt_pk_bf16(o[0], o[1]); hw.y = cvt_pk_bf16(o[2], o[3]);
                    const f32x4 rem = o - (f32x4){bflo(hw.x), bfhi(hw.x), bflo(hw.y), bfhi(hw.y)};
                    u32x2 lw; lw.x = cvt_pk_bf16(rem[0], rem[1]); lw.y = cvt_pk_bf16(rem[2], rem[3]);
                    *(LAS u32x2*)(Ahi + lr * ASTRB + c4 * 2) = hw; *(LAS u32x2*)(Alo + lr * ASTRB + c4 * 2) = lw; } }
        }
        __syncthreads(); RT_ACC(24);
        {
            const int ct = wave & 3, kh = wave >> 2; f32x4 acc = {0.f, 0.f, 0.f, 0.f};
            const int aoffb = (lane & 15) * ASTRB + (512 * kh + 8 * (lane >> 4)) * 2;
#pragma unroll
            for (int jj = 0; jj < 8; ++jj) { bB[jj][0] = bp[(size_t)(8 + jj) * 128]; bB[jj][1] = bp[(size_t)(8 + jj) * 128 + 1]; }
            SBAR();
#define RT_STEP(BF, sidx) do { const bf16x8 ah = *(const LAS bf16x8*)(Ahi + aoffb + (sidx) * 64), al = *(const LAS bf16x8*)(Alo + aoffb + (sidx) * 64); \
                const bf16x8 bh = __builtin_bit_cast(bf16x8, BF[0]), bl = __builtin_bit_cast(bf16x8, BF[1]); \
                acc = __builtin_amdgcn_mfma_f32_16x16x32_bf16(ah, bh, acc, 0, 0, 0); acc = __builtin_amdgcn_mfma_f32_16x16x32_bf16(al, bh, acc, 0, 0, 0); acc = __builtin_amdgcn_mfma_f32_16x16x32_bf16(ah, bl, acc, 0, 0, 0); } while (0)
#pragma unroll
            for (int jj = 0; jj < 8; ++jj) { RT_STEP(bA[jj], jj); if ((jj & 3) == 3) SBAR(); }
#pragma unroll
            for (int jj = 0; jj < 8; ++jj) { RT_STEP(bB[jj], 8 + jj); if ((jj & 3) == 3) SBAR(); }
#undef RT_STEP
#pragma unroll
            for (int r = 0; r < 4; ++r) LG[(kh * 16 + 4 * (lane >> 4) + r) * 64 + 16 * ct + (lane & 15)] = acc[r];
        }
        __syncthreads(); RT_ACC(25);
#pragma unroll 1
        for (int rr = 0; rr < 2; ++rr) {
            const int lr = 2 * wave + rr, tok = row0 + lr;
            const float logit = LG[lr * 64 + lane] + LG[(16 + lr) * 64 + lane];
            const float score = 1.0f / (1.0f + expf(-logit));
            const float sel = score + INF(I_e_bias)[lane];
            const int l_ = lane_fresh(); float m1 = sel; m1 = fmaxf(m1, shx(m1, 1, l_)); m1 = fmaxf(m1, shx(m1, 2, l_)); m1 = fmaxf(m1, shx(m1, 4, l_));
            const unsigned long long bm = __ballot(sel == m1);
            const unsigned gb = (unsigned)(bm >> (lane & ~7)) & 0xffu; const int first = __ffs((int)gb) - 1;
            float m2 = ((lane & 7) == first) ? -INFINITY : sel; m2 = fmaxf(m2, shx(m2, 1, l_)); m2 = fmaxf(m2, shx(m2, 2, l_)); m2 = fmaxf(m2, shx(m2, 4, l_));
            const float gs = m1 + m2; int grank = 0;
            { const unsigned ub = __float_as_uint(gs), uo = (ub & 0x80000000u) ? ~ub : (ub | 0x80000000u);
              const unsigned long long key = ((unsigned long long)uo << 8) | (unsigned)(7 - (lane >> 3));
#pragma unroll
              for (int q = 0; q < 8; ++q) { const unsigned long long ok = ((unsigned long long)(unsigned)__builtin_amdgcn_readlane((int)(key >> 32), 8 * q) << 32) | (unsigned)__builtin_amdgcn_readlane((int)(unsigned)key, 8 * q); grank += ok > key ? 1 : 0; } }
            const bool gsel = grank < TOPKG; const float sm = gsel ? sel : -INFINITY; int rank = 0;
            { const unsigned ub = __float_as_uint(sm), uo = (ub & 0x80000000u) ? ~ub : (ub | 0x80000000u);
              const unsigned long long key = ((unsigned long long)uo << 8) | (unsigned)(63 - lane);
              const int khi = (int)(key >> 32), klo = (int)(unsigned)key;
#pragma unroll
              for (int q = 0; q < 64; ++q) { const unsigned long long ok = ((unsigned long long)(unsigned)__builtin_amdgcn_readlane(khi, q) << 32) | (unsigned)__builtin_amdgcn_readlane(klo, q); rank += ok > key ? 1 : 0; } }
            const bool chosen = gsel && rank < TOPK;
            const float wsum = wave_sum(chosen ? score : 0.f);
            const float w = score / wsum * 2.5f;
            if (chosen && !dry) { const unsigned lp = __hip_atomic_fetch_add(lcnt + lane, 1u, __ATOMIC_RELAXED, __HIP_MEMORY_SCOPE_WORKGROUP);
                const int pi = ((ulocal * 16 + lr) * 8 + rank) & 1023; pe[pi] = ((unsigned)lane << 16) | lp; pw[pi] = w; }
        }
        if (!dry) ++ulocal;
        __syncthreads(); RT_ACC(26);
    }
    if (F.tid < 64) { const unsigned n = lcnt[F.tid]; lcnt[64 + F.tid] = n ? __hip_atomic_fetch_add((unsigned*)F.ctl + CW_CNT + (F.tid * 2) * 16, n, RLX_AGENT) : 0u; }
    __syncthreads();
    for (int pi = F.tid; pi < ulocal * 128; pi += NTHR) {
        const int ul = pi >> 7, lr = (pi >> 3) & 15, rank = pi & 7, tok = (F.vcu + ul * F.G) * 16 + lr;
        const unsigned v = pe[pi], e = v >> 16, pos = lcnt[64 + e] + (v & 0xffffu);
        LIST[(size_t)(e * 2) * 8192 + pos] = tok; WLIST[(size_t)(e * 2) * 8192 + pos] = pw[pi]; TOKSLOT[(size_t)tok * 8 + rank] = (e << 16) | pos; }
    __syncthreads(); RT_ACC(27);
#ifdef TSA
    if (blockIdx.x == TSWG && threadIdx.x == 0) { const unsigned long long t_ = __builtin_amdgcn_s_memrealtime(); ((LAS unsigned*)(F.lds + TAB_OFF + 2048))[42] = (unsigned)t_; ((LAS unsigned*)(F.lds + TAB_OFF + 2048))[43] = (unsigned)(t_ >> 32); }
#endif
    LAS float* scr = (LAS float*)(F.lds + wave * 16384);
    const int gw = F.vcu * NWAVES + wave, NGW = F.G * NWAVES;
    for (int rp = 0; rp < rep_conv; ++rp)
    for (int it = gw; it < 65 * 384; it += NGW) {
        const int e = it / 384, r = it % 384;
        const float* wg = e < 64 ? INF(I_w_eg) + (size_t)e * DM * EFF : INF(I_w_sg); const float* wu = e < 64 ? INF(I_w_eu) + (size_t)e * DM * EFF : INF(I_w_su); const float* wd = e < 64 ? INF(I_w_ed) + (size_t)e * EFF * DM : INF(I_w_sd);
        if (r < 128) transpose_item_fp8(wg, DM, EFF, wsp<unsigned char>(F, WS_WGU) + (size_t)e * 512 * DM, MapGU{0}, WGU_SCALE, scr, r, lane);
        else if (r < 256) transpose_item_fp8(wu, DM, EFF, wsp<unsigned char>(F, WS_WGU) + (size_t)e * 512 * DM, MapGU{1}, WGU_SCALE, scr, r - 128, lane);
        else transpose_item_fp8(wd, EFF, DM, wsp<unsigned char>(F, WS_WD) + (size_t)e * DM * EFF, MapOff{0}, WD_SCALE, scr, r - 256, lane);
    }
}

__device__ __forceinline__ void build_tables(Frame& F) {
    LAS int* tab = (LAS int*)(F.lds + TAB_OFF);
    if (F.tid < 128) tab[T_CNT + F.tid] = (int)__hip_atomic_load((unsigned*)F.ctl + CW_CNT + F.tid * 16, RLX_AGENT);
    __syncthreads();
    if (F.tid < 64) { const int e = F.tid; const int c0 = tab[T_CNT + 2 * e], c1 = tab[T_CNT + 2 * e + 1];
        int a = c0 + c1, y0 = c0, y1 = c1;
#pragma unroll
        for (int o = 1; o < 64; o <<= 1) { const int ta = shup_i(a, o, e), t0 = shup_i(y0, o, e), t1 = shup_i(y1, o, e); if (e >= o) { a += ta; y0 += t0; y1 += t1; } }
        tab[T_ABASE + e] = a - (c0 + c1); tab[T_YBASE + e] = y0 - c0; tab[T_YBASE + 64 + e] = y1 - c1; if (e == 63) tab[T_ABASE + 64] = a; }
    if (F.tid == 64) { tab[T_MBOX] = 0; tab[T_MBOX + 1] = 0; }
    __syncthreads();
}

struct GateUpSched {
    const LAS int* tab; const unsigned char* wgu; const int* list; int x, j, per;
    unsigned* qc; LAS int* mbox; unsigned pend;
    __device__ __forceinline__ int unit_index(int i) const { return (!DYNQ || i < 2) ? i * per + j : RFL(mbox[i & 1]); }
    __device__ __forceinline__ void grab() { if (DYNQ) if (RFL((int)(threadIdx.x >> 6)) == 0 && (threadIdx.x & 63) == 0) pend = __hip_atomic_fetch_add(qc, 1u, RLX_AGENT); }
    __device__ __forceinline__ void publish(int wid) { if (DYNQ) if (wid == 0) { if ((threadIdx.x & 63) == 0) mbox[nslot] = (int)(2 * per + pend); LDS_WAIT(); } nslot ^= 1; }
    int nslot;
    __device__ void init(Frame& F) { tab = (const LAS int*)(F.lds + TAB_OFF); wgu = wsp<unsigned char>(F, WS_WGU); list = wsp<int>(F, WS_LIST); x = (int)blockIdx.x % 8; j = (int)blockIdx.x / 8; per = F.G / 8;
        qc = (unsigned*)F.ctl + CW_Q + (0 * 8 + x) * 16; mbox = (LAS int*)(F.lds + TAB_OFF) + T_MBOX; pend = 0; nslot = 0; }
    __device__ bool next(int i, pg8::Unit& u) {
        const int L = unit_index(i);
        int k = -1, base = 0, a = 0;
#pragma unroll
        for (int q = 0; q < 8; ++q) { const int e = x + 8 * q; const int na = a + ((RFL(tab[T_CNT + 2 * e]) + RFL(tab[T_CNT + 2 * e + 1]) + 255) >> 8) * 2; if (k < 0 && L < na) { k = q; base = a; } a = na; }
        if (k >= 0) {
            if (i >= 1) grab();
            const int e = x + 8 * k, r = L - base, mt = r >> 1, pn = r & 1, n0 = RFL(tab[T_CNT + 2 * e]), ntot = n0 + RFL(tab[T_CNT + 2 * e + 1]);
            u.B = (const char*)(wgu + ((size_t)e * 512 + pn * 256) * DM); u.m0 = mt * 256; u.pn = pn; u.e = e; u.nrows = (ntot - mt * 256) < 256 ? (ntot - mt * 256) : 256;
            u.orow0 = RFL(tab[T_ABASE + e]) + mt * 256; u.l0 = list + (size_t)(2 * e) * 8192; u.l1 = list + (size_t)(2 * e + 1) * 8192; u.n0 = n0; u.ntot = ntot; return true; }
        const int r = L - a; if (r >= 16) return false;
        if (i >= 1) grab();
        const int mt = x + 8 * (r >> 1), pn = r & 1;
        u.B = (const char*)(wgu + ((size_t)64 * 512 + pn * 256) * DM); u.m0 = mt * 256; u.pn = pn; u.e = 64; u.nrows = 256; u.orow0 = ACT_SHARED_ROW0 + mt * 256; u.l0 = nullptr; u.l1 = nullptr; u.n0 = 0; u.ntot = 0; return true;
    }
};
struct DownSched {
    const LAS int* tab; const unsigned char* wd; const int* tab0; int x, j, per, c;
    unsigned* qc; LAS int* mbox; unsigned pend;
    __device__ __forceinline__ int unit_index(int i) const { return (!DYNQ || i < 2) ? i * per + j : RFL(mbox[i & 1]); }
    __device__ __forceinline__ void grab() { if (DYNQ) if (RFL((int)(threadIdx.x >> 6)) == 0 && (threadIdx.x & 63) == 0) pend = __hip_atomic_fetch_add(qc, 1u, RLX_AGENT); }
    __device__ __forceinline__ void publish(int wid) { if (DYNQ) if (wid == 0) { if ((threadIdx.x & 63) == 0) mbox[nslot] = (int)(2 * per + pend); LDS_WAIT(); } nslot ^= 1; }
    int nslot;
    __device__ void init(Frame& F, int c_) { tab = (const LAS int*)(F.lds + TAB_OFF); wd = wsp<unsigned char>(F, WS_WD); tab0 = wsp<int>(F, WS_LIST); x = (int)blockIdx.x % 8; j = (int)blockIdx.x / 8; per = F.G / 8; c = c_;
        qc = (unsigned*)F.ctl + CW_Q + ((1 + c_) * 8 + x) * 16; mbox = (LAS int*)(F.lds + TAB_OFF) + T_MBOX; pend = 0; nslot = 0; }
    __device__ bool next(int i, pg8::Unit& u) {
        const int L = unit_index(i);
        u.l0 = nullptr; u.l1 = nullptr; u.n0 = 0; u.ntot = 0;
        const float* wlist = (const float*)((const char*)tab0 + (WS_WLIST - WS_LIST));
        int k = -1, base = 0, a = 0;
#pragma unroll
        for (int q = 0; q < 8; ++q) { const int e = x + 8 * q; const int na = a + ((RFL(tab[T_CNT + 2 * e + c]) + 255) >> 8) * 4; if (k < 0 && L < na) { k = q; base = a; } a = na; }
        if (k >= 0) {
            if (i >= 1) grab();
            const int e = x + 8 * k, r = L - base, mt = r >> 2, pn = r & 3, n = RFL(tab[T_CNT + 2 * e + c]);
            u.B = (const char*)(wd + ((size_t)e * DM + pn * 256) * EFF); u.m0 = RFL(tab[T_ABASE + e]) + (c ? RFL(tab[T_CNT + 2 * e]) : 0) + mt * 256; u.pn = pn; u.e = e;
            u.nrows = (n - mt * 256) < 256 ? (n - mt * 256) : 256; u.orow0 = RFL(tab[T_YBASE + 64 * c + e]) + mt * 256; u.l1 = (const int*)(wlist + (size_t)(2 * e + c) * 8192 + mt * 256); return true; }
        const int r = L - a; if (r >= (CHTOK / 256 / 8) * 4) return false;
        if (i >= 1) grab();
        const int mt = x + 8 * (r >> 2), pn = r & 3;
        u.B = (const char*)(wd + ((size_t)64 * DM + pn * 256) * EFF); u.m0 = ACT_SHARED_ROW0 + c * CHTOK + mt * 256; u.pn = pn; u.e = 64; u.nrows = 256; u.orow0 = YS_SHARED_ROW0 + mt * 256; return true;
    }
};

__device__ __forceinline__ void combine(Frame& F, int c, bool dry) {
    const LAS int* tab = (const LAS int*)(F.lds + TAB_OFF);
    const int lane = F.lane, gw = F.vcu * NWAVES + F.wave, NGW = F.G * NWAVES;
    const unsigned char* ys = wsp<unsigned char>(F, WS_YS); const unsigned* TOKSLOT = wsp<unsigned>(F, WS_TOKSLOT); const float* mod = wsp<float>(F, WS_MOD);
    for (int tl = gw; tl < CHTOK; tl += NGW) {
        const int t = c * CHTOK + tl, b = t >> 11;
        int yr[9];
#pragma unroll
        for (int k = 0; k < 8; ++k) { const unsigned s = TOKSLOT[(size_t)t * 8 + k]; yr[k] = tab[T_YBASE + 64 * c + (int)(s >> 16)] + (int)(s & 0xffffu); }
        yr[8] = YS_SHARED_ROW0 + tl;
        u32x4 w[9];
#pragma unroll
        for (int k = 0; k < 9; ++k) w[k] = __builtin_nontemporal_load((const u32x4*)(ys + (size_t)yr[k] * 1024 + 16 * lane));
        f32x4 s[4];
#pragma unroll
        for (int q = 0; q < 4; ++q) s[q] = (f32x4){0.f, 0.f, 0.f, 0.f};
#pragma unroll
        for (int k = 0; k < 9; ++k) {
#pragma unroll
            for (int q = 0; q < 4; ++q) { const auto lo = __builtin_amdgcn_cvt_pk_f32_fp8((int)w[k][q], false), hi = __builtin_amdgcn_cvt_pk_f32_fp8((int)w[k][q], true);
                s[q] += (f32x4){lo[0], lo[1], hi[0], hi[1]}; } }
#pragma unroll
        for (int q = 0; q < 4; ++q) { const int c4 = 16 * lane + 4 * q;
            const f32x4 x1 = *(const f32x4*)(F.out + (size_t)t * DM + c4), g2 = *(const f32x4*)(mod + (size_t)b * 6144 + 5120 + c4);
            float* dst = dry ? (float*)(F.ws + WS_B + 253 * MiB) + (((size_t)t * DM + c4) & ((1u << 21) - 1)) : F.out + (size_t)t * DM + c4;
            *(f32x4*)dst = x1 + g2 * (s[q] * (1.0f / YS_SCALE)); }
    }
}
}
#ifndef PHMASK
#define PHMASK 0xffff
#endif
#define PH(k) ((PHMASK >> (k)) & 1)
#ifndef REPMASK
#define REPMASK 0
#endif
#ifndef XBAR
#define XBAR 0
#endif
#ifndef BARMASK
#define BARMASK 0
#endif
#define REP(k) for (int rep_ = 0; rep_ < 1 + ((REPMASK >> (k)) & 1); ++rep_)
#define MIDBAR(k) do { if (((BARMASK >> (k)) & 1) && rep_ == 0) GRID_BAR(); } while (0)

__global__ void __launch_bounds__(NTHR, 2) fwd_megakernel(Args args) {
    const Args& A = args;
    extern __shared__ __attribute__((aligned(16))) unsigned char lds_raw[];
    Frame F;
    F.lds = (LAS unsigned char*)lds_raw;
    F.MISC = (volatile LAS unsigned*)(F.lds + MISC_OFF);
    F.tid = threadIdx.x; F.lane = F.tid & 63; F.wave = __builtin_amdgcn_readfirstlane(F.tid >> 6);
    F.G = gridDim.x; { const int bx = blockIdx.x; F.vcu = (F.G % 8 == 0) ? (bx % 8) * (F.G / 8) + bx / 8 : bx; }
    F.ws = args.ws; F.ctl = (gu32*)(args.ws + WS_CTL); F.out = args.out;
    for (int u = F.tid; u < (LDS_BYTES - LDSCTL_OFF) / 4; u += NTHR) ((LAS unsigned*)(F.lds + LDSCTL_OFF))[u] = 0u;
    __syncthreads();
    XcdBarrier bar = xcd_barrier_post((unsigned*)(F.ctl + CW_BAR), F.MISC + 8);
#ifdef TSA
#define STAMP(k) do { if (blockIdx.x == TSWG && threadIdx.x == 0) { const unsigned long long t_ = __builtin_amdgcn_s_memrealtime(); ((LAS unsigned*)(F.lds + TAB_OFF + 2048))[2 * (k)] = (unsigned)t_; ((LAS unsigned*)(F.lds + TAB_OFF + 2048))[2 * (k) + 1] = (unsigned)(t_ >> 32); } } while (0)
#else
#define STAMP(k) do {} while (0)
#endif
#ifndef TSWG
#define TSWG 0
#endif
    int nbar_ = 0;
#define GRID_BAR() do { xcd_barrier(bar); F.refresh(); ++nbar_; STAMP(nbar_); } while (0)
    const int bx = (int)blockIdx.x;
    STAMP(0);

    REP(0) if (PH(0)) p0_prologue(F, args);
    for (int xb = 0; xb < XBAR; ++xb) GRID_BAR();
    GRID_BAR();
    REP(1) if (PH(1)) { p0_copies(F, args); s1_modnorm(F, args); }
#ifdef WSPROBE
    for (int q = 0; q < args.nrep; ++q) s1_modnorm(F, args);
#endif
    GRID_BAR();
    REP(2) if (PH(2)) {
        pg8::Gemm g{wsp<bf16_t>(F, WS_H), DM, DM}; pg8::DenseSched S; S.init(NT, INPAD, DM, wsp<bf16_t>(F, WS_WIN), F.G, bx);
        epi::EpiInProj E{wsp<bf16_t>(F, WS_NAQ), wsp<bf16_t>(F, WS_NAK), wsp<bf16_t>(F, WS_NAV), wsp<bf16_t>(F, WS_QLAT), wsp<bf16_t>(F, WS_KVLAT), wsp<bf16_t>(F, WS_SGNA), wsp<bf16_t>(F, WS_SGMLA),
                          wsp<float>(F, WS_KROT), wsp<float>(F, WS_QSQ), wsp<float>(F, WS_KVSQ), INF(I_g_na_q), INF(I_g_na_k), wsp<float>(F, WS_RCOS), wsp<float>(F, WS_RSIN)};
        pg8::gemm_phase<epi::EpiInProj, pg8::DenseSched, false>(F.lds, g, S, E);
        MIDBAR(2);
    }
    GRID_BAR();
    REP(3) if (PH(3)) {
        pg8::Gemm g{wsp<bf16_t>(F, WS_QLAT), QRANK, QRANK}; pg8::DenseSched S; S.init(NT, MH * QKD, QRANK, wsp<bf16_t>(F, WS_WUQ), F.G, bx);
        epi::EpiUpQ E{wsp<bf16_t>(F, WS_QM), wsp<float>(F, WS_QSS), wsp<float>(F, WS_QSQ), INF(I_g_mla_q), wsp<float>(F, WS_RCOS), wsp<float>(F, WS_RSIN)};
        pg8::gemm_phase<epi::EpiUpQ, pg8::DenseSched, false>(F.lds, g, S, E);
    }
    REP(3) if (PH(4)) {
        pg8::Gemm g{wsp<bf16_t>(F, WS_KVLAT), KVRANK, KVRANK}; pg8::DenseSched S; S.init(NT, MH * 128, KVRANK, wsp<bf16_t>(F, WS_WUKV), F.G, bx);
        epi::EpiUpKV E{wsp<bf16_t>(F, WS_KM), wsp<bf16_t>(F, WS_VM), wsp<float>(F, WS_KVSQ), wsp<float>(F, WS_KROT), INF(I_g_mla_k)};
        pg8::gemm_phase<epi::EpiUpKV, pg8::DenseSched, false>(F.lds, g, S, E);
    }
    GRID_BAR();
    if (PH(5)) s4_attention(F, args, 1 + ((REPMASK >> 4) & 1), 1 + ((REPMASK >> 5) & 1));
    GRID_BAR();
    REP(6) if (PH(6)) {
        pg8::Gemm g{wsp<bf16_t>(F, WS_YNA), DM, DM}; pg8::DenseSched S; S.init(NT, 2048, DM, wsp<bf16_t>(F, WS_WPCAT), F.G, bx);
        epi::EpiMergeCat E{wsp<bf16_t>(F, WS_SGNA), wsp<bf16_t>(F, WS_SGMLA), wsp<bf16_t>(F, WS_MERGED)};
        pg8::gemm_phase<epi::EpiMergeCat, pg8::DenseSched, false, false, true>(F.lds, g, S, E);
    }
    GRID_BAR();
    REP(8) if (PH(8)) {
        pg8::Gemm g{wsp<bf16_t>(F, WS_MERGED), DM, DM}; pg8::DenseSched S; S.init(NT, DM, DM, wsp<bf16_t>(F, WS_WOUT), F.G, bx);
        epi::EpiOut E{INF(I_x), F.out, wsp<float>(F, WS_MOD)};
        pg8::gemm_phase<epi::EpiOut, pg8::DenseSched, false>(F.lds, g, S, E);
    }
    GRID_BAR();
    if (PH(9)) moe::s7_router(F, args, 1 + ((REPMASK >> 9) & 1), 1 + ((REPMASK >> 13) & 1));
    GRID_BAR();
    moe::build_tables(F);
    REP(10) if (PH(10)) {
        pg8::Gemm g{wsp<bf16_t>(F, WS_H2), DM / 2, DM / 2}; moe::GateUpSched S; S.init(F);
        epi::EpiGateUp E{wsp<unsigned char>(F, WS_ACT)};
        pg8::gemm_phase<epi::EpiGateUp, moe::GateUpSched, true, true>(F.lds, g, S, E);
        MIDBAR(10);
    }
    GRID_BAR();
#pragma unroll 1
    for (int c = 0; c < NCHUNK; ++c) {
        for (int rep_ = 0; rep_ < 1 + (((REPMASK >> 11) | (REPMASK >> 14)) & 1); ++rep_) if (PH(11)) {
            pg8::Gemm g{wsp<bf16_t>(F, WS_ACT), EFF / 2, EFF / 2}; moe::DownSched S; S.init(F, c);
            epi::EpiDown E{wsp<unsigned char>(F, WS_YS), ((REPMASK >> 14) & 1) && rep_ == 0};
            pg8::gemm_phase<epi::EpiDown, moe::DownSched, true, true>(F.lds, g, S, E);
            MIDBAR(11);
        }
        GRID_BAR();
        if ((REPMASK >> 12) & 1) moe::combine(F, c, true);
        if (PH(12)) moe::combine(F, c, false);
        if (c + 1 < NCHUNK) GRID_BAR();
    }
#ifdef TSA
    __syncthreads(); STAMP(11);
    if (blockIdx.x == TSWG && threadIdx.x == 0) { LAS unsigned* tsb = (LAS unsigned*)(F.lds + TAB_OFF + 2048);
        const unsigned long long ta = ((unsigned long long)tsb[2 * TSA + 1] << 32) | tsb[2 * TSA], tb = ((unsigned long long)tsb[2 * TSB + 1] << 32) | tsb[2 * TSB];
#ifdef TSD
        const unsigned long long dl = (((unsigned long long)tsb[2 * TSD + 1] << 32) | tsb[2 * TSD]) * TSMULT,
#else
        const unsigned long long dl = (tb - ta) * TSMULT,
#endif
        t0 = __builtin_amdgcn_s_memrealtime();
        while (__builtin_amdgcn_s_memrealtime() - t0 < dl) __builtin_amdgcn_s_sleep(8); }
#endif
}

extern "C" void kernel_launch(void* const* d_in, const int* in_sizes, int n_in, void* d_out, int out_size, void* d_ws, size_t ws_size, hipStream_t stream) {
    static int grid = 0;
    if (grid == 0) {
        if (n_in != 28 || out_size != NT * DM || ws_size < WS_END) { fprintf(stderr, "kernel_launch: unexpected shapes: n_in %d out %d ws %zu (need %zu)\n", n_in, out_size, ws_size, (size_t)WS_END); grid = -1; return; }
        int dev = 0, cus = 0, per_cu = 0;
        if (hipGetDevice(&dev) != hipSuccess || hipDeviceGetAttribute(&cus, hipDeviceAttributeMultiprocessorCount, dev) != hipSuccess) { grid = -1; return; }
        if (hipFuncSetAttribute((const void*)fwd_megakernel, hipFuncAttributeMaxDynamicSharedMemorySize, LDS_BYTES) != hipSuccess) { fprintf(stderr, "kernel_launch: hipFuncSetAttribute failed\n"); grid = -1; return; }
        if (hipOccupancyMaxActiveBlocksPerMultiprocessor(&per_cu, (const void*)fwd_megakernel, NTHR, LDS_BYTES) != hipSuccess || per_cu < 1) { fprintf(stderr, "kernel_launch: occupancy query says %d blocks/CU\n", per_cu); (void)hipGetLastError(); }
        grid = cus;
        if (grid != 256) fprintf(stderr, "kernel_launch: %d CUs (expected 256)\n", grid);
    }
    if (grid < 0) return;
    if (hipMemsetAsync((char*)d_ws + WS_CTL, 0, CTL_ZERO_BYTES, stream) != hipSuccess) { fprintf(stderr, "kernel_launch: memset failed\n"); return; }
    Args a{};
    for (int i = 0; i < 28; ++i) a.in[i] = d_in[i];
    a.out = (float*)d_out; a.ws = (unsigned char*)d_ws;
#ifdef WSPROBE
    a.nrep = (int)(ws_size >> 26); a.pad = 0;
#endif
    void* kargs[] = {&a};
    const hipError_t le = hipLaunchCooperativeKernel((const void*)fwd_megakernel, dim3(grid), dim3(NTHR), kargs, LDS_BYTES, stream);
    if (le != hipSuccess) fprintf(stderr, "kernel_launch: cooperative launch failed: %s (grid %d)\n", hipGetErrorName(le), grid);
}
```

```cpp
#include <hip/hip_runtime.h>
#include <cstdio>
#include <cstdint>
#include <cmath>

#define GAS __attribute__((address_space(1)))
#define LAS __attribute__((address_space(3)))
typedef unsigned short bf16_t;
typedef short bf16x8 __attribute__((ext_vector_type(8)));
typedef short s16x4 __attribute__((ext_vector_type(4)));
typedef float f32x4 __attribute__((ext_vector_type(4)));
typedef float f32x2 __attribute__((ext_vector_type(2)));
typedef float f32x16 __attribute__((ext_vector_type(16)));
typedef unsigned u32x4 __attribute__((ext_vector_type(4)));
typedef int i32x4 __attribute__((ext_vector_type(4)));
typedef unsigned u32x2 __attribute__((ext_vector_type(2)));
typedef GAS unsigned gu32;

constexpr int DM = 1024, NB = 8, SEQ = 2048, NT = NB * SEQ;
constexpr int NAH = 8, NAD = 64, GRIDW = 64, GRIDR = SEQ / GRIDW;
constexpr int MH = 8, QRANK = 256, KVRANK = 128, NOPE = 64, ROPE = 32, VD = 64, QKD = 96;
constexpr int NEXP = 64, TOPK = 8, NGRP = 8, TOPKG = 4, EFF = 256;
constexpr float EPS = 1e-6f;
constexpr int INCOLS = 4000, INPAD = 4096;
constexpr int NCHUNK = 1, CHTOK = NT / NCHUNK;
constexpr float YS_SCALE = 16.0f;
constexpr float WGU_SCALE = 64.0f, ACT_SCALE = 16.0f, WD_SCALE = 32.0f;
constexpr int NWAVES = 8, NTHR = 512;

constexpr size_t MiB = 1u << 20;
constexpr size_t WS_CTL = 0, CTL_ZERO_BYTES = 128 * 1024;
constexpr size_t WS_MOD   = 1 * MiB;
constexpr size_t WS_RCOS  = WS_MOD + 256 * 1024;
constexpr size_t WS_RSIN  = WS_RCOS + 1 * MiB;
constexpr size_t WS_RFRAG = WS_RSIN + 1 * MiB;
constexpr size_t WS_QSQ   = WS_RFRAG + 256 * 1024;
constexpr size_t WS_KVSQ  = WS_QSQ + 256 * 1024;
constexpr size_t WS_QSS   = WS_KVSQ + 256 * 1024;
constexpr size_t WS_TOKSLOT = WS_QSS + 1 * MiB;
constexpr size_t WS_LIST  = 6 * MiB;
constexpr size_t WS_WLIST = 10 * MiB;
constexpr size_t WS_WIN   = 292 * MiB;
constexpr size_t WS_WUQ   = 22 * MiB;
constexpr size_t WS_WUKV  = WS_WUQ + 512 * 1024;
constexpr size_t WS_WPNA  = 23 * MiB;
constexpr size_t WS_WPMLA = 24 * MiB;
constexpr size_t WS_WOUT  = 25 * MiB;
constexpr size_t WS_KROT  = 27 * MiB;
constexpr size_t WS_B     = 30 * MiB;
constexpr float WIN_SCALE = 64.0f, MG_SCALE = 16.0f, WOUT_SCALE = 64.0f, Y_SCALE = 32.0f, WP_SCALE = 32.0f;
constexpr int LDH = DM + 64, LDW = DM + 64;
constexpr size_t WS_H     = WS_B + 201 * MiB;
constexpr size_t WS_QM    = WS_B + 0 * MiB;
constexpr size_t WS_NAQ   = WS_B + 32 * MiB;
constexpr size_t WS_NAK   = WS_B + 48 * MiB;
constexpr size_t WS_NAV   = WS_B + 64 * MiB;
constexpr size_t WS_QLAT  = WS_B + 80 * MiB;
constexpr size_t WS_KVLAT = WS_B + 88 * MiB;
constexpr size_t WS_SGNA  = WS_B + 96 * MiB;
constexpr size_t WS_SGMLA = WS_B + 128 * MiB;
constexpr size_t WS_KM    = WS_B + 160 * MiB;
constexpr size_t WS_VM    = WS_B + 185 * MiB;
constexpr size_t WS_YNA   = WS_B + 201 * MiB;
constexpr size_t WS_WPCAT = WS_B + 240 * MiB;
constexpr size_t WS_TMP   = WS_B + 32 * MiB;
constexpr size_t WS_MERGED= WS_B + 64 * MiB;
constexpr size_t WS_WD    = WS_B + 0 * MiB;
constexpr size_t WS_ACT   = WS_B + 33 * MiB;
constexpr size_t WS_WGU   = WS_B + 109 * MiB;
constexpr size_t WS_H2    = WS_B + 174 * MiB;
constexpr size_t WS_YS    = WS_B + 109 * MiB;
constexpr size_t WS_END   = 302 * MiB;
constexpr int ACT_SHARED_ROW0 = NT * TOPK;
constexpr int YS_SHARED_ROW0 = CHTOK * TOPK;
constexpr int CW_BAR = 4096;
constexpr int CW_CNT = 16384;

constexpr int RING_BYTES = 131072;
constexpr int LDSCTL_OFF = RING_BYTES, MISC_OFF = LDSCTL_OFF + 320;
constexpr int TAB_OFF = RING_BYTES + 1024;
constexpr int LDS_BYTES = 147456;

#define LDS_WAIT() asm volatile("s_waitcnt lgkmcnt(0)" ::: "memory")
#define VM_WAIT() asm volatile("s_waitcnt vmcnt(0)" ::: "memory")
#define SBAR() __builtin_amdgcn_sched_barrier(0)
#define RLX_AGENT __ATOMIC_RELAXED, __HIP_MEMORY_SCOPE_AGENT

__device__ __forceinline__ unsigned f2bf(float f) { unsigned u = __builtin_bit_cast(unsigned, f); return (u + 0x7fffu + ((u >> 16) & 1u)) >> 16; }
__device__ __forceinline__ unsigned pk2(float lo, float hi) { return f2bf(lo) | (f2bf(hi) << 16); }
__device__ __forceinline__ unsigned cvt_pk_bf16(float lo, float hi) { unsigned r; asm volatile("v_cvt_pk_bf16_f32 %0, %1, %2" : "=v"(r) : "v"(lo), "v"(hi)); return r; }
__device__ __forceinline__ float bf2f(unsigned short b) { return __builtin_bit_cast(float, (unsigned)b << 16); }
__device__ __forceinline__ float bflo(unsigned w) { return __builtin_bit_cast(float, w << 16); }
__device__ __forceinline__ float bfhi(unsigned w) { return __builtin_bit_cast(float, w & 0xffff0000u); }
__device__ __forceinline__ int lane_fresh() { int t = threadIdx.x; asm volatile("" : "+v"(t)); return t & 63; }
__device__ __forceinline__ float shx(float v, int m, int lane) { return __builtin_bit_cast(float, __builtin_amdgcn_ds_bpermute((lane ^ m) << 2, __builtin_bit_cast(int, v))); }
__device__ __forceinline__ int shup_i(int v, int d, int lane) { return __builtin_amdgcn_ds_bpermute(((lane - d) & 63) << 2, v); }
__device__ __forceinline__ float wave_sum(float v) {
    const int l = lane_fresh();
#pragma unroll
    for (int o = 1; o < 64; o <<= 1) v += shx(v, o, l);
    return v;
}
__device__ __forceinline__ float sigmoidf_fast(float v) { return __builtin_amdgcn_rcpf(1.0f + __expf(-v)); }
__device__ __forceinline__ float siluf_fast(float v) { return v * sigmoidf_fast(v); }
__device__ __forceinline__ float sq4(f32x4 a) { return (a[0] * a[0] + a[1] * a[1]) + (a[2] * a[2] + a[3] * a[3]); }

#ifdef WSPROBE
struct Args { const void* in[28]; float* out; unsigned char* ws; int nrep, pad; };
#else
struct Args { const void* in[28]; float* out; unsigned char* ws; };
#endif
enum { I_x = 0, I_c = 1, I_positions = 2, I_w_ada = 3, I_b_ada = 4, I_g_norm1 = 5, I_w_in = 6, I_g_na_q = 7, I_g_na_k = 8, I_na_rpb = 9, I_g_q_lat = 10, I_w_uq = 11, I_g_kv_lat = 12, I_w_ukv = 13, I_g_mla_q = 14, I_g_mla_k = 15, I_w_proj_na = 16, I_w_proj_mla = 17, I_w_out = 18, I_g_norm2 = 19, I_w_router = 20, I_e_bias = 21, I_w_eg = 22, I_w_eu = 23, I_w_ed = 24, I_w_sg = 25, I_w_su = 26, I_w_sd = 27 };
#define INF(k) ((const float*)A.in[k])

#ifndef TSWG
#define TSWG 0
#endif

__device__ __forceinline__ unsigned cvt4_fp8(f32x4 a, float sc) {
    int w = 0;
    w = __builtin_amdgcn_cvt_pk_fp8_f32(__builtin_amdgcn_fmed3f(a[0] * sc, -448.f, 448.f), __builtin_amdgcn_fmed3f(a[1] * sc, -448.f, 448.f), w, false);
    w = __builtin_amdgcn_cvt_pk_fp8_f32(__builtin_amdgcn_fmed3f(a[2] * sc, -448.f, 448.f), __builtin_amdgcn_fmed3f(a[3] * sc, -448.f, 448.f), w, true);
    return (unsigned)w;
}
namespace pg8 {
constexpr int BM = 256, BK = 64, HALF = 128, HTB = HALF * BK * 2, STAGE_BYTES = 8 * HTB, NXCD = 8, WGM = 8;
__host__ __device__ __forceinline__ int lds_byte(int r, int c) { const int st = (r >> 4) * 2 + (c >> 5), rr = r & 15, cc = c & 31, ob = rr * 64 + cc * 2; return st * 1024 + (ob ^ (((ob >> 9) & 1) << 5)); }
__host__ __device__ __forceinline__ void stage_rc(int b, int& R, int& C) { const int st = b / 1024, sb = b % 1024, swz = sb ^ (((sb >> 9) & 1) << 5); R = (st >> 1) * 16 + swz / 64; C = (st & 1) * 32 + (swz % 64) / 2; }
__host__ __device__ __forceinline__ int perm32(int rho) { const int n = rho >> 4, i = rho & 15; return 8 * (i >> 2) + 4 * n + (i & 3); }

struct Unit {
    const char* B;
    int m0;
    int pn;
    int e;
    int nrows;
    int orow0;
    const int* l0; const int* l1; int n0, ntot;
};
struct Gemm { const bf16_t* A; int lda; int K; int ldb; };

template <class Epi, class Sched, bool GATHER, bool FP8 = false, bool HALFK = false>
__device__ __forceinline__ void gemm_phase(LAS unsigned char* lds, const Gemm g, Sched& S, const Epi& E) {
    int tid_ = threadIdx.x; asm volatile("" : "+v"(tid_));
    const int tid = tid_, wid = __builtin_amdgcn_readfirstlane(tid >> 6), lane = tid & 63, wr = wid >> 2, wc = wid & 3, fr = lane & 15, fq = lane >> 4;
    const int K = g.K; int nt_ = K / BK; asm volatile("" : "+s"(nt_)); const int nt = nt_;
    unsigned voffB[2], voffA[2];
#pragma unroll
    for (int i = 0; i < 2; ++i) { int R, C; stage_rc(tid * 16 + i * 8192, R, C); const int Rb = Epi::PERM ? ((R & ~31) + perm32(R & 31)) : R;
        voffA[i] = (unsigned)(R * g.lda + C) * 2u; voffB[i] = (unsigned)(Rb * g.ldb + C) * 2u; }
    const size_t hstepA = (size_t)HALF * g.lda * 2;
    const size_t kstep = (size_t)(BK * 2);
    const size_t hstepB = (size_t)HALF * g.ldb * 2;
    const unsigned ldsw = (unsigned)wid * 1024u;
    const int aoff = lds_byte(wr * 64 + fr, fq * 8), boff = lds_byte(wc * 32 + fr, fq * 8);
    const char* Abase = (const char*)g.A;
#define PG8_SA(b, h) (((b) * 2 + (h)) * HTB)
#define PG8_SB(b, h) ((4 + (b) * 2 + (h)) * HTB)
#define PG8_STAGE(bufoff, gbase, voff) do { _Pragma("unroll") for (int _i = 0; _i < 2; ++_i) \
        __builtin_amdgcn_global_load_lds((const unsigned*)((const char*)(gbase) + (voff)[_i]), (LAS unsigned*)(lds + (bufoff) + ldsw + _i * 8192), 16, 0, 0); } while (0)
#define PG8_LDA(dst, b, h) do { _Pragma("unroll") for (int m = 0; m < 4; ++m) _Pragma("unroll") for (int k = 0; k < 2; ++k) dst[m][k] = *(const LAS bf16x8*)(lds + PG8_SA(b, h) + aoff + m * 2048 + k * 1024); } while (0)
#define PG8_LDB(dst, b, h) do { _Pragma("unroll") for (int n = 0; n < 2; ++n) _Pragma("unroll") for (int k = 0; k < 2; ++k) dst[n][k] = *(const LAS bf16x8*)(lds + PG8_SB(b, h) + boff + n * 2048 + k * 1024); } while (0)
#define PG8_CAT(x0, x1) __builtin_shufflevector(__builtin_bit_cast(i32x4, x0), __builtin_bit_cast(i32x4, x1), 0, 1, 2, 3, 4, 5, 6, 7)
#define PG8_MMA(ai, bj, At, Bt) do { __builtin_amdgcn_s_setprio(1); if constexpr (FP8) { _Pragma("unroll") for (int m = 0; m < 4; ++m) _Pragma("unroll") for (int n = 0; n < 2; ++n) \
        acc[ai][bj][m][n] = __builtin_amdgcn_mfma_scale_f32_16x16x128_f8f6f4(PG8_CAT(Bt[n][0], Bt[n][1]), PG8_CAT(At[m][0], At[m][1]), acc[ai][bj][m][n], 0, 0, 0, 0x7f7f7f7f, 0, 0x7f7f7f7f); } \
        else { _Pragma("unroll") for (int m = 0; m < 4; ++m) _Pragma("unroll") for (int n = 0; n < 2; ++n) _Pragma("unroll") for (int k = 0; k < 2; ++k) \
        acc[ai][bj][m][n] = __builtin_amdgcn_mfma_f32_16x16x32_bf16(Bt[n][k], At[m][k], acc[ai][bj][m][n], 0, 0, 0); } __builtin_amdgcn_s_setprio(0); } while (0)
#define PG8_MM2(ai) do { if constexpr (HALFK) { if (t < (nt >> 1)) { PG8_MMA(ai, 0, At, B0); } else { PG8_MMA(ai, 1, At, B1); } } else { PG8_MMA(ai, 0, At, B0); PG8_MMA(ai, 1, At, B1); } } while (0)
#define PG8_WAIT_V(n) asm volatile("s_waitcnt vmcnt(" #n ")" ::: "memory")
#define PG8_WAIT_L(n) asm volatile("s_waitcnt lgkmcnt(" #n ")" ::: "memory")
#define PG8_BAR __builtin_amdgcn_s_barrier()
#define PG8_SCHED __builtin_amdgcn_sched_barrier(0)
#define PG8_VOFF(dst, u) do { int _t = threadIdx.x; asm volatile("" : "+v"(_t)); _Pragma("unroll") for (int _h = 0; _h < 2; ++_h) _Pragma("unroll") for (int _i = 0; _i < 2; ++_i) { \
        int _R, _C; stage_rc(_t * 16 + _i * 8192, _R, _C); int _r = (u).m0 + _h * HALF + _R; \
        if ((u).l0) { _r = _r < (u).ntot ? _r : (u).ntot - 1; _r = _r < (u).n0 ? (u).l0[_r] : (u).l1[_r - (u).n0]; } \
        dst[_h][_i] = (unsigned)(_r * g.lda + _C) * 2u; } } while (0)
#define PG8_VROW(dst, u) do { int _t = threadIdx.x; asm volatile("" : "+v"(_t)); _Pragma("unroll") for (int _h = 0; _h < 2; ++_h) _Pragma("unroll") for (int _i = 0; _i < 2; ++_i) { \
        int _R, _C; stage_rc(_t * 16 + _i * 8192, _R, _C); int _r = (u).m0 + _h * HALF + _R; \
        if ((u).l0) { _r = _r < (u).ntot ? _r : (u).ntot - 1; _r = _r < (u).n0 ? (u).l0[_r] : (u).l1[_r - (u).n0]; } \
        dst[_h][_i] = _r; } } while (0)
#define PG8_STA(bufoff, sel_next, h, kt) do { if constexpr (GATHER) { PG8_STAGE(bufoff, Abase + (size_t)(kt) * kstep, cvo[h]); } \
        else { PG8_STAGE(bufoff, ((sel_next) ? nA : cA) + (h) * hstepA + (size_t)(kt) * kstep, voffA); } } while (0)
    Unit cur, nxt; int ui = 0;
    if (!S.next(0, cur)) return;
    E.prefetch(cur, 0, tid, lds);
    f32x4 acc[2][2][4][2];
#pragma unroll
    for (int a = 0; a < 2; ++a)
#pragma unroll
        for (int b = 0; b < 2; ++b)
#pragma unroll
            for (int m = 0; m < 4; ++m)
#pragma unroll
                for (int n = 0; n < 2; ++n) acc[a][b][m][n] = (f32x4){0.f, 0.f, 0.f, 0.f};
    bf16x8 At[4][2], B0[2][2], B1[2][2];
    unsigned cvo[2][2]; int nvr[2][2];
    const char* cA = Abase; const char* nA = Abase;
    if constexpr (GATHER) { PG8_VOFF(cvo, cur); } else { cA = Abase + (size_t)cur.m0 * g.lda * 2; }
    const char* cB = cur.B;
    PG8_STAGE(PG8_SB(0, 0), cB, voffB); PG8_STAGE(PG8_SB(0, 1), cB + hstepB, voffB); PG8_STA(PG8_SA(0, 0), false, 0, 0); PG8_STA(PG8_SA(0, 1), false, 1, 0);
    if (wr == 1) PG8_BAR;
    PG8_WAIT_V(2); PG8_BAR;
    PG8_STAGE(PG8_SB(1, 0), cB + kstep, voffB); PG8_STA(PG8_SA(1, 0), false, 0, 1); PG8_STAGE(PG8_SB(1, 1), cB + hstepB + kstep, voffB);
    PG8_WAIT_V(6); PG8_BAR;
    for (;;) {
        const bool has_next = S.next(ui + 1, nxt);
        if constexpr (GATHER) {
            if (has_next) { PG8_VROW(nvr, nxt); }
        } else { nA = has_next ? Abase + (size_t)nxt.m0 * g.lda * 2 : cA; }
        const char* nB = has_next ? nxt.B : cB;
#pragma unroll 1
        for (int t = 0; t < nt; t += 2) {
            const bool last = (t == nt - 2);
            const int kt2 = last ? 0 : t + 2;
            const char* b2 = last ? nB : cB + (size_t)(t + 2) * kstep; const char* b3 = b2 + kstep;
            PG8_LDB(B0, 0, 0); PG8_LDB(B1, 0, 1); PG8_SCHED; PG8_LDA(At, 0, 0); PG8_STA(PG8_SA(1, 1), false, 1, t + 1);
            if constexpr (GATHER) { if (last && has_next) { int _t = threadIdx.x; asm volatile("" : "+v"(_t));
#pragma unroll
                for (int h = 0; h < 2; ++h)
#pragma unroll
                    for (int i = 0; i < 2; ++i) { int _R, _C; stage_rc(_t * 16 + i * 8192, _R, _C); cvo[h][i] = (unsigned)(nvr[h][i] * g.lda + _C) * 2u; } } }
            PG8_WAIT_V(8); PG8_WAIT_L(0); PG8_BAR; PG8_MM2(0); PG8_BAR; PG8_SCHED;
            PG8_LDA(At, 0, 1); PG8_STAGE(PG8_SB(0, 0), b2, voffB); PG8_STAGE(PG8_SB(0, 1), b2 + hstepB, voffB); PG8_STA(PG8_SA(0, 0), last, 0, kt2);
            PG8_WAIT_V(8); PG8_WAIT_L(0); PG8_BAR; PG8_MM2(1); PG8_BAR; PG8_SCHED;
            PG8_LDB(B0, 1, 0); PG8_LDB(B1, 1, 1); PG8_SCHED; PG8_LDA(At, 1, 0); PG8_STA(PG8_SA(0, 1), last, 1, kt2);
            PG8_WAIT_V(8); PG8_WAIT_L(0); PG8_BAR; PG8_MM2(0); PG8_BAR; PG8_SCHED;
            PG8_LDA(At, 1, 1); PG8_STAGE(PG8_SB(1, 0), b3, voffB); PG8_STAGE(PG8_SB(1, 1), b3 + hstepB, voffB); PG8_STA(PG8_SA(1, 0), last, 0, kt2 + 1);
            PG8_WAIT_V(8); PG8_WAIT_L(0); PG8_BAR; PG8_MM2(1); PG8_BAR; PG8_SCHED;
        }
        S.publish(wid);
        if (wr == 0) PG8_BAR;
        { int t2 = threadIdx.x; asm volatile("" : "+v"(t2)); const int l2 = t2 & 63; E(acc, cur, wr, wc, l2 & 15, l2 >> 4, ui, lds); }
        if (!has_next) break;
#pragma unroll
        for (int a = 0; a < 2; ++a)
#pragma unroll
            for (int b = 0; b < 2; ++b)
#pragma unroll
                for (int m = 0; m < 4; ++m)
#pragma unroll
                    for (int n = 0; n < 2; ++n) acc[a][b][m][n] = (f32x4){0.f, 0.f, 0.f, 0.f};
        cur = nxt; cB = nB; cA = nA; ++ui;
        E.prefetch(cur, ui, tid, lds);

        if (wr == 1) PG8_BAR;
    }
    PG8_WAIT_V(0);
    PG8_BAR;
#undef PG8_SA
#undef PG8_SB
#undef PG8_STAGE
#undef PG8_LDA
#undef PG8_LDB
#undef PG8_MMA
#undef PG8_MM2
#undef PG8_CAT
#undef PG8_WAIT_V
#undef PG8_WAIT_L
#undef PG8_BAR
#undef PG8_SCHED
#undef PG8_VOFF
#undef PG8_VROW
#undef PG8_STA
}

struct DenseSched {
    int nM, nN, nwg, G, c; const bf16_t* Bt; int K;
    __device__ void init(int M, int N, int ldb_, const bf16_t* Bt_, int G_, int c_) { nM = M / BM; nN = N / BM; nwg = nM * nN; G = G_; c = c_; Bt = Bt_; K = ldb_; }
    __device__ __forceinline__ void publish(int) {}
    __device__ bool next(int i, Unit& u) const {
        const long L = (long)i * G + c; if (L >= nwg) return false;
        int wgid = (int)L; { const int q = nwg / NXCD, r = nwg % NXCD, xcd = wgid % NXCD, off = wgid / NXCD; wgid = (xcd < r ? xcd * (q + 1) : r * (q + 1) + (xcd - r) * q) + off; }
        const int nig = WGM * nN, gid = wgid / nig, fm = gid * WGM, gsz = (nM - fm) < WGM ? (nM - fm) : WGM;
        const int pm = fm + ((wgid % nig) % gsz), pn = (wgid % nig) / gsz;
        u.B = (const char*)Bt + (size_t)pn * BM * K * 2; u.m0 = pm * BM; u.pn = pn; u.e = pm; u.nrows = BM; u.orow0 = pm * BM; u.l0 = nullptr; u.l1 = nullptr; u.n0 = 0; u.ntot = 0;
        return true;
    }
};
}
#define XB_TMO      128
#define XB_XCNT(j)  (256  + 64 * (j))
#define XB_XSUB(j)  (1280 + 64 * (j))
#define XB_XGEN(j)  (2304 + 64 * (j))
#define XB_TOP      3328
#define XB_TOPGEN   3392
#define XCD_BAR_WORDS 3456
#define XB_SPIN_CAP (1u << 18)

__device__ __forceinline__ unsigned xb_ld(unsigned* p)              { return __hip_atomic_load(p, __ATOMIC_RELAXED, __HIP_MEMORY_SCOPE_AGENT); }
__device__ __forceinline__ unsigned xb_add(unsigned* p, unsigned v) { return __hip_atomic_fetch_add(p, v, __ATOMIC_RELAXED, __HIP_MEMORY_SCOPE_AGENT); }
__device__ __forceinline__ unsigned xb_xcc_id() { return (unsigned)__builtin_amdgcn_s_getreg((3 << 11) | 20) & 0xFu; }
#define XB_SPIN(cond, bar) do { unsigned _sp = 0; while (cond) { __builtin_amdgcn_s_sleep(1); \
    if ((++_sp & 255u) == 0u) { if (xb_ld(&(bar)[XB_TMO])) break; if (_sp > XB_SPIN_CAP) { atomicAdd(&(bar)[XB_TMO], 1u); break; } } } } while (0)

struct XcdBarrier { unsigned* bar; unsigned x; volatile LAS unsigned* st; };

__device__ __forceinline__ XcdBarrier xcd_barrier_post(unsigned* bar, volatile LAS unsigned* st) {
    XcdBarrier b; b.bar = bar; b.x = xb_xcc_id(); b.st = st;
    if (threadIdx.x == 0) (void)xb_add(&bar[XB_XCNT(b.x)], 1u);
    return b;
}
__device__ __forceinline__ void xcd_barrier_complete(unsigned* bar, unsigned x, unsigned& nloc, unsigned& nx) {
    const unsigned G = gridDim.x * gridDim.y * gridDim.z;
    unsigned sum, cnt, mine, sp = 0u;
    for (;;) {
        sum = 0u; cnt = 0u; mine = 0u;
#pragma unroll
        for (unsigned j = 0; j < 16; ++j) { const unsigned c = xb_ld(&bar[XB_XCNT(j)]); sum += c; cnt += (c > 0u) ? 1u : 0u; mine = (j == x) ? c : mine; }
        if (sum == G) break;
        __builtin_amdgcn_s_sleep(1);
        if ((++sp & 255u) == 0u) { if (xb_ld(&bar[XB_TMO])) break; if (sp > XB_SPIN_CAP) { atomicAdd(&bar[XB_TMO], 1u); break; } }
    }
    nloc = mine > 0u ? mine : 1u; nx = cnt > 0u ? cnt : 1u;
}
__device__ __forceinline__ void xcd_barrier(const XcdBarrier& b) {
    asm volatile("s_waitcnt vmcnt(0)" ::: "memory");
    __syncthreads();
    int tid_ = threadIdx.x; asm volatile("" : "+v"(tid_));
    if (tid_ == 0) {
        unsigned* bar = b.bar; asm volatile("" : "+s"(bar)); unsigned bx_ = b.x; asm volatile("" : "+s"(bx_));
        __builtin_amdgcn_s_waitcnt(0);
        unsigned nloc = b.st[0], nx = b.st[1];
        if (nloc == 0u) { xcd_barrier_complete(bar, bx_, nloc, nx); b.st[0] = nloc; b.st[1] = nx; }
        const unsigned old = xb_add(&bar[XB_XSUB(bx_)], 1u);
        const unsigned gen = old / nloc;
        if (old + 1u == (gen + 1u) * nloc) {
            __builtin_amdgcn_fence(__ATOMIC_RELEASE, "agent");
            asm volatile("s_waitcnt vmcnt(0)" ::: "memory");
            const unsigned og = xb_add(&bar[XB_TOP], 1u);
            const unsigned tg = og / nx;
            if (og + 1u == (tg + 1u) * nx) xb_add(&bar[XB_TOPGEN], 1u);
            else XB_SPIN(xb_ld(&bar[XB_TOPGEN]) == tg, bar);
            __builtin_amdgcn_fence(__ATOMIC_ACQUIRE, "agent");
            xb_add(&bar[XB_XGEN(bx_)], 1u);
            asm volatile("s_waitcnt vmcnt(0)" ::: "memory");
        } else {
            XB_SPIN(xb_ld(&bar[XB_XGEN(bx_)]) == gen, bar);
            __builtin_amdgcn_fence(__ATOMIC_ACQUIRE, "agent");
            asm volatile("s_waitcnt vmcnt(0)" ::: "memory");
        }
    }
    __syncthreads();
}
namespace epi {
using pg8::Unit;
__device__ __forceinline__ u32x4 pack8(f32x4 a, f32x4 b) { u32x4 w; w.x = cvt_pk_bf16(a[0], a[1]); w.y = cvt_pk_bf16(a[2], a[3]); w.z = cvt_pk_bf16(b[0], b[1]); w.w = cvt_pk_bf16(b[2], b[3]); return w; }

__device__ __forceinline__ float red_fq(float s) { const int l = lane_fresh(); s += shx(s, 16, l); s += shx(s, 32, l); return s; }
__device__ __forceinline__ void unpack8(u32x4 w, f32x4& a, f32x4& b) { a = (f32x4){bflo(w.x), bfhi(w.x), bflo(w.y), bfhi(w.y)}; b = (f32x4){bflo(w.z), bfhi(w.z), bflo(w.w), bfhi(w.w)}; }
__device__ __forceinline__ void rope32(f32x4 (&v)[2], const float* cs, const float* sn, int fq) {
#pragma unroll
    for (int n = 0; n < 2; ++n) {
        const f32x4 c4 = *(const f32x4*)(cs + 8 * (fq & 1) + 4 * n), s4 = *(const f32x4*)(sn + 8 * (fq & 1) + 4 * n);
        const int l_ = lane_fresh(); f32x4 p; p[0] = shx(v[n][0], 32, l_); p[1] = shx(v[n][1], 32, l_); p[2] = shx(v[n][2], 32, l_); p[3] = shx(v[n][3], 32, l_);
        v[n] = (fq < 2) ? (v[n] * c4 - p * s4) : (v[n] * c4 + p * s4);
    }
}

struct EpiInProj {
    static constexpr bool PERM = true;
    __device__ __forceinline__ void prefetch(const Unit&, int, int, LAS unsigned char*) const {}
    bf16_t *naq, *nak, *nav, *qlat, *kvlat, *sgna, *sgmla; float *krot, *qsq, *kvsq; const float *gq, *gk, *rcos, *rsin;
    __device__ __forceinline__ void operator()(const f32x4 (&acc)[2][2][4][2], const Unit& u, int wr, int wc, int fr, int fq, int ui, LAS unsigned char* lds) const {
        const int pn = u.pn, row0 = u.orow0 + wr * 64 + fr;
        if (pn < 4) {
            bf16_t* dst = pn < 2 ? naq : nak; const float* g = pn < 2 ? gq : gk; const int head = (pn & 1) * 4 + wc;
            f32x4 gv[2][2];
#pragma unroll
            for (int bj = 0; bj < 2; ++bj)
#pragma unroll
                for (int n = 0; n < 2; ++n) gv[bj][n] = *(const f32x4*)(g + 32 * bj + 8 * fq + 4 * n);
#pragma unroll
            for (int ai = 0; ai < 2; ++ai)
#pragma unroll
                for (int m = 0; m < 4; ++m) {
                    float ss = (sq4(acc[ai][0][m][0]) + sq4(acc[ai][0][m][1])) + (sq4(acc[ai][1][m][0]) + sq4(acc[ai][1][m][1]));
                    ss = red_fq(ss); const float rstd = rsqrtf(ss * (1.0f / 64.0f) + EPS);
                    bf16_t* rp = dst + (size_t)(row0 + ai * 128 + m * 16) * 512 + head * 64 + 8 * fq;
#pragma unroll
                    for (int bj = 0; bj < 2; ++bj) *(u32x4*)(rp + 32 * bj) = pack8(acc[ai][bj][m][0] * rstd * gv[bj][0], acc[ai][bj][m][1] * rstd * gv[bj][1]);
                }
        } else if (pn < 6) {
#pragma unroll
            for (int ai = 0; ai < 2; ++ai)
#pragma unroll
                for (int m = 0; m < 4; ++m) { bf16_t* rp = nav + (size_t)(row0 + ai * 128 + m * 16) * 512 + (pn - 4) * 256 + wc * 32 + 8 * fq;
#pragma unroll
                    for (int bj = 0; bj < 2; ++bj) *(u32x4*)(rp + 128 * bj) = pack8(acc[ai][bj][m][0] * (1.0f / WIN_SCALE), acc[ai][bj][m][1] * (1.0f / WIN_SCALE)); }
        } else if (pn == 6) {
#pragma unroll
            for (int ai = 0; ai < 2; ++ai)
#pragma unroll
                for (int m = 0; m < 4; ++m) { const int row = row0 + ai * 128 + m * 16; bf16_t* rp = qlat + (size_t)row * 256 + wc * 32 + 8 * fq;
                    float ss = (sq4(acc[ai][0][m][0]) + sq4(acc[ai][0][m][1])) + (sq4(acc[ai][1][m][0]) + sq4(acc[ai][1][m][1]));
                    ss = red_fq(ss); if (fq == 0) qsq[(size_t)row * 4 + wc] = ss;
#pragma unroll
                    for (int bj = 0; bj < 2; ++bj) *(u32x4*)(rp + 128 * bj) = pack8(acc[ai][bj][m][0], acc[ai][bj][m][1]); }
        } else if (pn == 7) {
#pragma unroll
            for (int ai = 0; ai < 2; ++ai)
#pragma unroll
                for (int m = 0; m < 4; ++m) { const int row = row0 + ai * 128 + m * 16;
                    float ss = sq4(acc[ai][0][m][0]) + sq4(acc[ai][0][m][1]);
                    ss = red_fq(ss); if (fq == 0) kvsq[(size_t)row * 4 + wc] = ss;
                    *(u32x4*)(kvlat + (size_t)row * 128 + wc * 32 + 8 * fq) = pack8(acc[ai][0][m][0], acc[ai][0][m][1]);
                    if (wc == 0) { f32x4 v[2] = {acc[ai][1][m][0] * (1.0f / WIN_SCALE), acc[ai][1][m][1] * (1.0f / WIN_SCALE)};
                        rope32(v, rcos + (size_t)row * 16, rsin + (size_t)row * 16, fq);
                        *(f32x4*)(krot + (size_t)row * 32 + 8 * fq) = v[0]; *(f32x4*)(krot + (size_t)row * 32 + 8 * fq + 4) = v[1]; } }
        } else {
            bf16_t* dst = pn < 12 ? sgna : sgmla; const int cb = ((pn - 8) & 3) * 256 + wc * 32 + 8 * fq;
#pragma unroll
            for (int ai = 0; ai < 2; ++ai)
#pragma unroll
                for (int m = 0; m < 4; ++m) { bf16_t* rp = dst + (size_t)(row0 + ai * 128 + m * 16) * 1024 + cb;
#pragma unroll
                    for (int bj = 0; bj < 2; ++bj) { f32x4 a = acc[ai][bj][m][0], b = acc[ai][bj][m][1];
#pragma unroll
                        for (int e = 0; e < 4; ++e) { a[e] = sigmoidf_fast(a[e] * (1.0f / WIN_SCALE)); b[e] = sigmoidf_fast(b[e] * (1.0f / WIN_SCALE)); }
                        *(u32x4*)(rp + 128 * bj) = pack8(a, b); } }
        }
    }
};

struct EpiUpQ {
    static constexpr bool PERM = true;
    __device__ __forceinline__ void prefetch(const Unit&, int, int, LAS unsigned char*) const {}
    bf16_t* qm; float* qss; const float* qsq; const float* g; const float *rcos, *rsin;
    __device__ __forceinline__ void operator()(const f32x4 (&acc)[2][2][4][2], const Unit& u, int wr, int wc, int fr, int fq, int ui, LAS unsigned char* lds) const {
        const int pn = u.pn, row0 = u.orow0 + wr * 64 + fr;
#pragma unroll
        for (int ai = 0; ai < 2; ++ai)
#pragma unroll
            for (int m = 0; m < 4; ++m) {
                const int row = row0 + ai * 128 + m * 16, b = row >> 11, s = row & 2047;
                const f32x4 sq = *(const f32x4*)(qsq + (size_t)row * 4);
                const float rstd = rsqrtf(((sq[0] + sq[1]) + (sq[2] + sq[3])) * (1.0f / 256.0f) + EPS);
                if (pn < 2) {
                    const int head = pn * 4 + wc;
                    f32x4 v[2][2]; float ss = 0.f;
#pragma unroll
                    for (int bj = 0; bj < 2; ++bj)
#pragma unroll
                        for (int n = 0; n < 2; ++n) { v[bj][n] = acc[ai][bj][m][n] * rstd; ss += sq4(v[bj][n]); }
                    ss = red_fq(ss); if (fq == 0) qss[((size_t)row * 8 + head) * 2 + 0] = ss;
                    bf16_t* rp = qm + ((size_t)(b * 8 + head) * 2048 + s) * 96 + 8 * fq;
#pragma unroll
                    for (int bj = 0; bj < 2; ++bj) *(u32x4*)(rp + 32 * bj) = pack8(v[bj][0] * *(const f32x4*)(g + 32 * bj + 8 * fq), v[bj][1] * *(const f32x4*)(g + 32 * bj + 8 * fq + 4));
                } else {
#pragma unroll
                    for (int bj = 0; bj < 2; ++bj) { const int head = 2 * wc + bj;
                        f32x4 v[2] = {acc[ai][bj][m][0] * rstd, acc[ai][bj][m][1] * rstd};
                        float ss = sq4(v[0]) + sq4(v[1]); ss = red_fq(ss); if (fq == 0) qss[((size_t)row * 8 + head) * 2 + 1] = ss;
                        rope32(v, rcos + (size_t)row * 16, rsin + (size_t)row * 16, fq);
                        *(u32x4*)(qm + ((size_t)(b * 8 + head) * 2048 + s) * 96 + 64 + 8 * fq) = pack8(v[0] * *(const f32x4*)(g + 64 + 8 * fq), v[1] * *(const f32x4*)(g + 64 + 8 * fq + 4)); }
                }
            }
    }
};

struct EpiUpKV {
    static constexpr bool PERM = true;
    __device__ __forceinline__ void prefetch(const Unit&, int, int, LAS unsigned char*) const {}
    bf16_t *km, *vm; const float* kvsq; const float* krot; const float* g;
    __device__ __forceinline__ void operator()(const f32x4 (&acc)[2][2][4][2], const Unit& u, int wr, int wc, int fr, int fq, int ui, LAS unsigned char* lds) const {
        const int pn = u.pn, row0 = u.orow0 + wr * 64 + fr, head = 2 * pn + (wc >> 1);
#pragma unroll
        for (int ai = 0; ai < 2; ++ai)
#pragma unroll
            for (int m = 0; m < 4; ++m) {
                const int row = row0 + ai * 128 + m * 16, b = row >> 11, s = row & 2047;
                const f32x4 sq = *(const f32x4*)(kvsq + (size_t)row * 4);
                const float rstd = rsqrtf(((sq[0] + sq[1]) + (sq[2] + sq[3])) * (1.0f / 128.0f) + EPS);
                if ((wc & 1) == 0) {
                    f32x4 v[2][2]; float ss = 0.f;
#pragma unroll
                    for (int bj = 0; bj < 2; ++bj)
#pragma unroll
                        for (int n = 0; n < 2; ++n) { v[bj][n] = acc[ai][bj][m][n] * rstd; ss += sq4(v[bj][n]); }
                    const f32x4 k0 = *(const f32x4*)(krot + (size_t)row * 32 + 8 * fq), k1 = *(const f32x4*)(krot + (size_t)row * 32 + 8 * fq + 4);
                    ss += sq4(k0) + sq4(k1); ss = red_fq(ss);
                    const float r96 = rsqrtf(ss * (1.0f / 96.0f) + EPS);
                    bf16_t* rp = km + ((size_t)(b * 8 + head) * 2048 + s) * 96 + 8 * fq;
#pragma unroll
                    for (int bj = 0; bj < 2; ++bj) *(u32x4*)(rp + 32 * bj) = pack8(v[bj][0] * r96 * *(const f32x4*)(g + 32 * bj + 8 * fq), v[bj][1] * r96 * *(const f32x4*)(g + 32 * bj + 8 * fq + 4));
                    *(u32x4*)(rp + 64) = pack8(k0 * r96 * *(const f32x4*)(g + 64 + 8 * fq), k1 * r96 * *(const f32x4*)(g + 64 + 8 * fq + 4));
                } else {
                    bf16_t* rp = vm + ((size_t)(b * 8 + head) * 2048 + s) * 64 + 8 * fq;
#pragma unroll
                    for (int bj = 0; bj < 2; ++bj) *(u32x4*)(rp + 32 * bj) = pack8(acc[ai][bj][m][0] * rstd, acc[ai][bj][m][1] * rstd);
                }
            }
    }
};

struct EpiMergeCat {
    static constexpr bool PERM = true;
    __device__ __forceinline__ void prefetch(const Unit&, int, int, LAS unsigned char*) const {}
    const bf16_t *sgna, *sgmla; unsigned char* out;
    __device__ __forceinline__ void operator()(const f32x4 (&acc)[2][2][4][2], const Unit& u, int wr, int wc, int fr, int fq, int ui, LAS unsigned char* lds) const {
        const int row0 = u.orow0 + wr * 64 + fr, cb = u.pn * 128 + wc * 32 + 8 * fq;
#pragma unroll
        for (int ai = 0; ai < 2; ++ai)
#pragma unroll
            for (int m = 0; m < 4; ++m) { const size_t off = (size_t)(row0 + ai * 128 + m * 16) * 1024 + cb;
                f32x4 ga, gb, ha, hb; unpack8(*(const u32x4*)(sgna + off), ga, gb); unpack8(*(const u32x4*)(sgmla + off), ha, hb);
                u32x2 w; w.x = cvt4_fp8(acc[ai][0][m][0] * ga + acc[ai][1][m][0] * ha, MG_SCALE / (Y_SCALE * WP_SCALE)); w.y = cvt4_fp8(acc[ai][0][m][1] * gb + acc[ai][1][m][1] * hb, MG_SCALE / (Y_SCALE * WP_SCALE)); *(u32x2*)(out + off) = w; }
    }
};

struct EpiOut {
    static constexpr bool PERM = false;
    __device__ __forceinline__ void prefetch(const Unit&, int, int, LAS unsigned char*) const {}
    const float* x; float* x1; const float* mod;
    __device__ __forceinline__ void operator()(const f32x4 (&acc)[2][2][4][2], const Unit& u, int wr, int wc, int fr, int fq, int ui, LAS unsigned char* lds) const {
        const int row0 = u.orow0 + wr * 64 + fr, cb = u.pn * 256 + wc * 32 + 4 * fq, b = u.orow0 >> 11;
        f32x4 gt[2][2];
#pragma unroll
        for (int bj = 0; bj < 2; ++bj)
#pragma unroll
            for (int n = 0; n < 2; ++n) gt[bj][n] = *(const f32x4*)(mod + (size_t)b * 6144 + 2048 + cb + 128 * bj + 16 * n);
#pragma unroll
        for (int ai = 0; ai < 2; ++ai)
#pragma unroll
            for (int m = 0; m < 4; ++m) { const size_t off = (size_t)(row0 + ai * 128 + m * 16) * 1024 + cb;
#pragma unroll
                for (int bj = 0; bj < 2; ++bj)
#pragma unroll
                    for (int n = 0; n < 2; ++n) { const f32x4 xv = *(const f32x4*)(x + off + 128 * bj + 16 * n); *(f32x4*)(x1 + off + 128 * bj + 16 * n) = xv + gt[bj][n] * (acc[ai][bj][m][n] * (1.0f / (MG_SCALE * WOUT_SCALE))); } }
    }
};

struct EpiGateUp {
    static constexpr bool PERM = true;
    __device__ __forceinline__ void prefetch(const Unit&, int, int, LAS unsigned char*) const {}
    unsigned char* act;
    __device__ __forceinline__ void operator()(const f32x4 (&acc)[2][2][4][2], const Unit& u, int wr, int wc, int fr, int fq, int ui, LAS unsigned char* lds) const {
        const int lr0 = wr * 64 + fr, cb = u.pn * 128 + wc * 32 + 8 * fq;
#pragma unroll
        for (int ai = 0; ai < 2; ++ai)
#pragma unroll
            for (int m = 0; m < 4; ++m) { const int lr = lr0 + ai * 128 + m * 16;
                if (lr < u.nrows) {
                    f32x4 a = acc[ai][0][m][0], b = acc[ai][0][m][1];
#pragma unroll
                    for (int e = 0; e < 4; ++e) { a[e] = siluf_fast(a[e] * (1.0f / WGU_SCALE)) * (acc[ai][1][m][0][e] * (1.0f / WGU_SCALE)); b[e] = siluf_fast(b[e] * (1.0f / WGU_SCALE)) * (acc[ai][1][m][1][e] * (1.0f / WGU_SCALE)); }
                    u32x2 w; w.x = cvt4_fp8(a, ACT_SCALE); w.y = cvt4_fp8(b, ACT_SCALE); *(u32x2*)(act + (size_t)(u.orow0 + lr) * 256 + cb) = w; } }
    }
};
__device__ __forceinline__ unsigned pk4_fp8_unused(f32x4 a) {
    int w = 0;
    w = __builtin_amdgcn_cvt_pk_fp8_f32(__builtin_amdgcn_fmed3f(a[0] * YS_SCALE, -448.f, 448.f), __builtin_amdgcn_fmed3f(a[1] * YS_SCALE, -448.f, 448.f), w, false);
    w = __builtin_amdgcn_cvt_pk_fp8_f32(__builtin_amdgcn_fmed3f(a[2] * YS_SCALE, -448.f, 448.f), __builtin_amdgcn_fmed3f(a[3] * YS_SCALE, -448.f, 448.f), w, true);
    return (unsigned)w;
}
struct EpiDown {
    static constexpr bool PERM = true;
    __device__ __forceinline__ void prefetch(const Unit& u, int ui, int tid, LAS unsigned char* lds) const {
        if (tid < 256) { LAS float* wl = (LAS float*)(lds + RING_BYTES + 1024 + 12288) + (ui & 1) * 256; wl[tid] = u.l1 ? ((const float*)u.l1)[tid] : 1.0f; } }
    unsigned char* ys; int dry;
    __device__ __forceinline__ void operator()(const f32x4 (&acc)[2][2][4][2], const Unit& u, int wr, int wc, int fr, int fq, int ui, LAS unsigned char* lds) const {
        if (dry) { float t = 0.f; _Pragma("unroll") for (int ai = 0; ai < 2; ++ai) _Pragma("unroll") for (int bj = 0; bj < 2; ++bj) _Pragma("unroll") for (int m = 0; m < 4; ++m) t += acc[ai][bj][m][0][0] + acc[ai][bj][m][1][3]; asm volatile("" :: "v"(t)); return; }
        const int lr0 = wr * 64 + fr, cb = u.pn * 256 + wc * 32 + 8 * fq;
#pragma unroll
        for (int ai = 0; ai < 2; ++ai)
#pragma unroll
            for (int m = 0; m < 4; ++m) { const int lr = lr0 + ai * 128 + m * 16;
                if (lr < u.nrows) { unsigned char* rp = ys + (size_t)(u.orow0 + lr) * 1024 + cb;
                    const float sc = (YS_SCALE / (ACT_SCALE * WD_SCALE)) * ((const LAS float*)(lds + RING_BYTES + 1024 + 12288))[(ui & 1) * 256 + lr];
#pragma unroll
                    for (int bj = 0; bj < 2; ++bj) { u32x2 w; w.x = cvt4_fp8(acc[ai][bj][m][0], sc); w.y = cvt4_fp8(acc[ai][bj][m][1], sc); *(u32x2*)(rp + 128 * bj) = w; } } }
    }
};
}
struct Frame {
    LAS unsigned char* lds;
    volatile LAS unsigned* MISC;
    gu32* ctl;
    int tid, lane, wave, vcu, G;
    unsigned char* ws;
    float* out;
    __device__ __forceinline__ void refresh() { int t = threadIdx.x; asm volatile("" : "+v"(t)); tid = t; lane = t & 63; wave = __builtin_amdgcn_readfirstlane(t >> 6);
        asm volatile("" : "+s"(ws)); asm volatile("" : "+s"(out)); ctl = (gu32*)(ws + WS_CTL); }
};
__device__ __forceinline__ int fresh_tid() { int t = threadIdx.x; asm volatile("" : "+v"(t)); return t; }
template <class T> __device__ __forceinline__ T* wsp(const Frame& F, size_t off) { return (T*)(F.ws + off); }

struct MapOff { int off; __device__ int operator()(int n) const { return n + off; } };
struct MapWin { __device__ int operator()(int n) const {
    if (n < 1024) { const int sec = n >> 9, nn = n & 511, hh = nn >> 6, d = nn & 63; return sec * 512 + (hh >> 2) * 256 + 128 * (d >> 5) + 32 * (hh & 3) + (d & 31); }
    return n < 1952 ? n : n + 96; } };
struct MapUq { __device__ int operator()(int n) const { const int hh = n / 96, d = n % 96;
    return d < 64 ? (hh >> 2) * 256 + 128 * (d >> 5) + 32 * (hh & 3) + (d & 31) : 512 + 128 * (hh & 1) + 32 * (hh >> 1) + (d - 64); } };
struct MapUkv { __device__ int operator()(int n) const { const int hh = n >> 7, d = n & 127, dd = d & 63, wcn = 2 * (hh & 1) + (d >> 6);
    return (hh >> 1) * 256 + 128 * (dd >> 5) + 32 * wcn + (dd & 31); } };
struct MapCat { int up; __device__ int operator()(int n) const { return (n >> 7) * 256 + up * 128 + (n & 127); } };
struct MapGU { int up; __device__ int operator()(int f) const { return (f >> 7) * 256 + up * 128 + (f & 127); } };

template <class Map> __device__ __forceinline__ void transpose_item(const float* W, int K, int N, bf16_t* WT, Map rm, const float* kscale, LAS float* scr, int item, int lane, int ldt = 0, int koff = 0) {
    if (ldt == 0) ldt = K;
    const int nblk = N / 32, kb = item / nblk, nb = item % nblk, k0 = 64 * kb, n0 = 32 * nb;
    float tv[32];
#pragma unroll
    for (int i = 0; i < 32; ++i) { const int kk = 2 * i + (lane >> 5); tv[i] = __builtin_nontemporal_load(W + (size_t)(k0 + kk) * N + n0 + (lane & 31)); }
#pragma unroll
    for (int i = 0; i < 32; ++i) { const int kk = 2 * i + (lane >> 5); float v = tv[i]; if (kscale) v *= kscale[k0 + kk]; scr[kk * 33 + (lane & 31)] = v; }
    LDS_WAIT(); asm volatile("" ::: "memory");
    const int c = lane & 7;
#pragma unroll
    for (int j = 0; j < 4; ++j) { const int n = (lane >> 3) + 8 * j; const LAS float* s = scr + (8 * c) * 33 + n;
        u32x4 o; o.x = pk2(s[0 * 33], s[1 * 33]); o.y = pk2(s[2 * 33], s[3 * 33]); o.z = pk2(s[4 * 33], s[5 * 33]); o.w = pk2(s[6 * 33], s[7 * 33]);
        *(u32x4*)(WT + (size_t)rm(n0 + n) * ldt + koff + k0 + 8 * c) = o; }
    LDS_WAIT(); asm volatile("" ::: "memory");
}


template <class Map> __device__ __forceinline__ void transpose_item_fp8(const float* W, int K, int N, unsigned char* WT, Map rm, float sc, LAS float* scr, int item, int lane, int ldt = 0, int koff = 0) {
    if (ldt == 0) ldt = K;
    const int nblk = N / 32, kb = item / nblk, nb = item % nblk, k0 = 64 * kb, n0 = 32 * nb;
    float tv[32];
#pragma unroll
    for (int i = 0; i < 32; ++i) { const int kk = 2 * i + (lane >> 5); tv[i] = __builtin_nontemporal_load(W + (size_t)(k0 + kk) * N + n0 + (lane & 31)); }
#pragma unroll
    for (int i = 0; i < 32; ++i) { const int kk = 2 * i + (lane >> 5); scr[kk * 33 + (lane & 31)] = tv[i]; }
    LDS_WAIT(); asm volatile("" ::: "memory");
    const int c = lane & 3;
#pragma unroll
    for (int j = 0; j < 2; ++j) { const int n = (lane >> 2) + 16 * j; const LAS float* s = scr + (16 * c) * 33 + n;
        u32x4 o;
#pragma unroll
        for (int q = 0; q < 4; ++q) o[q] = cvt4_fp8((f32x4){s[(4 * q + 0) * 33], s[(4 * q + 1) * 33], s[(4 * q + 2) * 33], s[(4 * q + 3) * 33]}, sc);
        *(u32x4*)(WT + (size_t)rm(n0 + n) * ldt + koff + k0 + 16 * c) = o; }
    LDS_WAIT(); asm volatile("" ::: "memory");
}

__device__ __forceinline__ void p0_prologue(Frame& F, const Args& A) {
    const int tid = F.tid;
    {
        LAS float* sc = (LAS float*)F.lds;
        LAS float* part = (LAS float*)(F.lds + 32768);
        for (int i = tid; i < NB * DM; i += NTHR) { const float v = INF(I_c)[i]; sc[i] = v / (1.0f + expf(-v)); }
        __syncthreads();
        for (int n0 = 24 * (int)blockIdx.x; n0 < 6 * DM; n0 += 24 * F.G) {
        const int kk = tid >> 5, col = tid & 31;
        float a[8];
#pragma unroll
        for (int b = 0; b < 8; ++b) a[b] = 0.f;
        if (col < 24) {
#pragma unroll 1
            for (int k0 = kk; k0 < DM; k0 += 16 * 32) { float wv[32];
#pragma unroll
                for (int q = 0; q < 32; ++q) wv[q] = INF(I_w_ada)[(size_t)(k0 + 16 * q) * 6144 + n0 + col];
#pragma unroll
                for (int q = 0; q < 32; ++q) {
#pragma unroll
                    for (int b = 0; b < 8; ++b) a[b] = fmaf(sc[b * DM + k0 + 16 * q], wv[q], a[b]); } }
        }
#pragma unroll
        for (int b = 0; b < 8; ++b) part[(kk * 8 + b) * 32 + col] = a[b];
        __syncthreads();
        if (tid < 192) { const int b = tid / 24, cc = tid % 24; float s = 0.f;
#pragma unroll
            for (int q = 0; q < 16; ++q) s += part[(q * 8 + b) * 32 + cc];
            wsp<float>(F, WS_MOD)[(size_t)b * 6144 + n0 + cc] = s + INF(I_b_ada)[n0 + cc]; }
        __syncthreads();
        }
    }
}
__device__ __forceinline__ void p0_copies(Frame& F, const Args& A) {
    const int tid = F.tid;
    LAS float* scr = (LAS float*)(F.lds + F.wave * 16384);
    const int gw = F.vcu * NWAVES + F.wave, NGW = F.G * NWAVES;
    constexpr int I_IN = 16 * 125, I_UQ = 4 * 24, I_UKV = 2 * 32, I_PN = 8 * 32, I_OUT = 16 * 32;
    constexpr int NITEMS = I_IN + I_UQ + I_UKV + 2 * I_PN + I_OUT;
    for (int it = gw; it < NITEMS; it += NGW) {
        int r = it;
        if (r < I_IN) { transpose_item_fp8(INF(I_w_in), DM, INCOLS, wsp<unsigned char>(F, WS_WIN), MapWin{}, WIN_SCALE, scr, r, F.lane, LDW); continue; } r -= I_IN;
        if (r < I_UQ) { transpose_item(INF(I_w_uq), QRANK, MH * QKD, wsp<bf16_t>(F, WS_WUQ), MapUq{}, INF(I_g_q_lat), scr, r, F.lane); continue; } r -= I_UQ;
        if (r < I_UKV) { transpose_item(INF(I_w_ukv), KVRANK, MH * 128, wsp<bf16_t>(F, WS_WUKV), MapUkv{}, INF(I_g_kv_lat), scr, r, F.lane); continue; } r -= I_UKV;
        if (r < I_PN) { transpose_item_fp8(INF(I_w_proj_na), 512, DM, wsp<unsigned char>(F, WS_WPCAT), MapCat{0}, WP_SCALE, scr, r, F.lane, 1024, 0); continue; } r -= I_PN;
        if (r < I_PN) { transpose_item_fp8(INF(I_w_proj_mla), 512, DM, wsp<unsigned char>(F, WS_WPCAT), MapCat{1}, WP_SCALE, scr, r, F.lane, 1024, 512); continue; } r -= I_PN;
        transpose_item_fp8(INF(I_w_out), DM, DM, wsp<unsigned char>(F, WS_WOUT), MapOff{0}, WOUT_SCALE, scr, r, F.lane);
    }
#ifdef TSA
    if (blockIdx.x == TSWG && threadIdx.x == 0) { const unsigned long long t_ = __builtin_amdgcn_s_memrealtime(); ((LAS unsigned*)(F.lds + TAB_OFF + 2048))[44] = (unsigned)t_; ((LAS unsigned*)(F.lds + TAB_OFF + 2048))[45] = (unsigned)(t_ >> 32); }
#endif
    const int gt = F.vcu * NTHR + tid, NGT = F.G * NTHR;
    for (int i = gt; i < 96 * 64; i += NGT) *(u32x4*)(wsp<unsigned char>(F, WS_WIN) + (size_t)(1952 + i / 64) * LDW + (size_t)(i % 64) * 16) = (u32x4){0u, 0u, 0u, 0u};
    for (int i = gt; i < 2048 * 32; i += NGT) { const int row = i >> 5, q = i & 31; *(u32x4*)(wsp<unsigned char>(F, WS_WPCAT) + (size_t)row * 1024 + ((row & 128) ? 0 : 512) + q * 16) = (u32x4){0u, 0u, 0u, 0u}; }
    for (int i = gt; i < NT * 16; i += NGT) { const int t = i >> 4, q = i & 15;
        const float inv = powf(10000.0f, -(float)q / 16.0f), ang = (float)((const int*)A.in[I_positions])[t] * inv;
        wsp<float>(F, WS_RCOS)[i] = cosf(ang); wsp<float>(F, WS_RSIN)[i] = sinf(ang); }
    for (int i = gt; i < 4 * 32 * 64; i += NGT) { const int ct = i >> 11, ks = (i >> 6) & 31, l = i & 63; float w[8];
#pragma unroll
        for (int j = 0; j < 8; ++j) w[j] = INF(I_w_router)[(size_t)(32 * ks + 8 * (l >> 4) + j) * NEXP + 16 * ct + (l & 15)];
        u32x4 hw, lw;
#pragma unroll
        for (int q = 0; q < 4; ++q) { const unsigned h2 = pk2(w[2 * q], w[2 * q + 1]); hw[q] = h2; lw[q] = pk2(w[2 * q] - bflo(h2), w[2 * q + 1] - bfhi(h2)); }
        wsp<u32x4>(F, WS_RFRAG)[(size_t)i * 2] = hw; wsp<u32x4>(F, WS_RFRAG)[(size_t)i * 2 + 1] = lw; }
#ifdef TSA
    if (blockIdx.x == TSWG && threadIdx.x == 0) { const unsigned long long t_ = __builtin_amdgcn_s_memrealtime(); ((LAS unsigned*)(F.lds + TAB_OFF + 2048))[46] = (unsigned)t_; ((LAS unsigned*)(F.lds + TAB_OFF + 2048))[47] = (unsigned)(t_ >> 32); }
#endif
}

__device__ __forceinline__ void s1_modnorm(Frame& F, const Args& A) {
    const int gw = F.vcu * NWAVES + F.wave, lane = F.lane;
    const float* mod = wsp<float>(F, WS_MOD); unsigned char* H = wsp<unsigned char>(F, WS_H);
    for (int r0 = gw * 8; r0 < NT; r0 += F.G * NWAVES * 8) {
    const int b = r0 >> 11;
    f32x4 ca[4], cs[4];
#pragma unroll
    for (int j = 0; j < 4; ++j) { const int c4 = 4 * lane + 256 * j;
        const f32x4 g = *(const f32x4*)(INF(I_g_norm1) + c4), sc = *(const f32x4*)(mod + (size_t)b * 6144 + 1024 + c4);
        ca[j] = g * (sc + 1.0f); cs[j] = *(const f32x4*)(mod + (size_t)b * 6144 + c4); }
#pragma unroll 1
    for (int qb = 0; qb < 8; qb += 4) {
    f32x4 v[4][4];
#pragma unroll
    for (int q = 0; q < 4; ++q)
#pragma unroll
        for (int j = 0; j < 4; ++j) v[q][j] = __builtin_nontemporal_load((const f32x4*)(INF(I_x) + (size_t)(r0 + qb + q) * DM + 4 * lane + 256 * j));
#pragma unroll
    for (int q = 0; q < 4; ++q) { float ss = 0.f;
#pragma unroll
        for (int j = 0; j < 4; ++j) ss += sq4(v[q][j]);
        const float rstd = rsqrtf(wave_sum(ss) * (1.0f / DM) + EPS);
#pragma unroll
        for (int j = 0; j < 4; ++j) { const f32x4 o = v[q][j] * rstd * ca[j] + cs[j];
            *(unsigned*)(H + (size_t)(r0 + qb + q) * LDH + 4 * lane + 256 * j) = cvt4_fp8(o, 1.0f); }
    }
    }
    }
}
namespace attn {
__device__ __forceinline__ int crow(int r, int hi) { return (r & 3) + 8 * (r >> 2) + 4 * hi; }
constexpr int KVBLK = 64;
constexpr int L_K = 0, L_V = 26624, L_WS = 43008, L_OST = 45056, L_BIAS = 77824, L_MASK = L_BIAS + 4 * 15 * 128 * 4, L_END = L_MASK + 4 * 128 * 4;
constexpr int KBUF = 13312, VBUF = 8192;
constexpr float THRN = 8.0f;

template <int DQK> struct Geo { static constexpr int KROWB = DQK * 2 + 16, NCH = DQK / 8, ND0 = DQK / 16; };

__device__ __forceinline__ int v_st(int k, int c) { const int kk = (k & ~0xC) | ((k & 4) << 1) | ((k & 8) >> 1); return ((kk >> 3) * 2 + (c >> 5)) * 512 + ((kk & 7) * 32 + (c & 31)) * 2; }
__device__ __forceinline__ int v_rd_base(int lane) { return ((lane & 3) << 3) | (((lane >> 2) & 3) << 6) | (((lane >> 4) & 1) << 5) | (((lane >> 5) & 1) << 8); }
constexpr int v_rd_off(int d0, int ks, int half) { return d0 * 512 + ks * 2048 + half * 1024; }
template <int OFF> __device__ __forceinline__ s16x4 tr_read(int vb) { s16x4 r; asm volatile("ds_read_b64_tr_b16 %0, %1 offset:%2" : "=&v"(r) : "v"(vb), "i"(OFF) : "memory"); return r; }

template <int D0> __device__ __forceinline__ void pv_one(f32x16& od, int vb, bf16x8 pa0, bf16x8 pa1, bf16x8 pa2, bf16x8 pa3) {
    const s16x4 l0 = tr_read<v_rd_off(D0, 0, 0)>(vb), h0 = tr_read<v_rd_off(D0, 0, 1)>(vb), l1 = tr_read<v_rd_off(D0, 1, 0)>(vb), h1 = tr_read<v_rd_off(D0, 1, 1)>(vb);
    const s16x4 l2 = tr_read<v_rd_off(D0, 2, 0)>(vb), h2 = tr_read<v_rd_off(D0, 2, 1)>(vb), l3 = tr_read<v_rd_off(D0, 3, 0)>(vb), h3 = tr_read<v_rd_off(D0, 3, 1)>(vb);
    asm volatile("s_waitcnt lgkmcnt(0)" ::: "memory"); SBAR();
#define PK(L, H) (bf16x8){L[0], L[1], L[2], L[3], H[0], H[1], H[2], H[3]}
    od = __builtin_amdgcn_mfma_f32_32x32x16_bf16(pa0, PK(l0, h0), od, 0, 0, 0);
    od = __builtin_amdgcn_mfma_f32_32x32x16_bf16(pa1, PK(l1, h1), od, 0, 0, 0);
    od = __builtin_amdgcn_mfma_f32_32x32x16_bf16(pa2, PK(l2, h2), od, 0, 0, 0);
    od = __builtin_amdgcn_mfma_f32_32x32x16_bf16(pa3, PK(l3, h3), od, 0, 0, 0);
#undef PK
}

template <int DQK> __device__ __forceinline__ void qkt(f32x16& p0, f32x16& p1, const LAS unsigned char* Ks, const bf16x8* qr, int r32, int hi) {
    p0 = f32x16{}; p1 = f32x16{};
#pragma unroll
    for (int d0 = 0; d0 < Geo<DQK>::ND0; ++d0) { const int cb = (d0 * 16 + hi * 8) * 2;
        const bf16x8 b0 = *(const LAS bf16x8*)(Ks + r32 * Geo<DQK>::KROWB + cb);
        const bf16x8 b1 = *(const LAS bf16x8*)(Ks + (32 + r32) * Geo<DQK>::KROWB + cb);
        p0 = __builtin_amdgcn_mfma_f32_32x32x16_bf16(b0, qr[d0], p0, 0, 0, 0);
        p1 = __builtin_amdgcn_mfma_f32_32x32x16_bf16(b1, qr[d0], p1, 0, 0, 0); }
}
__device__ __forceinline__ void softmax_tile(f32x16& p0, f32x16& p1, float& l_reg, float C, float nBC, bf16x8& pa0, bf16x8& pa1, bf16x8& pa2, bf16x8& pa3) {
#pragma unroll
    for (int r = 0; r < 16; ++r) { p0[r] = __builtin_amdgcn_exp2f(fmaf(p0[r], C, nBC)); p1[r] = __builtin_amdgcn_exp2f(fmaf(p1[r], C, nBC)); }
    float ps = 0;
#pragma unroll
    for (int r = 0; r < 16; ++r) ps += p0[r];
#pragma unroll
    for (int r = 0; r < 16; ++r) ps += p1[r];
    l_reg += ps;
#define PK4(P, BASE, OUT) do { unsigned a0 = cvt_pk_bf16(P[BASE + 0], P[BASE + 1]), a1 = cvt_pk_bf16(P[BASE + 2], P[BASE + 3]);   \
    unsigned b0 = cvt_pk_bf16(P[BASE + 4], P[BASE + 5]), b1 = cvt_pk_bf16(P[BASE + 6], P[BASE + 7]);                              \
    auto r0 = __builtin_amdgcn_permlane32_swap(a0, b0, false, false); auto r1 = __builtin_amdgcn_permlane32_swap(a1, b1, false, false); \
    u32x4 w = {r0[0], r1[0], r0[1], r1[1]}; OUT = __builtin_bit_cast(bf16x8, w); } while (0)
    PK4(p0, 0, pa0); PK4(p0, 8, pa1); PK4(p1, 0, pa2); PK4(p1, 8, pa3);
#undef PK4
}

template <int DQK, bool NA>
__device__ __forceinline__ void attn_unit(LAS unsigned char* lds, const bf16_t* Qw, int ldq, float qscale, const bf16_t* Kt, int ldk, const bf16_t* Vt, int ldv, bf16_t* Ow,
                                          int ntiles, float SCALE, float bound_raw, int na_first, int na_qc0, int na_dr0) {
    using G = Geo<DQK>;
    int tid_ = threadIdx.x; asm volatile("" : "+v"(tid_));
    const int tid = tid_, lane = tid & 63, r32 = lane & 31, hi = lane >> 5; const int wid = __builtin_amdgcn_readfirstlane(tid >> 6);
    const float C = SCALE * 1.4426950408889634f, nBC = -bound_raw * C;
    LAS float* wsf = (LAS float*)(lds + L_WS) + wid * 64;
    bf16x8 qr[G::ND0];
#pragma unroll
    for (int d0 = 0; d0 < G::ND0; ++d0) { u32x4 w = *(const u32x4*)(Qw + (size_t)r32 * ldq + d0 * 16 + hi * 8);
        if (!NA) { f32x4 a, b; a = (f32x4){bflo(w.x), bfhi(w.x), bflo(w.y), bfhi(w.y)} * qscale; b = (f32x4){bflo(w.z), bfhi(w.z), bflo(w.w), bfhi(w.w)} * qscale;
            w.x = cvt_pk_bf16(a[0], a[1]); w.y = cvt_pk_bf16(a[2], a[3]); w.z = cvt_pk_bf16(b[0], b[1]); w.w = cvt_pk_bf16(b[2], b[3]); }
        qr[d0] = __builtin_bit_cast(bf16x8, w); }
    const int vk = tid >> 3, vc = (tid & 7) * 8, vst = v_st(vk, vc);
    const int k0r = tid / G::NCH, k0c = tid % G::NCH; const int k1id = tid + 512, k1r = k1id / G::NCH, k1c = k1id % G::NCH; const bool k1on = (G::NCH == 12) && (tid < 256);
    const int vb0 = (int)(uintptr_t)(lds + L_V) + v_rd_base(lane);
    u32x4 sv, sk0, sk1;
#define SLOAD(j) do { const size_t kb_ = (size_t)(j) * KVBLK; sv = *(const u32x4*)(Vt + (kb_ + vk) * ldv + vc); sk0 = *(const u32x4*)(Kt + (kb_ + k0r) * ldk + k0c * 8); \
        if (k1on) sk1 = *(const u32x4*)(Kt + (kb_ + k1r) * ldk + k1c * 8); } while (0)
#define SWRITE(bf) do { *(LAS u32x4*)(lds + L_V + (bf) * VBUF + vst) = sv; *(LAS u32x4*)(lds + L_K + (bf) * KBUF + k0r * G::KROWB + k0c * 16) = sk0; \
        if (k1on) *(LAS u32x4*)(lds + L_K + (bf) * KBUF + k1r * G::KROWB + k1c * 16) = sk1; } while (0)
    float l_reg = 0.f; f32x16 o[2]; o[0] = f32x16{}; o[1] = f32x16{};
    const LAS float* tb_lane = nullptr; f32x4 mk0[4], mk1[4];
    if (NA) { const int qc = na_qc0 + r32, i0 = 4 * hi - qc + 63, sft = i0 & 3;
        tb_lane = (const LAS float*)(lds + L_BIAS) + sft * (15 * 128) + (i0 - sft);
        int qe = qc < 8 ? 8 : (qc > 56 ? 56 : qc); const int j0 = 4 * hi - qe + 56, sf2 = j0 & 3;
        const LAS float* tm = (const LAS float*)(lds + L_MASK) + sf2 * 128 + (j0 - sf2);
#pragma unroll
        for (int g4 = 0; g4 < 4; ++g4) { mk0[g4] = *(const LAS f32x4*)(tm + 8 * g4); mk1[g4] = *(const LAS f32x4*)(tm + 8 * g4 + 32); } }
    SLOAD(0); VM_WAIT(); SWRITE(0); if (ntiles > 1) SLOAD(1);
    __syncthreads();
    for (int j = 0; j < ntiles; ++j) {
        const int bf = j & 1;
        bool active = true; int dr = 0;
        if (NA) { dr = na_dr0 + j; active = (j >= na_first) && (j < na_first + 8); }
        if (active) {
            f32x16 p0, p1; bf16x8 pa0, pa1, pa2, pa3;
            qkt<DQK>(p0, p1, lds + L_K + bf * KBUF, qr, r32, hi);
            if (NA) {
                const LAS float* bt = tb_lane + (dr + 7) * 128;
#pragma unroll
                for (int g4 = 0; g4 < 4; ++g4) {
                    const f32x4 b0 = *(const LAS f32x4*)(bt + 8 * g4), b1 = *(const LAS f32x4*)(bt + 8 * g4 + 32);
#pragma unroll
                    for (int e = 0; e < 4; ++e) { p0[4 * g4 + e] = (p0[4 * g4 + e] + b0[e]) + mk0[g4][e]; p1[4 * g4 + e] = (p1[4 * g4 + e] + b1[e]) + mk1[g4][e]; }
                }
            }
            softmax_tile(p0, p1, l_reg, C, nBC, pa0, pa1, pa2, pa3);
            SBAR();
            pv_one<0>(o[0], vb0 + bf * VBUF, pa0, pa1, pa2, pa3); pv_one<1>(o[1], vb0 + bf * VBUF, pa0, pa1, pa2, pa3);
        }
        if (j + 1 < ntiles) { VM_WAIT(); SWRITE(bf ^ 1); if (j + 2 < ntiles) SLOAD(j + 2); }
        __syncthreads();
    }
#undef SLOAD
#undef SWRITE
    { auto rr = __builtin_amdgcn_permlane32_swap(__float_as_uint(l_reg), __float_as_uint(l_reg), false, false); l_reg = __uint_as_float(rr[0]) + __uint_as_float(rr[1]); }
    if (hi == 0) wsf[32 + r32] = l_reg; LDS_WAIT();
    float rli[16];
#pragma unroll
    for (int r = 0; r < 16; ++r) rli[r] = __builtin_amdgcn_rcpf(wsf[32 + crow(r, hi)]);
    LAS bf16_t* stg = (LAS bf16_t*)(lds + L_OST) + wid * 2048;
#pragma unroll
    for (int r = 0; r < 16; ++r) { const int orow = crow(r, hi);
#pragma unroll
        for (int d0 = 0; d0 < 2; ++d0) stg[orow * 64 + d0 * 32 + r32] = (bf16_t)f2bf(o[d0][r] * rli[r]); }
    LDS_WAIT();
#pragma unroll
    for (int i = 0; i < 4; ++i) { const int row = i * 8 + (lane >> 3), ch = lane & 7; const u32x4 v = *(const LAS u32x4*)(stg + row * 64 + ch * 8); u32x2 w8; w8.x = cvt4_fp8((f32x4){bflo(v.x), bfhi(v.x), bflo(v.y), bfhi(v.y)}, Y_SCALE); w8.y = cvt4_fp8((f32x4){bflo(v.z), bfhi(v.z), bflo(v.w), bfhi(v.w)}, Y_SCALE); *(u32x2*)((unsigned char*)Ow + (size_t)row * 1024 + ch * 8) = w8; }
    LDS_WAIT();
    __syncthreads();
}

__device__ __forceinline__ void partialSM(f32x16& p0, f32x16& p1, float C, float nBC) {
#pragma unroll
    for (int r = 0; r < 16; ++r) { p0[r] = fmaf(p0[r], C, nBC); p1[r] = fmaf(p1[r], C, nBC); }
#pragma unroll
    for (int r = 0; r < 16; ++r) p0[r] = __builtin_amdgcn_exp2f(p0[r]);
}
__device__ __forceinline__ void finishSM(f32x16& p0, f32x16& p1, float& l_reg, bf16x8& pa0, bf16x8& pa1, bf16x8& pa2, bf16x8& pa3) {
#pragma unroll
    for (int r = 0; r < 16; ++r) p1[r] = __builtin_amdgcn_exp2f(p1[r]);
    float ps = 0;
#pragma unroll
    for (int r = 0; r < 16; ++r) ps += p0[r];
#pragma unroll
    for (int r = 0; r < 16; ++r) ps += p1[r];
    l_reg += ps;
#define PK4(P, BASE, OUT) do { unsigned a0 = cvt_pk_bf16(P[BASE + 0], P[BASE + 1]), a1 = cvt_pk_bf16(P[BASE + 2], P[BASE + 3]);   \
    unsigned b0 = cvt_pk_bf16(P[BASE + 4], P[BASE + 5]), b1 = cvt_pk_bf16(P[BASE + 6], P[BASE + 7]);                              \
    auto r0 = __builtin_amdgcn_permlane32_swap(a0, b0, false, false); auto r1 = __builtin_amdgcn_permlane32_swap(a1, b1, false, false); \
    u32x4 w = {r0[0], r1[0], r0[1], r1[1]}; OUT = __builtin_bit_cast(bf16x8, w); } while (0)
    PK4(p0, 0, pa0); PK4(p0, 8, pa1); PK4(p1, 0, pa2); PK4(p1, 8, pa3);
#undef PK4
}
template <int DQK>
__device__ __forceinline__ void attn_unit_pipe(LAS unsigned char* lds, const bf16_t* Qw, int ldq, float qscale, const bf16_t* Kt, int ldk, const bf16_t* Vt, int ldv, bf16_t* Ow, int ntiles, float SCALE, float bound_raw) {
    using G = Geo<DQK>;
    int tid_ = threadIdx.x; asm volatile("" : "+v"(tid_));
    const int tid = tid_, lane = tid & 63, r32 = lane & 31, hi = lane >> 5; const int wid = __builtin_amdgcn_readfirstlane(tid >> 6);
    const float C = SCALE * 1.4426950408889634f, nBC = -bound_raw * C;
    constexpr int P_K = 0, P_V = 3 * KBUF, P_WS = P_V + 3 * VBUF, P_OST = P_WS + 2048;
    LAS float* wsf = (LAS float*)(lds + P_WS) + wid * 64;
    bf16x8 qr[G::ND0];
#pragma unroll
    for (int d0 = 0; d0 < G::ND0; ++d0) { u32x4 w = *(const u32x4*)(Qw + (size_t)r32 * ldq + d0 * 16 + hi * 8);
        f32x4 a, b; a = (f32x4){bflo(w.x), bfhi(w.x), bflo(w.y), bfhi(w.y)} * qscale; b = (f32x4){bflo(w.z), bfhi(w.z), bflo(w.w), bfhi(w.w)} * qscale;
        w.x = cvt_pk_bf16(a[0], a[1]); w.y = cvt_pk_bf16(a[2], a[3]); w.z = cvt_pk_bf16(b[0], b[1]); w.w = cvt_pk_bf16(b[2], b[3]);
        qr[d0] = __builtin_bit_cast(bf16x8, w); }
    const int vk = tid >> 3, vc = (tid & 7) * 8, vst = v_st(vk, vc);
    const int k0r = tid / G::NCH, k0c = tid % G::NCH; const int k1id = tid + 512, k1r = k1id / G::NCH, k1c = k1id % G::NCH; const bool k1on = (G::NCH == 12) && (wid < 4);
    const int vb0 = (int)(uintptr_t)(lds + P_V) + v_rd_base(lane);
    u32x4 evv, ek0, ek1, ovv, ok0, ok1;
    const __amdgpu_buffer_rsrc_t krs = __builtin_amdgcn_make_buffer_rsrc((void*)Kt, 0, 0x7fffffff, 0x00020000);
    const __amdgpu_buffer_rsrc_t vrs = __builtin_amdgcn_make_buffer_rsrc((void*)Vt, 0, 0x7fffffff, 0x00020000);
    const int voV = (vk * ldv + vc) * 2, voK0 = (k0r * ldk + k0c * 8) * 2, voK1 = (k1r * ldk + k1c * 8) * 2;
#define SLOAD(V_, K0_, K1_, j) do { V_ = __builtin_bit_cast(u32x4, __builtin_amdgcn_raw_buffer_load_b128(vrs, voV, (j) * (KVBLK * 2) * ldv, 0)); \
        K0_ = __builtin_bit_cast(u32x4, __builtin_amdgcn_raw_buffer_load_b128(krs, voK0, (j) * (KVBLK * 2) * ldk, 0)); \
        if (k1on) K1_ = __builtin_bit_cast(u32x4, __builtin_amdgcn_raw_buffer_load_b128(krs, voK1, (j) * (KVBLK * 2) * ldk, 0)); } while (0)
#define SWRITE(bf, V_, K0_, K1_) do { *(LAS u32x4*)(lds + P_V + (bf) * VBUF + vst) = V_; *(LAS u32x4*)(lds + P_K + (bf) * KBUF + k0r * G::KROWB + k0c * 16) = K0_; \
        if (k1on) *(LAS u32x4*)(lds + P_K + (bf) * KBUF + k1r * G::KROWB + k1c * 16) = K1_; } while (0)
#define RESC(a) do { if (__any((a) < 1.f)) { if (hi == 0) wsf[r32] = (a); LDS_WAIT(); \
        _Pragma("unroll") for (int d = 0; d < 2; ++d) _Pragma("unroll") for (int r = 0; r < 16; ++r) o[d][r] *= wsf[crow(r, hi)]; } } while (0)
    float l_reg = 0.f; f32x16 o[2]; o[0] = f32x16{}; o[1] = f32x16{};
    f32x16 pA0, pA1, pB0, pB1; bf16x8 pa0, pa1, pa2, pa3;
    const LAS unsigned char* Kp = lds + P_K;
    SLOAD(evv, ek0, ek1, 0); SWRITE(0, evv, ek0, ek1); __syncthreads();
    qkt<DQK>(pA0, pA1, Kp, qr, r32, hi); partialSM(pA0, pA1, C, nBC);
    SLOAD(ovv, ok0, ok1, 1); SLOAD(evv, ek0, ek1, 2);
    SWRITE(1, ovv, ok0, ok1); __syncthreads();
    int pb = 0, cb = 1, nb = 2;
    for (int j = 1; j + 1 < ntiles; j += 2) {
        SBAR(); qkt<DQK>(pB0, pB1, Kp + cb * KBUF, qr, r32, hi);
        finishSM(pA0, pA1, l_reg, pa0, pa1, pa2, pa3); SBAR();
        SLOAD(ovv, ok0, ok1, j + 2); SBAR();
        pv_one<0>(o[0], vb0 + pb * VBUF, pa0, pa1, pa2, pa3); pv_one<1>(o[1], vb0 + pb * VBUF, pa0, pa1, pa2, pa3); partialSM(pB0, pB1, C, nBC);
        SWRITE(nb, evv, ek0, ek1);
        __syncthreads();
        SBAR(); qkt<DQK>(pA0, pA1, Kp + nb * KBUF, qr, r32, hi);
        finishSM(pB0, pB1, l_reg, pa0, pa1, pa2, pa3); SBAR();
        if (j + 3 < ntiles) SLOAD(evv, ek0, ek1, j + 3); SBAR();
        pv_one<0>(o[0], vb0 + cb * VBUF, pa0, pa1, pa2, pa3); pv_one<1>(o[1], vb0 + cb * VBUF, pa0, pa1, pa2, pa3); partialSM(pA0, pA1, C, nBC);
        SWRITE(pb, ovv, ok0, ok1);
        __syncthreads();
        { const int t_ = cb; cb = pb; pb = nb; nb = t_; }
    }
    SBAR(); qkt<DQK>(pB0, pB1, Kp + cb * KBUF, qr, r32, hi);
    finishSM(pA0, pA1, l_reg, pa0, pa1, pa2, pa3); SBAR();
    pv_one<0>(o[0], vb0 + pb * VBUF, pa0, pa1, pa2, pa3); pv_one<1>(o[1], vb0 + pb * VBUF, pa0, pa1, pa2, pa3); partialSM(pB0, pB1, C, nBC);
    finishSM(pB0, pB1, l_reg, pa0, pa1, pa2, pa3); SBAR();
    pv_one<0>(o[0], vb0 + cb * VBUF, pa0, pa1, pa2, pa3); pv_one<1>(o[1], vb0 + cb * VBUF, pa0, pa1, pa2, pa3);
#undef SLOAD
#undef SWRITE
#undef RESC
    { auto rr = __builtin_amdgcn_permlane32_swap(__float_as_uint(l_reg), __float_as_uint(l_reg), false, false); l_reg = __uint_as_float(rr[0]) + __uint_as_float(rr[1]); }
    if (hi == 0) wsf[32 + r32] = l_reg; LDS_WAIT();
    float rli[16];
#pragma unroll
    for (int r = 0; r < 16; ++r) rli[r] = __builtin_amdgcn_rcpf(wsf[32 + crow(r, hi)]);
    LAS bf16_t* stg = (LAS bf16_t*)(lds + P_OST) + wid * 2048;
#pragma unroll
    for (int r = 0; r < 16; ++r) { const int orow = crow(r, hi);
#pragma unroll
        for (int d0 = 0; d0 < 2; ++d0) stg[orow * 64 + d0 * 32 + r32] = (bf16_t)f2bf(o[d0][r] * rli[r]); }
    LDS_WAIT();
#pragma unroll
    for (int i = 0; i < 4; ++i) { const int lf = lane_fresh(), row = i * 8 + (lf >> 3), ch = lf & 7; const u32x4 v = *(const LAS u32x4*)(stg + row * 64 + ch * 8); u32x2 w8; w8.x = cvt4_fp8((f32x4){bflo(v.x), bfhi(v.x), bflo(v.y), bfhi(v.y)}, Y_SCALE); w8.y = cvt4_fp8((f32x4){bflo(v.z), bfhi(v.z), bflo(v.w), bfhi(v.w)}, Y_SCALE); *(u32x2*)((unsigned char*)Ow + (size_t)row * 1024 + ch * 8) = w8; }
    LDS_WAIT();
    __syncthreads();
}

constexpr int NA2_TAB = RING_BYTES + 1024 + 4096, NA2_WS = RING_BYTES + 1024 + 12288;
__device__ __forceinline__ void na_wave(LAS unsigned char* lds, const bf16_t* Qw, const bf16_t* Kt, const bf16_t* Vt, bf16_t* Ow, int qc0, int dr0, float bound_raw) {
    int tid_ = threadIdx.x; asm volatile("" : "+v"(tid_));
    const int lane = tid_ & 63, r32 = lane & 31, hi = lane >> 5; const int wid = __builtin_amdgcn_readfirstlane(tid_ >> 6);
    constexpr float SCALE = 0.125f; const float C = SCALE * 1.4426950408889634f, nBC = -bound_raw * C;
    LAS unsigned char* Kl = lds + wid * 16384; LAS unsigned char* Vl = Kl + 8192;
    LAS float* wsf = (LAS float*)(lds + NA2_WS) + wid * 64;
    bf16x8 qr[4];
#pragma unroll
    for (int d0 = 0; d0 < 4; ++d0) qr[d0] = *(const bf16x8*)(Qw + (size_t)r32 * 512 + d0 * 16 + hi * 8);
    const int qc = qc0 + r32, qe = qc < 8 ? 8 : (qc > 56 ? 56 : qc);
    f32x4 mk0[4], mk1[4];
#pragma unroll
    for (int g4 = 0; g4 < 4; ++g4)
#pragma unroll
        for (int e = 0; e < 4; ++e) { const int kc = 8 * g4 + 4 * hi + e; mk0[g4][e] = ((unsigned)(kc - qe + 8) < 16u) ? 0.f : -1e30f; mk1[g4][e] = ((unsigned)(kc + 32 - qe + 8) < 16u) ? 0.f : -1e30f; }
    const int i0 = 4 * hi - qc + 63, sft = i0 & 3;
    const LAS float* tb = (const LAS float*)(lds + NA2_TAB) + sft * (15 * 32);
    int boff[4];
#pragma unroll
    for (int g4 = 0; g4 < 4; ++g4) boff[g4] = ((i0 - sft) + 8 * g4) & 31;
    const int krow0 = qc0 ? 24 : 0;
    { const int zr0 = qc0 ? 0 : 40;
#pragma unroll
      for (int i = 0; i < 3; ++i) { const int c = lane + 64 * i, row = zr0 + (c >> 3), ch = c & 7;
          *(LAS u32x4*)(Kl + row * 128 + ((ch ^ (row & 7)) << 4)) = (u32x4){0u, 0u, 0u, 0u}; *(LAS u32x4*)(Vl + v_st(row, ch * 8)) = (u32x4){0u, 0u, 0u, 0u}; } }
    u32x4 sk[5], sv[5];
#define NA_LOAD(j) do { _Pragma("unroll") for (int i = 0; i < 5; ++i) { const int c = lane + 64 * i, row = krow0 + (c >> 3), ch = c & 7; \
        sk[i] = *(const u32x4*)(Kt + ((size_t)(j) * 64 + row) * 512 + ch * 8); sv[i] = *(const u32x4*)(Vt + ((size_t)(j) * 64 + row) * 512 + ch * 8); } } while (0)
#define NA_WRITE() do { _Pragma("unroll") for (int i = 0; i < 5; ++i) { const int c = lane + 64 * i, row = krow0 + (c >> 3), ch = c & 7; \
        *(LAS u32x4*)(Kl + row * 128 + ((ch ^ (row & 7)) << 4)) = sk[i]; *(LAS u32x4*)(Vl + v_st(row, ch * 8)) = sv[i]; } } while (0)
    const int vb0 = (int)(uintptr_t)Vl + v_rd_base(lane);
    float l_reg = 0.f; f32x16 o[2]; o[0] = f32x16{}; o[1] = f32x16{};
    NA_LOAD(0); NA_WRITE(); NA_LOAD(1);
#pragma unroll 1
    for (int j = 0; j < 8; ++j) {
        f32x16 p0 = f32x16{}, p1 = f32x16{}; bf16x8 pa0, pa1, pa2, pa3;
#pragma unroll
        for (int d0 = 0; d0 < 4; ++d0) { const int ch = 2 * d0 + hi;
            const bf16x8 b0 = *(const LAS bf16x8*)(Kl + r32 * 128 + ((ch ^ (r32 & 7)) << 4));
            const bf16x8 b1 = *(const LAS bf16x8*)(Kl + (32 + r32) * 128 + ((ch ^ (r32 & 7)) << 4));
            p0 = __builtin_amdgcn_mfma_f32_32x32x16_bf16(b0, qr[d0], p0, 0, 0, 0);
            p1 = __builtin_amdgcn_mfma_f32_32x32x16_bf16(b1, qr[d0], p1, 0, 0, 0); }
        { const LAS float* bt = tb + (dr0 + j + 7) * 32;
#pragma unroll
          for (int g4 = 0; g4 < 4; ++g4) { const f32x4 bv = *(const LAS f32x4*)(bt + boff[g4]);
#pragma unroll
            for (int e = 0; e < 4; ++e) { p0[4 * g4 + e] = (p0[4 * g4 + e] + bv[e]) + mk0[g4][e]; p1[4 * g4 + e] = (p1[4 * g4 + e] + bv[e]) + mk1[g4][e]; } } }
        softmax_tile(p0, p1, l_reg, C, nBC, pa0, pa1, pa2, pa3);
        SBAR();
        pv_one<0>(o[0], vb0, pa0, pa1, pa2, pa3); pv_one<1>(o[1], vb0, pa0, pa1, pa2, pa3);
        if (j + 1 < 8) { NA_WRITE(); if (j + 2 < 8) NA_LOAD(j + 2); }
    }
#undef NA_LOAD
#undef NA_WRITE
    { auto rr = __builtin_amdgcn_permlane32_swap(__float_as_uint(l_reg), __float_as_uint(l_reg), false, false); l_reg = __uint_as_float(rr[0]) + __uint_as_float(rr[1]); }
    if (hi == 0) wsf[32 + r32] = l_reg; LDS_WAIT();
    float rli[16];
#pragma unroll
    for (int r = 0; r < 16; ++r) rli[r] = __builtin_amdgcn_rcpf(wsf[32 + crow(r, hi)]);
    LAS bf16_t* stg = (LAS bf16_t*)Kl;
#pragma unroll
    for (int r = 0; r < 16; ++r) { const int orow = crow(r, hi);
#pragma unroll
        for (int d0 = 0; d0 < 2; ++d0) stg[orow * 64 + d0 * 32 + r32] = (bf16_t)f2bf(o[d0][r] * rli[r]); }
    LDS_WAIT();
#pragma unroll
    for (int i = 0; i < 4; ++i) { const int row = i * 8 + (lane >> 3), ch = lane & 7; const u32x4 v = *(const LAS u32x4*)(stg + row * 64 + ch * 8); u32x2 w8; w8.x = cvt4_fp8((f32x4){bflo(v.x), bfhi(v.x), bflo(v.y), bfhi(v.y)}, Y_SCALE); w8.y = cvt4_fp8((f32x4){bflo(v.z), bfhi(v.z), bflo(v.w), bfhi(v.w)}, Y_SCALE); *(u32x2*)((unsigned char*)Ow + (size_t)row * 1024 + ch * 8) = w8; }
    LDS_WAIT();
}
}

__device__ __forceinline__ void s4_attention(Frame& F, const Args& A, int rep_mla, int rep_na) {
    const int wave = F.wave;
    float bound_mla;
    { int l = threadIdx.x & 63; asm volatile("" : "+v"(l)); float mq = 0.f, mk = 0.f;
      for (int i = l; i < QKD; i += 64) { mq = fmaxf(mq, fabsf(INF(I_g_mla_q)[i])); mk = fmaxf(mk, fabsf(INF(I_g_mla_k)[i])); }
#pragma unroll
      for (int o = 1; o < 64; o <<= 1) { mq = fmaxf(mq, shx(mq, o, l)); mk = fmaxf(mk, shx(mk, o, l)); }
      bound_mla = (float)QKD * mq * mk * 1.0001f; }
    for (int rp = 0; rp < rep_mla; ++rp)
    for (int un = F.vcu; un < NB * MH * 8; un += F.G) {
        const int bh = un >> 3, qb = un & 7, b = bh >> 3, h = bh & 7;
        const int s0 = qb * 256 + wave * 32, t0 = b * SEQ + s0, r32 = F.lane & 31;
        const float* qss = wsp<float>(F, WS_QSS) + ((size_t)(t0 + r32) * 8 + h) * 2;
        const float qscale = rsqrtf((qss[0] + qss[1]) * (1.0f / 96.0f) + EPS);
        attn::attn_unit_pipe<96>(F.lds, wsp<bf16_t>(F, WS_QM) + ((size_t)bh * SEQ + s0) * 96, 96, qscale,
                                 wsp<bf16_t>(F, WS_KM) + (size_t)bh * SEQ * 96, 96, wsp<bf16_t>(F, WS_VM) + (size_t)bh * SEQ * 64, 64,
                                 (bf16_t*)(wsp<unsigned char>(F, WS_YNA) + (size_t)t0 * 1024 + 512 + h * 64), SEQ / 64, 0.10206207261596577f, bound_mla);
    }
#ifdef TSA
    if (blockIdx.x == TSWG && threadIdx.x == 0) { const unsigned long long t_ = __builtin_amdgcn_s_memrealtime(); ((LAS unsigned*)(F.lds + TAB_OFF + 2048))[40] = (unsigned)t_; ((LAS unsigned*)(F.lds + TAB_OFF + 2048))[41] = (unsigned)(t_ >> 32); }
#endif
    float bound_na;
    { int l = threadIdx.x & 63; asm volatile("" : "+v"(l)); float nq = fabsf(INF(I_g_na_q)[l]), nk = fabsf(INF(I_g_na_k)[l]), bm = 0.f;
      for (int i = l; i < NAH * 15 * 31; i += 64) bm = fmaxf(bm, fabsf(INF(I_na_rpb)[i]));
#pragma unroll
      for (int o = 1; o < 64; o <<= 1) { nq = fmaxf(nq, shx(nq, o, l)); nk = fmaxf(nk, shx(nk, o, l)); bm = fmaxf(bm, shx(bm, o, l)); }
      bound_na = (float)NAD * nq * nk * 1.0001f + 8.0f * bm; }
    for (int rp = 0; rp < rep_na; ++rp)
    for (int un = F.vcu; un < NB * NAH * 8; un += F.G) {
        const int bh = un >> 3, g = un & 7, b = bh >> 3, h = bh & 7;
        LAS float* tb = (LAS float*)(F.lds + attn::NA2_TAB);
        for (int i = F.tid; i < 4 * 15 * 32; i += NTHR) { const int sft = i / (15 * 32), rr = (i >> 5) % 15, mm = i & 31, x_ = (mm + sft + 1) & 31, dc = x_ < 16 ? x_ : x_ - 32;
            tb[i] = (dc >= -15) ? INF(I_na_rpb)[(size_t)(h * 15 + rr) * 31 + dc + 15] * 8.0f : 0.f; }
        const int qrow = 4 * g + (wave >> 1); int rs = qrow - 4; rs = rs < 0 ? 0 : (rs > 24 ? 24 : rs);
        const int t0 = b * SEQ + qrow * 64 + 32 * (wave & 1);
        __syncthreads();
        attn::na_wave(F.lds, wsp<bf16_t>(F, WS_NAQ) + (size_t)t0 * 512 + h * 64,
                      wsp<bf16_t>(F, WS_NAK) + (size_t)(b * SEQ + rs * 64) * 512 + h * 64, wsp<bf16_t>(F, WS_NAV) + (size_t)(b * SEQ + rs * 64) * 512 + h * 64,
                      (bf16_t*)(wsp<unsigned char>(F, WS_YNA) + (size_t)t0 * 1024 + h * 64), 32 * (wave & 1), rs - qrow, bound_na);
        __syncthreads();
    }
}
namespace moe {
#define RFL(x) __builtin_amdgcn_readfirstlane(x)
constexpr int ASTRB = 2064;
constexpr int L_AHI = 0, L_ALO = 16 * ASTRB, L_LG = 32 * ASTRB, L_END = L_LG + 2 * 16 * 64 * 4;
constexpr int T_CNT = 0, T_ABASE = 128, T_YBASE = 200, T_PRE = 336, T_MBOX = 340;
constexpr bool DYNQ = false;
constexpr int CW_Q = 20480;

__device__ __forceinline__ void s7_router(Frame& F, const Args& A, int rep_conv, int rep_rt) {
    const int lane = F.lane, wave = F.wave;
    const float* mod = wsp<float>(F, WS_MOD); unsigned char* H2 = wsp<unsigned char>(F, WS_H2);
    LAS unsigned char* Ahi = F.lds + L_AHI; LAS unsigned char* Alo = F.lds + L_ALO; LAS float* LG = (LAS float*)(F.lds + L_LG);
    const u32x4* rfrag = wsp<u32x4>(F, WS_RFRAG);
    int* LIST = wsp<int>(F, WS_LIST); float* WLIST = wsp<float>(F, WS_WLIST); unsigned* TOKSLOT = wsp<unsigned>(F, WS_TOKSLOT);
    LAS unsigned* pe = (LAS unsigned*)(F.lds + 81920);
    LAS float* pw = (LAS float*)(F.lds + 81920 + 4096);
    LAS unsigned* lcnt = (LAS unsigned*)(F.lds + 81920 + 8192);
    if (F.tid < 128) lcnt[F.tid] = 0u;
    __syncthreads();
    int ulocal = 0;
#ifdef TSA
#define RT_ACC(k) do { if (blockIdx.x == TSWG && threadIdx.x == 0) { const unsigned long long t_ = __builtin_amdgcn_s_memrealtime(); LAS unsigned* q_ = (LAS unsigned*)(F.lds + TAB_OFF + 2048); const unsigned long long d_ = t_ - rt_prev; unsigned long long a_ = ((unsigned long long)q_[2 * (k) + 1] << 32) | q_[2 * (k)]; a_ += d_; q_[2 * (k)] = (unsigned)a_; q_[2 * (k) + 1] = (unsigned)(a_ >> 32); rt_prev = t_; } } while (0)
    unsigned long long rt_prev = __builtin_amdgcn_s_memrealtime();
    if (blockIdx.x == TSWG && threadIdx.x == 0) { LAS unsigned* q_ = (LAS unsigned*)(F.lds + TAB_OFF + 2048); for (int k = 48; k < 64; ++k) q_[k] = 0u; }
#else
#define RT_ACC(k) do {} while (0)
#endif
    for (int rp = 0; rp < rep_rt; ++rp)
    for (int un = F.vcu; un < NT / 16; un += F.G) {
        const bool dry = rp + 1 < rep_rt;
        const int row0 = un * 16, b = row0 >> 11;
        const u32x4* bp = rfrag + ((size_t)((wave & 3) * 32 + 16 * (wave >> 2)) * 64 + lane) * 2;
        u32x4 bA[8][2], bB[8][2];
#pragma unroll
        for (int jj = 0; jj < 8; ++jj) { bA[jj][0] = bp[(size_t)jj * 128]; bA[jj][1] = bp[(size_t)jj * 128 + 1]; }
        SBAR();
        {
            f32x4 v[2][4], cg[4], csh[4];
#pragma unroll
            for (int rr = 0; rr < 2; ++rr)
#pragma unroll
                for (int j = 0; j < 4; ++j) v[rr][j] = *(const f32x4*)(F.out + (size_t)(row0 + 2 * wave + rr) * DM + 4 * lane + 256 * j);
#pragma unroll
            for (int j = 0; j < 4; ++j) { const int c4 = 4 * lane + 256 * j;
                cg[j] = *(const f32x4*)(INF(I_g_norm2) + c4) * (*(const f32x4*)(mod + (size_t)b * 6144 + 4096 + c4) + 1.0f); csh[j] = *(const f32x4*)(mod + (size_t)b * 6144 + 3072 + c4); }
#pragma unroll
            for (int rr = 0; rr < 2; ++rr) { const int lr = 2 * wave + rr, row = row0 + lr; float ss = 0.f;
#pragma unroll
                for (int j = 0; j < 4; ++j) ss += sq4(v[rr][j]);
                const float rstd = rsqrtf(wave_sum(ss) * (1.0f / DM) + EPS);
#pragma unroll
                for (int j = 0; j < 4; ++j) { const int c4 = 4 * lane + 256 * j;
                    const f32x4 o = v[rr][j] * rstd * cg[j] + csh[j];
                    *(unsigned*)(H2 + (size_t)row * DM + c4) = cvt4_fp8(o, 1.0f);
                    u32x2 hw; hw.x = cvt_pk_bf16(o[0], o[1]); hw.y = cvt_pk_bf16(o[2], o[3]);
                    const f32x4 rem = o - (f32x4){bflo(hw.x), bfhi(hw.x), bflo(hw.y), bfhi(hw.y)};
                    u32x2 lw; lw.x = cvt_pk_bf16(rem[0], rem[1]); lw.y = cvt_pk_bf16(rem[2], rem[3]);
                    *(LAS u32x2*)(Ahi + lr * ASTRB + c4 * 2) = hw; *(LAS u32x2*)(Alo + lr * ASTRB + c4 * 2) = lw; } }
        }
        __syncthreads(); RT_ACC(24);
        {
            const int ct = wave & 3, kh = wave >> 2; f32x4 acc = {0.f, 0.f, 0.f, 0.f};
            const int aoffb = (lane & 15) * ASTRB + (512 * kh + 8 * (lane >> 4)) * 2;
#pragma unroll
            for (int jj = 0; jj < 8; ++jj) { bB[jj][0] = bp[(size_t)(8 + jj) * 128]; bB[jj][1] = bp[(size_t)(8 + jj) * 128 + 1]; }
            SBAR();
#define RT_STEP(BF, sidx) do { const bf16x8 ah = *(const LAS bf16x8*)(Ahi + aoffb + (sidx) * 64), al = *(const LAS bf16x8*)(Alo + aoffb + (sidx) * 64); \
                const bf16x8 bh = __builtin_bit_cast(bf16x8, BF[0]), bl = __builtin_bit_cast(bf16x8, BF[1]); \
                acc = __builtin_amdgcn_mfma_f32_16x16x32_bf16(ah, bh, acc, 0, 0, 0); acc = __builtin_amdgcn_mfma_f32_16x16x32_bf16(al, bh, acc, 0, 0, 0); acc = __builtin_amdgcn_mfma_f32_16x16x32_bf16(ah, bl, acc, 0, 0, 0); } while (0)
#pragma unroll
            for (int jj = 0; jj < 8; ++jj) { RT_STEP(bA[jj], jj); if ((jj & 3) == 3) SBAR(); }
#pragma unroll
            for (int jj = 0; jj < 8; ++jj) { RT_STEP(bB[jj], 8 + jj); if ((jj & 3) == 3) SBAR(); }
#undef RT_STEP
#pragma unroll
            for (int r = 0; r < 4; ++r) LG[(kh * 16 + 4 * (lane >> 4) + r) * 64 + 16 * ct + (lane & 15)] = acc[r];
        }
        __syncthreads(); RT_ACC(25);
#pragma unroll 1
        for (int rr = 0; rr < 2; ++rr) {
            const int lr = 2 * wave + rr, tok = row0 + lr;
            const float logit = LG[lr * 64 + lane] + LG[(16 + lr) * 64 + lane];
            const float score = 1.0f / (1.0f + expf(-logit));
            const float sel = score + INF(I_e_bias)[lane];
            const int l_ = lane_fresh(); float m1 = sel; m1 = fmaxf(m1, shx(m1, 1, l_)); m1 = fmaxf(m1, shx(m1, 2, l_)); m1 = fmaxf(m1, shx(m1, 4, l_));
            const unsigned long long bm = __ballot(sel == m1);
            const unsigned gb = (unsigned)(bm >> (lane & ~7)) & 0xffu; const int first = __ffs((int)gb) - 1;
            float m2 = ((lane & 7) == first) ? -INFINITY : sel; m2 = fmaxf(m2, shx(m2, 1, l_)); m2 = fmaxf(m2, shx(m2, 2, l_)); m2 = fmaxf(m2, shx(m2, 4, l_));
            const float gs = m1 + m2; int grank = 0;
            { const unsigned ub = __float_as_uint(gs), uo = (ub & 0x80000000u) ? ~ub : (ub | 0x80000000u);
              const unsigned long long key = ((unsigned long long)uo << 8) | (unsigned)(7 - (lane >> 3));
#pragma unroll
              for (int q = 0; q < 8; ++q) { const unsigned long long ok = ((unsigned long long)(unsigned)__builtin_amdgcn_readlane((int)(key >> 32), 8 * q) << 32) | (unsigned)__builtin_amdgcn_readlane((int)(unsigned)key, 8 * q); grank += ok > key ? 1 : 0; } }
            const bool gsel = grank < TOPKG; const float sm = gsel ? sel : -INFINITY; int rank = 0;
            { const unsigned ub = __float_as_uint(sm), uo = (ub & 0x80000000u) ? ~ub : (ub | 0x80000000u);
              const unsigned long long key = ((unsigned long long)uo << 8) | (unsigned)(63 - lane);
              const int khi = (int)(key >> 32), klo = (int)(unsigned)key;
#pragma unroll
              for (int q = 0; q < 64; ++q) { const unsigned long long ok = ((unsigned long long)(unsigned)__builtin_amdgcn_readlane(khi, q) << 32) | (unsigned)__builtin_amdgcn_readlane(klo, q); rank += ok > key ? 1 : 0; } }
            const bool chosen = gsel && rank < TOPK;
            const float wsum = wave_sum(chosen ? score : 0.f);
            const float w = score / wsum * 2.5f;
            if (chosen && !dry) { const unsigned lp = __hip_atomic_fetch_add(lcnt + lane, 1u, __ATOMIC_RELAXED, __HIP_MEMORY_SCOPE_WORKGROUP);
                const int pi = ((ulocal * 16 + lr) * 8 + rank) & 1023; pe[pi] = ((unsigned)lane << 16) | lp; pw[pi] = w; }
        }
        if (!dry) ++ulocal;
        __syncthreads(); RT_ACC(26);
    }
    if (F.tid < 64) { const unsigned n = lcnt[F.tid]; lcnt[64 + F.tid] = n ? __hip_atomic_fetch_add((unsigned*)F.ctl + CW_CNT + (F.tid * 2) * 16, n, RLX_AGENT) : 0u; }
    __syncthreads();
    for (int pi = F.tid; pi < ulocal * 128; pi += NTHR) {
        const int ul = pi >> 7, lr = (pi >> 3) & 15, rank = pi & 7, tok = (F.vcu + ul * F.G) * 16 + lr;
        const unsigned v = pe[pi], e = v >> 16, pos = lcnt[64 + e] + (v & 0xffffu);
        LIST[(size_t)(e * 2) * 8192 + pos] = tok; WLIST[(size_t)(e * 2) * 8192 + pos] = pw[pi]; TOKSLOT[(size_t)tok * 8 + rank] = (e << 16) | pos; }
    __syncthreads(); RT_ACC(27);
#ifdef TSA
    if (blockIdx.x == TSWG && threadIdx.x == 0) { const unsigned long long t_ = __builtin_amdgcn_s_memrealtime(); ((LAS unsigned*)(F.lds + TAB_OFF + 2048))[42] = (unsigned)t_; ((LAS unsigned*)(F.lds + TAB_OFF + 2048))[43] = (unsigned)(t_ >> 32); }
#endif
    LAS float* scr = (LAS float*)(F.lds + wave * 16384);
    const int gw = F.vcu * NWAVES + wave, NGW = F.G * NWAVES;
    for (int rp = 0; rp < rep_conv; ++rp)
    for (int it = gw; it < 65 * 384; it += NGW) {
        const int e = it / 384, r = it % 384;
        const float* wg = e < 64 ? INF(I_w_eg) + (size_t)e * DM * EFF : INF(I_w_sg); const float* wu = e < 64 ? INF(I_w_eu) + (size_t)e * DM * EFF : INF(I_w_su); const float* wd = e < 64 ? INF(I_w_ed) + (size_t)e * EFF * DM : INF(I_w_sd);
        if (r < 128) transpose_item_fp8(wg, DM, EFF, wsp<unsigned char>(F, WS_WGU) + (size_t)e * 512 * DM, MapGU{0}, WGU_SCALE, scr, r, lane);
        else if (r < 256) transpose_item_fp8(wu, DM, EFF, wsp<unsigned char>(F, WS_WGU) + (size_t)e * 512 * DM, MapGU{1}, WGU_SCALE, scr, r - 128, lane);
        else transpose_item_fp8(wd, EFF, DM, wsp<unsigned char>(F, WS_WD) + (size_t)e * DM * EFF, MapOff{0}, WD_SCALE, scr, r - 256, lane);
    }
}

__device__ __forceinline__ void build_tables(Frame& F) {
    LAS int* tab = (LAS int*)(F.lds + TAB_OFF);
    if (F.tid < 128) tab[T_CNT + F.tid] = (int)__hip_atomic_load((unsigned*)F.ctl + CW_CNT + F.tid * 16, RLX_AGENT);
    __syncthreads();
    if (F.tid < 64) { const int e = F.tid; const int c0 = tab[T_CNT + 2 * e], c1 = tab[T_CNT + 2 * e + 1];
        int a = c0 + c1, y0 = c0, y1 = c1;
#pragma unroll
        for (int o = 1; o < 64; o <<= 1) { const int ta = shup_i(a, o, e), t0 = shup_i(y0, o, e), t1 = shup_i(y1, o, e); if (e >= o) { a += ta; y0 += t0; y1 += t1; } }
        tab[T_ABASE + e] = a - (c0 + c1); tab[T_YBASE + e] = y0 - c0; tab[T_YBASE + 64 + e] = y1 - c1; if (e == 63) tab[T_ABASE + 64] = a; }
    if (F.tid == 64) { tab[T_MBOX] = 0; tab[T_MBOX + 1] = 0; }
    __syncthreads();
}

struct GateUpSched {
    const LAS int* tab; const unsigned char* wgu; const int* list; int x, j, per;
    unsigned* qc; LAS int* mbox; unsigned pend;
    __device__ __forceinline__ int unit_index(int i) const { return (!DYNQ || i < 2) ? i * per + j : RFL(mbox[i & 1]); }
    __device__ __forceinline__ void grab() { if (DYNQ) if (RFL((int)(threadIdx.x >> 6)) == 0 && (threadIdx.x & 63) == 0) pend = __hip_atomic_fetch_add(qc, 1u, RLX_AGENT); }
    __device__ __forceinline__ void publish(int wid) { if (DYNQ) if (wid == 0) { if ((threadIdx.x & 63) == 0) mbox[nslot] = (int)(2 * per + pend); LDS_WAIT(); } nslot ^= 1; }
    int nslot;
    __device__ void init(Frame& F) { tab = (const LAS int*)(F.lds + TAB_OFF); wgu = wsp<unsigned char>(F, WS_WGU); list = wsp<int>(F, WS_LIST); x = (int)blockIdx.x % 8; j = (int)blockIdx.x / 8; per = F.G / 8;
        qc = (unsigned*)F.ctl + CW_Q + (0 * 8 + x) * 16; mbox = (LAS int*)(F.lds + TAB_OFF) + T_MBOX; pend = 0; nslot = 0; }
    __device__ bool next(int i, pg8::Unit& u) {
        const int L = unit_index(i);
        int k = -1, base = 0, a = 0;
#pragma unroll
        for (int q = 0; q < 8; ++q) { const int e = x + 8 * q; const int na = a + ((RFL(tab[T_CNT + 2 * e]) + RFL(tab[T_CNT + 2 * e + 1]) + 255) >> 8) * 2; if (k < 0 && L < na) { k = q; base = a; } a = na; }
        if (k >= 0) {
            if (i >= 1) grab();
            const int e = x + 8 * k, r = L - base, mt = r >> 1, pn = r & 1, n0 = RFL(tab[T_CNT + 2 * e]), ntot = n0 + RFL(tab[T_CNT + 2 * e + 1]);
            u.B = (const char*)(wgu + ((size_t)e * 512 + pn * 256) * DM); u.m0 = mt * 256; u.pn = pn; u.e = e; u.nrows = (ntot - mt * 256) < 256 ? (ntot - mt * 256) : 256;
            u.orow0 = RFL(tab[T_ABASE + e]) + mt * 256; u.l0 = list + (size_t)(2 * e) * 8192; u.l1 = list + (size_t)(2 * e + 1) * 8192; u.n0 = n0; u.ntot = ntot; return true; }
        const int r = L - a; if (r >= 16) return false;
        if (i >= 1) grab();
        const int mt = x + 8 * (r >> 1), pn = r & 1;
        u.B = (const char*)(wgu + ((size_t)64 * 512 + pn * 256) * DM); u.m0 = mt * 256; u.pn = pn; u.e = 64; u.nrows = 256; u.orow0 = ACT_SHARED_ROW0 + mt * 256; u.l0 = nullptr; u.l1 = nullptr; u.n0 = 0; u.ntot = 0; return true;
    }
};
struct DownSched {
    const LAS int* tab; const unsigned char* wd; const int* tab0; int x, j, per, c;
    unsigned* qc; LAS int* mbox; unsigned pend;
    __device__ __forceinline__ int unit_index(int i) const { return (!DYNQ || i < 2) ? i * per + j : RFL(mbox[i & 1]); }
    __device__ __forceinline__ void grab() { if (DYNQ) if (RFL((int)(threadIdx.x >> 6)) == 0 && (threadIdx.x & 63) == 0) pend = __hip_atomic_fetch_add(qc, 1u, RLX_AGENT); }
    __device__ __forceinline__ void publish(int wid) { if (DYNQ) if (wid == 0) { if ((threadIdx.x & 63) == 0) mbox[nslot] = (int)(2 * per + pend); LDS_WAIT(); } nslot ^= 1; }
    int nslot;
    __device__ void init(Frame& F, int c_) { tab = (const LAS int*)(F.lds + TAB_OFF); wd = wsp<unsigned char>(F, WS_WD); tab0 = wsp<int>(F, WS_LIST); x = (int)blockIdx.x % 8; j = (int)blockIdx.x / 8; per = F.G / 8; c = c_;
        qc = (unsigned*)F.ctl + CW_Q + ((1 + c_) * 8 + x) * 16; mbox = (LAS int*)(F.lds + TAB_OFF) + T_MBOX; pend = 0; nslot = 0; }
    __device__ bool next(int i, pg8::Unit& u) {
        const int L = unit_index(i);
        u.l0 = nullptr; u.l1 = nullptr; u.n0 = 0; u.ntot = 0;
        const float* wlist = (const float*)((const char*)tab0 + (WS_WLIST - WS_LIST));
        int k = -1, base = 0, a = 0;
#pragma unroll
        for (int q = 0; q < 8; ++q) { const int e = x + 8 * q; const int na = a + ((RFL(tab[T_CNT + 2 * e + c]) + 255) >> 8) * 4; if (k < 0 && L < na) { k = q; base = a; } a = na; }
        if (k >= 0) {
            if (i >= 1) grab();
            const int e = x + 8 * k, r = L - base, mt = r >> 2, pn = r & 3, n = RFL(tab[T_CNT + 2 * e + c]);
            u.B = (const char*)(wd + ((size_t)e * DM + pn * 256) * EFF); u.m0 = RFL(tab[T_ABASE + e]) + (c ? RFL(tab[T_CNT + 2 * e]) : 0) + mt * 256; u.pn = pn; u.e = e;
            u.nrows = (n - mt * 256) < 256 ? (n - mt * 256) : 256; u.orow0 = RFL(tab[T_YBASE + 64 * c + e]) + mt * 256; u.l1 = (const int*)(wlist + (size_t)(2 * e + c) * 8192 + mt * 256); return true; }
        const int r = L - a; if (r >= (CHTOK / 256 / 8) * 4) return false;
        if (i >= 1) grab();
        const int mt = x + 8 * (r >> 2), pn = r & 3;
        u.B = (const char*)(wd + ((size_t)64 * DM + pn * 256) * EFF); u.m0 = ACT_SHARED_ROW0 + c * CHTOK + mt * 256; u.pn = pn; u.e = 64; u.nrows = 256; u.orow0 = YS_SHARED_ROW0 + mt * 256; return true;
    }
};

__device__ __forceinline__ void combine(Frame& F, int c, bool dry) {
    const LAS int* tab = (const LAS int*)(F.lds + TAB_OFF);
    const int lane = F.lane, gw = F.vcu * NWAVES + F.wave, NGW = F.G * NWAVES;
    const unsigned char* ys = wsp<unsigned char>(F, WS_YS); const unsigned* TOKSLOT = wsp<unsigned>(F, WS_TOKSLOT); const float* mod = wsp<float>(F, WS_MOD);
    for (int tl = gw; tl < CHTOK; tl += NGW) {
        const int t = c * CHTOK + tl, b = t >> 11;
        int yr[9];
#pragma unroll
        for (int k = 0; k < 8; ++k) { const unsigned s = TOKSLOT[(size_t)t * 8 + k]; yr[k] = tab[T_YBASE + 64 * c + (int)(s >> 16)] + (int)(s & 0xffffu); }
        yr[8] = YS_SHARED_ROW0 + tl;
        u32x4 w[9];
#pragma unroll
        for (int k = 0; k < 9; ++k) w[k] = __builtin_nontemporal_load((const u32x4*)(ys + (size_t)yr[k] * 1024 + 16 * lane));
        f32x4 s[4];
#pragma unroll
        for (int q = 0; q < 4; ++q) s[q] = (f32x4){0.f, 0.f, 0.f, 0.f};
#pragma unroll
        for (int k = 0; k < 9; ++k) {
#pragma unroll
            for (int q = 0; q < 4; ++q) { const auto lo = __builtin_amdgcn_cvt_pk_f32_fp8((int)w[k][q], false), hi = __builtin_amdgcn_cvt_pk_f32_fp8((int)w[k][q], true);
                s[q] += (f32x4){lo[0], lo[1], hi[0], hi[1]}; } }
#pragma unroll
        for (int q = 0; q < 4; ++q) { const int c4 = 16 * lane + 4 * q;
            const f32x4 x1 = *(const f32x4*)(F.out + (size_t)t * DM + c4), g2 = *(const f32x4*)(mod + (size_t)b * 6144 + 5120 + c4);
            float* dst = dry ? (float*)(F.ws + WS_B + 253 * MiB) + (((size_t)t * DM + c4) & ((1u << 21) - 1)) : F.out + (size_t)t * DM + c4;
            *(f32x4*)dst = x1 + g2 * (s[q] * (1.0f / YS_SCALE)); }
    }
}
}
#ifndef PHMASK
#define PHMASK 0xffff
#endif
#define PH(k) ((PHMASK >> (k)) & 1)
#ifndef REPMASK
#define REPMASK 0
#endif
#ifndef XBAR
#define XBAR 0
#endif
#ifndef BARMASK
#define BARMASK 0
#endif
#define REP(k) for (int rep_ = 0; rep_ < 1 + ((REPMASK >> (k)) & 1); ++rep_)
#define MIDBAR(k) do { if (((BARMASK >> (k)) & 1) && rep_ == 0) GRID_BAR(); } while (0)

__global__ void __launch_bounds__(NTHR, 2) fwd_megakernel(Args args) {
    const Args& A = args;
    extern __shared__ __attribute__((aligned(16))) unsigned char lds_raw[];
    Frame F;
    F.lds = (LAS unsigned char*)lds_raw;
    F.MISC = (volatile LAS unsigned*)(F.lds + MISC_OFF);
    F.tid = threadIdx.x; F.lane = F.tid & 63; F.wave = __builtin_amdgcn_readfirstlane(F.tid >> 6);
    F.G = gridDim.x; { const int bx = blockIdx.x; F.vcu = (F.G % 8 == 0) ? (bx % 8) * (F.G / 8) + bx / 8 : bx; }
    F.ws = args.ws; F.ctl = (gu32*)(args.ws + WS_CTL); F.out = args.out;
    for (int u = F.tid; u < (LDS_BYTES - LDSCTL_OFF) / 4; u += NTHR) ((LAS unsigned*)(F.lds + LDSCTL_OFF))[u] = 0u;
    __syncthreads();
    XcdBarrier bar = xcd_barrier_post((unsigned*)(F.ctl + CW_BAR), F.MISC + 8);
#ifdef TSA
#define STAMP(k) do { if (blockIdx.x == TSWG && threadIdx.x == 0) { const unsigned long long t_ = __builtin_amdgcn_s_memrealtime(); ((LAS unsigned*)(F.lds + TAB_OFF + 2048))[2 * (k)] = (unsigned)t_; ((LAS unsigned*)(F.lds + TAB_OFF + 2048))[2 * (k) + 1] = (unsigned)(t_ >> 32); } } while (0)
#else
#define STAMP(k) do {} while (0)
#endif
#ifndef TSWG
#define TSWG 0
#endif
    int nbar_ = 0;
#define GRID_BAR() do { xcd_barrier(bar); F.refresh(); ++nbar_; STAMP(nbar_); } while (0)
    const int bx = (int)blockIdx.x;
    STAMP(0);

    REP(0) if (PH(0)) p0_prologue(F, args);
    for (int xb = 0; xb < XBAR; ++xb) GRID_BAR();
    GRID_BAR();
    REP(1) if (PH(1)) { p0_copies(F, args); s1_modnorm(F, args); }
#ifdef WSPROBE
    for (int q = 0; q < args.nrep; ++q) s1_modnorm(F, args);
#endif
    GRID_BAR();
    REP(2) if (PH(2)) {
        pg8::Gemm g{wsp<bf16_t>(F, WS_H), LDH / 2, DM / 2, LDW / 2}; pg8::DenseSched S; S.init(NT, INPAD, LDW / 2, wsp<bf16_t>(F, WS_WIN), F.G, bx);
        epi::EpiInProj E{wsp<bf16_t>(F, WS_NAQ), wsp<bf16_t>(F, WS_NAK), wsp<bf16_t>(F, WS_NAV), wsp<bf16_t>(F, WS_QLAT), wsp<bf16_t>(F, WS_KVLAT), wsp<bf16_t>(F, WS_SGNA), wsp<bf16_t>(F, WS_SGMLA),
                          wsp<float>(F, WS_KROT), wsp<float>(F, WS_QSQ), wsp<float>(F, WS_KVSQ), INF(I_g_na_q), INF(I_g_na_k), wsp<float>(F, WS_RCOS), wsp<float>(F, WS_RSIN)};
        pg8::gemm_phase<epi::EpiInProj, pg8::DenseSched, true, true>(F.lds, g, S, E);
        MIDBAR(2);
    }
    GRID_BAR();
    REP(3) if (PH(3)) {
        pg8::Gemm g{wsp<bf16_t>(F, WS_QLAT), QRANK, QRANK, QRANK}; pg8::DenseSched S; S.init(NT, MH * QKD, QRANK, wsp<bf16_t>(F, WS_WUQ), F.G, bx);
        epi::EpiUpQ E{wsp<bf16_t>(F, WS_QM), wsp<float>(F, WS_QSS), wsp<float>(F, WS_QSQ), INF(I_g_mla_q), wsp<float>(F, WS_RCOS), wsp<float>(F, WS_RSIN)};
        pg8::gemm_phase<epi::EpiUpQ, pg8::DenseSched, false>(F.lds, g, S, E);
    }
    REP(3) if (PH(4)) {
        pg8::Gemm g{wsp<bf16_t>(F, WS_KVLAT), KVRANK, KVRANK, KVRANK}; pg8::DenseSched S; S.init(NT, MH * 128, KVRANK, wsp<bf16_t>(F, WS_WUKV), F.G, bx);
        epi::EpiUpKV E{wsp<bf16_t>(F, WS_KM), wsp<bf16_t>(F, WS_VM), wsp<float>(F, WS_KVSQ), wsp<float>(F, WS_KROT), INF(I_g_mla_k)};
        pg8::gemm_phase<epi::EpiUpKV, pg8::DenseSched, false>(F.lds, g, S, E);
    }
    GRID_BAR();
    if (PH(5)) s4_attention(F, args, 1 + ((REPMASK >> 4) & 1), 1 + ((REPMASK >> 5) & 1));
    GRID_BAR();
    REP(6) if (PH(6)) {
        pg8::Gemm g{wsp<bf16_t>(F, WS_YNA), DM / 2, DM / 2, DM / 2}; pg8::DenseSched S; S.init(NT, 2048, DM / 2, wsp<bf16_t>(F, WS_WPCAT), F.G, bx);
        epi::EpiMergeCat E{wsp<bf16_t>(F, WS_SGNA), wsp<bf16_t>(F, WS_SGMLA), wsp<unsigned char>(F, WS_MERGED)};
        pg8::gemm_phase<epi::EpiMergeCat, pg8::DenseSched, true, true, true>(F.lds, g, S, E);
    }
    GRID_BAR();
    REP(8) if (PH(8)) {
        pg8::Gemm g{wsp<bf16_t>(F, WS_MERGED), DM / 2, DM / 2, DM / 2}; pg8::DenseSched S; S.init(NT, DM, DM / 2, wsp<bf16_t>(F, WS_WOUT), F.G, bx);
        epi::EpiOut E{INF(I_x), F.out, wsp<float>(F, WS_MOD)};
        pg8::gemm_phase<epi::EpiOut, pg8::DenseSched, true, true>(F.lds, g, S, E);
    }
    GRID_BAR();
    if (PH(9)) moe::s7_router(F, args, 1 + ((REPMASK >> 9) & 1), 1 + ((REPMASK >> 13) & 1));
    GRID_BAR();
    moe::build_tables(F);
    REP(10) if (PH(10)) {
        pg8::Gemm g{wsp<bf16_t>(F, WS_H2), DM / 2, DM / 2, DM / 2}; moe::GateUpSched S; S.init(F);
        epi::EpiGateUp E{wsp<unsigned char>(F, WS_ACT)};
        pg8::gemm_phase<epi::EpiGateUp, moe::GateUpSched, true, true>(F.lds, g, S, E);
        MIDBAR(10);
    }
    GRID_BAR();
#pragma unroll 1
    for (int c = 0; c < NCHUNK; ++c) {
        for (int rep_ = 0; rep_ < 1 + (((REPMASK >> 11) | (REPMASK >> 14)) & 1); ++rep_) if (PH(11)) {
            pg8::Gemm g{wsp<bf16_t>(F, WS_ACT), EFF / 2, EFF / 2, EFF / 2}; moe::DownSched S; S.init(F, c);
            epi::EpiDown E{wsp<unsigned char>(F, WS_YS), ((REPMASK >> 14) & 1) && rep_ == 0};
            pg8::gemm_phase<epi::EpiDown, moe::DownSched, true, true>(F.lds, g, S, E);
            MIDBAR(11);
        }
        GRID_BAR();
        if ((REPMASK >> 12) & 1) moe::combine(F, c, true);
        if (PH(12)) moe::combine(F, c, false);
        if (c + 1 < NCHUNK) GRID_BAR();
    }
#ifdef TSA
    __syncthreads(); STAMP(11);
    if (blockIdx.x == TSWG && threadIdx.x == 0) { LAS unsigned* tsb = (LAS unsigned*)(F.lds + TAB_OFF + 2048);
        const unsigned long long ta = ((unsigned long long)tsb[2 * TSA + 1] << 32) | tsb[2 * TSA], tb = ((unsigned long long)tsb[2 * TSB + 1] << 32) | tsb[2 * TSB];
#ifdef TSD
        const unsigned long long dl = (((unsigned long long)tsb[2 * TSD + 1] << 32) | tsb[2 * TSD]) * TSMULT,
#else
        const unsigned long long dl = (tb - ta) * TSMULT,
#endif
        t0 = __builtin_amdgcn_s_memrealtime();
        while (__builtin_amdgcn_s_memrealtime() - t0 < dl) __builtin_amdgcn_s_sleep(8); }
#endif
}

extern "C" void kernel_launch(void* const* d_in, const int* in_sizes, int n_in, void* d_out, int out_size, void* d_ws, size_t ws_size, hipStream_t stream) {
    static int grid = 0;
    if (grid == 0) {
        if (n_in != 28 || out_size != NT * DM || ws_size < WS_END) { fprintf(stderr, "kernel_launch: unexpected shapes: n_in %d out %d ws %zu (need %zu)\n", n_in, out_size, ws_size, (size_t)WS_END); grid = -1; return; }
        int dev = 0, cus = 0, per_cu = 0;
        if (hipGetDevice(&dev) != hipSuccess || hipDeviceGetAttribute(&cus, hipDeviceAttributeMultiprocessorCount, dev) != hipSuccess) { grid = -1; return; }
        if (hipFuncSetAttribute((const void*)fwd_megakernel, hipFuncAttributeMaxDynamicSharedMemorySize, LDS_BYTES) != hipSuccess) { fprintf(stderr, "kernel_launch: hipFuncSetAttribute failed\n"); grid = -1; return; }
        if (hipOccupancyMaxActiveBlocksPerMultiprocessor(&per_cu, (const void*)fwd_megakernel, NTHR, LDS_BYTES) != hipSuccess || per_cu < 1) { fprintf(stderr, "kernel_launch: occupancy query says %d blocks/CU\n", per_cu); (void)hipGetLastError(); }
        grid = cus;
        if (grid != 256) fprintf(stderr, "kernel_launch: %d CUs (expected 256)\n", grid);
    }
    if (grid < 0) return;
    if (hipMemsetAsync((char*)d_ws + WS_CTL, 0, CTL_ZERO_BYTES, stream) != hipSuccess) { fprintf(stderr, "kernel_launch: memset failed\n"); return; }
    Args a{};
    for (int i = 0; i < 28; ++i) a.in[i] = d_in[i];
    a.out = (float*)d_out; a.ws = (unsigned char*)d_ws;
#ifdef WSPROBE
    a.nrep = (int)(ws_size >> 26); a.pad = 0;
#endif
    void* kargs[] = {&a};
    const hipError_t le = hipLaunchCooperativeKernel((const void*)fwd_megakernel, dim3(grid), dim3(NTHR), kargs, LDS_BYTES, stream);
    if (le != hipSuccess) fprintf(stderr, "kernel_launch: cooperative launch failed: %s (grid %d)\n", hipGetErrorName(le), grid);
}
```

```cpp
#include <hip/hip_runtime.h>
#include <cstdio>
#include <cstdint>
#include <cmath>

#define GAS __attribute__((address_space(1)))
#define LAS __attribute__((address_space(3)))
typedef unsigned short bf16_t;
typedef short bf16x8 __attribute__((ext_vector_type(8)));
typedef short s16x4 __attribute__((ext_vector_type(4)));
typedef float f32x4 __attribute__((ext_vector_type(4)));
typedef float f32x2 __attribute__((ext_vector_type(2)));
typedef float f32x16 __attribute__((ext_vector_type(16)));
typedef unsigned u32x4 __attribute__((ext_vector_type(4)));
typedef int i32x4 __attribute__((ext_vector_type(4)));
typedef unsigned u32x2 __attribute__((ext_vector_type(2)));
typedef GAS unsigned gu32;

constexpr int DM = 1024, NB = 8, SEQ = 2048, NT = NB * SEQ;
constexpr int NAH = 8, NAD = 64, GRIDW = 64, GRIDR = SEQ / GRIDW;
constexpr int MH = 8, QRANK = 256, KVRANK = 128, NOPE = 64, ROPE = 32, VD = 64, QKD = 96;
constexpr int NEXP = 64, TOPK = 8, NGRP = 8, TOPKG = 4, EFF = 256;
constexpr float EPS = 1e-6f;
constexpr int INCOLS = 4000, INPAD = 4096;
constexpr int NCHUNK = 1, CHTOK = NT / NCHUNK;
constexpr float YS_SCALE = 16.0f;
constexpr float WGU_SCALE = 64.0f, ACT_SCALE = 16.0f, WD_SCALE = 32.0f;
constexpr int NWAVES = 8, NTHR = 512;

constexpr size_t MiB = 1u << 20;
constexpr size_t WS_CTL = 0, CTL_ZERO_BYTES = 128 * 1024;
constexpr size_t WS_MOD   = 1 * MiB;
constexpr size_t WS_RCOS  = WS_MOD + 256 * 1024;
constexpr size_t WS_RSIN  = WS_RCOS + 1 * MiB;
constexpr size_t WS_RFRAG = WS_RSIN + 1 * MiB;
constexpr size_t WS_QSQ   = WS_RFRAG + 256 * 1024;
constexpr size_t WS_KVSQ  = WS_QSQ + 256 * 1024;
constexpr size_t WS_QSS   = WS_KVSQ + 256 * 1024;
constexpr size_t WS_TOKSLOT = WS_QSS + 1 * MiB;
constexpr size_t WS_LIST  = 6 * MiB;
constexpr size_t WS_WLIST = 10 * MiB;
constexpr size_t WS_WIN   = 292 * MiB;
constexpr size_t WS_WUQ   = 22 * MiB;
constexpr size_t WS_WUKV  = WS_WUQ + 512 * 1024;
constexpr size_t WS_WPNA  = 23 * MiB;
constexpr size_t WS_WPMLA = 24 * MiB;
constexpr size_t WS_WOUT  = 25 * MiB;
constexpr size_t WS_KROT  = 27 * MiB;
constexpr size_t WS_B     = 30 * MiB;
constexpr float WIN_SCALE = 64.0f, MG_SCALE = 16.0f, WOUT_SCALE = 64.0f, Y_SCALE = 32.0f, WP_SCALE = 32.0f;
constexpr int LDH = DM + 64, LDW = DM + 64;
constexpr size_t WS_H     = WS_B + 201 * MiB;
constexpr size_t WS_QM    = WS_B + 0 * MiB;
constexpr size_t WS_NAQ   = WS_B + 32 * MiB;
constexpr size_t WS_NAK   = WS_B + 48 * MiB;
constexpr size_t WS_NAV   = WS_B + 64 * MiB;
constexpr size_t WS_QLAT  = WS_B + 80 * MiB;
constexpr size_t WS_KVLAT = WS_B + 88 * MiB;
constexpr size_t WS_SGNA  = WS_B + 96 * MiB;
constexpr size_t WS_SGMLA = WS_B + 128 * MiB;
constexpr size_t WS_KM    = WS_B + 160 * MiB;
constexpr size_t WS_VM    = WS_B + 185 * MiB;
constexpr size_t WS_YNA   = WS_B + 201 * MiB;
constexpr size_t WS_WPCAT = WS_B + 240 * MiB;
constexpr size_t WS_TMP   = WS_B + 32 * MiB;
constexpr size_t WS_MERGED= WS_B + 48 * MiB;
constexpr size_t WS_X1    = WS_B + 70 * MiB;
constexpr size_t WS_WD    = WS_B + 0 * MiB;
constexpr size_t WS_ACT   = WS_B + 33 * MiB;
constexpr size_t WS_WGU   = WS_B + 109 * MiB;
constexpr size_t WS_H2    = WS_B + 174 * MiB;
constexpr size_t WS_YS    = WS_B + 109 * MiB;
constexpr size_t WS_END   = 302 * MiB;
constexpr int ACT_SHARED_ROW0 = NT * TOPK;
constexpr int YS_SHARED_ROW0 = CHTOK * TOPK;
constexpr int CW_BAR = 4096;
constexpr int CW_CNT = 16384;

constexpr int RING_BYTES = 131072;
constexpr int LDSCTL_OFF = RING_BYTES, MISC_OFF = LDSCTL_OFF + 320;
constexpr int TAB_OFF = RING_BYTES + 1024;
constexpr int LDS_BYTES = 147456;

#define LDS_WAIT() asm volatile("s_waitcnt lgkmcnt(0)" ::: "memory")
#define VM_WAIT() asm volatile("s_waitcnt vmcnt(0)" ::: "memory")
#define SBAR() __builtin_amdgcn_sched_barrier(0)
#define RLX_AGENT __ATOMIC_RELAXED, __HIP_MEMORY_SCOPE_AGENT

__device__ __forceinline__ unsigned f2bf(float f) { unsigned u = __builtin_bit_cast(unsigned, f); return (u + 0x7fffu + ((u >> 16) & 1u)) >> 16; }
__device__ __forceinline__ unsigned pk2(float lo, float hi) { return f2bf(lo) | (f2bf(hi) << 16); }
__device__ __forceinline__ unsigned cvt_pk_bf16(float lo, float hi) { unsigned r; asm volatile("v_cvt_pk_bf16_f32 %0, %1, %2" : "=v"(r) : "v"(lo), "v"(hi)); return r; }
__device__ __forceinline__ float bf2f(unsigned short b) { return __builtin_bit_cast(float, (unsigned)b << 16); }
__device__ __forceinline__ float bflo(unsigned w) { return __builtin_bit_cast(float, w << 16); }
__device__ __forceinline__ float bfhi(unsigned w) { return __builtin_bit_cast(float, w & 0xffff0000u); }
__device__ __forceinline__ int lane_fresh() { int t = threadIdx.x; asm volatile("" : "+v"(t)); return t & 63; }
__device__ __forceinline__ float shx(float v, int m, int lane) { return __builtin_bit_cast(float, __builtin_amdgcn_ds_bpermute((lane ^ m) << 2, __builtin_bit_cast(int, v))); }
__device__ __forceinline__ int shup_i(int v, int d, int lane) { return __builtin_amdgcn_ds_bpermute(((lane - d) & 63) << 2, v); }
__device__ __forceinline__ float wave_sum(float v) {
    const int l = lane_fresh();
#pragma unroll
    for (int o = 1; o < 64; o <<= 1) v += shx(v, o, l);
    return v;
}
__device__ __forceinline__ float sigmoidf_fast(float v) { return __builtin_amdgcn_rcpf(1.0f + __expf(-v)); }
__device__ __forceinline__ float siluf_fast(float v) { return v * sigmoidf_fast(v); }
__device__ __forceinline__ float sq4(f32x4 a) { return (a[0] * a[0] + a[1] * a[1]) + (a[2] * a[2] + a[3] * a[3]); }

#ifdef WSPROBE
struct Args { const void* in[28]; float* out; unsigned char* ws; int nrep, pad; };
#else
struct Args { const void* in[28]; float* out; unsigned char* ws; };
#endif
enum { I_x = 0, I_c = 1, I_positions = 2, I_w_ada = 3, I_b_ada = 4, I_g_norm1 = 5, I_w_in = 6, I_g_na_q = 7, I_g_na_k = 8, I_na_rpb = 9, I_g_q_lat = 10, I_w_uq = 11, I_g_kv_lat = 12, I_w_ukv = 13, I_g_mla_q = 14, I_g_mla_k = 15, I_w_proj_na = 16, I_w_proj_mla = 17, I_w_out = 18, I_g_norm2 = 19, I_w_router = 20, I_e_bias = 21, I_w_eg = 22, I_w_eu = 23, I_w_ed = 24, I_w_sg = 25, I_w_su = 26, I_w_sd = 27 };
#define INF(k) ((const float*)A.in[k])

#ifndef TSWG
#define TSWG 0
#endif

__device__ __forceinline__ unsigned cvt4_fp8(f32x4 a, float sc) {
    int w = 0;
    w = __builtin_amdgcn_cvt_pk_fp8_f32(__builtin_amdgcn_fmed3f(a[0] * sc, -448.f, 448.f), __builtin_amdgcn_fmed3f(a[1] * sc, -448.f, 448.f), w, false);
    w = __builtin_amdgcn_cvt_pk_fp8_f32(__builtin_amdgcn_fmed3f(a[2] * sc, -448.f, 448.f), __builtin_amdgcn_fmed3f(a[3] * sc, -448.f, 448.f), w, true);
    return (unsigned)w;
}
namespace pg8 {
constexpr int BM = 256, BK = 64, HALF = 128, HTB = HALF * BK * 2, STAGE_BYTES = 8 * HTB, NXCD = 8, WGM = 8;
__host__ __device__ __forceinline__ int lds_byte(int r, int c) { const int st = (r >> 4) * 2 + (c >> 5), rr = r & 15, cc = c & 31, ob = rr * 64 + cc * 2; return st * 1024 + (ob ^ (((ob >> 9) & 1) << 5)); }
__host__ __device__ __forceinline__ void stage_rc(int b, int& R, int& C) { const int st = b / 1024, sb = b % 1024, swz = sb ^ (((sb >> 9) & 1) << 5); R = (st >> 1) * 16 + swz / 64; C = (st & 1) * 32 + (swz % 64) / 2; }
__host__ __device__ __forceinline__ int perm32(int rho) { const int n = rho >> 4, i = rho & 15; return 8 * (i >> 2) + 4 * n + (i & 3); }

struct Unit {
    const char* B;
    int m0;
    int pn;
    int e;
    int nrows;
    int orow0;
    const int* l0; const int* l1; int n0, ntot;
};
struct Gemm { const bf16_t* A; int lda; int K; int ldb; };

template <class Epi, class Sched, bool GATHER, bool FP8 = false, bool HALFK = false>
__device__ __forceinline__ void gemm_phase(LAS unsigned char* lds, const Gemm g, Sched& S, const Epi& E) {
    int tid_ = threadIdx.x; asm volatile("" : "+v"(tid_));
    const int tid = tid_, wid = __builtin_amdgcn_readfirstlane(tid >> 6), lane = tid & 63, wr = wid >> 2, wc = wid & 3, fr = lane & 15, fq = lane >> 4;
    const int K = g.K; int nt_ = K / BK; asm volatile("" : "+s"(nt_)); const int nt = nt_;
    unsigned voffB[2], voffA[2];
#pragma unroll
    for (int i = 0; i < 2; ++i) { int R, C; stage_rc(tid * 16 + i * 8192, R, C); const int Rb = Epi::PERM ? ((R & ~31) + perm32(R & 31)) : R;
        voffA[i] = (unsigned)(R * g.lda + C) * 2u; voffB[i] = (unsigned)(Rb * g.ldb + C) * 2u; }
    const size_t hstepA = (size_t)HALF * g.lda * 2;
    const size_t kstep = (size_t)(BK * 2);
    const size_t hstepB = (size_t)HALF * g.ldb * 2;
    const unsigned ldsw = (unsigned)wid * 1024u;
    const int aoff = lds_byte(wr * 64 + fr, fq * 8), boff = lds_byte(wc * 32 + fr, fq * 8);
    const char* Abase = (const char*)g.A;
#define PG8_SA(b, h) (((b) * 2 + (h)) * HTB)
#define PG8_SB(b, h) ((4 + (b) * 2 + (h)) * HTB)
#define PG8_STAGE(bufoff, gbase, voff) do { _Pragma("unroll") for (int _i = 0; _i < 2; ++_i) \
        __builtin_amdgcn_global_load_lds((const unsigned*)((const char*)(gbase) + (voff)[_i]), (LAS unsigned*)(lds + (bufoff) + ldsw + _i * 8192), 16, 0, 0); } while (0)
#define PG8_LDA(dst, b, h) do { _Pragma("unroll") for (int m = 0; m < 4; ++m) _Pragma("unroll") for (int k = 0; k < 2; ++k) dst[m][k] = *(const LAS bf16x8*)(lds + PG8_SA(b, h) + aoff + m * 2048 + k * 1024); } while (0)
#define PG8_LDB(dst, b, h) do { _Pragma("unroll") for (int n = 0; n < 2; ++n) _Pragma("unroll") for (int k = 0; k < 2; ++k) dst[n][k] = *(const LAS bf16x8*)(lds + PG8_SB(b, h) + boff + n * 2048 + k * 1024); } while (0)
#define PG8_CAT(x0, x1) __builtin_shufflevector(__builtin_bit_cast(i32x4, x0), __builtin_bit_cast(i32x4, x1), 0, 1, 2, 3, 4, 5, 6, 7)
#define PG8_MMA(ai, bj, At, Bt) do { __builtin_amdgcn_s_setprio(1); if constexpr (FP8) { _Pragma("unroll") for (int m = 0; m < 4; ++m) _Pragma("unroll") for (int n = 0; n < 2; ++n) \
        acc[ai][bj][m][n] = __builtin_amdgcn_mfma_scale_f32_16x16x128_f8f6f4(PG8_CAT(Bt[n][0], Bt[n][1]), PG8_CAT(At[m][0], At[m][1]), acc[ai][bj][m][n], 0, 0, 0, 0x7f7f7f7f, 0, 0x7f7f7f7f); } \
        else { _Pragma("unroll") for (int m = 0; m < 4; ++m) _Pragma("unroll") for (int n = 0; n < 2; ++n) _Pragma("unroll") for (int k = 0; k < 2; ++k) \
        acc[ai][bj][m][n] = __builtin_amdgcn_mfma_f32_16x16x32_bf16(Bt[n][k], At[m][k], acc[ai][bj][m][n], 0, 0, 0); } __builtin_amdgcn_s_setprio(0); } while (0)
#define PG8_MM2(ai) do { if constexpr (HALFK) { if (t < (nt >> 1)) { PG8_MMA(ai, 0, At, B0); } else { PG8_MMA(ai, 1, At, B1); } } else { PG8_MMA(ai, 0, At, B0); PG8_MMA(ai, 1, At, B1); } } while (0)
#define PG8_WAIT_V(n) asm volatile("s_waitcnt vmcnt(" #n ")" ::: "memory")
#define PG8_WAIT_L(n) asm volatile("s_waitcnt lgkmcnt(" #n ")" ::: "memory")
#define PG8_BAR __builtin_amdgcn_s_barrier()
#define PG8_SCHED __builtin_amdgcn_sched_barrier(0)
#define PG8_VOFF(dst, u) do { int _t = threadIdx.x; asm volatile("" : "+v"(_t)); _Pragma("unroll") for (int _h = 0; _h < 2; ++_h) _Pragma("unroll") for (int _i = 0; _i < 2; ++_i) { \
        int _R, _C; stage_rc(_t * 16 + _i * 8192, _R, _C); int _r = (u).m0 + _h * HALF + _R; \
        if ((u).l0) { _r = _r < (u).ntot ? _r : (u).ntot - 1; _r = _r < (u).n0 ? (u).l0[_r] : (u).l1[_r - (u).n0]; } \
        dst[_h][_i] = (unsigned)(_r * g.lda + _C) * 2u; } } while (0)
#define PG8_VROW(dst, u) do { int _t = threadIdx.x; asm volatile("" : "+v"(_t)); _Pragma("unroll") for (int _h = 0; _h < 2; ++_h) _Pragma("unroll") for (int _i = 0; _i < 2; ++_i) { \
        int _R, _C; stage_rc(_t * 16 + _i * 8192, _R, _C); int _r = (u).m0 + _h * HALF + _R; \
        if ((u).l0) { _r = _r < (u).ntot ? _r : (u).ntot - 1; _r = _r < (u).n0 ? (u).l0[_r] : (u).l1[_r - (u).n0]; } \
        dst[_h][_i] = _r; } } while (0)
#define PG8_STA(bufoff, sel_next, h, kt) do { if constexpr (GATHER) { PG8_STAGE(bufoff, Abase + (size_t)(kt) * kstep, cvo[h]); } \
        else { PG8_STAGE(bufoff, ((sel_next) ? nA : cA) + (h) * hstepA + (size_t)(kt) * kstep, voffA); } } while (0)
    Unit cur, nxt; int ui = 0;
    if (!S.next(0, cur)) return;
    E.prefetch(cur, 0, tid, lds);
    f32x4 acc[2][2][4][2];
#pragma unroll
    for (int a = 0; a < 2; ++a)
#pragma unroll
        for (int b = 0; b < 2; ++b)
#pragma unroll
            for (int m = 0; m < 4; ++m)
#pragma unroll
                for (int n = 0; n < 2; ++n) acc[a][b][m][n] = (f32x4){0.f, 0.f, 0.f, 0.f};
    bf16x8 At[4][2], B0[2][2], B1[2][2];
    unsigned cvo[2][2]; int nvr[2][2];
    const char* cA = Abase; const char* nA = Abase;
    if constexpr (GATHER) { PG8_VOFF(cvo, cur); } else { cA = Abase + (size_t)cur.m0 * g.lda * 2; }
    const char* cB = cur.B;
    PG8_STAGE(PG8_SB(0, 0), cB, voffB); PG8_STAGE(PG8_SB(0, 1), cB + hstepB, voffB); PG8_STA(PG8_SA(0, 0), false, 0, 0); PG8_STA(PG8_SA(0, 1), false, 1, 0);
    if (wr == 1) PG8_BAR;
    PG8_WAIT_V(2); PG8_BAR;
    PG8_STAGE(PG8_SB(1, 0), cB + kstep, voffB); PG8_STA(PG8_SA(1, 0), false, 0, 1); PG8_STAGE(PG8_SB(1, 1), cB + hstepB + kstep, voffB);
    PG8_WAIT_V(6); PG8_BAR;
    for (;;) {
        const bool has_next = S.next(ui + 1, nxt);
        if constexpr (GATHER) {
            if constexpr (!Sched::kDense) { if (has_next) { PG8_VROW(nvr, nxt); } }
        } else { nA = has_next ? Abase + (size_t)nxt.m0 * g.lda * 2 : cA; }
        const char* nB = has_next ? nxt.B : cB;
#pragma unroll 1
        for (int t = 0; t < nt; t += 2) {
            const bool last = (t == nt - 2);
            const int kt2 = last ? 0 : t + 2;
            const char* b2 = last ? nB : cB + (size_t)(t + 2) * kstep; const char* b3 = b2 + kstep;
            PG8_LDB(B0, 0, 0); PG8_LDB(B1, 0, 1); PG8_SCHED; PG8_LDA(At, 0, 0); PG8_STA(PG8_SA(1, 1), false, 1, t + 1);
            if constexpr (GATHER) { if (last && has_next) { int _t = threadIdx.x; asm volatile("" : "+v"(_t));
#pragma unroll
                for (int h = 0; h < 2; ++h)
#pragma unroll
                    for (int i = 0; i < 2; ++i) { int _R, _C; stage_rc(_t * 16 + i * 8192, _R, _C); const int r_ = Sched::kDense ? nxt.m0 + h * HALF + _R : nvr[h][i]; cvo[h][i] = (unsigned)(r_ * g.lda + _C) * 2u; } } }
            PG8_WAIT_V(8); PG8_WAIT_L(0); PG8_BAR; PG8_MM2(0); PG8_BAR; PG8_SCHED;
            PG8_LDA(At, 0, 1); PG8_STAGE(PG8_SB(0, 0), b2, voffB); PG8_STAGE(PG8_SB(0, 1), b2 + hstepB, voffB); PG8_STA(PG8_SA(0, 0), last, 0, kt2);
            PG8_WAIT_V(8); PG8_WAIT_L(0); PG8_BAR; PG8_MM2(1); PG8_BAR; PG8_SCHED;
            PG8_LDB(B0, 1, 0); PG8_LDB(B1, 1, 1); PG8_SCHED; PG8_LDA(At, 1, 0); PG8_STA(PG8_SA(0, 1), last, 1, kt2);
            PG8_WAIT_V(8); PG8_WAIT_L(0); PG8_BAR; PG8_MM2(0); PG8_BAR; PG8_SCHED;
            PG8_LDA(At, 1, 1); PG8_STAGE(PG8_SB(1, 0), b3, voffB); PG8_STAGE(PG8_SB(1, 1), b3 + hstepB, voffB); PG8_STA(PG8_SA(1, 0), last, 0, kt2 + 1);
            PG8_WAIT_V(8); PG8_WAIT_L(0); PG8_BAR; PG8_MM2(1); PG8_BAR; PG8_SCHED;
        }
        S.publish(wid);
        if (wr == 0) PG8_BAR;
        { int t2 = threadIdx.x; asm volatile("" : "+v"(t2)); const int l2 = t2 & 63; E(acc, cur, wr, wc, l2 & 15, l2 >> 4, ui, lds); }
        if (!has_next) break;
#pragma unroll
        for (int a = 0; a < 2; ++a)
#pragma unroll
            for (int b = 0; b < 2; ++b)
#pragma unroll
                for (int m = 0; m < 4; ++m)
#pragma unroll
                    for (int n = 0; n < 2; ++n) acc[a][b][m][n] = (f32x4){0.f, 0.f, 0.f, 0.f};
        cur = nxt; cB = nB; cA = nA; ++ui;
        E.prefetch(cur, ui, tid, lds);

        if (wr == 1) PG8_BAR;
    }
    PG8_WAIT_V(0);
    PG8_BAR;
#undef PG8_SA
#undef PG8_SB
#undef PG8_STAGE
#undef PG8_LDA
#undef PG8_LDB
#undef PG8_MMA
#undef PG8_MM2
#undef PG8_CAT
#undef PG8_WAIT_V
#undef PG8_WAIT_L
#undef PG8_BAR
#undef PG8_SCHED
#undef PG8_VOFF
#undef PG8_VROW
#undef PG8_STA
}

struct DenseSched {
    static constexpr bool kDense = true;
    int nM, nN, nwg, G, c; const bf16_t* Bt; int K;
    __device__ void init(int M, int N, int ldb_, const bf16_t* Bt_, int G_, int c_) { nM = M / BM; nN = N / BM; nwg = nM * nN; G = G_; c = c_; Bt = Bt_; K = ldb_; }
    __device__ __forceinline__ void publish(int) {}
    __device__ bool next(int i, Unit& u) const {
        const long L = (long)i * G + c; if (L >= nwg) return false;
        int wgid = (int)L; { const int q = nwg / NXCD, r = nwg % NXCD, xcd = wgid % NXCD, off = wgid / NXCD; wgid = (xcd < r ? xcd * (q + 1) : r * (q + 1) + (xcd - r) * q) + off; }
        const int nig = WGM * nN, gid = wgid / nig, fm = gid * WGM, gsz = (nM - fm) < WGM ? (nM - fm) : WGM;
        const int pm = fm + ((wgid % nig) % gsz), pn = (wgid % nig) / gsz;
        u.B = (const char*)Bt + (size_t)pn * BM * K * 2; u.m0 = pm * BM; u.pn = pn; u.e = pm; u.nrows = BM; u.orow0 = pm * BM; u.l0 = nullptr; u.l1 = nullptr; u.n0 = 0; u.ntot = 0;
        return true;
    }
};
}
#define XB_TMO      128
#define XB_XCNT(j)  (256  + 64 * (j))
#define XB_XSUB(j)  (1280 + 64 * (j))
#define XB_XGEN(j)  (2304 + 64 * (j))
#define XB_TOP      3328
#define XB_TOPGEN   3392
#define XCD_BAR_WORDS 3456
#define XB_SPIN_CAP (1u << 18)

__device__ __forceinline__ unsigned xb_ld(unsigned* p)              { return __hip_atomic_load(p, __ATOMIC_RELAXED, __HIP_MEMORY_SCOPE_AGENT); }
__device__ __forceinline__ unsigned xb_add(unsigned* p, unsigned v) { return __hip_atomic_fetch_add(p, v, __ATOMIC_RELAXED, __HIP_MEMORY_SCOPE_AGENT); }
__device__ __forceinline__ unsigned xb_xcc_id() { return (unsigned)__builtin_amdgcn_s_getreg((3 << 11) | 20) & 0xFu; }
#define XB_SPIN(cond, bar) do { unsigned _sp = 0; while (cond) { __builtin_amdgcn_s_sleep(1); \
    if ((++_sp & 255u) == 0u) { if (xb_ld(&(bar)[XB_TMO])) break; if (_sp > XB_SPIN_CAP) { atomicAdd(&(bar)[XB_TMO], 1u); break; } } } } while (0)

struct XcdBarrier { unsigned* bar; unsigned x; volatile LAS unsigned* st; };

__device__ __forceinline__ XcdBarrier xcd_barrier_post(unsigned* bar, volatile LAS unsigned* st) {
    XcdBarrier b; b.bar = bar; b.x = xb_xcc_id(); b.st = st;
    if (threadIdx.x == 0) (void)xb_add(&bar[XB_XCNT(b.x)], 1u);
    return b;
}
__device__ __forceinline__ void xcd_barrier_complete(unsigned* bar, unsigned x, unsigned& nloc, unsigned& nx) {
    const unsigned G = gridDim.x * gridDim.y * gridDim.z;
    unsigned sum, cnt, mine, sp = 0u;
    for (;;) {
        sum = 0u; cnt = 0u; mine = 0u;
#pragma unroll
        for (unsigned j = 0; j < 16; ++j) { const unsigned c = xb_ld(&bar[XB_XCNT(j)]); sum += c; cnt += (c > 0u) ? 1u : 0u; mine = (j == x) ? c : mine; }
        if (sum == G) break;
        __builtin_amdgcn_s_sleep(1);
        if ((++sp & 255u) == 0u) { if (xb_ld(&bar[XB_TMO])) break; if (sp > XB_SPIN_CAP) { atomicAdd(&bar[XB_TMO], 1u); break; } }
    }
    nloc = mine > 0u ? mine : 1u; nx = cnt > 0u ? cnt : 1u;
}
__device__ __forceinline__ void xcd_barrier(const XcdBarrier& b) {
    asm volatile("s_waitcnt vmcnt(0)" ::: "memory");
    __syncthreads();
    int tid_ = threadIdx.x; asm volatile("" : "+v"(tid_));
    if (tid_ == 0) {
        unsigned* bar = b.bar; asm volatile("" : "+s"(bar)); unsigned bx_ = b.x; asm volatile("" : "+s"(bx_));
        __builtin_amdgcn_s_waitcnt(0);
        unsigned nloc = b.st[0], nx = b.st[1];
        if (nloc == 0u) { xcd_barrier_complete(bar, bx_, nloc, nx); b.st[0] = nloc; b.st[1] = nx; }
        const unsigned old = xb_add(&bar[XB_XSUB(bx_)], 1u);
        const unsigned gen = old / nloc;
        if (old + 1u == (gen + 1u) * nloc) {
            __builtin_amdgcn_fence(__ATOMIC_RELEASE, "agent");
            asm volatile("s_waitcnt vmcnt(0)" ::: "memory");
            const unsigned og = xb_add(&bar[XB_TOP], 1u);
            const unsigned tg = og / nx;
            if (og + 1u == (tg + 1u) * nx) xb_add(&bar[XB_TOPGEN], 1u);
            else XB_SPIN(xb_ld(&bar[XB_TOPGEN]) == tg, bar);
            __builtin_amdgcn_fence(__ATOMIC_ACQUIRE, "agent");
            xb_add(&bar[XB_XGEN(bx_)], 1u);
            asm volatile("s_waitcnt vmcnt(0)" ::: "memory");
        } else {
            XB_SPIN(xb_ld(&bar[XB_XGEN(bx_)]) == gen, bar);
            __builtin_amdgcn_fence(__ATOMIC_ACQUIRE, "agent");
            asm volatile("s_waitcnt vmcnt(0)" ::: "memory");
        }
    }
    __syncthreads();
}
namespace epi {
using pg8::Unit;
__device__ __forceinline__ u32x4 pack8(f32x4 a, f32x4 b) { u32x4 w; w.x = cvt_pk_bf16(a[0], a[1]); w.y = cvt_pk_bf16(a[2], a[3]); w.z = cvt_pk_bf16(b[0], b[1]); w.w = cvt_pk_bf16(b[2], b[3]); return w; }

__device__ __forceinline__ float red_fq(float s) { const int l = lane_fresh(); s += shx(s, 16, l); s += shx(s, 32, l); return s; }
__device__ __forceinline__ void unpack8(u32x4 w, f32x4& a, f32x4& b) { a = (f32x4){bflo(w.x), bfhi(w.x), bflo(w.y), bfhi(w.y)}; b = (f32x4){bflo(w.z), bfhi(w.z), bflo(w.w), bfhi(w.w)}; }
__device__ __forceinline__ void rope32(f32x4 (&v)[2], const float* cs, const float* sn, int fq) {
#pragma unroll
    for (int n = 0; n < 2; ++n) {
        const f32x4 c4 = *(const f32x4*)(cs + 8 * (fq & 1) + 4 * n), s4 = *(const f32x4*)(sn + 8 * (fq & 1) + 4 * n);
        const int l_ = lane_fresh(); f32x4 p; p[0] = shx(v[n][0], 32, l_); p[1] = shx(v[n][1], 32, l_); p[2] = shx(v[n][2], 32, l_); p[3] = shx(v[n][3], 32, l_);
        v[n] = (fq < 2) ? (v[n] * c4 - p * s4) : (v[n] * c4 + p * s4);
    }
}

struct EpiInProj {
    static constexpr bool PERM = true;
    __device__ __forceinline__ void prefetch(const Unit&, int, int, LAS unsigned char*) const {}
    bf16_t *naq, *nak, *nav, *qlat, *kvlat, *sgna, *sgmla; float *krot, *qsq, *kvsq; const float *gq, *gk, *rcos, *rsin;
    __device__ __forceinline__ void operator()(const f32x4 (&acc)[2][2][4][2], const Unit& u, int wr, int wc, int fr, int fq, int ui, LAS unsigned char* lds) const {
        const int pn = u.pn, row0 = u.orow0 + wr * 64 + fr;
        if (pn < 4) {
            bf16_t* dst = pn < 2 ? naq : nak; const float* g = pn < 2 ? gq : gk; const int head = (pn & 1) * 4 + wc;
            f32x4 gv[2][2];
#pragma unroll
            for (int bj = 0; bj < 2; ++bj)
#pragma unroll
                for (int n = 0; n < 2; ++n) gv[bj][n] = *(const f32x4*)(g + 32 * bj + 8 * fq + 4 * n);
#pragma unroll
            for (int ai = 0; ai < 2; ++ai)
#pragma unroll
                for (int m = 0; m < 4; ++m) {
                    float ss = (sq4(acc[ai][0][m][0]) + sq4(acc[ai][0][m][1])) + (sq4(acc[ai][1][m][0]) + sq4(acc[ai][1][m][1]));
                    ss = red_fq(ss); const float rstd = rsqrtf(ss * (1.0f / 64.0f) + EPS);
                    bf16_t* rp = dst + (size_t)(row0 + ai * 128 + m * 16) * 512 + head * 64 + 8 * fq;
#pragma unroll
                    for (int bj = 0; bj < 2; ++bj) *(u32x4*)(rp + 32 * bj) = pack8(acc[ai][bj][m][0] * rstd * gv[bj][0], acc[ai][bj][m][1] * rstd * gv[bj][1]);
                }
        } else if (pn < 6) {
#pragma unroll
            for (int ai = 0; ai < 2; ++ai)
#pragma unroll
                for (int m = 0; m < 4; ++m) { bf16_t* rp = nav + (size_t)(row0 + ai * 128 + m * 16) * 512 + (pn - 4) * 256 + wc * 32 + 8 * fq;
#pragma unroll
                    for (int bj = 0; bj < 2; ++bj) *(u32x4*)(rp + 128 * bj) = pack8(acc[ai][bj][m][0] * (1.0f / WIN_SCALE), acc[ai][bj][m][1] * (1.0f / WIN_SCALE)); }
        } else if (pn == 6) {
#pragma unroll
            for (int ai = 0; ai < 2; ++ai)
#pragma unroll
                for (int m = 0; m < 4; ++m) { const int row = row0 + ai * 128 + m * 16; bf16_t* rp = qlat + (size_t)row * 256 + wc * 32 + 8 * fq;
                    float ss = (sq4(acc[ai][0][m][0]) + sq4(acc[ai][0][m][1])) + (sq4(acc[ai][1][m][0]) + sq4(acc[ai][1][m][1]));
                    ss = red_fq(ss); if (fq == 0) qsq[(size_t)row * 4 + wc] = ss;
#pragma unroll
                    for (int bj = 0; bj < 2; ++bj) *(u32x4*)(rp + 128 * bj) = pack8(acc[ai][bj][m][0], acc[ai][bj][m][1]); }
        } else if (pn == 7) {
#pragma unroll
            for (int ai = 0; ai < 2; ++ai)
#pragma unroll
                for (int m = 0; m < 4; ++m) { const int row = row0 + ai * 128 + m * 16;
                    float ss = sq4(acc[ai][0][m][0]) + sq4(acc[ai][0][m][1]);
                    ss = red_fq(ss); if (fq == 0) kvsq[(size_t)row * 4 + wc] = ss;
                    *(u32x4*)(kvlat + (size_t)row * 128 + wc * 32 + 8 * fq) = pack8(acc[ai][0][m][0], acc[ai][0][m][1]);
                    if (wc == 0) { f32x4 v[2] = {acc[ai][1][m][0] * (1.0f / WIN_SCALE), acc[ai][1][m][1] * (1.0f / WIN_SCALE)};
                        rope32(v, rcos + (size_t)row * 16, rsin + (size_t)row * 16, fq);
                        *(f32x4*)(krot + (size_t)row * 32 + 8 * fq) = v[0]; *(f32x4*)(krot + (size_t)row * 32 + 8 * fq + 4) = v[1]; } }
        } else {
            unsigned char* dst = (unsigned char*)(pn < 12 ? sgna : sgmla); const int cb = ((pn - 8) & 3) * 256 + wc * 32 + 8 * fq;
#pragma unroll
            for (int ai = 0; ai < 2; ++ai)
#pragma unroll
                for (int m = 0; m < 4; ++m) { unsigned char* rp = dst + (size_t)(row0 + ai * 128 + m * 16) * 1024 + cb;
#pragma unroll
                    for (int bj = 0; bj < 2; ++bj) { f32x4 a = acc[ai][bj][m][0], b = acc[ai][bj][m][1];
#pragma unroll
                        for (int e = 0; e < 4; ++e) { a[e] = sigmoidf_fast(a[e] * (1.0f / WIN_SCALE)); b[e] = sigmoidf_fast(b[e] * (1.0f / WIN_SCALE)); }
                        u32x2 w; w.x = cvt4_fp8(a, 256.0f); w.y = cvt4_fp8(b, 256.0f); *(u32x2*)(rp + 128 * bj) = w; } }
        }
    }
};

struct EpiUpQ {
    static constexpr bool PERM = true;
    __device__ __forceinline__ void prefetch(const Unit&, int, int, LAS unsigned char*) const {}
    bf16_t* qm; float* qss; const float* qsq; const float* g; const float *rcos, *rsin;
    __device__ __forceinline__ void operator()(const f32x4 (&acc)[2][2][4][2], const Unit& u, int wr, int wc, int fr, int fq, int ui, LAS unsigned char* lds) const {
        const int pn = u.pn, row0 = u.orow0 + wr * 64 + fr;
#pragma unroll
        for (int ai = 0; ai < 2; ++ai)
#pragma unroll
            for (int m = 0; m < 4; ++m) {
                const int row = row0 + ai * 128 + m * 16, b = row >> 11, s = row & 2047;
                const f32x4 sq = *(const f32x4*)(qsq + (size_t)row * 4);
                const float rstd = rsqrtf(((sq[0] + sq[1]) + (sq[2] + sq[3])) * (1.0f / 256.0f) + EPS);
                if (pn < 2) {
                    const int head = pn * 4 + wc;
                    f32x4 v[2][2]; float ss = 0.f;
#pragma unroll
                    for (int bj = 0; bj < 2; ++bj)
#pragma unroll
                        for (int n = 0; n < 2; ++n) { v[bj][n] = acc[ai][bj][m][n] * rstd; ss += sq4(v[bj][n]); }
                    ss = red_fq(ss); if (fq == 0) qss[((size_t)row * 8 + head) * 2 + 0] = ss;
                    bf16_t* rp = qm + ((size_t)(b * 8 + head) * 2048 + s) * 96 + 8 * fq;
#pragma unroll
                    for (int bj = 0; bj < 2; ++bj) *(u32x4*)(rp + 32 * bj) = pack8(v[bj][0] * *(const f32x4*)(g + 32 * bj + 8 * fq), v[bj][1] * *(const f32x4*)(g + 32 * bj + 8 * fq + 4));
                } else {
#pragma unroll
                    for (int bj = 0; bj < 2; ++bj) { const int head = 2 * wc + bj;
                        f32x4 v[2] = {acc[ai][bj][m][0] * rstd, acc[ai][bj][m][1] * rstd};
                        float ss = sq4(v[0]) + sq4(v[1]); ss = red_fq(ss); if (fq == 0) qss[((size_t)row * 8 + head) * 2 + 1] = ss;
                        rope32(v, rcos + (size_t)row * 16, rsin + (size_t)row * 16, fq);
                        *(u32x4*)(qm + ((size_t)(b * 8 + head) * 2048 + s) * 96 + 64 + 8 * fq) = pack8(v[0] * *(const f32x4*)(g + 64 + 8 * fq), v[1] * *(const f32x4*)(g + 64 + 8 * fq + 4)); }
                }
            }
    }
};

struct EpiUpKV {
    static constexpr bool PERM = true;
    __device__ __forceinline__ void prefetch(const Unit&, int, int, LAS unsigned char*) const {}
    bf16_t *km, *vm; const float* kvsq; const float* krot; const float* g;
    __device__ __forceinline__ void operator()(const f32x4 (&acc)[2][2][4][2], const Unit& u, int wr, int wc, int fr, int fq, int ui, LAS unsigned char* lds) const {
        const int pn = u.pn, row0 = u.orow0 + wr * 64 + fr, head = 2 * pn + (wc >> 1);
#pragma unroll
        for (int ai = 0; ai < 2; ++ai)
#pragma unroll
            for (int m = 0; m < 4; ++m) {
                const int row = row0 + ai * 128 + m * 16, b = row >> 11, s = row & 2047;
                const f32x4 sq = *(const f32x4*)(kvsq + (size_t)row * 4);
                const float rstd = rsqrtf(((sq[0] + sq[1]) + (sq[2] + sq[3])) * (1.0f / 128.0f) + EPS);
                if ((wc & 1) == 0) {
                    f32x4 v[2][2]; float ss = 0.f;
#pragma unroll
                    for (int bj = 0; bj < 2; ++bj)
#pragma unroll
                        for (int n = 0; n < 2; ++n) { v[bj][n] = acc[ai][bj][m][n] * rstd; ss += sq4(v[bj][n]); }
                    const f32x4 k0 = *(const f32x4*)(krot + (size_t)row * 32 + 8 * fq), k1 = *(const f32x4*)(krot + (size_t)row * 32 + 8 * fq + 4);
                    ss += sq4(k0) + sq4(k1); ss = red_fq(ss);
                    const float r96 = rsqrtf(ss * (1.0f / 96.0f) + EPS);
                    bf16_t* rp = km + ((size_t)(b * 8 + head) * 2048 + s) * 96 + 8 * fq;
#pragma unroll
                    for (int bj = 0; bj < 2; ++bj) *(u32x4*)(rp + 32 * bj) = pack8(v[bj][0] * r96 * *(const f32x4*)(g + 32 * bj + 8 * fq), v[bj][1] * r96 * *(const f32x4*)(g + 32 * bj + 8 * fq + 4));
                    *(u32x4*)(rp + 64) = pack8(k0 * r96 * *(const f32x4*)(g + 64 + 8 * fq), k1 * r96 * *(const f32x4*)(g + 64 + 8 * fq + 4));
                } else {
                    bf16_t* rp = vm + ((size_t)(b * 8 + head) * 2048 + s) * 64 + 8 * fq;
#pragma unroll
                    for (int bj = 0; bj < 2; ++bj) *(u32x4*)(rp + 32 * bj) = pack8(acc[ai][bj][m][0] * rstd, acc[ai][bj][m][1] * rstd);
                }
            }
    }
};

struct EpiMergeCat {
    static constexpr bool PERM = true;
    __device__ __forceinline__ void prefetch(const Unit&, int, int, LAS unsigned char*) const {}
    const bf16_t *sgna, *sgmla; unsigned char* out;
    __device__ __forceinline__ void operator()(const f32x4 (&acc)[2][2][4][2], const Unit& u, int wr, int wc, int fr, int fq, int ui, LAS unsigned char* lds) const {
        const int row0 = u.orow0 + wr * 64 + fr, cb = u.pn * 128 + wc * 32 + 8 * fq;
#pragma unroll
        for (int ai = 0; ai < 2; ++ai)
#pragma unroll
            for (int m = 0; m < 4; ++m) { const size_t off = (size_t)(row0 + ai * 128 + m * 16) * 1024 + cb;
                const u32x2 g8 = *(const u32x2*)((const unsigned char*)sgna + off), h8 = *(const u32x2*)((const unsigned char*)sgmla + off);
                constexpr float sc_ = MG_SCALE / (Y_SCALE * WP_SCALE * 256.0f);
                f32x4 r0, r1;
                { const auto a_ = __builtin_amdgcn_cvt_pk_f32_fp8((int)g8.x, false), b_ = __builtin_amdgcn_cvt_pk_f32_fp8((int)g8.x, true); r0 = acc[ai][0][m][0] * (f32x4){a_[0], a_[1], b_[0], b_[1]}; }
                { const auto a_ = __builtin_amdgcn_cvt_pk_f32_fp8((int)h8.x, false), b_ = __builtin_amdgcn_cvt_pk_f32_fp8((int)h8.x, true); r0 += acc[ai][1][m][0] * (f32x4){a_[0], a_[1], b_[0], b_[1]}; }
                { const auto a_ = __builtin_amdgcn_cvt_pk_f32_fp8((int)g8.y, false), b_ = __builtin_amdgcn_cvt_pk_f32_fp8((int)g8.y, true); r1 = acc[ai][0][m][1] * (f32x4){a_[0], a_[1], b_[0], b_[1]}; }
                { const auto a_ = __builtin_amdgcn_cvt_pk_f32_fp8((int)h8.y, false), b_ = __builtin_amdgcn_cvt_pk_f32_fp8((int)h8.y, true); r1 += acc[ai][1][m][1] * (f32x4){a_[0], a_[1], b_[0], b_[1]}; }
                u32x2 w; w.x = cvt4_fp8(r0, sc_); w.y = cvt4_fp8(r1, sc_); *(u32x2*)(out + off) = w; }
    }
};

struct EpiOut {
    static constexpr bool PERM = false;
    __device__ __forceinline__ void prefetch(const Unit&, int, int, LAS unsigned char*) const {}
    const float* x; bf16_t* x1; const float* mod;
    __device__ __forceinline__ void operator()(const f32x4 (&acc)[2][2][4][2], const Unit& u, int wr, int wc, int fr, int fq, int ui, LAS unsigned char* lds) const {
        const int row0 = u.orow0 + wr * 64 + fr, cb = u.pn * 256 + wc * 32 + 4 * fq, b = u.orow0 >> 11;
        f32x4 gt[2][2];
#pragma unroll
        for (int bj = 0; bj < 2; ++bj)
#pragma unroll
            for (int n = 0; n < 2; ++n) gt[bj][n] = *(const f32x4*)(mod + (size_t)b * 6144 + 2048 + cb + 128 * bj + 16 * n);
#pragma unroll
        for (int ai = 0; ai < 2; ++ai)
#pragma unroll
            for (int m = 0; m < 4; ++m) { const size_t off = (size_t)(row0 + ai * 128 + m * 16) * 1024 + cb;
#pragma unroll
                for (int bj = 0; bj < 2; ++bj)
#pragma unroll
                    for (int n = 0; n < 2; ++n) { const f32x4 xv = *(const f32x4*)(x + off + 128 * bj + 16 * n); const f32x4 o = xv + gt[bj][n] * (acc[ai][bj][m][n] * (1.0f / (MG_SCALE * WOUT_SCALE))); u32x2 w; w.x = cvt_pk_bf16(o[0], o[1]); w.y = cvt_pk_bf16(o[2], o[3]); *(u32x2*)(x1 + off + 128 * bj + 16 * n) = w; } }
    }
};

struct EpiGateUp {
    static constexpr bool PERM = true;
    __device__ __forceinline__ void prefetch(const Unit&, int, int, LAS unsigned char*) const {}
    unsigned char* act;
    __device__ __forceinline__ void operator()(const f32x4 (&acc)[2][2][4][2], const Unit& u, int wr, int wc, int fr, int fq, int ui, LAS unsigned char* lds) const {
        const int lr0 = wr * 64 + fr, cb = u.pn * 128 + wc * 32 + 8 * fq;
#pragma unroll
        for (int ai = 0; ai < 2; ++ai)
#pragma unroll
            for (int m = 0; m < 4; ++m) { const int lr = lr0 + ai * 128 + m * 16;
                if (lr < u.nrows) {
                    f32x4 a = acc[ai][0][m][0], b = acc[ai][0][m][1];
#pragma unroll
                    for (int e = 0; e < 4; ++e) { a[e] = siluf_fast(a[e] * (1.0f / WGU_SCALE)) * (acc[ai][1][m][0][e] * (1.0f / WGU_SCALE)); b[e] = siluf_fast(b[e] * (1.0f / WGU_SCALE)) * (acc[ai][1][m][1][e] * (1.0f / WGU_SCALE)); }
                    u32x2 w; w.x = cvt4_fp8(a, ACT_SCALE); w.y = cvt4_fp8(b, ACT_SCALE); *(u32x2*)(act + (size_t)(u.orow0 + lr) * 256 + cb) = w; } }
    }
};
__device__ __forceinline__ unsigned pk4_fp8_unused(f32x4 a) {
    int w = 0;
    w = __builtin_amdgcn_cvt_pk_fp8_f32(__builtin_amdgcn_fmed3f(a[0] * YS_SCALE, -448.f, 448.f), __builtin_amdgcn_fmed3f(a[1] * YS_SCALE, -448.f, 448.f), w, false);
    w = __builtin_amdgcn_cvt_pk_fp8_f32(__builtin_amdgcn_fmed3f(a[2] * YS_SCALE, -448.f, 448.f), __builtin_amdgcn_fmed3f(a[3] * YS_SCALE, -448.f, 448.f), w, true);
    return (unsigned)w;
}
struct EpiDown {
    static constexpr bool PERM = true;
    __device__ __forceinline__ void prefetch(const Unit& u, int ui, int tid, LAS unsigned char* lds) const {
        if (tid < 256) { LAS float* wl = (LAS float*)(lds + RING_BYTES + 1024 + 12288) + (ui & 1) * 256; wl[tid] = u.l1 ? ((const float*)u.l1)[tid] : 1.0f; } }
    unsigned char* ys; int dry;
    __device__ __forceinline__ void operator()(const f32x4 (&acc)[2][2][4][2], const Unit& u, int wr, int wc, int fr, int fq, int ui, LAS unsigned char* lds) const {
        if (dry) { float t = 0.f; _Pragma("unroll") for (int ai = 0; ai < 2; ++ai) _Pragma("unroll") for (int bj = 0; bj < 2; ++bj) _Pragma("unroll") for (int m = 0; m < 4; ++m) t += acc[ai][bj][m][0][0] + acc[ai][bj][m][1][3]; asm volatile("" :: "v"(t)); return; }
        const int lr0 = wr * 64 + fr, cb = u.pn * 256 + wc * 32 + 8 * fq;
#pragma unroll
        for (int ai = 0; ai < 2; ++ai)
#pragma unroll
            for (int m = 0; m < 4; ++m) { const int lr = lr0 + ai * 128 + m * 16;
                if (lr < u.nrows) { unsigned char* rp = ys + (size_t)(u.orow0 + lr) * 1024 + cb;
                    const float sc = (YS_SCALE / (ACT_SCALE * WD_SCALE)) * ((const LAS float*)(lds + RING_BYTES + 1024 + 12288))[(ui & 1) * 256 + lr];
#pragma unroll
                    for (int bj = 0; bj < 2; ++bj) { u32x2 w; w.x = cvt4_fp8(acc[ai][bj][m][0], sc); w.y = cvt4_fp8(acc[ai][bj][m][1], sc); *(u32x2*)(rp + 128 * bj) = w; } } }
    }
};
}
struct Frame {
    LAS unsigned char* lds;
    volatile LAS unsigned* MISC;
    gu32* ctl;
    int tid, lane, wave, vcu, G;
    unsigned char* ws;
    float* out;
    __device__ __forceinline__ void refresh() { int t = threadIdx.x; asm volatile("" : "+v"(t)); tid = t; lane = t & 63; wave = __builtin_amdgcn_readfirstlane(t >> 6);
        asm volatile("" : "+s"(ws)); asm volatile("" : "+s"(out)); ctl = (gu32*)(ws + WS_CTL); }
};
__device__ __forceinline__ int fresh_tid() { int t = threadIdx.x; asm volatile("" : "+v"(t)); return t; }
template <class T> __device__ __forceinline__ T* wsp(const Frame& F, size_t off) { return (T*)(F.ws + off); }

struct MapOff { int off; __device__ int operator()(int n) const { return n + off; } };
struct MapWin { __device__ int operator()(int n) const {
    if (n < 1024) { const int sec = n >> 9, nn = n & 511, hh = nn >> 6, d = nn & 63; return sec * 512 + (hh >> 2) * 256 + 128 * (d >> 5) + 32 * (hh & 3) + (d & 31); }
    return n < 1952 ? n : n + 96; } };
struct MapUq { __device__ int operator()(int n) const { const int hh = n / 96, d = n % 96;
    return d < 64 ? (hh >> 2) * 256 + 128 * (d >> 5) + 32 * (hh & 3) + (d & 31) : 512 + 128 * (hh & 1) + 32 * (hh >> 1) + (d - 64); } };
struct MapUkv { __device__ int operator()(int n) const { const int hh = n >> 7, d = n & 127, dd = d & 63, wcn = 2 * (hh & 1) + (d >> 6);
    return (hh >> 1) * 256 + 128 * (dd >> 5) + 32 * wcn + (dd & 31); } };
struct MapCat { int up; __device__ int operator()(int n) const { return (n >> 7) * 256 + up * 128 + (n & 127); } };
struct MapGU { int up; __device__ int operator()(int f) const { return (f >> 7) * 256 + up * 128 + (f & 127); } };

template <class Map> __device__ __forceinline__ void transpose_item(const float* W, int K, int N, bf16_t* WT, Map rm, const float* kscale, LAS float* scr, int item, int lane, int ldt = 0, int koff = 0) {
    if (ldt == 0) ldt = K;
    const int nblk = N / 32, kb = item / nblk, nb = item % nblk, k0 = 64 * kb, n0 = 32 * nb;
    float tv[32];
#pragma unroll
    for (int i = 0; i < 32; ++i) { const int kk = 2 * i + (lane >> 5); tv[i] = __builtin_nontemporal_load(W + (size_t)(k0 + kk) * N + n0 + (lane & 31)); }
#pragma unroll
    for (int i = 0; i < 32; ++i) { const int kk = 2 * i + (lane >> 5); float v = tv[i]; if (kscale) v *= kscale[k0 + kk]; scr[kk * 33 + (lane & 31)] = v; }
    LDS_WAIT(); asm volatile("" ::: "memory");
    const int c = lane & 7;
#pragma unroll
    for (int j = 0; j < 4; ++j) { const int n = (lane >> 3) + 8 * j; const LAS float* s = scr + (8 * c) * 33 + n;
        u32x4 o; o.x = pk2(s[0 * 33], s[1 * 33]); o.y = pk2(s[2 * 33], s[3 * 33]); o.z = pk2(s[4 * 33], s[5 * 33]); o.w = pk2(s[6 * 33], s[7 * 33]);
        *(u32x4*)(WT + (size_t)rm(n0 + n) * ldt + koff + k0 + 8 * c) = o; }
    LDS_WAIT(); asm volatile("" ::: "memory");
}


template <class Map> __device__ __forceinline__ void transpose_item_fp8(const float* W, int K, int N, unsigned char* WT, Map rm, float sc, LAS float* scr, int item, int lane, int ldt = 0, int koff = 0) {
    if (ldt == 0) ldt = K;
    const int nblk = N / 32, kb = item / nblk, nb = item % nblk, k0 = 64 * kb, n0 = 32 * nb;
    float tv[32];
#pragma unroll
    for (int i = 0; i < 32; ++i) { const int kk = 2 * i + (lane >> 5); tv[i] = __builtin_nontemporal_load(W + (size_t)(k0 + kk) * N + n0 + (lane & 31)); }
#pragma unroll
    for (int i = 0; i < 32; ++i) { const int kk = 2 * i + (lane >> 5); scr[kk * 33 + (lane & 31)] = tv[i]; }
    LDS_WAIT(); asm volatile("" ::: "memory");
    const int c = lane & 3;
#pragma unroll
    for (int j = 0; j < 2; ++j) { const int n = (lane >> 2) + 16 * j; const LAS float* s = scr + (16 * c) * 33 + n;
        u32x4 o;
#pragma unroll
        for (int q = 0; q < 4; ++q) o[q] = cvt4_fp8((f32x4){s[(4 * q + 0) * 33], s[(4 * q + 1) * 33], s[(4 * q + 2) * 33], s[(4 * q + 3) * 33]}, sc);
        *(u32x4*)(WT + (size_t)rm(n0 + n) * ldt + koff + k0 + 16 * c) = o; }
    LDS_WAIT(); asm volatile("" ::: "memory");
}

__device__ __forceinline__ void p0_prologue(Frame& F, const Args& A) {
    const int tid = F.tid;
    {
        LAS float* sc = (LAS float*)F.lds;
        LAS float* part = (LAS float*)(F.lds + 32768);
        for (int i = tid; i < NB * DM; i += NTHR) { const float v = INF(I_c)[i]; sc[i] = v / (1.0f + expf(-v)); }
        __syncthreads();
        for (int n0 = 24 * (int)blockIdx.x; n0 < 6 * DM; n0 += 24 * F.G) {
        const int kk = tid >> 5, col = tid & 31;
        float a[8];
#pragma unroll
        for (int b = 0; b < 8; ++b) a[b] = 0.f;
        if (col < 24) {
#pragma unroll 1
            for (int k0 = kk; k0 < DM; k0 += 16 * 32) { float wv[32];
#pragma unroll
                for (int q = 0; q < 32; ++q) wv[q] = INF(I_w_ada)[(size_t)(k0 + 16 * q) * 6144 + n0 + col];
#pragma unroll
                for (int q = 0; q < 32; ++q) {
#pragma unroll
                    for (int b = 0; b < 8; ++b) a[b] = fmaf(sc[b * DM + k0 + 16 * q], wv[q], a[b]); } }
        }
#pragma unroll
        for (int b = 0; b < 8; ++b) part[(kk * 8 + b) * 32 + col] = a[b];
        __syncthreads();
        if (tid < 192) { const int b = tid / 24, cc = tid % 24; float s = 0.f;
#pragma unroll
            for (int q = 0; q < 16; ++q) s += part[(q * 8 + b) * 32 + cc];
            wsp<float>(F, WS_MOD)[(size_t)b * 6144 + n0 + cc] = s + INF(I_b_ada)[n0 + cc]; }
        __syncthreads();
        }
    }
}
__device__ __forceinline__ void p0_copies(Frame& F, const Args& A) {
    const int tid = F.tid;
    LAS float* scr = (LAS float*)(F.lds + F.wave * 16384);
    const int gw = F.vcu * NWAVES + F.wave, NGW = F.G * NWAVES;
    constexpr int I_IN = 16 * 125, I_UQ = 4 * 24, I_UKV = 2 * 32, I_PN = 8 * 32, I_OUT = 16 * 32;
    constexpr int NITEMS = I_IN + I_UQ + I_UKV + 2 * I_PN + I_OUT;
    for (int it = gw; it < NITEMS; it += NGW) {
        int r = it;
        if (r < I_IN) { transpose_item_fp8(INF(I_w_in), DM, INCOLS, wsp<unsigned char>(F, WS_WIN), MapWin{}, WIN_SCALE, scr, r, F.lane, LDW); continue; } r -= I_IN;
        if (r < I_UQ) { transpose_item(INF(I_w_uq), QRANK, MH * QKD, wsp<bf16_t>(F, WS_WUQ), MapUq{}, INF(I_g_q_lat), scr, r, F.lane); continue; } r -= I_UQ;
        if (r < I_UKV) { transpose_item(INF(I_w_ukv), KVRANK, MH * 128, wsp<bf16_t>(F, WS_WUKV), MapUkv{}, INF(I_g_kv_lat), scr, r, F.lane); continue; } r -= I_UKV;
        if (r < I_PN) { transpose_item_fp8(INF(I_w_proj_na), 512, DM, wsp<unsigned char>(F, WS_WPCAT), MapCat{0}, WP_SCALE, scr, r, F.lane, 1024, 0); continue; } r -= I_PN;
        if (r < I_PN) { transpose_item_fp8(INF(I_w_proj_mla), 512, DM, wsp<unsigned char>(F, WS_WPCAT), MapCat{1}, WP_SCALE, scr, r, F.lane, 1024, 512); continue; } r -= I_PN;
        transpose_item_fp8(INF(I_w_out), DM, DM, wsp<unsigned char>(F, WS_WOUT), MapOff{0}, WOUT_SCALE, scr, r, F.lane);
    }
#ifdef TSA
    if (blockIdx.x == TSWG && threadIdx.x == 0) { const unsigned long long t_ = __builtin_amdgcn_s_memrealtime(); ((LAS unsigned*)(F.lds + TAB_OFF + 2048))[44] = (unsigned)t_; ((LAS unsigned*)(F.lds + TAB_OFF + 2048))[45] = (unsigned)(t_ >> 32); }
#endif
    const int gt = F.vcu * NTHR + tid, NGT = F.G * NTHR;
    for (int i = gt; i < 96 * 64; i += NGT) *(u32x4*)(wsp<unsigned char>(F, WS_WIN) + (size_t)(1952 + i / 64) * LDW + (size_t)(i % 64) * 16) = (u32x4){0u, 0u, 0u, 0u};
    for (int i = gt; i < 2048 * 32; i += NGT) { const int row = i >> 5, q = i & 31; *(u32x4*)(wsp<unsigned char>(F, WS_WPCAT) + (size_t)row * 1024 + ((row & 128) ? 0 : 512) + q * 16) = (u32x4){0u, 0u, 0u, 0u}; }
    for (int i = gt; i < NT * 16; i += NGT) { const int t = i >> 4, q = i & 15;
        const float inv = powf(10000.0f, -(float)q / 16.0f), ang = (float)((const int*)A.in[I_positions])[t] * inv;
        wsp<float>(F, WS_RCOS)[i] = cosf(ang); wsp<float>(F, WS_RSIN)[i] = sinf(ang); }
    for (int i = gt; i < 4 * 32 * 64; i += NGT) { const int ct = i >> 11, ks = (i >> 6) & 31, l = i & 63; float w[8];
#pragma unroll
        for (int j = 0; j < 8; ++j) w[j] = INF(I_w_router)[(size_t)(32 * ks + 8 * (l >> 4) + j) * NEXP + 16 * ct + (l & 15)];
        u32x4 hw, lw;
#pragma unroll
        for (int q = 0; q < 4; ++q) { const unsigned h2 = pk2(w[2 * q], w[2 * q + 1]); hw[q] = h2; lw[q] = pk2(w[2 * q] - bflo(h2), w[2 * q + 1] - bfhi(h2)); }
        wsp<u32x4>(F, WS_RFRAG)[(size_t)i * 2] = hw; wsp<u32x4>(F, WS_RFRAG)[(size_t)i * 2 + 1] = lw; }
#ifdef TSA
    if (blockIdx.x == TSWG && threadIdx.x == 0) { const unsigned long long t_ = __builtin_amdgcn_s_memrealtime(); ((LAS unsigned*)(F.lds + TAB_OFF + 2048))[46] = (unsigned)t_; ((LAS unsigned*)(F.lds + TAB_OFF + 2048))[47] = (unsigned)(t_ >> 32); }
#endif
}

__device__ __forceinline__ void s1_modnorm(Frame& F, const Args& A) {
    const int gw = F.vcu * NWAVES + F.wave, lane = F.lane;
    const float* mod = wsp<float>(F, WS_MOD); unsigned char* H = wsp<unsigned char>(F, WS_H);
    for (int r0 = gw * 8; r0 < NT; r0 += F.G * NWAVES * 8) {
    const int b = r0 >> 11;
    f32x4 ca[4], cs[4];
#pragma unroll
    for (int j = 0; j < 4; ++j) { const int c4 = 4 * lane + 256 * j;
        const f32x4 g = *(const f32x4*)(INF(I_g_norm1) + c4), sc = *(const f32x4*)(mod + (size_t)b * 6144 + 1024 + c4);
        ca[j] = g * (sc + 1.0f); cs[j] = *(const f32x4*)(mod + (size_t)b * 6144 + c4); }
#pragma unroll 1
    for (int qb = 0; qb < 8; qb += 4) {
    f32x4 v[4][4];
#pragma unroll
    for (int q = 0; q < 4; ++q)
#pragma unroll
        for (int j = 0; j < 4; ++j) v[q][j] = __builtin_nontemporal_load((const f32x4*)(INF(I_x) + (size_t)(r0 + qb + q) * DM + 4 * lane + 256 * j));
#pragma unroll
    for (int q = 0; q < 4; ++q) { float ss = 0.f;
#pragma unroll
        for (int j = 0; j < 4; ++j) ss += sq4(v[q][j]);
        const float rstd = rsqrtf(wave_sum(ss) * (1.0f / DM) + EPS);
#pragma unroll
        for (int j = 0; j < 4; ++j) { const f32x4 o = v[q][j] * rstd * ca[j] + cs[j];
            *(unsigned*)(H + (size_t)(r0 + qb + q) * LDH + 4 * lane + 256 * j) = cvt4_fp8(o, 1.0f); }
    }
    }
    }
}
namespace attn {
__device__ __forceinline__ int crow(int r, int hi) { return (r & 3) + 8 * (r >> 2) + 4 * hi; }
constexpr int KVBLK = 64;
constexpr int L_K = 0, L_V = 26624, L_WS = 43008, L_OST = 45056, L_BIAS = 77824, L_MASK = L_BIAS + 4 * 15 * 128 * 4, L_END = L_MASK + 4 * 128 * 4;
constexpr int KBUF = 13312, VBUF = 8192;
constexpr float THRN = 8.0f;

template <int DQK> struct Geo { static constexpr int KROWB = DQK * 2 + 16, NCH = DQK / 8, ND0 = DQK / 16; };

__device__ __forceinline__ int v_st(int k, int c) { const int kk = (k & ~0xC) | ((k & 4) << 1) | ((k & 8) >> 1); return ((kk >> 3) * 2 + (c >> 5)) * 512 + ((kk & 7) * 32 + (c & 31)) * 2; }
__device__ __forceinline__ int v_rd_base(int lane) { return ((lane & 3) << 3) | (((lane >> 2) & 3) << 6) | (((lane >> 4) & 1) << 5) | (((lane >> 5) & 1) << 8); }
constexpr int v_rd_off(int d0, int ks, int half) { return d0 * 512 + ks * 2048 + half * 1024; }
template <int OFF> __device__ __forceinline__ s16x4 tr_read(int vb) { s16x4 r; asm volatile("ds_read_b64_tr_b16 %0, %1 offset:%2" : "=&v"(r) : "v"(vb), "i"(OFF) : "memory"); return r; }

template <int D0> __device__ __forceinline__ void pv_one(f32x16& od, int vb, bf16x8 pa0, bf16x8 pa1, bf16x8 pa2, bf16x8 pa3) {
    const s16x4 l0 = tr_read<v_rd_off(D0, 0, 0)>(vb), h0 = tr_read<v_rd_off(D0, 0, 1)>(vb), l1 = tr_read<v_rd_off(D0, 1, 0)>(vb), h1 = tr_read<v_rd_off(D0, 1, 1)>(vb);
    const s16x4 l2 = tr_read<v_rd_off(D0, 2, 0)>(vb), h2 = tr_read<v_rd_off(D0, 2, 1)>(vb), l3 = tr_read<v_rd_off(D0, 3, 0)>(vb), h3 = tr_read<v_rd_off(D0, 3, 1)>(vb);
    asm volatile("s_waitcnt lgkmcnt(0)" ::: "memory"); SBAR();
#define PK(L, H) (bf16x8){L[0], L[1], L[2], L[3], H[0], H[1], H[2], H[3]}
    od = __builtin_amdgcn_mfma_f32_32x32x16_bf16(pa0, PK(l0, h0), od, 0, 0, 0);
    od = __builtin_amdgcn_mfma_f32_32x32x16_bf16(pa1, PK(l1, h1), od, 0, 0, 0);
    od = __builtin_amdgcn_mfma_f32_32x32x16_bf16(pa2, PK(l2, h2), od, 0, 0, 0);
    od = __builtin_amdgcn_mfma_f32_32x32x16_bf16(pa3, PK(l3, h3), od, 0, 0, 0);
#undef PK
}

template <int DQK> __device__ __forceinline__ void qkt(f32x16& p0, f32x16& p1, const LAS unsigned char* Ks, const bf16x8* qr, int r32, int hi) {
    p0 = f32x16{}; p1 = f32x16{};
#pragma unroll
    for (int d0 = 0; d0 < Geo<DQK>::ND0; ++d0) { const int cb = (d0 * 16 + hi * 8) * 2;
        const bf16x8 b0 = *(const LAS bf16x8*)(Ks + r32 * Geo<DQK>::KROWB + cb);
        const bf16x8 b1 = *(const LAS bf16x8*)(Ks + (32 + r32) * Geo<DQK>::KROWB + cb);
        p0 = __builtin_amdgcn_mfma_f32_32x32x16_bf16(b0, qr[d0], p0, 0, 0, 0);
        p1 = __builtin_amdgcn_mfma_f32_32x32x16_bf16(b1, qr[d0], p1, 0, 0, 0); }
}
__device__ __forceinline__ void softmax_tile(f32x16& p0, f32x16& p1, float& l_reg, float C, float nBC, bf16x8& pa0, bf16x8& pa1, bf16x8& pa2, bf16x8& pa3) {
#pragma unroll
    for (int r = 0; r < 16; ++r) { p0[r] = __builtin_amdgcn_exp2f(fmaf(p0[r], C, nBC)); p1[r] = __builtin_amdgcn_exp2f(fmaf(p1[r], C, nBC)); }
    float ps = 0;
#pragma unroll
    for (int r = 0; r < 16; ++r) ps += p0[r];
#pragma unroll
    for (int r = 0; r < 16; ++r) ps += p1[r];
    l_reg += ps;
#define PK4(P, BASE, OUT) do { unsigned a0 = cvt_pk_bf16(P[BASE + 0], P[BASE + 1]), a1 = cvt_pk_bf16(P[BASE + 2], P[BASE + 3]);   \
    unsigned b0 = cvt_pk_bf16(P[BASE + 4], P[BASE + 5]), b1 = cvt_pk_bf16(P[BASE + 6], P[BASE + 7]);                              \
    auto r0 = __builtin_amdgcn_permlane32_swap(a0, b0, false, false); auto r1 = __builtin_amdgcn_permlane32_swap(a1, b1, false, false); \
    u32x4 w = {r0[0], r1[0], r0[1], r1[1]}; OUT = __builtin_bit_cast(bf16x8, w); } while (0)
    PK4(p0, 0, pa0); PK4(p0, 8, pa1); PK4(p1, 0, pa2); PK4(p1, 8, pa3);
#undef PK4
}

template <int DQK, bool NA>
__device__ __forceinline__ void attn_unit(LAS unsigned char* lds, const bf16_t* Qw, int ldq, float qscale, const bf16_t* Kt, int ldk, const bf16_t* Vt, int ldv, bf16_t* Ow,
                                          int ntiles, float SCALE, float bound_raw, int na_first, int na_qc0, int na_dr0) {
    using G = Geo<DQK>;
    int tid_ = threadIdx.x; asm volatile("" : "+v"(tid_));
    const int tid = tid_, lane = tid & 63, r32 = lane & 31, hi = lane >> 5; const int wid = __builtin_amdgcn_readfirstlane(tid >> 6);
    const float C = SCALE * 1.4426950408889634f, nBC = -bound_raw * C;
    LAS float* wsf = (LAS float*)(lds + L_WS) + wid * 64;
    bf16x8 qr[G::ND0];
#pragma unroll
    for (int d0 = 0; d0 < G::ND0; ++d0) { u32x4 w = *(const u32x4*)(Qw + (size_t)r32 * ldq + d0 * 16 + hi * 8);
        if (!NA) { f32x4 a, b; a = (f32x4){bflo(w.x), bfhi(w.x), bflo(w.y), bfhi(w.y)} * qscale; b = (f32x4){bflo(w.z), bfhi(w.z), bflo(w.w), bfhi(w.w)} * qscale;
            w.x = cvt_pk_bf16(a[0], a[1]); w.y = cvt_pk_bf16(a[2], a[3]); w.z = cvt_pk_bf16(b[0], b[1]); w.w = cvt_pk_bf16(b[2], b[3]); }
        qr[d0] = __builtin_bit_cast(bf16x8, w); }
    const int vk = tid >> 3, vc = (tid & 7) * 8, vst = v_st(vk, vc);
    const int k0r = tid / G::NCH, k0c = tid % G::NCH; const int k1id = tid + 512, k1r = k1id / G::NCH, k1c = k1id % G::NCH; const bool k1on = (G::NCH == 12) && (tid < 256);
    const int vb0 = (int)(uintptr_t)(lds + L_V) + v_rd_base(lane);
    u32x4 sv, sk0, sk1;
#define SLOAD(j) do { const size_t kb_ = (size_t)(j) * KVBLK; sv = *(const u32x4*)(Vt + (kb_ + vk) * ldv + vc); sk0 = *(const u32x4*)(Kt + (kb_ + k0r) * ldk + k0c * 8); \
        if (k1on) sk1 = *(const u32x4*)(Kt + (kb_ + k1r) * ldk + k1c * 8); } while (0)
#define SWRITE(bf) do { *(LAS u32x4*)(lds + L_V + (bf) * VBUF + vst) = sv; *(LAS u32x4*)(lds + L_K + (bf) * KBUF + k0r * G::KROWB + k0c * 16) = sk0; \
        if (k1on) *(LAS u32x4*)(lds + L_K + (bf) * KBUF + k1r * G::KROWB + k1c * 16) = sk1; } while (0)
    float l_reg = 0.f; f32x16 o[2]; o[0] = f32x16{}; o[1] = f32x16{};
    const LAS float* tb_lane = nullptr; f32x4 mk0[4], mk1[4];
    if (NA) { const int qc = na_qc0 + r32, i0 = 4 * hi - qc + 63, sft = i0 & 3;
        tb_lane = (const LAS float*)(lds + L_BIAS) + sft * (15 * 128) + (i0 - sft);
        int qe = qc < 8 ? 8 : (qc > 56 ? 56 : qc); const int j0 = 4 * hi - qe + 56, sf2 = j0 & 3;
        const LAS float* tm = (const LAS float*)(lds + L_MASK) + sf2 * 128 + (j0 - sf2);
#pragma unroll
        for (int g4 = 0; g4 < 4; ++g4) { mk0[g4] = *(const LAS f32x4*)(tm + 8 * g4); mk1[g4] = *(const LAS f32x4*)(tm + 8 * g4 + 32); } }
    SLOAD(0); VM_WAIT(); SWRITE(0); if (ntiles > 1) SLOAD(1);
    __syncthreads();
    for (int j = 0; j < ntiles; ++j) {
        const int bf = j & 1;
        bool active = true; int dr = 0;
        if (NA) { dr = na_dr0 + j; active = (j >= na_first) && (j < na_first + 8); }
        if (active) {
            f32x16 p0, p1; bf16x8 pa0, pa1, pa2, pa3;
            qkt<DQK>(p0, p1, lds + L_K + bf * KBUF, qr, r32, hi);
            if (NA) {
                const LAS float* bt = tb_lane + (dr + 7) * 128;
#pragma unroll
                for (int g4 = 0; g4 < 4; ++g4) {
                    const f32x4 b0 = *(const LAS f32x4*)(bt + 8 * g4), b1 = *(const LAS f32x4*)(bt + 8 * g4 + 32);
#pragma unroll
                    for (int e = 0; e < 4; ++e) { p0[4 * g4 + e] = (p0[4 * g4 + e] + b0[e]) + mk0[g4][e]; p1[4 * g4 + e] = (p1[4 * g4 + e] + b1[e]) + mk1[g4][e]; }
                }
            }
            softmax_tile(p0, p1, l_reg, C, nBC, pa0, pa1, pa2, pa3);
            SBAR();
            pv_one<0>(o[0], vb0 + bf * VBUF, pa0, pa1, pa2, pa3); pv_one<1>(o[1], vb0 + bf * VBUF, pa0, pa1, pa2, pa3);
        }
        if (j + 1 < ntiles) { VM_WAIT(); SWRITE(bf ^ 1); if (j + 2 < ntiles) SLOAD(j + 2); }
        __syncthreads();
    }
#undef SLOAD
#undef SWRITE
    { auto rr = __builtin_amdgcn_permlane32_swap(__float_as_uint(l_reg), __float_as_uint(l_reg), false, false); l_reg = __uint_as_float(rr[0]) + __uint_as_float(rr[1]); }
    if (hi == 0) wsf[32 + r32] = l_reg; LDS_WAIT();
    float rli[16];
#pragma unroll
    for (int r = 0; r < 16; ++r) rli[r] = __builtin_amdgcn_rcpf(wsf[32 + crow(r, hi)]);
    LAS bf16_t* stg = (LAS bf16_t*)(lds + L_OST) + wid * 2048;
#pragma unroll
    for (int r = 0; r < 16; ++r) { const int orow = crow(r, hi);
#pragma unroll
        for (int d0 = 0; d0 < 2; ++d0) stg[orow * 64 + d0 * 32 + r32] = (bf16_t)f2bf(o[d0][r] * rli[r]); }
    LDS_WAIT();
#pragma unroll
    for (int i = 0; i < 4; ++i) { const int row = i * 8 + (lane >> 3), ch = lane & 7; const u32x4 v = *(const LAS u32x4*)(stg + row * 64 + ch * 8); u32x2 w8; w8.x = cvt4_fp8((f32x4){bflo(v.x), bfhi(v.x), bflo(v.y), bfhi(v.y)}, Y_SCALE); w8.y = cvt4_fp8((f32x4){bflo(v.z), bfhi(v.z), bflo(v.w), bfhi(v.w)}, Y_SCALE); *(u32x2*)((unsigned char*)Ow + (size_t)row * 1024 + ch * 8) = w8; }
    LDS_WAIT();
    __syncthreads();
}

__device__ __forceinline__ void partialSM(f32x16& p0, f32x16& p1, float C, float nBC) {
#pragma unroll
    for (int r = 0; r < 16; ++r) { p0[r] = fmaf(p0[r], C, nBC); p1[r] = fmaf(p1[r], C, nBC); }
#pragma unroll
    for (int r = 0; r < 16; ++r) p0[r] = __builtin_amdgcn_exp2f(p0[r]);
}
__device__ __forceinline__ void finishSM(f32x16& p0, f32x16& p1, float& l_reg, bf16x8& pa0, bf16x8& pa1, bf16x8& pa2, bf16x8& pa3) {
#pragma unroll
    for (int r = 0; r < 16; ++r) p1[r] = __builtin_amdgcn_exp2f(p1[r]);
    float ps = 0;
#pragma unroll
    for (int r = 0; r < 16; ++r) ps += p0[r];
#pragma unroll
    for (int r = 0; r < 16; ++r) ps += p1[r];
    l_reg += ps;
#define PK4(P, BASE, OUT) do { unsigned a0 = cvt_pk_bf16(P[BASE + 0], P[BASE + 1]), a1 = cvt_pk_bf16(P[BASE + 2], P[BASE + 3]);   \
    unsigned b0 = cvt_pk_bf16(P[BASE + 4], P[BASE + 5]), b1 = cvt_pk_bf16(P[BASE + 6], P[BASE + 7]);                              \
    auto r0 = __builtin_amdgcn_permlane32_swap(a0, b0, false, false); auto r1 = __builtin_amdgcn_permlane32_swap(a1, b1, false, false); \
    u32x4 w = {r0[0], r1[0], r0[1], r1[1]}; OUT = __builtin_bit_cast(bf16x8, w); } while (0)
    PK4(p0, 0, pa0); PK4(p0, 8, pa1); PK4(p1, 0, pa2); PK4(p1, 8, pa3);
#undef PK4
}
template <int DQK>
__device__ __forceinline__ void attn_unit_pipe(LAS unsigned char* lds, const bf16_t* Qw, int ldq, float qscale, const bf16_t* Kt, int ldk, const bf16_t* Vt, int ldv, bf16_t* Ow, int ntiles, float SCALE, float bound_raw) {
    using G = Geo<DQK>;
    int tid_ = threadIdx.x; asm volatile("" : "+v"(tid_));
    const int tid = tid_, lane = tid & 63, r32 = lane & 31, hi = lane >> 5; const int wid = __builtin_amdgcn_readfirstlane(tid >> 6);
    const float C = SCALE * 1.4426950408889634f, nBC = -bound_raw * C;
    constexpr int P_K = 0, P_V = 3 * KBUF, P_WS = P_V + 3 * VBUF, P_OST = P_WS + 2048;
    LAS float* wsf = (LAS float*)(lds + P_WS) + wid * 64;
    bf16x8 qr[G::ND0];
#pragma unroll
    for (int d0 = 0; d0 < G::ND0; ++d0) { u32x4 w = *(const u32x4*)(Qw + (size_t)r32 * ldq + d0 * 16 + hi * 8);
        f32x4 a, b; a = (f32x4){bflo(w.x), bfhi(w.x), bflo(w.y), bfhi(w.y)} * qscale; b = (f32x4){bflo(w.z), bfhi(w.z), bflo(w.w), bfhi(w.w)} * qscale;
        w.x = cvt_pk_bf16(a[0], a[1]); w.y = cvt_pk_bf16(a[2], a[3]); w.z = cvt_pk_bf16(b[0], b[1]); w.w = cvt_pk_bf16(b[2], b[3]);
        qr[d0] = __builtin_bit_cast(bf16x8, w); }
    const int vk = tid >> 3, vc = (tid & 7) * 8, vst = v_st(vk, vc);
    const int k0r = tid / G::NCH, k0c = tid % G::NCH; const int k1id = tid + 512, k1r = k1id / G::NCH, k1c = k1id % G::NCH; const bool k1on = (G::NCH == 12) && (wid < 4);
    const int vb0 = (int)(uintptr_t)(lds + P_V) + v_rd_base(lane);
    u32x4 evv, ek0, ek1, ovv, ok0, ok1;
    const __amdgpu_buffer_rsrc_t krs = __builtin_amdgcn_make_buffer_rsrc((void*)Kt, 0, 0x7fffffff, 0x00020000);
    const __amdgpu_buffer_rsrc_t vrs = __builtin_amdgcn_make_buffer_rsrc((void*)Vt, 0, 0x7fffffff, 0x00020000);
    const int voV = (vk * ldv + vc) * 2, voK0 = (k0r * ldk + k0c * 8) * 2, voK1 = (k1r * ldk + k1c * 8) * 2;
#define SLOAD(V_, K0_, K1_, j) do { V_ = __builtin_bit_cast(u32x4, __builtin_amdgcn_raw_buffer_load_b128(vrs, voV, (j) * (KVBLK * 2) * ldv, 0)); \
        K0_ = __builtin_bit_cast(u32x4, __builtin_amdgcn_raw_buffer_load_b128(krs, voK0, (j) * (KVBLK * 2) * ldk, 0)); \
        if (k1on) K1_ = __builtin_bit_cast(u32x4, __builtin_amdgcn_raw_buffer_load_b128(krs, voK1, (j) * (KVBLK * 2) * ldk, 0)); } while (0)
#define SWRITE(bf, V_, K0_, K1_) do { *(LAS u32x4*)(lds + P_V + (bf) * VBUF + vst) = V_; *(LAS u32x4*)(lds + P_K + (bf) * KBUF + k0r * G::KROWB + k0c * 16) = K0_; \
        if (k1on) *(LAS u32x4*)(lds + P_K + (bf) * KBUF + k1r * G::KROWB + k1c * 16) = K1_; } while (0)
#define RESC(a) do { if (__any((a) < 1.f)) { if (hi == 0) wsf[r32] = (a); LDS_WAIT(); \
        _Pragma("unroll") for (int d = 0; d < 2; ++d) _Pragma("unroll") for (int r = 0; r < 16; ++r) o[d][r] *= wsf[crow(r, hi)]; } } while (0)
    float l_reg = 0.f; f32x16 o[2]; o[0] = f32x16{}; o[1] = f32x16{};
    f32x16 pA0, pA1, pB0, pB1; bf16x8 pa0, pa1, pa2, pa3;
    const LAS unsigned char* Kp = lds + P_K;
    SLOAD(evv, ek0, ek1, 0); SWRITE(0, evv, ek0, ek1); __syncthreads();
    qkt<DQK>(pA0, pA1, Kp, qr, r32, hi); partialSM(pA0, pA1, C, nBC);
    SLOAD(ovv, ok0, ok1, 1); SLOAD(evv, ek0, ek1, 2);
    SWRITE(1, ovv, ok0, ok1); __syncthreads();
    int pb = 0, cb = 1, nb = 2;
    for (int j = 1; j + 1 < ntiles; j += 2) {
        SBAR(); qkt<DQK>(pB0, pB1, Kp + cb * KBUF, qr, r32, hi);
        finishSM(pA0, pA1, l_reg, pa0, pa1, pa2, pa3); SBAR();
        SLOAD(ovv, ok0, ok1, j + 2); SBAR();
        pv_one<0>(o[0], vb0 + pb * VBUF, pa0, pa1, pa2, pa3); pv_one<1>(o[1], vb0 + pb * VBUF, pa0, pa1, pa2, pa3); partialSM(pB0, pB1, C, nBC);
        SWRITE(nb, evv, ek0, ek1);
        __syncthreads();
        SBAR(); qkt<DQK>(pA0, pA1, Kp + nb * KBUF, qr, r32, hi);
        finishSM(pB0, pB1, l_reg, pa0, pa1, pa2, pa3); SBAR();
        if (j + 3 < ntiles) SLOAD(evv, ek0, ek1, j + 3); SBAR();
        pv_one<0>(o[0], vb0 + cb * VBUF, pa0, pa1, pa2, pa3); pv_one<1>(o[1], vb0 + cb * VBUF, pa0, pa1, pa2, pa3); partialSM(pA0, pA1, C, nBC);
        SWRITE(pb, ovv, ok0, ok1);
        __syncthreads();
        { const int t_ = cb; cb = pb; pb = nb; nb = t_; }
    }
    SBAR(); qkt<DQK>(pB0, pB1, Kp + cb * KBUF, qr, r32, hi);
    finishSM(pA0, pA1, l_reg, pa0, pa1, pa2, pa3); SBAR();
    pv_one<0>(o[0], vb0 + pb * VBUF, pa0, pa1, pa2, pa3); pv_one<1>(o[1], vb0 + pb * VBUF, pa0, pa1, pa2, pa3); partialSM(pB0, pB1, C, nBC);
    finishSM(pB0, pB1, l_reg, pa0, pa1, pa2, pa3); SBAR();
    pv_one<0>(o[0], vb0 + cb * VBUF, pa0, pa1, pa2, pa3); pv_one<1>(o[1], vb0 + cb * VBUF, pa0, pa1, pa2, pa3);
#undef SLOAD
#undef SWRITE
#undef RESC
    { auto rr = __builtin_amdgcn_permlane32_swap(__float_as_uint(l_reg), __float_as_uint(l_reg), false, false); l_reg = __uint_as_float(rr[0]) + __uint_as_float(rr[1]); }
    {
    const int te_ = fresh_tid(); const int lane = te_ & 63, r32 = lane & 31, hi = lane >> 5; const int wid = __builtin_amdgcn_readfirstlane(te_ >> 6);
    LAS float* wsf = (LAS float*)(lds + P_WS) + wid * 64;
    if (hi == 0) wsf[32 + r32] = l_reg; LDS_WAIT();
    float rli[16];
#pragma unroll
    for (int r = 0; r < 16; ++r) rli[r] = __builtin_amdgcn_rcpf(wsf[32 + crow(r, hi)]);
    LAS bf16_t* stg = (LAS bf16_t*)(lds + P_OST) + wid * 2048;
#pragma unroll
    for (int r = 0; r < 16; ++r) { const int orow = crow(r, hi);
#pragma unroll
        for (int d0 = 0; d0 < 2; ++d0) stg[orow * 64 + d0 * 32 + r32] = (bf16_t)f2bf(o[d0][r] * rli[r]); }
    LDS_WAIT();
#pragma unroll
    for (int i = 0; i < 4; ++i) { const int lf = lane_fresh(), row = i * 8 + (lf >> 3), ch = lf & 7; const u32x4 v = *(const LAS u32x4*)(stg + row * 64 + ch * 8); u32x2 w8; w8.x = cvt4_fp8((f32x4){bflo(v.x), bfhi(v.x), bflo(v.y), bfhi(v.y)}, Y_SCALE); w8.y = cvt4_fp8((f32x4){bflo(v.z), bfhi(v.z), bflo(v.w), bfhi(v.w)}, Y_SCALE); *(u32x2*)((unsigned char*)Ow + (size_t)row * 1024 + ch * 8) = w8; }
    LDS_WAIT();
    }
    __syncthreads();
}

constexpr int NA2_TAB = RING_BYTES + 1024 + 4096, NA2_WS = RING_BYTES + 1024 + 12288;
__device__ __forceinline__ void na_wave(LAS unsigned char* lds, const bf16_t* Qw, const bf16_t* Kt, const bf16_t* Vt, bf16_t* Ow, int qc0, int dr0, float bound_raw) {
    int tid_ = threadIdx.x; asm volatile("" : "+v"(tid_));
    const int lane = tid_ & 63, r32 = lane & 31, hi = lane >> 5; const int wid = __builtin_amdgcn_readfirstlane(tid_ >> 6);
    constexpr float SCALE = 0.125f; const float C = SCALE * 1.4426950408889634f, nBC = -bound_raw * C;
    LAS unsigned char* Kl = lds + wid * 16384; LAS unsigned char* Vl = Kl + 8192;
    LAS float* wsf = (LAS float*)(lds + NA2_WS) + wid * 64;
    bf16x8 qr[4];
#pragma unroll
    for (int d0 = 0; d0 < 4; ++d0) qr[d0] = *(const bf16x8*)(Qw + (size_t)r32 * 512 + d0 * 16 + hi * 8);
    const int qc = qc0 + r32, qe = qc < 8 ? 8 : (qc > 56 ? 56 : qc);
    unsigned mb0 = 0u, mb1 = 0u;
#pragma unroll
    for (int r = 0; r < 16; ++r) { const int kc = crow(r, hi); mb0 |= ((unsigned)(kc - qe + 8) < 16u) ? (1u << r) : 0u; mb1 |= ((unsigned)(kc + 32 - qe + 8) < 16u) ? (1u << r) : 0u; }
    const int i0 = 4 * hi - qc + 63, sft = i0 & 3;
    const LAS float* tb = (const LAS float*)(lds + NA2_TAB) + sft * (15 * 32);
    const int boff0 = (i0 - sft) & 31;
    const int krow0 = qc0 ? 24 : 0;
    { const int zr0 = qc0 ? 0 : 40;
#pragma unroll
      for (int i = 0; i < 3; ++i) { const int c = lane + 64 * i, row = zr0 + (c >> 3), ch = c & 7;
          *(LAS u32x4*)(Kl + row * 128 + ((ch ^ (row & 7)) << 4)) = (u32x4){0u, 0u, 0u, 0u}; *(LAS u32x4*)(Vl + v_st(row, ch * 8)) = (u32x4){0u, 0u, 0u, 0u}; } }
    u32x4 sk0[5], sk1[5], sv[5];
    const __amdgpu_buffer_rsrc_t krs = __builtin_amdgcn_make_buffer_rsrc((void*)Kt, 0, 0x7fffffff, 0x00020000);
    const __amdgpu_buffer_rsrc_t vrs = __builtin_amdgcn_make_buffer_rsrc((void*)Vt, 0, 0x7fffffff, 0x00020000);
    const int vo0 = ((krow0 + (lane >> 3)) * 512 + (lane & 7) * 8) * 2;
#define NA_LOADK(SK, j) do { _Pragma("unroll") for (int i = 0; i < 5; ++i) SK[i] = __builtin_bit_cast(u32x4, __builtin_amdgcn_raw_buffer_load_b128(krs, vo0, (j) * 65536 + i * 8192, 0)); } while (0)
#define NA_LOADV(j) do { _Pragma("unroll") for (int i = 0; i < 5; ++i) sv[i] = __builtin_bit_cast(u32x4, __builtin_amdgcn_raw_buffer_load_b128(vrs, vo0, (j) * 65536 + i * 8192, 0)); } while (0)
#define NA_WRITEK(SK) do { _Pragma("unroll") for (int i = 0; i < 5; ++i) { const int c = lane + 64 * i, row = krow0 + (c >> 3), ch = c & 7; *(LAS u32x4*)(Kl + row * 128 + ((ch ^ (row & 7)) << 4)) = SK[i]; } } while (0)
#define NA_WRITEV() do { _Pragma("unroll") for (int i = 0; i < 5; ++i) { const int c = lane + 64 * i, row = krow0 + (c >> 3), ch = c & 7; *(LAS u32x4*)(Vl + v_st(row, ch * 8)) = sv[i]; } } while (0)
    const int vb0 = (int)(uintptr_t)Vl + v_rd_base(lane);
    float l_reg = 0.f; f32x16 o[2]; o[0] = f32x16{}; o[1] = f32x16{};
    bf16x8 pa0, pa1, pa2, pa3;
#define NA_QK(j) do { f32x16 p0 = f32x16{}, p1 = f32x16{}; \
        _Pragma("unroll") for (int d0 = 0; d0 < 4; ++d0) { const int ch = 2 * d0 + hi; \
            const bf16x8 b0 = *(const LAS bf16x8*)(Kl + r32 * 128 + ((ch ^ (r32 & 7)) << 4)); \
            const bf16x8 b1 = *(const LAS bf16x8*)(Kl + (32 + r32) * 128 + ((ch ^ (r32 & 7)) << 4)); \
            p0 = __builtin_amdgcn_mfma_f32_32x32x16_bf16(b0, qr[d0], p0, 0, 0, 0); p1 = __builtin_amdgcn_mfma_f32_32x32x16_bf16(b1, qr[d0], p1, 0, 0, 0); } \
        { const LAS float* bt = tb + (dr0 + (j) + 7) * 32; \
          _Pragma("unroll") for (int g4 = 0; g4 < 4; ++g4) { const f32x4 bv = *(const LAS f32x4*)(bt + ((boff0 + 8 * g4) & 31)); \
            _Pragma("unroll") for (int e = 0; e < 4; ++e) { p0[4 * g4 + e] = ((mb0 >> (4 * g4 + e)) & 1u) ? p0[4 * g4 + e] + bv[e] : -1e30f; p1[4 * g4 + e] = ((mb1 >> (4 * g4 + e)) & 1u) ? p1[4 * g4 + e] + bv[e] : -1e30f; } } } \
        softmax_tile(p0, p1, l_reg, C, nBC, pa0, pa1, pa2, pa3); SBAR(); } while (0)
#define NA_PV() do { pv_one<0>(o[0], vb0, pa0, pa1, pa2, pa3); pv_one<1>(o[1], vb0, pa0, pa1, pa2, pa3); } while (0)
    NA_LOADK(sk0, 0); NA_LOADV(0); NA_WRITEK(sk0); NA_WRITEV(); NA_LOADK(sk0, 1); NA_LOADK(sk1, 2); NA_LOADV(1);
#pragma unroll 1
    for (int j = 0; j < 8; j += 2) {
        NA_QK(j);     NA_WRITEK(sk0); if (j + 3 < 8) NA_LOADK(sk0, j + 3);
        NA_PV();      NA_WRITEV(); if (j + 2 < 8) NA_LOADV(j + 2);
        NA_QK(j + 1); if (j + 2 < 8) { NA_WRITEK(sk1); if (j + 4 < 8) NA_LOADK(sk1, j + 4); }
        NA_PV();      if (j + 2 < 8) { NA_WRITEV(); if (j + 3 < 8) NA_LOADV(j + 3); }
    }
#undef NA_QK
#undef NA_PV
#undef NA_LOADK
#undef NA_LOADV
#undef NA_WRITEK
#undef NA_WRITEV
    { auto rr = __builtin_amdgcn_permlane32_swap(__float_as_uint(l_reg), __float_as_uint(l_reg), false, false); l_reg = __uint_as_float(rr[0]) + __uint_as_float(rr[1]); }
    if (hi == 0) wsf[32 + r32] = l_reg; LDS_WAIT();
    float rli[16];
#pragma unroll
    for (int r = 0; r < 16; ++r) rli[r] = __builtin_amdgcn_rcpf(wsf[32 + crow(r, hi)]);
    LAS bf16_t* stg = (LAS bf16_t*)Kl;
#pragma unroll
    for (int r = 0; r < 16; ++r) { const int orow = crow(r, hi);
#pragma unroll
        for (int d0 = 0; d0 < 2; ++d0) stg[orow * 64 + d0 * 32 + r32] = (bf16_t)f2bf(o[d0][r] * rli[r]); }
    LDS_WAIT();
#pragma unroll
    for (int i = 0; i < 4; ++i) { const int lf = lane_fresh(), row = i * 8 + (lf >> 3), ch = lf & 7; const u32x4 v = *(const LAS u32x4*)(stg + row * 64 + ch * 8); u32x2 w8; w8.x = cvt4_fp8((f32x4){bflo(v.x), bfhi(v.x), bflo(v.y), bfhi(v.y)}, Y_SCALE); w8.y = cvt4_fp8((f32x4){bflo(v.z), bfhi(v.z), bflo(v.w), bfhi(v.w)}, Y_SCALE); *(u32x2*)((unsigned char*)Ow + (size_t)row * 1024 + ch * 8) = w8; }
    LDS_WAIT();
}
}

__device__ __forceinline__ void s4_attention(Frame& F, const Args& A, int rep_mla, int rep_na) {
    const int wave = F.wave;
    float bound_mla;
    { int l = threadIdx.x & 63; asm volatile("" : "+v"(l)); float mq = 0.f, mk = 0.f;
      for (int i = l; i < QKD; i += 64) { mq = fmaxf(mq, fabsf(INF(I_g_mla_q)[i])); mk = fmaxf(mk, fabsf(INF(I_g_mla_k)[i])); }
#pragma unroll
      for (int o = 1; o < 64; o <<= 1) { mq = fmaxf(mq, shx(mq, o, l)); mk = fmaxf(mk, shx(mk, o, l)); }
      bound_mla = (float)QKD * mq * mk * 1.0001f; }
    for (int rp = 0; rp < rep_mla; ++rp)
    for (int un = F.vcu; un < NB * MH * 8; un += F.G) {
        const int bh = un >> 3, qb = un & 7, b = bh >> 3, h = bh & 7;
        const int s0 = qb * 256 + wave * 32, t0 = b * SEQ + s0, r32 = fresh_tid() & 31;
        const float* qss = wsp<float>(F, WS_QSS) + ((size_t)(t0 + r32) * 8 + h) * 2;
        const float qscale = rsqrtf((qss[0] + qss[1]) * (1.0f / 96.0f) + EPS);
        attn::attn_unit_pipe<96>(F.lds, wsp<bf16_t>(F, WS_QM) + ((size_t)bh * SEQ + s0) * 96, 96, qscale,
                                 wsp<bf16_t>(F, WS_KM) + (size_t)bh * SEQ * 96, 96, wsp<bf16_t>(F, WS_VM) + (size_t)bh * SEQ * 64, 64,
                                 (bf16_t*)(wsp<unsigned char>(F, WS_YNA) + (size_t)t0 * 1024 + 512 + h * 64), SEQ / 64, 0.10206207261596577f, bound_mla);
    }
#ifdef TSA
    if (blockIdx.x == TSWG && threadIdx.x == 0) { const unsigned long long t_ = __builtin_amdgcn_s_memrealtime(); ((LAS unsigned*)(F.lds + TAB_OFF + 2048))[40] = (unsigned)t_; ((LAS unsigned*)(F.lds + TAB_OFF + 2048))[41] = (unsigned)(t_ >> 32); }
#endif
    float bound_na;
    { int l = threadIdx.x & 63; asm volatile("" : "+v"(l)); float nq = fabsf(INF(I_g_na_q)[l]), nk = fabsf(INF(I_g_na_k)[l]), bm = 0.f;
      for (int i = l; i < NAH * 15 * 31; i += 64) bm = fmaxf(bm, fabsf(INF(I_na_rpb)[i]));
#pragma unroll
      for (int o = 1; o < 64; o <<= 1) { nq = fmaxf(nq, shx(nq, o, l)); nk = fmaxf(nk, shx(nk, o, l)); bm = fmaxf(bm, shx(bm, o, l)); }
      bound_na = (float)NAD * nq * nk * 1.0001f + 8.0f * bm; }
    for (int rp = 0; rp < rep_na; ++rp)
    for (int un = F.vcu; un < NB * NAH * 8; un += F.G) {
        const int bh = un >> 3, g = un & 7, b = bh >> 3, h = bh & 7;
        LAS float* tb = (LAS float*)(F.lds + attn::NA2_TAB);
        for (int i = fresh_tid(); i < 4 * 15 * 32; i += NTHR) { const int sft = i / (15 * 32), rr = (i >> 5) % 15, mm = i & 31, x_ = (mm + sft + 1) & 31, dc = x_ < 16 ? x_ : x_ - 32;
            tb[i] = (dc >= -15) ? INF(I_na_rpb)[(size_t)(h * 15 + rr) * 31 + dc + 15] * 8.0f : 0.f; }
        const int qrow = 4 * g + (wave >> 1); int rs = qrow - 4; rs = rs < 0 ? 0 : (rs > 24 ? 24 : rs);
        const int t0 = b * SEQ + qrow * 64 + 32 * (wave & 1);
        __syncthreads();
        attn::na_wave(F.lds, wsp<bf16_t>(F, WS_NAQ) + (size_t)t0 * 512 + h * 64,
                      wsp<bf16_t>(F, WS_NAK) + (size_t)(b * SEQ + rs * 64) * 512 + h * 64, wsp<bf16_t>(F, WS_NAV) + (size_t)(b * SEQ + rs * 64) * 512 + h * 64,
                      (bf16_t*)(wsp<unsigned char>(F, WS_YNA) + (size_t)t0 * 1024 + h * 64), 32 * (wave & 1), rs - qrow, bound_na);
        __syncthreads();
    }
}
namespace moe {
#define RFL(x) __builtin_amdgcn_readfirstlane(x)
constexpr int ASTRB = 2064;
constexpr int L_AHI = 0, L_ALO = 16 * ASTRB, L_LG = 32 * ASTRB, L_END = L_LG + 2 * 16 * 64 * 4;
constexpr int T_CNT = 0, T_ABASE = 128, T_YBASE = 200, T_PRE = 336, T_MBOX = 340;
constexpr bool DYNQ = false;
constexpr int CW_Q = 20480;

__device__ __forceinline__ void s7_router(Frame& F, const Args& A, int rep_conv, int rep_rt) {
    const int lane = F.lane, wave = F.wave;
    const float* mod = wsp<float>(F, WS_MOD); unsigned char* H2 = wsp<unsigned char>(F, WS_H2);
    LAS unsigned char* Ahi = F.lds + L_AHI; LAS unsigned char* Alo = F.lds + L_ALO; LAS float* LG = (LAS float*)(F.lds + L_LG);
    const u32x4* rfrag = wsp<u32x4>(F, WS_RFRAG);
    int* LIST = wsp<int>(F, WS_LIST); float* WLIST = wsp<float>(F, WS_WLIST); unsigned* TOKSLOT = wsp<unsigned>(F, WS_TOKSLOT);
    LAS unsigned* pe = (LAS unsigned*)(F.lds + 81920);
    LAS float* pw = (LAS float*)(F.lds + 81920 + 4096);
    LAS unsigned* lcnt = (LAS unsigned*)(F.lds + 81920 + 8192);
    if (F.tid < 128) lcnt[F.tid] = 0u;
    __syncthreads();
    int ulocal = 0;
#ifdef TSA
#define RT_ACC(k) do { if (blockIdx.x == TSWG && threadIdx.x == 0) { const unsigned long long t_ = __builtin_amdgcn_s_memrealtime(); LAS unsigned* q_ = (LAS unsigned*)(F.lds + TAB_OFF + 2048); const unsigned long long d_ = t_ - rt_prev; unsigned long long a_ = ((unsigned long long)q_[2 * (k) + 1] << 32) | q_[2 * (k)]; a_ += d_; q_[2 * (k)] = (unsigned)a_; q_[2 * (k) + 1] = (unsigned)(a_ >> 32); rt_prev = t_; } } while (0)
    unsigned long long rt_prev = __builtin_amdgcn_s_memrealtime();
    if (blockIdx.x == TSWG && threadIdx.x == 0) { LAS unsigned* q_ = (LAS unsigned*)(F.lds + TAB_OFF + 2048); for (int k = 48; k < 64; ++k) q_[k] = 0u; }
#else
#define RT_ACC(k) do {} while (0)
#endif
    for (int rp = 0; rp < rep_rt; ++rp)
    for (int un = F.vcu; un < NT / 16; un += F.G) {
        const bool dry = rp + 1 < rep_rt;
        const int row0 = un * 16, b = row0 >> 11;
        const u32x4* bp = rfrag + ((size_t)((wave & 3) * 32 + 16 * (wave >> 2)) * 64 + lane) * 2;
        u32x4 bA[8][2], bB[8][2];
#pragma unroll
        for (int jj = 0; jj < 8; ++jj) { bA[jj][0] = bp[(size_t)jj * 128]; bA[jj][1] = bp[(size_t)jj * 128 + 1]; }
        SBAR();
        {
            f32x4 v[2][4], cg[4], csh[4];
#pragma unroll
            for (int rr = 0; rr < 2; ++rr)
#pragma unroll
                for (int j = 0; j < 4; ++j) { const u32x2 w_ = *(const u32x2*)(wsp<bf16_t>(F, WS_X1) + (size_t)(row0 + 2 * wave + rr) * DM + 4 * lane + 256 * j); v[rr][j] = (f32x4){bflo(w_.x), bfhi(w_.x), bflo(w_.y), bfhi(w_.y)}; }
#pragma unroll
            for (int j = 0; j < 4; ++j) { const int c4 = 4 * lane + 256 * j;
                cg[j] = *(const f32x4*)(INF(I_g_norm2) + c4) * (*(const f32x4*)(mod + (size_t)b * 6144 + 4096 + c4) + 1.0f); csh[j] = *(const f32x4*)(mod + (size_t)b * 6144 + 3072 + c4); }
#pragma unroll
            for (int rr = 0; rr < 2; ++rr) { const int lr = 2 * wave + rr, row = row0 + lr; float ss = 0.f;
#pragma unroll
                for (int j = 0; j < 4; ++j) ss += sq4(v[rr][j]);
                const float rstd = rsqrtf(wave_sum(ss) * (1.0f / DM) + EPS);
#pragma unroll
                for (int j = 0; j < 4; ++j) { const int c4 = 4 * lane + 256 * j;
                    const f32x4 o = v[rr][j] * rstd * cg[j] + csh[j];
                    *(unsigned*)(H2 + (size_t)row * DM + c4) = cvt4_fp8(o, 1.0f);
                    u32x2 hw; hw.x = cvt_pk_bf16(o[0], o[1]); hw.y = cvt_pk_bf16(o[2], o[3]);
                    const f32x4 rem = o - (f32x4){bflo(hw.x), bfhi(hw.x), bflo(hw.y), bfhi(hw.y)};
                    u32x2 lw; lw.x = cvt_pk_bf16(rem[0], rem[1]); lw.y = cvt_pk_bf16(rem[2], rem[3]);
                    *(LAS u32x2*)(Ahi + lr * ASTRB + c4 * 2) = hw; *(LAS u32x2*)(Alo + lr * ASTRB + c4 * 2) = lw; } }
        }
        __syncthreads(); RT_ACC(24);
        {
            const int ct = wave & 3, kh = wave >> 2; f32x4 acc = {0.f, 0.f, 0.f, 0.f};
            const int aoffb = (lane & 15) * ASTRB + (512 * kh + 8 * (lane >> 4)) * 2;
#pragma unroll
            for (int jj = 0; jj < 8; ++jj) { bB[jj][0] = bp[(size_t)(8 + jj) * 128]; bB[jj][1] = bp[(size_t)(8 + jj) * 128 + 1]; }
            SBAR();
#define RT_STEP(BF, sidx) do { const bf16x8 ah = *(const LAS bf16x8*)(Ahi + aoffb + (sidx) * 64), al = *(const LAS bf16x8*)(Alo + aoffb + (sidx) * 64); \
                const bf16x8 bh = __builtin_bit_cast(bf16x8, BF[0]), bl = __builtin_bit_cast(bf16x8, BF[1]); \
                acc = __builtin_amdgcn_mfma_f32_16x16x32_bf16(ah, bh, acc, 0, 0, 0); acc = __builtin_amdgcn_mfma_f32_16x16x32_bf16(al, bh, acc, 0, 0, 0); acc = __builtin_amdgcn_mfma_f32_16x16x32_bf16(ah, bl, acc, 0, 0, 0); } while (0)
#pragma unroll
            for (int jj = 0; jj < 8; ++jj) { RT_STEP(bA[jj], jj); if ((jj & 3) == 3) SBAR(); }
#pragma unroll
            for (int jj = 0; jj < 8; ++jj) { RT_STEP(bB[jj], 8 + jj); if ((jj & 3) == 3) SBAR(); }
#undef RT_STEP
#pragma unroll
            for (int r = 0; r < 4; ++r) LG[(kh * 16 + 4 * (lane >> 4) + r) * 64 + 16 * ct + (lane & 15)] = acc[r];
        }
        __syncthreads(); RT_ACC(25);
#pragma unroll 1
        for (int rr = 0; rr < 2; ++rr) {
            const int lr = 2 * wave + rr, tok = row0 + lr;
            const float logit = LG[lr * 64 + lane] + LG[(16 + lr) * 64 + lane];
            const float score = 1.0f / (1.0f + expf(-logit));
            const float sel = score + INF(I_e_bias)[lane];
            const int l_ = lane_fresh(); float m1 = sel; m1 = fmaxf(m1, shx(m1, 1, l_)); m1 = fmaxf(m1, shx(m1, 2, l_)); m1 = fmaxf(m1, shx(m1, 4, l_));
            const unsigned long long bm = __ballot(sel == m1);
            const unsigned gb = (unsigned)(bm >> (lane & ~7)) & 0xffu; const int first = __ffs((int)gb) - 1;
            float m2 = ((lane & 7) == first) ? -INFINITY : sel; m2 = fmaxf(m2, shx(m2, 1, l_)); m2 = fmaxf(m2, shx(m2, 2, l_)); m2 = fmaxf(m2, shx(m2, 4, l_));
            const float gs = m1 + m2; int grank = 0;
            { const unsigned ub = __float_as_uint(gs), uo = (ub & 0x80000000u) ? ~ub : (ub | 0x80000000u);
              const unsigned long long key = ((unsigned long long)uo << 8) | (unsigned)(7 - (lane >> 3));
#pragma unroll
              for (int q = 0; q < 8; ++q) { const unsigned long long ok = ((unsigned long long)(unsigned)__builtin_amdgcn_readlane((int)(key >> 32), 8 * q) << 32) | (unsigned)__builtin_amdgcn_readlane((int)(unsigned)key, 8 * q); grank += ok > key ? 1 : 0; } }
            const bool gsel = grank < TOPKG; const float sm = gsel ? sel : -INFINITY; int rank = 0;
            { const unsigned ub = __float_as_uint(sm), uo = (ub & 0x80000000u) ? ~ub : (ub | 0x80000000u);
              const unsigned long long key = ((unsigned long long)uo << 8) | (unsigned)(63 - lane);
              const int khi = (int)(key >> 32), klo = (int)(unsigned)key;
#pragma unroll
              for (int q = 0; q < 64; ++q) { const unsigned long long ok = ((unsigned long long)(unsigned)__builtin_amdgcn_readlane(khi, q) << 32) | (unsigned)__builtin_amdgcn_readlane(klo, q); rank += ok > key ? 1 : 0; } }
            const bool chosen = gsel && rank < TOPK;
            const float wsum = wave_sum(chosen ? score : 0.f);
            const float w = score / wsum * 2.5f;
            if (chosen && !dry) { const unsigned lp = __hip_atomic_fetch_add(lcnt + lane, 1u, __ATOMIC_RELAXED, __HIP_MEMORY_SCOPE_WORKGROUP);
                const int pi = ((ulocal * 16 + lr) * 8 + rank) & 1023; pe[pi] = ((unsigned)lane << 16) | lp; pw[pi] = w; }
        }
        if (!dry) ++ulocal;
        __syncthreads(); RT_ACC(26);
    }
    if (F.tid < 64) { const unsigned n = lcnt[F.tid]; lcnt[64 + F.tid] = n ? __hip_atomic_fetch_add((unsigned*)F.ctl + CW_CNT + (F.tid * 2) * 16, n, RLX_AGENT) : 0u; }
    __syncthreads();
    for (int pi = F.tid; pi < ulocal * 128; pi += NTHR) {
        const int ul = pi >> 7, lr = (pi >> 3) & 15, rank = pi & 7, tok = (F.vcu + ul * F.G) * 16 + lr;
        const unsigned v = pe[pi], e = v >> 16, pos = lcnt[64 + e] + (v & 0xffffu);
        LIST[(size_t)(e * 2) * 8192 + pos] = tok; WLIST[(size_t)(e * 2) * 8192 + pos] = pw[pi]; TOKSLOT[(size_t)tok * 8 + rank] = (e << 16) | pos; }
    __syncthreads(); RT_ACC(27);
#ifdef TSA
    if (blockIdx.x == TSWG && threadIdx.x == 0) { const unsigned long long t_ = __builtin_amdgcn_s_memrealtime(); ((LAS unsigned*)(F.lds + TAB_OFF + 2048))[42] = (unsigned)t_; ((LAS unsigned*)(F.lds + TAB_OFF + 2048))[43] = (unsigned)(t_ >> 32); }
#endif
    LAS float* scr = (LAS float*)(F.lds + wave * 16384);
    const int gw = F.vcu * NWAVES + wave, NGW = F.G * NWAVES;
    for (int rp = 0; rp < rep_conv; ++rp)
    for (int it = gw; it < 65 * 384; it += NGW) {
        const int e = it / 384, r = it % 384;
        const float* wg = e < 64 ? INF(I_w_eg) + (size_t)e * DM * EFF : INF(I_w_sg); const float* wu = e < 64 ? INF(I_w_eu) + (size_t)e * DM * EFF : INF(I_w_su); const float* wd = e < 64 ? INF(I_w_ed) + (size_t)e * EFF * DM : INF(I_w_sd);
        if (r < 128) transpose_item_fp8(wg, DM, EFF, wsp<unsigned char>(F, WS_WGU) + (size_t)e * 512 * DM, MapGU{0}, WGU_SCALE, scr, r, lane);
        else if (r < 256) transpose_item_fp8(wu, DM, EFF, wsp<unsigned char>(F, WS_WGU) + (size_t)e * 512 * DM, MapGU{1}, WGU_SCALE, scr, r - 128, lane);
        else transpose_item_fp8(wd, EFF, DM, wsp<unsigned char>(F, WS_WD) + (size_t)e * DM * EFF, MapOff{0}, WD_SCALE, scr, r - 256, lane);
    }
}

__device__ __forceinline__ void build_tables(Frame& F) {
    LAS int* tab = (LAS int*)(F.lds + TAB_OFF);
    if (F.tid < 128) tab[T_CNT + F.tid] = (int)__hip_atomic_load((unsigned*)F.ctl + CW_CNT + F.tid * 16, RLX_AGENT);
    __syncthreads();
    if (F.tid < 64) { const int e = F.tid; const int c0 = tab[T_CNT + 2 * e], c1 = tab[T_CNT + 2 * e + 1];
        int a = c0 + c1, y0 = c0, y1 = c1;
#pragma unroll
        for (int o = 1; o < 64; o <<= 1) { const int ta = shup_i(a, o, e), t0 = shup_i(y0, o, e), t1 = shup_i(y1, o, e); if (e >= o) { a += ta; y0 += t0; y1 += t1; } }
        tab[T_ABASE + e] = a - (c0 + c1); tab[T_YBASE + e] = y0 - c0; tab[T_YBASE + 64 + e] = y1 - c1; if (e == 63) tab[T_ABASE + 64] = a; }
    if (F.tid == 64) { tab[T_MBOX] = 0; tab[T_MBOX + 1] = 0; }
    __syncthreads();
}

struct GateUpSched {
    static constexpr bool kDense = false;
    const LAS int* tab; const unsigned char* wgu; const int* list; int x, j, per;
    unsigned* qc; LAS int* mbox; unsigned pend;
    __device__ __forceinline__ int unit_index(int i) const { return (!DYNQ || i < 2) ? i * per + j : RFL(mbox[i & 1]); }
    __device__ __forceinline__ void grab() { if (DYNQ) if (RFL((int)(threadIdx.x >> 6)) == 0 && (threadIdx.x & 63) == 0) pend = __hip_atomic_fetch_add(qc, 1u, RLX_AGENT); }
    __device__ __forceinline__ void publish(int wid) { if (DYNQ) if (wid == 0) { if ((threadIdx.x & 63) == 0) mbox[nslot] = (int)(2 * per + pend); LDS_WAIT(); } nslot ^= 1; }
    int nslot;
    __device__ void init(Frame& F) { tab = (const LAS int*)(F.lds + TAB_OFF); wgu = wsp<unsigned char>(F, WS_WGU); list = wsp<int>(F, WS_LIST); x = (int)blockIdx.x % 8; j = (int)blockIdx.x / 8; per = F.G / 8;
        qc = (unsigned*)F.ctl + CW_Q + (0 * 8 + x) * 16; mbox = (LAS int*)(F.lds + TAB_OFF) + T_MBOX; pend = 0; nslot = 0; }
    __device__ bool next(int i, pg8::Unit& u) {
        const int L = unit_index(i);
        int k = -1, base = 0, a = 0;
#pragma unroll
        for (int q = 0; q < 8; ++q) { const int e = x + 8 * q; const int na = a + ((RFL(tab[T_CNT + 2 * e]) + RFL(tab[T_CNT + 2 * e + 1]) + 255) >> 8) * 2; if (k < 0 && L < na) { k = q; base = a; } a = na; }
        if (k >= 0) {
            if (i >= 1) grab();
            const int e = x + 8 * k, r = L - base, mt = r >> 1, pn = r & 1, n0 = RFL(tab[T_CNT + 2 * e]), ntot = n0 + RFL(tab[T_CNT + 2 * e + 1]);
            u.B = (const char*)(wgu + ((size_t)e * 512 + pn * 256) * DM); u.m0 = mt * 256; u.pn = pn; u.e = e; u.nrows = (ntot - mt * 256) < 256 ? (ntot - mt * 256) : 256;
            u.orow0 = RFL(tab[T_ABASE + e]) + mt * 256; u.l0 = list + (size_t)(2 * e) * 8192; u.l1 = list + (size_t)(2 * e + 1) * 8192; u.n0 = n0; u.ntot = ntot; return true; }
        const int r = L - a; if (r >= 16) return false;
        if (i >= 1) grab();
        const int mt = x + 8 * (r >> 1), pn = r & 1;
        u.B = (const char*)(wgu + ((size_t)64 * 512 + pn * 256) * DM); u.m0 = mt * 256; u.pn = pn; u.e = 64; u.nrows = 256; u.orow0 = ACT_SHARED_ROW0 + mt * 256; u.l0 = nullptr; u.l1 = nullptr; u.n0 = 0; u.ntot = 0; return true;
    }
};
struct DownSched {
    static constexpr bool kDense = true;
    const LAS int* tab; const unsigned char* wd; const int* tab0; int x, j, per, c;
    unsigned* qc; LAS int* mbox; unsigned pend;
    __device__ __forceinline__ int unit_index(int i) const { return (!DYNQ || i < 2) ? i * per + j : RFL(mbox[i & 1]); }
    __device__ __forceinline__ void grab() { if (DYNQ) if (RFL((int)(threadIdx.x >> 6)) == 0 && (threadIdx.x & 63) == 0) pend = __hip_atomic_fetch_add(qc, 1u, RLX_AGENT); }
    __device__ __forceinline__ void publish(int wid) { if (DYNQ) if (wid == 0) { if ((threadIdx.x & 63) == 0) mbox[nslot] = (int)(2 * per + pend); LDS_WAIT(); } nslot ^= 1; }
    int nslot;
    __device__ void init(Frame& F, int c_) { tab = (const LAS int*)(F.lds + TAB_OFF); wd = wsp<unsigned char>(F, WS_WD); tab0 = wsp<int>(F, WS_LIST); x = (int)blockIdx.x % 8; j = (int)blockIdx.x / 8; per = F.G / 8; c = c_;
        qc = (unsigned*)F.ctl + CW_Q + ((1 + c_) * 8 + x) * 16; mbox = (LAS int*)(F.lds + TAB_OFF) + T_MBOX; pend = 0; nslot = 0; }
    __device__ bool next(int i, pg8::Unit& u) {
        const int L = unit_index(i);
        u.l0 = nullptr; u.l1 = nullptr; u.n0 = 0; u.ntot = 0;
        const float* wlist = (const float*)((const char*)tab0 + (WS_WLIST - WS_LIST));
        int k = -1, base = 0, a = 0;
#pragma unroll
        for (int q = 0; q < 8; ++q) { const int e = x + 8 * q; const int na = a + ((RFL(tab[T_CNT + 2 * e + c]) + 255) >> 8) * 4; if (k < 0 && L < na) { k = q; base = a; } a = na; }
        if (k >= 0) {
            if (i >= 1) grab();
            const int e = x + 8 * k, r = L - base, mt = r >> 2, pn = r & 3, n = RFL(tab[T_CNT + 2 * e + c]);
            u.B = (const char*)(wd + ((size_t)e * DM + pn * 256) * EFF); u.m0 = RFL(tab[T_ABASE + e]) + (c ? RFL(tab[T_CNT + 2 * e]) : 0) + mt * 256; u.pn = pn; u.e = e;
            u.nrows = (n - mt * 256) < 256 ? (n - mt * 256) : 256; u.orow0 = RFL(tab[T_YBASE + 64 * c + e]) + mt * 256; u.l1 = (const int*)(wlist + (size_t)(2 * e + c) * 8192 + mt * 256); return true; }
        const int r = L - a; if (r >= (CHTOK / 256 / 8) * 4) return false;
        if (i >= 1) grab();
        const int mt = x + 8 * (r >> 2), pn = r & 3;
        u.B = (const char*)(wd + ((size_t)64 * DM + pn * 256) * EFF); u.m0 = ACT_SHARED_ROW0 + c * CHTOK + mt * 256; u.pn = pn; u.e = 64; u.nrows = 256; u.orow0 = YS_SHARED_ROW0 + mt * 256; return true;
    }
};

__device__ __forceinline__ void combine(Frame& F, int c, bool dry) {
    const LAS int* tab = (const LAS int*)(F.lds + TAB_OFF);
    const int lane = F.lane, gw = F.vcu * NWAVES + F.wave, NGW = F.G * NWAVES;
    const unsigned char* ys = wsp<unsigned char>(F, WS_YS); const unsigned* TOKSLOT = wsp<unsigned>(F, WS_TOKSLOT); const float* mod = wsp<float>(F, WS_MOD);
    for (int tl = gw; tl < CHTOK; tl += NGW) {
        const int t = c * CHTOK + tl, b = t >> 11;
        int yr[9];
#pragma unroll
        for (int k = 0; k < 8; ++k) { const unsigned s = TOKSLOT[(size_t)t * 8 + k]; yr[k] = tab[T_YBASE + 64 * c + (int)(s >> 16)] + (int)(s & 0xffffu); }
        yr[8] = YS_SHARED_ROW0 + tl;
        u32x4 w[9];
#pragma unroll
        for (int k = 0; k < 9; ++k) w[k] = __builtin_nontemporal_load((const u32x4*)(ys + (size_t)yr[k] * 1024 + 16 * lane));
        f32x4 s[4];
#pragma unroll
        for (int q = 0; q < 4; ++q) s[q] = (f32x4){0.f, 0.f, 0.f, 0.f};
#pragma unroll
        for (int k = 0; k < 9; ++k) {
#pragma unroll
            for (int q = 0; q < 4; ++q) { const auto lo = __builtin_amdgcn_cvt_pk_f32_fp8((int)w[k][q], false), hi = __builtin_amdgcn_cvt_pk_f32_fp8((int)w[k][q], true);
                s[q] += (f32x4){lo[0], lo[1], hi[0], hi[1]}; } }
#pragma unroll
        for (int q = 0; q < 4; ++q) { const int c4 = 16 * lane + 4 * q;
            const u32x2 xw = *(const u32x2*)(wsp<bf16_t>(F, WS_X1) + (size_t)t * DM + c4); const f32x4 x1 = (f32x4){bflo(xw.x), bfhi(xw.x), bflo(xw.y), bfhi(xw.y)}, g2 = *(const f32x4*)(mod + (size_t)b * 6144 + 5120 + c4);
            float* dst = dry ? (float*)(F.ws + WS_B + 253 * MiB) + (((size_t)t * DM + c4) & ((1u << 21) - 1)) : F.out + (size_t)t * DM + c4;
            *(f32x4*)dst = x1 + g2 * (s[q] * (1.0f / YS_SCALE)); }
    }
}
}
#ifndef PHMASK
#define PHMASK 0xffff
#endif
#define PH(k) ((PHMASK >> (k)) & 1)
#ifndef REPMASK
#define REPMASK 0
#endif
#ifndef XBAR
#define XBAR 0
#endif
#ifndef BARMASK
#define BARMASK 0
#endif
#define REP(k) for (int rep_ = 0; rep_ < 1 + ((REPMASK >> (k)) & 1); ++rep_)
#define MIDBAR(k) do { if (((BARMASK >> (k)) & 1) && rep_ == 0) GRID_BAR(); } while (0)

__global__ void __launch_bounds__(NTHR, 2) fwd_megakernel(Args args) {
    const Args& A = args;
    extern __shared__ __attribute__((aligned(16))) unsigned char lds_raw[];
    Frame F;
    F.lds = (LAS unsigned char*)lds_raw;
    F.MISC = (volatile LAS unsigned*)(F.lds + MISC_OFF);
    F.tid = threadIdx.x; F.lane = F.tid & 63; F.wave = __builtin_amdgcn_readfirstlane(F.tid >> 6);
    F.G = gridDim.x; { const int bx = blockIdx.x; F.vcu = (F.G % 8 == 0) ? (bx % 8) * (F.G / 8) + bx / 8 : bx; }
    F.ws = args.ws; F.ctl = (gu32*)(args.ws + WS_CTL); F.out = args.out;
    for (int u = F.tid; u < (LDS_BYTES - LDSCTL_OFF) / 4; u += NTHR) ((LAS unsigned*)(F.lds + LDSCTL_OFF))[u] = 0u;
    __syncthreads();
    XcdBarrier bar = xcd_barrier_post((unsigned*)(F.ctl + CW_BAR), F.MISC + 8);
#ifdef TSA
#define STAMP(k) do { if (blockIdx.x == TSWG && threadIdx.x == 0) { const unsigned long long t_ = __builtin_amdgcn_s_memrealtime(); ((LAS unsigned*)(F.lds + TAB_OFF + 2048))[2 * (k)] = (unsigned)t_; ((LAS unsigned*)(F.lds + TAB_OFF + 2048))[2 * (k) + 1] = (unsigned)(t_ >> 32); } } while (0)
#else
#define STAMP(k) do {} while (0)
#endif
#ifndef TSWG
#define TSWG 0
#endif
    int nbar_ = 0;
#define GRID_BAR() do { xcd_barrier(bar); F.refresh(); ++nbar_; STAMP(nbar_); } while (0)
    const int bx = (int)blockIdx.x;
    STAMP(0);

    REP(0) if (PH(0)) p0_prologue(F, args);
    for (int xb = 0; xb < XBAR; ++xb) GRID_BAR();
    GRID_BAR();
    REP(1) if (PH(1)) { p0_copies(F, args); s1_modnorm(F, args); }
#ifdef WSPROBE
    for (int q = 0; q < args.nrep; ++q) s1_modnorm(F, args);
#endif
    GRID_BAR();
    REP(2) if (PH(2)) {
        pg8::Gemm g{wsp<bf16_t>(F, WS_H), LDH / 2, DM / 2, LDW / 2}; pg8::DenseSched S; S.init(NT, INPAD, LDW / 2, wsp<bf16_t>(F, WS_WIN), F.G, bx);
        epi::EpiInProj E{wsp<bf16_t>(F, WS_NAQ), wsp<bf16_t>(F, WS_NAK), wsp<bf16_t>(F, WS_NAV), wsp<bf16_t>(F, WS_QLAT), wsp<bf16_t>(F, WS_KVLAT), wsp<bf16_t>(F, WS_SGNA), wsp<bf16_t>(F, WS_SGMLA),
                          wsp<float>(F, WS_KROT), wsp<float>(F, WS_QSQ), wsp<float>(F, WS_KVSQ), INF(I_g_na_q), INF(I_g_na_k), wsp<float>(F, WS_RCOS), wsp<float>(F, WS_RSIN)};
        pg8::gemm_phase<epi::EpiInProj, pg8::DenseSched, true, true>(F.lds, g, S, E);
        MIDBAR(2);
    }
    GRID_BAR();
    REP(3) if (PH(3)) {
        pg8::Gemm g{wsp<bf16_t>(F, WS_QLAT), QRANK, QRANK, QRANK}; pg8::DenseSched S; S.init(NT, MH * QKD, QRANK, wsp<bf16_t>(F, WS_WUQ), F.G, bx);
        epi::EpiUpQ E{wsp<bf16_t>(F, WS_QM), wsp<float>(F, WS_QSS), wsp<float>(F, WS_QSQ), INF(I_g_mla_q), wsp<float>(F, WS_RCOS), wsp<float>(F, WS_RSIN)};
        pg8::gemm_phase<epi::EpiUpQ, pg8::DenseSched, false>(F.lds, g, S, E);
    }
    REP(3) if (PH(4)) {
        pg8::Gemm g{wsp<bf16_t>(F, WS_KVLAT), KVRANK, KVRANK, KVRANK}; pg8::DenseSched S; S.init(NT, MH * 128, KVRANK, wsp<bf16_t>(F, WS_WUKV), F.G, bx);
        epi::EpiUpKV E{wsp<bf16_t>(F, WS_KM), wsp<bf16_t>(F, WS_VM), wsp<float>(F, WS_KVSQ), wsp<float>(F, WS_KROT), INF(I_g_mla_k)};
        pg8::gemm_phase<epi::EpiUpKV, pg8::DenseSched, false>(F.lds, g, S, E);
    }
    GRID_BAR();
    if (PH(5)) s4_attention(F, args, 1 + ((REPMASK >> 4) & 1), 1 + ((REPMASK >> 5) & 1));
    GRID_BAR();
    REP(6) if (PH(6)) {
        pg8::Gemm g{wsp<bf16_t>(F, WS_YNA), DM / 2, DM / 2, DM / 2}; pg8::DenseSched S; S.init(NT, 2048, DM / 2, wsp<bf16_t>(F, WS_WPCAT), F.G, bx);
        epi::EpiMergeCat E{wsp<bf16_t>(F, WS_SGNA), wsp<bf16_t>(F, WS_SGMLA), wsp<unsigned char>(F, WS_MERGED)};
        pg8::gemm_phase<epi::EpiMergeCat, pg8::DenseSched, true, true, true>(F.lds, g, S, E);
    }
    GRID_BAR();
    REP(8) if (PH(8)) {
        pg8::Gemm g{wsp<bf16_t>(F, WS_MERGED), DM / 2, DM / 2, DM / 2}; pg8::DenseSched S; S.init(NT, DM, DM / 2, wsp<bf16_t>(F, WS_WOUT), F.G, bx);
        epi::EpiOut E{INF(I_x), wsp<bf16_t>(F, WS_X1), wsp<float>(F, WS_MOD)};
        pg8::gemm_phase<epi::EpiOut, pg8::DenseSched, true, true>(F.lds, g, S, E);
    }
    GRID_BAR();
    if (PH(9)) moe::s7_router(F, args, 1 + ((REPMASK >> 9) & 1), 1 + ((REPMASK >> 13) & 1));
    GRID_BAR();
    moe::build_tables(F);
    REP(10) if (PH(10)) {
        pg8::Gemm g{wsp<bf16_t>(F, WS_H2), DM / 2, DM / 2, DM / 2}; moe::GateUpSched S; S.init(F);
        epi::EpiGateUp E{wsp<unsigned char>(F, WS_ACT)};
        pg8::gemm_phase<epi::EpiGateUp, moe::GateUpSched, true, true>(F.lds, g, S, E);
        MIDBAR(10);
    }
    GRID_BAR();
#pragma unroll 1
    for (int c = 0; c < NCHUNK; ++c) {
        for (int rep_ = 0; rep_ < 1 + (((REPMASK >> 11) | (REPMASK >> 14)) & 1); ++rep_) if (PH(11)) {
            pg8::Gemm g{wsp<bf16_t>(F, WS_ACT), EFF / 2, EFF / 2, EFF / 2}; moe::DownSched S; S.init(F, c);
            epi::EpiDown E{wsp<unsigned char>(F, WS_YS), ((REPMASK >> 14) & 1) && rep_ == 0};
            pg8::gemm_phase<epi::EpiDown, moe::DownSched, true, true>(F.lds, g, S, E);
            MIDBAR(11);
        }
        GRID_BAR();
        if ((REPMASK >> 12) & 1) moe::combine(F, c, true);
        if (PH(12)) moe::combine(F, c, false);
        if (c + 1 < NCHUNK) GRID_BAR();
    }
#ifdef TSA
    __syncthreads(); STAMP(11);
    if (blockIdx.x == TSWG && threadIdx.x == 0) { LAS unsigned* tsb = (LAS unsigned*)(F.lds + TAB_OFF + 2048);
        const unsigned long long ta = ((unsigned long long)tsb[2 * TSA + 1] << 32) | tsb[2 * TSA], tb = ((unsigned long long)tsb[2 * TSB + 1] << 32) | tsb[2 * TSB];
#ifdef TSD
        const unsigned long long dl = (((unsigned long long)tsb[2 * TSD + 1] << 32) | tsb[2 * TSD]) * TSMULT,
#else
        const unsigned long long dl = (tb - ta) * TSMULT,
#endif
        t0 = __builtin_amdgcn_s_memrealtime();
        while (__builtin_amdgcn_s_memrealtime() - t0 < dl) __builtin_amdgcn_s_sleep(8); }
#endif
}

extern "C" void kernel_launch(void* const* d_in, const int* in_sizes, int n_in, void* d_out, int out_size, void* d_ws, size_t ws_size, hipStream_t stream) {
    static int grid = 0;
    if (grid == 0) {
        if (n_in != 28 || out_size != NT * DM || ws_size < WS_END) { fprintf(stderr, "kernel_launch: unexpected shapes: n_in %d out %d ws %zu (need %zu)\n", n_in, out_size, ws_size, (size_t)WS_END); grid = -1; return; }
        int dev = 0, cus = 0, per_cu = 0;
        if (hipGetDevice(&dev) != hipSuccess || hipDeviceGetAttribute(&cus, hipDeviceAttributeMultiprocessorCount, dev) != hipSuccess) { grid = -1; return; }
        if (hipFuncSetAttribute((const void*)fwd_megakernel, hipFuncAttributeMaxDynamicSharedMemorySize, LDS_BYTES) != hipSuccess) { fprintf(stderr, "kernel_launch: hipFuncSetAttribute failed\n"); grid = -1; return; }
        if (hipOccupancyMaxActiveBlocksPerMultiprocessor(&per_cu, (const void*)fwd_megakernel, NTHR, LDS_BYTES) != hipSuccess || per_cu < 1) { fprintf(stderr, "kernel_launch: occupancy query says %d blocks/CU\n", per_cu); (void)hipGetLastError(); }
        grid = cus;
        if (grid != 256) fprintf(stderr, "kernel_launch: %d CUs (expected 256)\n", grid);
    }
    if (grid < 0) return;
    if (hipMemsetAsync((char*)d_ws + WS_CTL, 0, CTL_ZERO_BYTES, stream) != hipSuccess) { fprintf(stderr, "kernel_launch: memset failed\n"); return; }
    Args a{};
    for (int i = 0; i < 28; ++i) a.in[i] = d_in[i];
    a.out = (float*)d_out; a.ws = (unsigned char*)d_ws;
#ifdef WSPROBE
    a.nrep = (int)(ws_size >> 26); a.pad = 0;
#endif
    void* kargs[] = {&a};
    const hipError_t le = hipLaunchCooperativeKernel((const void*)fwd_megakernel, dim3(grid), dim3(NTHR), kargs, LDS_BYTES, stream);
    if (le != hipSuccess) fprintf(stderr, "kernel_launch: cooperative launch failed: %s (grid %d)\n", hipGetErrorName(le), grid);
}
```
